# Optimizing an MI355X kernel written in HIP

```python
import math
import jax, jax.numpy as jnp
from jax import lax
import numpy as np

D_MODEL = 1024
BATCH = 8
SEQ = 4096
DEPTH = 1

N_META = 16
CHUNK = 128
ROPE_BASE = 10000.0
EPS = 1e-6
MLA_HEADS = 8
MLA_Q_LORA = 384
MLA_KV_LORA = 256
MLA_NOPE = 64
MLA_ROPE = 32
MLA_V = 64
MLA_QK = MLA_NOPE + MLA_ROPE
RET_HEADS = 8
RET_DK = 64
RET_DV = 128
PEER_HEADS = 8
PEER_NKEYS = 128
PEER_EXPERTS = PEER_NKEYS * PEER_NKEYS
PEER_DQ = 128
PEER_TOPK = 16
PEER_BLOCK = 256
IN_SIZES = (MLA_Q_LORA, MLA_KV_LORA, MLA_ROPE, RET_HEADS * RET_DK, RET_HEADS * RET_DK,
            RET_HEADS * RET_DV, RET_HEADS * RET_DV, D_MODEL, D_MODEL)
IN_WIDTH = sum(IN_SIZES)

kernel_name = "hybrid_mla_retention_peer_meta"


def rmsnorm(x, g):
    xf = x.astype(jnp.float32)
    y = xf * lax.rsqrt(jnp.mean(xf * xf, axis=-1, keepdims=True) + EPS)
    return (y * g.astype(jnp.float32)).astype(x.dtype)


def rope(x, pos):
    half = x.shape[-1] // 2
    inv = ROPE_BASE ** (-jnp.arange(half, dtype=jnp.float32) / half)
    ang = pos.astype(jnp.float32)[:, None] * inv[None, :]
    cos, sin = jnp.cos(ang), jnp.sin(ang)
    xf = x.astype(jnp.float32)
    x1, x2 = xf[..., :half], xf[..., half:]
    return jnp.concatenate([x1 * cos - x2 * sin, x1 * sin + x2 * cos], -1).astype(x.dtype)


def causal_block_attention(q, k, v):
    B, H, L, dqk = q.shape
    dv = v.shape[-1]
    nblk = -(-L // CHUNK)
    Lp = nblk * CHUNK
    qp = jnp.pad(q, ((0, 0), (0, 0), (0, Lp - L), (0, 0)))
    kpos = jnp.arange(L)
    scale = 1.0 / math.sqrt(dqk)

    def one_block(i):
        qb = lax.dynamic_slice_in_dim(qp, i * CHUNK, CHUNK, axis=2)
        s = jnp.einsum('bhqd,bhkd->bhqk', qb, k).astype(jnp.float32) * scale
        qpos = i * CHUNK + jnp.arange(CHUNK)
        s = jnp.where(kpos[None, :] <= qpos[:, None], s, -jnp.inf)
        p = jax.nn.softmax(s, axis=-1)
        return jnp.einsum('bhqk,bhkd->bhqd', p.astype(v.dtype), v)

    out = lax.map(one_block, jnp.arange(nblk))
    out = out.transpose(1, 2, 0, 3, 4).reshape(B, H, Lp, dv)
    return out[:, :, :L]


def mla_branch(c_q, c_kv, k_pe, pos, g_q_lora, w_uq, g_kv_lora, w_ukv, g_qk_q, g_qk_k):
    B, L, _ = c_q.shape
    q = (rmsnorm(c_q, g_q_lora) @ w_uq).reshape(B, L, MLA_HEADS, MLA_QK)
    kv = (rmsnorm(c_kv, g_kv_lora) @ w_ukv).reshape(B, L, MLA_HEADS, MLA_NOPE + MLA_V)
    k_nope, v = kv[..., :MLA_NOPE], kv[..., MLA_NOPE:]
    k = jnp.concatenate([k_nope, jnp.broadcast_to(k_pe[:, :, None, :], (B, L, MLA_HEADS, MLA_ROPE))], -1)
    q = rmsnorm(q, g_qk_q).transpose(0, 2, 1, 3)
    k = rmsnorm(k, g_qk_k).transpose(0, 2, 1, 3)
    q = jnp.concatenate([q[..., :MLA_NOPE], rope(q[..., MLA_NOPE:], pos)], -1)
    k = jnp.concatenate([k[..., :MLA_NOPE], rope(k[..., MLA_NOPE:], pos)], -1)
    o = causal_block_attention(q, k, v.transpose(0, 2, 1, 3))
    return o.transpose(0, 2, 1, 3).reshape(B, L, MLA_HEADS * MLA_V)


def retention_branch(q, k, v, gate, pos, g_gn):
    B, L, _ = q.shape
    H, C = RET_HEADS, CHUNK
    q = rope(q.reshape(B, L, H, RET_DK).transpose(0, 2, 1, 3), pos)
    k = rope(k.reshape(B, L, H, RET_DK).transpose(0, 2, 1, 3), pos) * (RET_DK ** -0.5)
    v = v.reshape(B, L, H, RET_DV).transpose(0, 2, 1, 3)
    P = (-N_META) % C
    Lp = L + P
    NC = Lp // C
    padf = lambda t: jnp.pad(t, ((0, 0), (0, 0), (P, 0), (0, 0))).reshape(B, H, NC, C, t.shape[-1])
    qc, kc, vc = padf(q), padf(k), padf(v)

    log_gamma = jnp.log(1.0 - 2.0 ** (-5.0 - jnp.arange(H, dtype=jnp.float32)))
    idx = jnp.arange(C, dtype=jnp.float32)
    diff = idx[:, None] - idx[None, :]
    decay = jnp.where(diff[None] >= 0, jnp.exp(jnp.maximum(diff, 0.0)[None] * log_gamma[:, None, None]), 0.0)
    zeta = jnp.exp((C - 1 - idx)[None, :] * log_gamma[:, None])
    xi = jnp.exp((idx + 1)[None, :] * log_gamma[:, None])
    gamma_c = jnp.exp(C * log_gamma)

    scores = jnp.einsum('bhncd,bhnmd->bhncm', qc, kc) * decay[None, :, None]
    inner = jnp.einsum('bhncm,bhnme->bhnce', scores, vc)
    chunk_kv = jnp.einsum('bhnmd,bhnme->bhnde', kc * zeta[None, :, None, :, None], vc)

    def step(state, kv_n):
        return gamma_c[None, :, None, None] * state + kv_n, state

    init = jnp.zeros((B, H, RET_DK, RET_DV), chunk_kv.dtype)
    _, prev_states = lax.scan(step, init, jnp.moveaxis(chunk_kv, 2, 0))
    prev_states = jnp.moveaxis(prev_states, 0, 2)
    cross = jnp.einsum('bhncd,bhnde->bhnce', qc, prev_states) * xi[None, :, None, :, None]
    y = (inner + cross).reshape(B, H, Lp, RET_DV)[:, :, P:]

    yf = y.astype(jnp.float32)
    mu = jnp.mean(yf, -1, keepdims=True)
    var = jnp.mean((yf - mu) ** 2, -1, keepdims=True)
    yn = ((yf - mu) * lax.rsqrt(var + EPS)).transpose(0, 2, 1, 3).reshape(B, L, H * RET_DV)
    yn = (yn * g_gn.astype(jnp.float32)).astype(gate.dtype)
    return jax.nn.silu(gate) * yn


def mixer_sublayer(h, pos, g_mix, w_in, g_q_lora, w_uq, g_kv_lora, w_ukv, g_qk_q, g_qk_k,
                   w_mla_out, g_ret_gn, w_ret_out, w_mix_out):
    hn = rmsnorm(h, g_mix)
    z = hn @ w_in
    c_q, c_kv, k_pe, r_q, r_k, r_v, r_g, za, zr = jnp.split(z, np.cumsum(IN_SIZES)[:-1].tolist(), axis=-1)
    y_a = mla_branch(c_q, c_kv, k_pe, pos, g_q_lora, w_uq, g_kv_lora, w_ukv, g_qk_q, g_qk_k) @ w_mla_out
    y_r = retention_branch(r_q, r_k, r_v, r_g, pos, g_ret_gn) @ w_ret_out
    merged = jax.nn.sigmoid(za) * y_a + jax.nn.sigmoid(zr) * y_r
    return merged @ w_mix_out


def peer_sublayer(h, g_ffn, w_peer_q, keys_1, keys_2, peer_u, peer_v):
    shape = h.shape
    x = rmsnorm(h, g_ffn).reshape(-1, shape[-1])
    T = x.shape[0]
    q = (x @ w_peer_q).reshape(T, PEER_HEADS, PEER_DQ)
    half = PEER_DQ // 2
    s1 = jnp.einsum('thd,kd->thk', q[..., :half], keys_1).astype(jnp.float32)
    s2 = jnp.einsum('thd,kd->thk', q[..., half:], keys_2).astype(jnp.float32)
    v1, i1 = lax.top_k(s1, PEER_TOPK)
    v2, i2 = lax.top_k(s2, PEER_TOPK)
    cand = (v1[..., :, None] + v2[..., None, :]).reshape(T, PEER_HEADS, PEER_TOPK * PEER_TOPK)
    sc, ci = lax.top_k(cand, PEER_TOPK)
    e1 = jnp.take_along_axis(i1, ci // PEER_TOPK, axis=-1)
    e2 = jnp.take_along_axis(i2, ci % PEER_TOPK, axis=-1)
    eidx = (e1 * PEER_NKEYS + e2).reshape(T, PEER_HEADS * PEER_TOPK)
    gates = jax.nn.softmax(sc, axis=-1).reshape(T, PEER_HEADS * PEER_TOPK).astype(x.dtype)

    pad = (-T) % PEER_BLOCK
    nb = (T + pad) // PEER_BLOCK
    xb = jnp.pad(x, ((0, pad), (0, 0))).reshape(nb, PEER_BLOCK, -1)
    ib = jnp.pad(eidx, ((0, pad), (0, 0))).reshape(nb, PEER_BLOCK, -1)
    gb = jnp.pad(gates, ((0, pad), (0, 0))).reshape(nb, PEER_BLOCK, -1)

    def block(args):
        xt, it, gt = args
        act = jax.nn.gelu(jnp.einsum('td,tkd->tk', xt, peer_u[it]), approximate=False)
        return jnp.einsum('tk,tkd->td', gt * act, peer_v[it])

    y = lax.map(block, (xb, ib, gb)).reshape(nb * PEER_BLOCK, -1)[:T]
    return y.reshape(shape)


def setup_inputs(seed: int = 0) -> dict:
    key = jax.random.key(seed)
    ks = jax.random.split(key, 20)
    f32 = jnp.float32
    nrm = lambda k, s, sc: jax.random.normal(k, s, f32) * sc
    gain = lambda k, s: 1.0 + 0.02 * jax.random.normal(k, s, f32)
    return {
        "x": nrm(ks[0], (BATCH, SEQ, D_MODEL), 1.0),
        "meta_tokens": nrm(ks[1], (N_META, D_MODEL), 1.0),
        "g_mix": gain(ks[2], (DEPTH, D_MODEL)),
        "w_in": nrm(ks[3], (DEPTH, D_MODEL, IN_WIDTH), D_MODEL ** -0.5),
        "g_q_lora": gain(ks[4], (DEPTH, MLA_Q_LORA)),
        "w_uq": nrm(ks[5], (DEPTH, MLA_Q_LORA, MLA_HEADS * MLA_QK), MLA_Q_LORA ** -0.5),
        "g_kv_lora": gain(ks[6], (DEPTH, MLA_KV_LORA)),
        "w_ukv": nrm(ks[7], (DEPTH, MLA_KV_LORA, MLA_HEADS * (MLA_NOPE + MLA_V)), MLA_KV_LORA ** -0.5),
        "g_qk_q": gain(ks[8], (DEPTH, MLA_QK)),
        "g_qk_k": gain(ks[9], (DEPTH, MLA_QK)),
        "w_mla_out": nrm(ks[10], (DEPTH, MLA_HEADS * MLA_V, D_MODEL), (MLA_HEADS * MLA_V) ** -0.5),
        "g_ret_gn": gain(ks[11], (DEPTH, RET_HEADS * RET_DV)),
        "w_ret_out": nrm(ks[12], (DEPTH, RET_HEADS * RET_DV, D_MODEL), (RET_HEADS * RET_DV) ** -0.5),
        "w_mix_out": nrm(ks[13], (DEPTH, D_MODEL, D_MODEL), D_MODEL ** -0.5),
        "g_ffn": gain(ks[14], (DEPTH, D_MODEL)),
        "w_peer_q": nrm(ks[15], (DEPTH, D_MODEL, PEER_HEADS * PEER_DQ), D_MODEL ** -0.5),
        "peer_keys_1": nrm(ks[16], (DEPTH, PEER_NKEYS, PEER_DQ // 2), (PEER_DQ // 2) ** -0.5),
        "peer_keys_2": nrm(ks[17], (DEPTH, PEER_NKEYS, PEER_DQ // 2), (PEER_DQ // 2) ** -0.5),
        "peer_u": nrm(ks[18], (DEPTH, PEER_EXPERTS, D_MODEL), D_MODEL ** -0.5),
        "peer_v": nrm(ks[19], (DEPTH, PEER_EXPERTS, D_MODEL), PEER_HEADS ** -0.5),
    }


def reference(x, meta_tokens, g_mix, w_in, g_q_lora, w_uq, g_kv_lora, w_ukv, g_qk_q, g_qk_k,
              w_mla_out, g_ret_gn, w_ret_out, w_mix_out, g_ffn, w_peer_q, peer_keys_1,
              peer_keys_2, peer_u, peer_v):
    B = x.shape[0]
    meta = jnp.broadcast_to(meta_tokens.astype(x.dtype)[None], (B, N_META, x.shape[-1]))
    h = jnp.concatenate([meta, x], axis=1)
    pos = jnp.arange(h.shape[1])
    for layer in range(DEPTH):
        h = h + mixer_sublayer(h, pos, g_mix[layer], w_in[layer], g_q_lora[layer], w_uq[layer],
                               g_kv_lora[layer], w_ukv[layer], g_qk_q[layer], g_qk_k[layer],
                               w_mla_out[layer], g_ret_gn[layer], w_ret_out[layer], w_mix_out[layer])
        if layer == DEPTH - 1:
            h = h[:, N_META:]
        h = h + peer_sublayer(h, g_ffn[layer], w_peer_q[layer], peer_keys_1[layer], peer_keys_2[layer],
                              peer_u[layer], peer_v[layer])
    return h
```

```cpp
#include <hip/hip_runtime.h>
#include <stdint.h>
#include <math.h>

typedef unsigned short bf16_t;
typedef float f32x4 __attribute__((ext_vector_type(4)));
typedef unsigned u32x4 __attribute__((ext_vector_type(4)));

constexpr int D = 1024, BATCH = 8, SEQ = 4096, NMETA = 16;
constexpr int T = BATCH * SEQ;
constexpr int MP = 33024;
constexpr float EPS = 1e-6f;
constexpr int NIN = 5888;
constexpr int C_LAT = 0, C_RQ = 768, C_RK = 1280, C_RV = 1792, C_RG = 2816, C_SA = 3840, C_SR = 4864;
constexpr float QSCALE = 1.4426950408889634f * 0.10206207261596575f;

constexpr size_t al(size_t x) { return (x + 255) & ~(size_t)255; }
constexpr size_t WS_CTL = 0;
constexpr size_t WS_WIN = 1u << 20;
constexpr size_t WS_WUQ = WS_WIN + al((size_t)NIN * 1024 * 2);
constexpr size_t WS_WUKV = WS_WUQ + al((size_t)768 * 384 * 2);
constexpr size_t WS_WMLA = WS_WUKV + al((size_t)1024 * 256 * 2);
constexpr size_t WS_WRET = WS_WMLA + al((size_t)1024 * 512 * 2);
constexpr size_t WS_WMIX = WS_WRET + al((size_t)1024 * 1024 * 2);
constexpr size_t WS_WPQ = WS_WMIX + al((size_t)1024 * 1024 * 2);
constexpr size_t WS_KEYS = WS_WPQ + al((size_t)1024 * 1024 * 2);
constexpr size_t WS_ROPE32 = WS_KEYS + al((size_t)2 * 128 * 64 * 2);
constexpr size_t WS_ROPE16 = WS_ROPE32 + al((size_t)4112 * 32 * 8);
constexpr size_t WS_RINV2 = WS_ROPE16 + al((size_t)4112 * 16 * 8);
constexpr size_t WS_XB = WS_RINV2 + al((size_t)T * 4);
constexpr size_t WS_LAT = WS_XB + al((size_t)MP * 1024 * 2);
constexpr size_t WS_RQ = WS_LAT + al((size_t)MP * 768 * 2);
constexpr size_t WS_RK = WS_RQ + al((size_t)MP * 512 * 2);
constexpr size_t WS_RV = WS_RK + al((size_t)MP * 512 * 2);
constexpr size_t WS_RG = WS_RV + al((size_t)MP * 1024 * 2);
constexpr size_t WS_K = WS_RG + al((size_t)T * 1024 * 2);
constexpr size_t WS_V = WS_K + al((size_t)MP * 768 * 2);
constexpr size_t WS_RET = WS_V + al((size_t)MP * 512 * 2);
constexpr size_t WS_END = WS_RET + al((size_t)T * 1024 * 2);
static_assert(WS_END <= 536870912ull, "workspace map exceeds 512 MiB");
constexpr size_t WS_Q = WS_XB, WS_MG = WS_XB, WS_AO = WS_LAT, WS_H1B = WS_RV, WS_PQ = WS_RG, WS_SELI = WS_K, WS_SELG = WS_K + (size_t)T * 128 * 4;
static_assert(WS_SELG + (size_t)T * 128 * 4 <= WS_RET, "SEL overlay");

__device__ __forceinline__ unsigned f2bf(float f) { unsigned u = __builtin_bit_cast(unsigned, f); return (u + 0x7fffu + ((u >> 16) & 1u)) >> 16; }
__device__ __forceinline__ float bf2f(unsigned h) { return __builtin_bit_cast(float, h << 16); }
__device__ __forceinline__ unsigned pk2(float lo, float hi) { return f2bf(lo) | (f2bf(hi) << 16); }
__device__ __forceinline__ float wave_sum(float v) {
#pragma unroll
    for (int o = 1; o < 64; o <<= 1) v += __shfl_xor(v, o);
    return v;
}
__device__ __forceinline__ int row_pos(int row) { return row < T ? NMETA + (row & (SEQ - 1)) : (row - T < NMETA ? row - T : 0); }
__device__ __forceinline__ float sigmoidf_(float x) { return 1.f / (1.f + __expf(-x)); }

struct Ptrs {
    const float* in[20];
    float* out;
    unsigned char* ws;
};

__global__ void __launch_bounds__(256) k_prep_rows(Ptrs p) {
    const int lane = threadIdx.x & 63, gw = (blockIdx.x * 256 + threadIdx.x) >> 6, nw = (gridDim.x * 256) >> 6;
    bf16_t* XB = (bf16_t*)(p.ws + WS_XB);
    for (int r = gw; r < MP; r += nw) {
        f32x4 v[4];
        if (r < T + NMETA) {
            const float* src = r < T ? p.in[0] + (size_t)r * D : p.in[1] + (size_t)(r - T) * D;
#pragma unroll
            for (int j = 0; j < 4; ++j) v[j] = *(const f32x4*)(src + lane * 4 + 256 * j);
        } else {
#pragma unroll
            for (int j = 0; j < 4; ++j) v[j] = (f32x4){0.f, 0.f, 0.f, 0.f};
        }
        float ss = 0.f;
#pragma unroll
        for (int j = 0; j < 4; ++j) ss += v[j].x * v[j].x + v[j].y * v[j].y + v[j].z * v[j].z + v[j].w * v[j].w;
        ss = wave_sum(ss);
        const float rinv = rsqrtf(ss * (1.f / D) + EPS);
#pragma unroll
        for (int j = 0; j < 4; ++j) {
            uint2 o; o.x = pk2(v[j].x * rinv, v[j].y * rinv); o.y = pk2(v[j].z * rinv, v[j].w * rinv);
            *(uint2*)(XB + (size_t)r * D + lane * 4 + 256 * j) = o;
        }
    }
}

__device__ __forceinline__ int win_src(int n) {
    if (n < 672) return n;
    if (n < 768) return -1;
    if (n < C_RV) { const int base = n < C_RK ? 672 : 1184, q = (n - (n < C_RK ? C_RQ : C_RK)), hh = q >> 6, pp = q & 63; return base + hh * 64 + (pp >> 1) + 32 * (pp & 1); }
    if (n < C_RG) return 1696 + (n - C_RV);
    if (n < C_SA) return 2720 + (n - C_RG);
    if (n < C_SR) return 3744 + (n - C_SA);
    return 4768 + (n - C_SR);
}
template <int MODE>
__global__ void __launch_bounds__(256) k_prep_w(const float* __restrict__ W, const float* __restrict__ gain, bf16_t* __restrict__ Wt, int K, int Nsrc, int Ndst) {
    __shared__ float tile[64][65];
    const int n0 = blockIdx.x * 64, k0 = blockIdx.y * 64, tx = threadIdx.x & 63, ty = threadIdx.x >> 6;
    const int n = n0 + tx; const int src = MODE == 1 ? win_src(n) : n;
    for (int kk = ty; kk < 64; kk += 4) {
        float v = 0.f;
        if (src >= 0 && n < Ndst) { v = W[(size_t)(k0 + kk) * Nsrc + src]; if (gain) v *= gain[k0 + kk]; }
        tile[kk][tx] = v;
    }
    __syncthreads();
    for (int nn = ty; nn < 64; nn += 4) if (n0 + nn < Ndst) Wt[(size_t)(n0 + nn) * K + k0 + tx] = (bf16_t)f2bf(tile[tx][nn]);
}
__global__ void k_prep_rope(Ptrs p) {
    const int i = blockIdx.x * blockDim.x + threadIdx.x;
    float2* R32 = (float2*)(p.ws + WS_ROPE32); float2* R16 = (float2*)(p.ws + WS_ROPE16);
    if (i < 4112 * 32) { const int pos = i >> 5, f = i & 31; const float inv = (float)pow(10000.0, -(double)f / 32.0); const float ang = (float)pos * inv; R32[i] = make_float2((float)cos((double)ang), (float)sin((double)ang)); }
    if (i < 4112 * 16) { const int pos = i >> 4, f = i & 15; const float inv = (float)pow(10000.0, -(double)f / 16.0); const float ang = (float)pos * inv; R16[i] = make_float2((float)cos((double)ang), (float)sin((double)ang)); }
}

__device__ __forceinline__ void st8(bf16_t* dst, const float (&v)[8]) {
    u32x4 w; w.x = pk2(v[0], v[1]); w.y = pk2(v[2], v[3]); w.z = pk2(v[4], v[5]); w.w = pk2(v[6], v[7]); *(u32x4*)dst = w;
}
struct EpiIn {
    bf16_t *LAT, *RQ, *RK, *RV, *RG, *SA, *SR; const float2* R32;
    __device__ __forceinline__ void apply(int row, int col0, const float (&v)[8]) const {
        if (col0 < C_RQ) { st8(LAT + (size_t)row * 768 + col0, v); return; }
        if (col0 < C_RV) {
            const bool isq = col0 < C_RK; const int c = col0 - (isq ? C_RQ : C_RK); const int i0 = (c & 63) >> 1;
            const float2* rp = R32 + row_pos(row) * 32 + i0; const float sc = isq ? 1.f : 0.125f;
            float o[8];
#pragma unroll
            for (int j = 0; j < 4; ++j) { const float2 cs = rp[j]; const float x1 = v[2 * j], x2 = v[2 * j + 1]; o[2 * j] = (x1 * cs.x - x2 * cs.y) * sc; o[2 * j + 1] = (x1 * cs.y + x2 * cs.x) * sc; }
            st8((isq ? RQ : RK) + (size_t)row * 512 + c, o); return;
        }
        if (col0 < C_RG) { st8(RV + (size_t)row * 1024 + (col0 - C_RV), v); return; }
        if (row >= T) return;
        float o[8];
        if (col0 < C_SA) {
#pragma unroll
            for (int j = 0; j < 8; ++j) o[j] = v[j] * sigmoidf_(v[j]);
            st8(RG + (size_t)row * 1024 + (col0 - C_RG), o); return;
        }
#pragma unroll
        for (int j = 0; j < 8; ++j) o[j] = sigmoidf_(v[j]);
        if (col0 < C_SR) st8(SA + (size_t)row * 1024 + (col0 - C_SA), o); else st8(SR + (size_t)row * 1024 + (col0 - C_SR), o);
    }
};
struct EpiQraw { bf16_t* Q; __device__ __forceinline__ void apply(int row, int col0, const float (&v)[8]) const { st8(Q + (size_t)row * 768 + col0, v); } };
struct EpiKVraw {
    bf16_t *K, *V;
    __device__ __forceinline__ void apply(int row, int col0, const float (&v)[8]) const {
        const int h = col0 >> 7, j = col0 & 127;
        if (j < 64) st8(K + (size_t)row * 768 + h * 96 + j, v); else st8(V + (size_t)row * 512 + h * 64 + (j - 64), v);
    }
};
__device__ __forceinline__ void ld8(const bf16_t* src, float (&o)[8]) {
    const u32x4 w = *(const u32x4*)src;
    o[0] = bf2f(w.x & 0xffff); o[1] = bf2f(w.x >> 16); o[2] = bf2f(w.y & 0xffff); o[3] = bf2f(w.y >> 16);
    o[4] = bf2f(w.z & 0xffff); o[5] = bf2f(w.z >> 16); o[6] = bf2f(w.w & 0xffff); o[7] = bf2f(w.w >> 16);
}
struct EpiMerge1 { bf16_t* MG; const bf16_t* SA;
    __device__ __forceinline__ void apply(int row, int col0, const float (&v)[8]) const {
        float g[8], o[8]; ld8(SA + (size_t)row * 1024 + col0, g);
#pragma unroll
        for (int j = 0; j < 8; ++j) o[j] = g[j] * v[j];
        st8(MG + (size_t)row * 1024 + col0, o); } };
struct EpiMerge2 { bf16_t* MG; const bf16_t* SR;
    __device__ __forceinline__ void apply(int row, int col0, const float (&v)[8]) const {
        float g[8], m[8], o[8]; ld8(SR + (size_t)row * 1024 + col0, g); ld8(MG + (size_t)row * 1024 + col0, m);
#pragma unroll
        for (int j = 0; j < 8; ++j) o[j] = m[j] + g[j] * v[j];
        st8(MG + (size_t)row * 1024 + col0, o); } };
struct EpiMix { const float* x; float* out; bf16_t* H1B;
    __device__ __forceinline__ void apply(int row, int col0, const float (&v)[8]) const {
        const f32x4 a = *(const f32x4*)(x + (size_t)row * D + col0), b = *(const f32x4*)(x + (size_t)row * D + col0 + 4);
        float o[8] = {a.x + v[0], a.y + v[1], a.z + v[2], a.w + v[3], b.x + v[4], b.y + v[5], b.z + v[6], b.w + v[7]};
        *(f32x4*)(out + (size_t)row * D + col0) = (f32x4){o[0], o[1], o[2], o[3]}; *(f32x4*)(out + (size_t)row * D + col0 + 4) = (f32x4){o[4], o[5], o[6], o[7]};
        st8(H1B + (size_t)row * D + col0, o); } };
struct EpiPQ { bf16_t* PQ; const float* RINV2;
    __device__ __forceinline__ void apply(int row, int col0, const float (&v)[8]) const {
        const float r = RINV2[row]; float o[8];
#pragma unroll
        for (int j = 0; j < 8; ++j) o[j] = v[j] * r;
        st8(PQ + (size_t)row * D + col0, o); } };

template <class Epi>
__global__ void __launch_bounds__(256) gemm_ref(const bf16_t* __restrict__ A, int lda, const bf16_t* __restrict__ Bt, int ldb, int K, Epi E) {
    __shared__ float As[32][64 + 4];
    __shared__ float Bs[32][128 + 4];
    const int tid = threadIdx.x, tx = tid & 15, ty = tid >> 4;
    const int m0 = blockIdx.y * 64, n0 = blockIdx.x * 128;
    float acc[4][8];
#pragma unroll
    for (int i = 0; i < 4; ++i)
#pragma unroll
        for (int j = 0; j < 8; ++j) acc[i][j] = 0.f;
    for (int k0 = 0; k0 < K; k0 += 32) {
        { const int m = tid & 63, kc = tid >> 6; float t[8]; ld8(A + (size_t)(m0 + m) * lda + k0 + kc * 8, t);
#pragma unroll
          for (int j = 0; j < 8; ++j) As[kc * 8 + j][m] = t[j]; }
#pragma unroll
        for (int i = 0; i < 2; ++i) { const int n = tid & 127, kc = (tid >> 7) + 2 * i; float t[8]; ld8(Bt + (size_t)(n0 + n) * ldb + k0 + kc * 8, t);
#pragma unroll
          for (int j = 0; j < 8; ++j) Bs[kc * 8 + j][n] = t[j]; }
        __syncthreads();
#pragma unroll 8
        for (int kk = 0; kk < 32; ++kk) {
            const f32x4 a = *(const f32x4*)&As[kk][ty * 4]; const f32x4 b0 = *(const f32x4*)&Bs[kk][tx * 8], b1 = *(const f32x4*)&Bs[kk][tx * 8 + 4];
            const float av[4] = {a.x, a.y, a.z, a.w}, bv[8] = {b0.x, b0.y, b0.z, b0.w, b1.x, b1.y, b1.z, b1.w};
#pragma unroll
            for (int i = 0; i < 4; ++i)
#pragma unroll
                for (int j = 0; j < 8; ++j) acc[i][j] += av[i] * bv[j];
        }
        __syncthreads();
    }
#pragma unroll
    for (int i = 0; i < 4; ++i) E.apply(m0 + ty * 4 + i, n0 + tx * 8, acc[i]);
}

__global__ void __launch_bounds__(256) k_finalize(Ptrs p) {
    const int lane = threadIdx.x & 63, gw = (blockIdx.x * 256 + threadIdx.x) >> 6, nw = (gridDim.x * 256) >> 6;
    const bf16_t* LAT = (const bf16_t*)(p.ws + WS_LAT);
    bf16_t* Q = (bf16_t*)(p.ws + WS_Q); bf16_t* K = (bf16_t*)(p.ws + WS_K); bf16_t* V = (bf16_t*)(p.ws + WS_V);
    const float2* R16 = (const float2*)(p.ws + WS_ROPE16);
    const float* gq = p.in[8]; const float* gk = p.in[9];
    const int l = lane & 31, hh = lane >> 5;
    for (int r = gw; r < MP; r += nw) {
        const bf16_t* lr = LAT + (size_t)r * 768;
        float sa = 0.f, sb = 0.f;
#pragma unroll
        for (int j = 0; j < 6; ++j) { const float c = bf2f(lr[lane + 64 * j]); sa += c * c; }
#pragma unroll
        for (int j = 0; j < 4; ++j) { const float c = bf2f(lr[384 + lane + 64 * j]); sb += c * c; }
        sa = wave_sum(sa); sb = wave_sum(sb);
        const float alpha = rsqrtf(sa * (1.f / 384.f) + EPS), beta = rsqrtf(sb * (1.f / 256.f) + EPS);
        const float kpe = bf2f(lr[640 + l]);
        const float2 cs = R16[row_pos(r) * 16 + (l & 15)];
        for (int it = 0; it < 4; ++it) {
            const int h = it * 2 + hh;
            if (r < T) {
                bf16_t* qp = Q + (size_t)r * 768 + h * 96;
                float q0 = bf2f(qp[l]) * alpha, q1 = bf2f(qp[32 + l]) * alpha, q2 = bf2f(qp[64 + l]) * alpha;
                float ss = q0 * q0 + q1 * q1 + q2 * q2;
#pragma unroll
                for (int o = 1; o < 32; o <<= 1) ss += __shfl_xor(ss, o);
                const float rq = rsqrtf(ss * (1.f / 96.f) + EPS);
                q0 *= rq * gq[l]; q1 *= rq * gq[32 + l]; q2 *= rq * gq[64 + l];
                const float pr = __shfl_xor(q2, 16);
                const float q2r = (l < 16) ? (q2 * cs.x - pr * cs.y) : (pr * cs.y + q2 * cs.x);
                qp[l] = (bf16_t)f2bf(q0 * QSCALE); qp[32 + l] = (bf16_t)f2bf(q1 * QSCALE); qp[64 + l] = (bf16_t)f2bf(q2r * QSCALE);
            }
            {
                bf16_t* kp = K + (size_t)r * 768 + h * 96;
                float k0 = bf2f(kp[l]) * beta, k1 = bf2f(kp[32 + l]) * beta, k2 = kpe;
                float ss = k0 * k0 + k1 * k1 + k2 * k2;
#pragma unroll
                for (int o = 1; o < 32; o <<= 1) ss += __shfl_xor(ss, o);
                const float rk = rsqrtf(ss * (1.f / 96.f) + EPS);
                k0 *= rk * gk[l]; k1 *= rk * gk[32 + l]; k2 *= rk * gk[64 + l];
                const float pr = __shfl_xor(k2, 16);
                const float k2r = (l < 16) ? (k2 * cs.x - pr * cs.y) : (pr * cs.y + k2 * cs.x);
                kp[l] = (bf16_t)f2bf(k0); kp[32 + l] = (bf16_t)f2bf(k1); kp[64 + l] = (bf16_t)f2bf(k2r);
                bf16_t* vp = V + (size_t)r * 512 + h * 64;
                vp[l] = (bf16_t)f2bf(bf2f(vp[l]) * beta); vp[32 + l] = (bf16_t)f2bf(bf2f(vp[32 + l]) * beta);
            }
        }
    }
}

__global__ void __launch_bounds__(64) k_attn_naive(Ptrs p) {
    const bf16_t* Q = (const bf16_t*)(p.ws + WS_Q); const bf16_t* K = (const bf16_t*)(p.ws + WS_K); const bf16_t* V = (const bf16_t*)(p.ws + WS_V);
    bf16_t* AO = (bf16_t*)(p.ws + WS_AO);
    const int s = blockIdx.x * 64 + threadIdx.x, h = blockIdx.y, b = blockIdx.z;
    const int row = b * SEQ + s;
    float q[96], o[64];
#pragma unroll
    for (int d = 0; d < 96; d += 8) { float t[8]; ld8(Q + (size_t)row * 768 + h * 96 + d, t);
#pragma unroll
        for (int j = 0; j < 8; ++j) q[d + j] = t[j]; }
#pragma unroll
    for (int d = 0; d < 64; ++d) o[d] = 0.f;
    float m = -INFINITY, l = 0.f;
    const int smax = blockIdx.x * 64 + 63;
    for (int j = 0; j < NMETA + smax + 1; ++j) {
        const int krow = j < NMETA ? T + j : b * SEQ + (j - NMETA);
        const bf16_t* kp = K + (size_t)krow * 768 + h * 96; const bf16_t* vp = V + (size_t)krow * 512 + h * 64;
        float sc = 0.f;
#pragma unroll
        for (int d = 0; d < 96; d += 8) { float t[8]; ld8(kp + d, t);
#pragma unroll
            for (int jj = 0; jj < 8; ++jj) sc += q[d + jj] * t[jj]; }
        const bool valid = (j < NMETA) || (j - NMETA <= s);
        if (valid) {
            const float mn = fmaxf(m, sc); const float a = exp2f(m - mn), pp = exp2f(sc - mn);
            l = l * a + pp; m = mn;
#pragma unroll
            for (int d = 0; d < 64; d += 8) { float t[8]; ld8(vp + d, t);
#pragma unroll
                for (int jj = 0; jj < 8; ++jj) o[d + jj] = o[d + jj] * a + pp * t[jj]; }
        }
    }
    const float il = 1.f / l;
#pragma unroll
    for (int d = 0; d < 64; d += 8) { float t[8];
#pragma unroll
        for (int jj = 0; jj < 8; ++jj) t[jj] = o[d + jj] * il;
        st8(AO + (size_t)row * 512 + h * 64 + d, t); }
}

__global__ void __launch_bounds__(128) k_ret_naive(Ptrs p) {
    const bf16_t* RQ = (const bf16_t*)(p.ws + WS_RQ); const bf16_t* RK = (const bf16_t*)(p.ws + WS_RK); const bf16_t* RV = (const bf16_t*)(p.ws + WS_RV);
    const bf16_t* RG = (const bf16_t*)(p.ws + WS_RG); bf16_t* RET = (bf16_t*)(p.ws + WS_RET);
    const float* ggn = p.in[11];
    __shared__ float red[2][4];
    const int e = threadIdx.x, h = blockIdx.x & 7, b = blockIdx.x >> 3;
    const float gamma = 1.f - exp2f(-5.f - (float)h);
    float S[64];
#pragma unroll
    for (int d = 0; d < 64; ++d) S[d] = 0.f;
    const float gg = ggn[h * 128 + e];
    for (int t = 0; t < NMETA + SEQ; ++t) {
        const int row = t < NMETA ? T + t : b * SEQ + (t - NMETA);
        const bf16_t* qp = RQ + (size_t)row * 512 + h * 64; const bf16_t* kp = RK + (size_t)row * 512 + h * 64;
        const float v = bf2f(RV[(size_t)row * 1024 + h * 128 + e]);
        float y = 0.f;
#pragma unroll
        for (int d = 0; d < 64; d += 8) { float kq[8], qq[8]; ld8(kp + d, kq); ld8(qp + d, qq);
#pragma unroll
            for (int j = 0; j < 8; ++j) { S[d + j] = gamma * S[d + j] + kq[j] * v; y += qq[j] * S[d + j]; } }
        if (t >= NMETA) {
            const float s1 = wave_sum(y), s2 = wave_sum(y * y);
            const int buf = t & 1;
            if ((e & 63) == 0) { red[buf][(e >> 6) * 2] = s1; red[buf][(e >> 6) * 2 + 1] = s2; }
            __syncthreads();
            const float mu = (red[buf][0] + red[buf][2]) * (1.f / 128.f); const float ex2 = (red[buf][1] + red[buf][3]) * (1.f / 128.f);
            const float var = fmaxf(ex2 - mu * mu, 0.f);
            const float yn = (y - mu) * rsqrtf(var + EPS) * gg;
            const float g = bf2f(RG[(size_t)row * 1024 + h * 128 + e]);
            RET[(size_t)row * 1024 + h * 128 + e] = (bf16_t)f2bf(g * yn);
        }
    }
}

__global__ void __launch_bounds__(256) k_rinv2(Ptrs p) {
    const int lane = threadIdx.x & 63, gw = (blockIdx.x * 256 + threadIdx.x) >> 6, nw = (gridDim.x * 256) >> 6;
    float* R = (float*)(p.ws + WS_RINV2);
    for (int r = gw; r < T; r += nw) {
        float ss = 0.f;
#pragma unroll
        for (int j = 0; j < 4; ++j) { const f32x4 v = *(const f32x4*)(p.out + (size_t)r * D + lane * 4 + 256 * j); ss += v.x * v.x + v.y * v.y + v.z * v.z + v.w * v.w; }
        ss = wave_sum(ss);
        if (lane == 0) R[r] = rsqrtf(ss * (1.f / D) + EPS);
    }
}

__global__ void __launch_bounds__(32) k_peer_select_naive(Ptrs p) {
    __shared__ float sc[256][32];
    __shared__ int ii[32][32];
    const bf16_t* PQ = (const bf16_t*)(p.ws + WS_PQ);
    const float* k1 = p.in[16]; const float* k2 = p.in[17];
    int* SELI = (int*)(p.ws + WS_SELI); float* SELG = (float*)(p.ws + WS_SELG);
    const int tid = threadIdx.x, gid = blockIdx.x * 32 + tid, tok = gid >> 3, hd = gid & 7;
    float q[128];
#pragma unroll
    for (int d = 0; d < 128; d += 8) { float t[8]; ld8(PQ + (size_t)tok * D + hd * 128 + d, t);
#pragma unroll
        for (int j = 0; j < 8; ++j) q[d + j] = t[j]; }
    for (int kk = 0; kk < 128; ++kk) {
        float a = 0.f, b = 0.f;
#pragma unroll
        for (int d = 0; d < 64; ++d) { a += q[d] * k1[kk * 64 + d]; b += q[64 + d] * k2[kk * 64 + d]; }
        sc[kk][tid] = a; sc[128 + kk][tid] = b;
    }
    float v1[16], v2[16];
#pragma unroll
    for (int r = 0; r < 16; ++r) {
        float best = -INFINITY; int bi = 0;
        for (int kk = 0; kk < 128; ++kk) { const float x = sc[kk][tid]; if (x > best) { best = x; bi = kk; } }
        sc[bi][tid] = -INFINITY; v1[r] = best; ii[r][tid] = bi;
        best = -INFINITY; bi = 0;
        for (int kk = 0; kk < 128; ++kk) { const float x = sc[128 + kk][tid]; if (x > best) { best = x; bi = kk; } }
        sc[128 + bi][tid] = -INFINITY; v2[r] = best; ii[16 + r][tid] = bi;
    }
#pragma unroll
    for (int i = 0; i < 16; ++i)
#pragma unroll
        for (int j = 0; j < 16; ++j) sc[i * 16 + j][tid] = v1[i] + v2[j];
    float sv[16]; int se[16];
#pragma unroll
    for (int r = 0; r < 16; ++r) {
        float best = -INFINITY; int bi = 0;
        for (int c = 0; c < 256; ++c) { const float x = sc[c][tid]; if (x > best) { best = x; bi = c; } }
        sc[bi][tid] = -INFINITY; sv[r] = best; se[r] = ii[bi >> 4][tid] * 128 + ii[16 + (bi & 15)][tid];
    }
    float den = 0.f; const float mx = sv[0];
#pragma unroll
    for (int r = 0; r < 16; ++r) { sv[r] = __expf(sv[r] - mx); den += sv[r]; }
    const float id = 1.f / den;
#pragma unroll
    for (int r = 0; r < 16; ++r) { SELI[(size_t)tok * 128 + hd * 16 + r] = se[r]; SELG[(size_t)tok * 128 + hd * 16 + r] = sv[r] * id; }
}

__global__ void __launch_bounds__(256) k_peer_gather_naive(Ptrs p) {
    __shared__ float wk[128];
    const int* SELI = (const int*)(p.ws + WS_SELI); const float* SELG = (const float*)(p.ws + WS_SELG);
    const float* RINV2 = (const float*)(p.ws + WS_RINV2); const float* gffn = p.in[14]; const float* U = p.in[18]; const float* Vt = p.in[19];
    const int tok = blockIdx.x, tid = threadIdx.x, lane = tid & 63, w = tid >> 6;
    const float r2 = RINV2[tok];
    f32x4 xr[4];
#pragma unroll
    for (int j = 0; j < 4; ++j) { const f32x4 hv = *(const f32x4*)(p.out + (size_t)tok * D + lane * 4 + 256 * j); const f32x4 g = *(const f32x4*)(gffn + lane * 4 + 256 * j); xr[j] = hv * g * r2; }
    for (int k = w * 32; k < w * 32 + 32; ++k) {
        const float* up = U + (size_t)SELI[(size_t)tok * 128 + k] * D;
        float dsum = 0.f;
#pragma unroll
        for (int j = 0; j < 4; ++j) { const f32x4 u = *(const f32x4*)(up + lane * 4 + 256 * j); dsum += u.x * xr[j].x + u.y * xr[j].y + u.z * xr[j].z + u.w * xr[j].w; }
        dsum = wave_sum(dsum);
        const float act = 0.5f * dsum * (1.f + erff(dsum * 0.70710678118654752f));
        if (lane == 0) wk[k] = SELG[(size_t)tok * 128 + k] * act;
    }
    __syncthreads();
    f32x4 acc = (f32x4){0.f, 0.f, 0.f, 0.f};
    for (int k = 0; k < 128; ++k) { const f32x4 v = *(const f32x4*)(Vt + (size_t)SELI[(size_t)tok * 128 + k] * D + tid * 4); acc += v * wk[k]; }
    f32x4* op = (f32x4*)(p.out + (size_t)tok * D + tid * 4); *op = *op + acc;
}

template <class Epi> static void launch_gemm(hipStream_t st, const bf16_t* A, int lda, const bf16_t* Bt, int ldb, int M, int N, int K, Epi E) {
    hipLaunchKernelGGL(gemm_ref<Epi>, dim3(N / 128, M / 64), dim3(256), 0, st, A, lda, Bt, ldb, K, E);
}
extern "C" void kernel_launch(void* const* d_in, const int* in_sizes, int n_in, void* d_out, int out_size, void* d_ws, size_t ws_size, hipStream_t stream) {
    Ptrs p{}; for (int i = 0; i < 20; ++i) p.in[i] = (const float*)d_in[i]; p.out = (float*)d_out; p.ws = (unsigned char*)d_ws;
    unsigned char* ws = p.ws;
    bf16_t *WIN = (bf16_t*)(ws + WS_WIN), *WUQ = (bf16_t*)(ws + WS_WUQ), *WUKV = (bf16_t*)(ws + WS_WUKV), *WMLA = (bf16_t*)(ws + WS_WMLA), *WRET = (bf16_t*)(ws + WS_WRET),
           *WMIX = (bf16_t*)(ws + WS_WMIX), *WPQ = (bf16_t*)(ws + WS_WPQ);
    bf16_t *XB = (bf16_t*)(ws + WS_XB), *LAT = (bf16_t*)(ws + WS_LAT), *RQ = (bf16_t*)(ws + WS_RQ), *RK = (bf16_t*)(ws + WS_RK), *RV = (bf16_t*)(ws + WS_RV), *RG = (bf16_t*)(ws + WS_RG);
    bf16_t *SA = (bf16_t*)d_out, *SR = SA + (size_t)T * 1024;
    bf16_t *Q = (bf16_t*)(ws + WS_Q), *K = (bf16_t*)(ws + WS_K), *V = (bf16_t*)(ws + WS_V), *AO = (bf16_t*)(ws + WS_AO), *RET = (bf16_t*)(ws + WS_RET), *MG = (bf16_t*)(ws + WS_MG),
           *H1B = (bf16_t*)(ws + WS_H1B), *PQ = (bf16_t*)(ws + WS_PQ);
    hipLaunchKernelGGL(k_prep_rows, dim3(1024), dim3(256), 0, stream, p);
    hipLaunchKernelGGL(k_prep_rope, dim3((4112 * 32 + 255) / 256), dim3(256), 0, stream, p);
    hipLaunchKernelGGL(k_prep_w<1>, dim3(NIN / 64, 1024 / 64), dim3(256), 0, stream, p.in[3], p.in[2], WIN, 1024, 5792, NIN);
    hipLaunchKernelGGL(k_prep_w<0>, dim3(768 / 64, 384 / 64), dim3(256), 0, stream, p.in[5], p.in[4], WUQ, 384, 768, 768);
    hipLaunchKernelGGL(k_prep_w<0>, dim3(1024 / 64, 256 / 64), dim3(256), 0, stream, p.in[7], p.in[6], WUKV, 256, 1024, 1024);
    hipLaunchKernelGGL(k_prep_w<0>, dim3(1024 / 64, 512 / 64), dim3(256), 0, stream, p.in[10], (const float*)nullptr, WMLA, 512, 1024, 1024);
    hipLaunchKernelGGL(k_prep_w<0>, dim3(1024 / 64, 1024 / 64), dim3(256), 0, stream, p.in[12], (const float*)nullptr, WRET, 1024, 1024, 1024);
    hipLaunchKernelGGL(k_prep_w<0>, dim3(1024 / 64, 1024 / 64), dim3(256), 0, stream, p.in[13], (const float*)nullptr, WMIX, 1024, 1024, 1024);
    hipLaunchKernelGGL(k_prep_w<0>, dim3(1024 / 64, 1024 / 64), dim3(256), 0, stream, p.in[15], p.in[14], WPQ, 1024, 1024, 1024);
    launch_gemm(stream, XB, 1024, WIN, 1024, MP, NIN, 1024, EpiIn{LAT, RQ, RK, RV, RG, SA, SR, (const float2*)(ws + WS_ROPE32)});
    launch_gemm(stream, LAT, 768, WUQ, 384, T, 768, 384, EpiQraw{Q});
    launch_gemm(stream, LAT + 384, 768, WUKV, 256, MP, 1024, 256, EpiKVraw{K, V});
    hipLaunchKernelGGL(k_finalize, dim3(1024), dim3(256), 0, stream, p);
    hipLaunchKernelGGL(k_attn_naive, dim3(SEQ / 64, 8, BATCH), dim3(64), 0, stream, p);
    hipLaunchKernelGGL(k_ret_naive, dim3(64), dim3(128), 0, stream, p);
    launch_gemm(stream, AO, 512, WMLA, 512, T, 1024, 512, EpiMerge1{MG, SA});
    launch_gemm(stream, RET, 1024, WRET, 1024, T, 1024, 1024, EpiMerge2{MG, SR});
    launch_gemm(stream, MG, 1024, WMIX, 1024, T, 1024, 1024, EpiMix{p.in[0], p.out, H1B});
    hipLaunchKernelGGL(k_rinv2, dim3(1024), dim3(256), 0, stream, p);
    launch_gemm(stream, H1B, 1024, WPQ, 1024, T, 1024, 1024, EpiPQ{PQ, (const float*)(ws + WS_RINV2)});
    hipLaunchKernelGGL(k_peer_select_naive, dim3(T * 8 / 32), dim3(32), 0, stream, p);
    hipLaunchKernelGGL(k_peer_gather_naive, dim3(T), dim3(256), 0, stream, p);
}
```

```cpp
#include <hip/hip_runtime.h>
#include <stdint.h>
#include <math.h>
#include <utility>

typedef unsigned short bf16_t;
typedef float f32x4 __attribute__((ext_vector_type(4)));
typedef unsigned u32x4 __attribute__((ext_vector_type(4)));

constexpr int D = 1024, BATCH = 8, SEQ = 4096, NMETA = 16;
constexpr int T = BATCH * SEQ;
constexpr int MP = 33024;
constexpr float EPS = 1e-6f;
constexpr int NIN = 5888;
constexpr int C_LAT = 0, C_RQ = 768, C_RK = 1280, C_RV = 1792, C_RG = 2816, C_SA = 3840, C_SR = 4864;
constexpr float QSCALE = 1.4426950408889634f * 0.10206207261596575f;

constexpr size_t al(size_t x) { return (x + 255) & ~(size_t)255; }
constexpr size_t WS_CTL = 0;
constexpr size_t WS_WIN = 1u << 20;
constexpr size_t WS_WUQ = WS_WIN + al((size_t)NIN * 1024 * 2);
constexpr size_t WS_WUKV = WS_WUQ + al((size_t)768 * 384 * 2);
constexpr size_t WS_WMLA = WS_WUKV + al((size_t)1024 * 256 * 2);
constexpr size_t WS_WRET = WS_WMLA + al((size_t)1024 * 512 * 2);
constexpr size_t WS_WMIX = WS_WRET + al((size_t)1024 * 1024 * 2);
constexpr size_t WS_WPQ = WS_WMIX + al((size_t)1024 * 1024 * 2);
constexpr size_t WS_KEYS = WS_WPQ + al((size_t)1024 * 1024 * 2);
constexpr size_t WS_ROPE32 = WS_KEYS + al((size_t)2 * 128 * 64 * 2);
constexpr size_t WS_ROPE16 = WS_ROPE32 + al((size_t)4112 * 32 * 8);
constexpr size_t WS_RINV2 = WS_ROPE16 + al((size_t)4112 * 16 * 8);
constexpr size_t WS_XB = WS_RINV2 + al((size_t)T * 4);
constexpr size_t WS_LAT = WS_XB + al((size_t)MP * 1024 * 2);
constexpr size_t WS_RQ = WS_LAT + al((size_t)MP * 768 * 2);
constexpr size_t WS_RK = WS_RQ + al((size_t)MP * 512 * 2);
constexpr size_t WS_RV = WS_RK + al((size_t)MP * 512 * 2);
constexpr size_t WS_RG = WS_RV + al((size_t)MP * 1024 * 2);
constexpr size_t WS_K = WS_RG + al((size_t)T * 1024 * 2);
constexpr size_t WS_V = WS_K + al((size_t)MP * 768 * 2);
constexpr int VT_LEN = 4160;
constexpr size_t WS_RET = WS_V + al((size_t)64 * 64 * VT_LEN * 2);

constexpr size_t WS_END = WS_RET + al((size_t)T * 1024 * 2);
static_assert(WS_END <= 536870912ull, "workspace map exceeds 512 MiB");
constexpr size_t WS_Q = WS_XB, WS_MG = WS_XB, WS_AO = WS_LAT, WS_H1B = WS_RV, WS_PQ = WS_RG, WS_SELI = WS_K, WS_SELG = WS_K + (size_t)T * 128 * 4;
static_assert(WS_SELG + (size_t)T * 128 * 4 <= WS_RET, "SEL overlay");
constexpr size_t WS_VRAW = WS_RET, WS_VT = WS_V;
__host__ __device__ __forceinline__ int vt_pos(int tile, int k) { const int x = k & 15; return 64 * tile + (k & 48) + ((x >= 4 && x < 12) ? (x ^ 12) : x); }

__device__ __forceinline__ unsigned f2bf(float f) { unsigned u = __builtin_bit_cast(unsigned, f); return (u + 0x7fffu + ((u >> 16) & 1u)) >> 16; }
__device__ __forceinline__ float bf2f(unsigned h) { return __builtin_bit_cast(float, h << 16); }
__device__ __forceinline__ unsigned pk2(float lo, float hi) { return f2bf(lo) | (f2bf(hi) << 16); }
__device__ __forceinline__ float wave_sum(float v) {
#pragma unroll
    for (int o = 1; o < 64; o <<= 1) v += __shfl_xor(v, o);
    return v;
}
__device__ __forceinline__ int row_pos(int row) { return row < T ? NMETA + (row & (SEQ - 1)) : (row - T < NMETA ? row - T : 0); }
__device__ __forceinline__ float sigmoidf_(float x) { return 1.f / (1.f + __expf(-x)); }

struct Ptrs {
    const float* in[20];
    float* out;
    unsigned char* ws;
};

__global__ void __launch_bounds__(256) k_prep_rows(Ptrs p) {
    const int lane = threadIdx.x & 63, gw = (blockIdx.x * 256 + threadIdx.x) >> 6, nw = (gridDim.x * 256) >> 6;
    bf16_t* XB = (bf16_t*)(p.ws + WS_XB);
    for (int r = gw; r < MP; r += nw) {
        f32x4 v[4];
        if (r < T + NMETA) {
            const float* src = r < T ? p.in[0] + (size_t)r * D : p.in[1] + (size_t)(r - T) * D;
#pragma unroll
            for (int j = 0; j < 4; ++j) v[j] = *(const f32x4*)(src + lane * 4 + 256 * j);
        } else {
#pragma unroll
            for (int j = 0; j < 4; ++j) v[j] = (f32x4){0.f, 0.f, 0.f, 0.f};
        }
        float ss = 0.f;
#pragma unroll
        for (int j = 0; j < 4; ++j) ss += v[j].x * v[j].x + v[j].y * v[j].y + v[j].z * v[j].z + v[j].w * v[j].w;
        ss = wave_sum(ss);
        const float rinv = rsqrtf(ss * (1.f / D) + EPS);
#pragma unroll
        for (int j = 0; j < 4; ++j) {
            uint2 o; o.x = pk2(v[j].x * rinv, v[j].y * rinv); o.y = pk2(v[j].z * rinv, v[j].w * rinv);
            *(uint2*)(XB + (size_t)r * D + lane * 4 + 256 * j) = o;
        }
    }
}

__device__ __forceinline__ int win_src(int n) {
    if (n < 672) return n;
    if (n < 768) return -1;
    if (n < C_RV) { const int base = n < C_RK ? 672 : 1184, q = (n - (n < C_RK ? C_RQ : C_RK)), hh = q >> 6, pp = q & 63; return base + hh * 64 + (pp >> 1) + 32 * (pp & 1); }
    if (n < C_RG) return 1696 + (n - C_RV);
    if (n < C_SA) return 2720 + (n - C_RG);
    if (n < C_SR) return 3744 + (n - C_SA);
    return 4768 + (n - C_SR);
}
template <int MODE>
__global__ void __launch_bounds__(256) k_prep_w(const float* __restrict__ W, const float* __restrict__ gain, bf16_t* __restrict__ Wt, int K, int Nsrc, int Ndst) {
    __shared__ float tile[64][65];
    const int n0 = blockIdx.x * 64, k0 = blockIdx.y * 64, tx = threadIdx.x & 63, ty = threadIdx.x >> 6;
    const int n = n0 + tx; const int src = MODE == 1 ? win_src(n) : n;
    for (int kk = ty; kk < 64; kk += 4) {
        float v = 0.f;
        if (src >= 0 && n < Ndst) { v = W[(size_t)(k0 + kk) * Nsrc + src]; if (gain) v *= gain[k0 + kk]; }
        tile[kk][tx] = v;
    }
    __syncthreads();
    for (int nn = ty; nn < 64; nn += 4) if (n0 + nn < Ndst) Wt[(size_t)(n0 + nn) * K + k0 + tx] = (bf16_t)f2bf(tile[tx][nn]);
}
__global__ void k_prep_rope(Ptrs p) {
    const int i = blockIdx.x * blockDim.x + threadIdx.x;
    float2* R32 = (float2*)(p.ws + WS_ROPE32); float2* R16 = (float2*)(p.ws + WS_ROPE16);
    if (i < 4112 * 32) { const int pos = i >> 5, f = i & 31; const float inv = (float)pow(10000.0, -(double)f / 32.0); const float ang = (float)pos * inv; R32[i] = make_float2((float)cos((double)ang), (float)sin((double)ang)); }
    if (i < 4112 * 16) { const int pos = i >> 4, f = i & 15; const float inv = (float)pow(10000.0, -(double)f / 16.0); const float ang = (float)pos * inv; R16[i] = make_float2((float)cos((double)ang), (float)sin((double)ang)); }
}

__device__ __forceinline__ void st8(bf16_t* dst, const float (&v)[8]) {
    u32x4 w; w.x = pk2(v[0], v[1]); w.y = pk2(v[2], v[3]); w.z = pk2(v[4], v[5]); w.w = pk2(v[6], v[7]); *(u32x4*)dst = w;
}
struct EpiIn {
    bf16_t *LAT, *RQ, *RK, *RV, *RG, *SA, *SR; const float2* R32;
    __device__ __forceinline__ void apply(int row, int col0, const float (&v)[8]) const {
        if (col0 < C_RQ) { st8(LAT + (size_t)row * 768 + col0, v); return; }
        if (col0 < C_RV) {
            const bool isq = col0 < C_RK; const int c = col0 - (isq ? C_RQ : C_RK); const int i0 = (c & 63) >> 1;
            const int hh = c >> 6, cc = row < T ? (row & 127) : (row - T);
            const float lg = __log2f(1.f - exp2f(-5.f - (float)hh)) * (float)(cc + 1);
            const float2* rp = R32 + row_pos(row) * 32 + i0; const float sc = isq ? exp2f(lg) : 0.125f * exp2f(-lg);
            float o[8];
#pragma unroll
            for (int j = 0; j < 4; ++j) { const float2 cs = rp[j]; const float x1 = v[2 * j], x2 = v[2 * j + 1]; o[2 * j] = (x1 * cs.x - x2 * cs.y) * sc; o[2 * j + 1] = (x1 * cs.y + x2 * cs.x) * sc; }
            st8((isq ? RQ : RK) + (size_t)row * 512 + c, o); return;
        }
        if (col0 < C_RG) { st8(RV + (size_t)row * 1024 + (col0 - C_RV), v); return; }
        if (row >= T) return;
        float o[8];
        if (col0 < C_SA) {
#pragma unroll
            for (int j = 0; j < 8; ++j) o[j] = v[j] * sigmoidf_(v[j]);
            st8(RG + (size_t)row * 1024 + (col0 - C_RG), o); return;
        }
#pragma unroll
        for (int j = 0; j < 8; ++j) o[j] = sigmoidf_(v[j]);
        if (col0 < C_SR) st8(SA + (size_t)row * 1024 + (col0 - C_SA), o); else st8(SR + (size_t)row * 1024 + (col0 - C_SR), o);
    }
};
struct EpiQraw { bf16_t* Q; __device__ __forceinline__ void apply(int row, int col0, const float (&v)[8]) const { st8(Q + (size_t)row * 768 + col0, v); } };
struct EpiKVraw {
    bf16_t *K, *V;
    __device__ __forceinline__ void apply(int row, int col0, const float (&v)[8]) const {
        const int h = col0 >> 7, j = col0 & 127;
        if (j < 64) st8(K + (size_t)row * 768 + h * 96 + j, v); else st8(V + (size_t)row * 512 + h * 64 + (j - 64), v);
    }
};
__device__ __forceinline__ void ld8(const bf16_t* src, float (&o)[8]) {
    const u32x4 w = *(const u32x4*)src;
    o[0] = bf2f(w.x & 0xffff); o[1] = bf2f(w.x >> 16); o[2] = bf2f(w.y & 0xffff); o[3] = bf2f(w.y >> 16);
    o[4] = bf2f(w.z & 0xffff); o[5] = bf2f(w.z >> 16); o[6] = bf2f(w.w & 0xffff); o[7] = bf2f(w.w >> 16);
}
struct EpiMerge1 { bf16_t* MG; const bf16_t* SA;
    __device__ __forceinline__ void apply(int row, int col0, const float (&v)[8]) const {
        float g[8], o[8]; ld8(SA + (size_t)row * 1024 + col0, g);
#pragma unroll
        for (int j = 0; j < 8; ++j) o[j] = g[j] * v[j];
        st8(MG + (size_t)row * 1024 + col0, o); } };
struct EpiMerge2 { bf16_t* MG; const bf16_t* SR;
    __device__ __forceinline__ void apply(int row, int col0, const float (&v)[8]) const {
        float g[8], m[8], o[8]; ld8(SR + (size_t)row * 1024 + col0, g); ld8(MG + (size_t)row * 1024 + col0, m);
#pragma unroll
        for (int j = 0; j < 8; ++j) o[j] = m[j] + g[j] * v[j];
        st8(MG + (size_t)row * 1024 + col0, o); } };
struct EpiMix { const float* x; float* out; bf16_t* H1B;
    __device__ __forceinline__ void apply(int row, int col0, const float (&v)[8]) const {
        const f32x4 a = *(const f32x4*)(x + (size_t)row * D + col0), b = *(const f32x4*)(x + (size_t)row * D + col0 + 4);
        float o[8] = {a.x + v[0], a.y + v[1], a.z + v[2], a.w + v[3], b.x + v[4], b.y + v[5], b.z + v[6], b.w + v[7]};
        *(f32x4*)(out + (size_t)row * D + col0) = (f32x4){o[0], o[1], o[2], o[3]}; *(f32x4*)(out + (size_t)row * D + col0 + 4) = (f32x4){o[4], o[5], o[6], o[7]};
        st8(H1B + (size_t)row * D + col0, o); } };
struct EpiPQ { bf16_t* PQ; const float* RINV2;
    __device__ __forceinline__ void apply(int row, int col0, const float (&v)[8]) const {
        const float r = RINV2[row]; float o[8];
#pragma unroll
        for (int j = 0; j < 8; ++j) o[j] = v[j] * r;
        st8(PQ + (size_t)row * D + col0, o); } };

template <class Epi>
__global__ void __launch_bounds__(256) gemm_ref(const bf16_t* __restrict__ A, int lda, const bf16_t* __restrict__ Bt, int ldb, int K, Epi E) {
    __shared__ float As[32][64 + 4];
    __shared__ float Bs[32][128 + 4];
    const int tid = threadIdx.x, tx = tid & 15, ty = tid >> 4;
    const int m0 = blockIdx.y * 64, n0 = blockIdx.x * 128;
    float acc[4][8];
#pragma unroll
    for (int i = 0; i < 4; ++i)
#pragma unroll
        for (int j = 0; j < 8; ++j) acc[i][j] = 0.f;
    for (int k0 = 0; k0 < K; k0 += 32) {
        { const int m = tid & 63, kc = tid >> 6; float t[8]; ld8(A + (size_t)(m0 + m) * lda + k0 + kc * 8, t);
#pragma unroll
          for (int j = 0; j < 8; ++j) As[kc * 8 + j][m] = t[j]; }
#pragma unroll
        for (int i = 0; i < 2; ++i) { const int n = tid & 127, kc = (tid >> 7) + 2 * i; float t[8]; ld8(Bt + (size_t)(n0 + n) * ldb + k0 + kc * 8, t);
#pragma unroll
          for (int j = 0; j < 8; ++j) Bs[kc * 8 + j][n] = t[j]; }
        __syncthreads();
#pragma unroll 8
        for (int kk = 0; kk < 32; ++kk) {
            const f32x4 a = *(const f32x4*)&As[kk][ty * 4]; const f32x4 b0 = *(const f32x4*)&Bs[kk][tx * 8], b1 = *(const f32x4*)&Bs[kk][tx * 8 + 4];
            const float av[4] = {a.x, a.y, a.z, a.w}, bv[8] = {b0.x, b0.y, b0.z, b0.w, b1.x, b1.y, b1.z, b1.w};
#pragma unroll
            for (int i = 0; i < 4; ++i)
#pragma unroll
                for (int j = 0; j < 8; ++j) acc[i][j] += av[i] * bv[j];
        }
        __syncthreads();
    }
#pragma unroll
    for (int i = 0; i < 4; ++i) E.apply(m0 + ty * 4 + i, n0 + tx * 8, acc[i]);
}

namespace pg8 {
#define PG8_LAS __attribute__((address_space(3)))
typedef short bf16x8 __attribute__((ext_vector_type(8)));
constexpr int BM = 256, BK = 64, HALF = 128, HTB = HALF * BK * 2, STAGE_BYTES = 8 * HTB, NXCD = 8, WGM = 8;
__host__ __device__ __forceinline__ int lds_byte(int r, int c) { const int st = (r >> 4) * 2 + (c >> 5), rr = r & 15, cc = c & 31, ob = rr * 64 + cc * 2; return st * 1024 + (ob ^ (((ob >> 9) & 1) << 5)); }
__host__ __device__ __forceinline__ void stage_rc(int b, int& R, int& C) { const int st = b / 1024, sb = b % 1024, swz = sb ^ (((sb >> 9) & 1) << 5); R = (st >> 1) * 16 + swz / 64; C = (st & 1) * 32 + (swz % 64) / 2; }
__host__ __device__ __forceinline__ int perm32(int rho) { const int n = rho >> 4, i = rho & 15; return 8 * (i >> 2) + 4 * n + (i & 3); }
struct Unit { int pm, pn; };
struct Gemm { const bf16_t* A; const bf16_t* Bt; int lda, ldb, M, N, K, pad; };
struct StaticOrder {
    int nM, nN, nwg, G, c;
    __host__ __device__ void init(int M, int N, int G_, int c_) { nM = M / BM; nN = N / BM; nwg = nM * nN; G = G_; c = c_; }
    __host__ __device__ bool next(int i, Unit& u) const {
        const long L = (long)i * G + c; if (L >= nwg) return false;
        int wgid = (int)L; { const int q = nwg / NXCD, r = nwg % NXCD, xcd = wgid % NXCD, off = wgid / NXCD; wgid = (xcd < r ? xcd * (q + 1) : r * (q + 1) + (xcd - r) * q) + off; }
        const int nig = WGM * nN, gid = wgid / nig, fm = gid * WGM, gsz = (nM - fm) < WGM ? (nM - fm) : WGM;
        u.pm = fm + ((wgid % nig) % gsz); u.pn = (wgid % nig) / gsz; return true;
    }
};
template <class Epi>
__device__ __forceinline__ void run_epi(const Epi& E, const f32x4 (&acc)[2][2][4][2], const Unit& u, int wr, int wc, int fr, int fq) {
    const int row0 = u.pm * BM + wr * 64 + fr, col0 = u.pn * BM + wc * 32 + 8 * fq;
#pragma unroll
    for (int ai = 0; ai < 2; ++ai)
#pragma unroll
        for (int m = 0; m < 4; ++m)
#pragma unroll
            for (int bj = 0; bj < 2; ++bj) {
                const f32x4 a = acc[ai][bj][m][0], b = acc[ai][bj][m][1];
                const float v[8] = {a[0], a[1], a[2], a[3], b[0], b[1], b[2], b[3]};
                E.apply(row0 + ai * HALF + m * 16, col0 + bj * HALF, v);
            }
}
template <class Epi>
__device__ __forceinline__ void gemm_phase(PG8_LAS unsigned char* lds, const Gemm g, const StaticOrder& S, const Epi& E) {
    const int tid = threadIdx.x, wid = __builtin_amdgcn_readfirstlane(tid >> 6), lane = tid & 63, wr = wid >> 2, wc = wid & 3, fr = lane & 15, fq = lane >> 4;
    const int K = g.K, nt = K / BK;
    unsigned voffA[2], voffB[2];
#pragma unroll
    for (int i = 0; i < 2; ++i) { int R, C; stage_rc(tid * 16 + i * 8192, R, C); const int Rb = (R & ~31) + perm32(R & 31);
        voffA[i] = (unsigned)(R * g.lda + C) * 2u; voffB[i] = (unsigned)(Rb * g.ldb + C) * 2u; }
    const size_t kstep = (size_t)(BK * 2);
    const size_t hstepA = (size_t)HALF * g.lda * 2, hstepB = (size_t)HALF * g.ldb * 2;
    const size_t tstepA = 2 * hstepA, tstepB = 2 * hstepB;
    const unsigned ldsw = (unsigned)wid * 1024u;
    const int aoff = lds_byte(wr * 64 + fr, fq * 8), boff = lds_byte(wc * 32 + fr, fq * 8);
#define PG8_SA(b, h) (((b) * 2 + (h)) * HTB)
#define PG8_SB(b, h) ((4 + (b) * 2 + (h)) * HTB)
#define PG8_STAGE(bufoff, gbase, voff) do { _Pragma("unroll") for (int _i = 0; _i < 2; ++_i) \
        __builtin_amdgcn_global_load_lds((const unsigned*)((const char*)(gbase) + (voff)[_i]), (PG8_LAS unsigned*)(lds + (bufoff) + ldsw + _i * 8192), 16, 0, 0); } while (0)
#define PG8_LDA(dst, b, h) do { _Pragma("unroll") for (int m = 0; m < 4; ++m) _Pragma("unroll") for (int k = 0; k < 2; ++k) dst[m][k] = *(const PG8_LAS bf16x8*)(lds + PG8_SA(b, h) + aoff + m * 2048 + k * 1024); } while (0)
#define PG8_LDB(dst, b, h) do { _Pragma("unroll") for (int n = 0; n < 2; ++n) _Pragma("unroll") for (int k = 0; k < 2; ++k) dst[n][k] = *(const PG8_LAS bf16x8*)(lds + PG8_SB(b, h) + boff + n * 2048 + k * 1024); } while (0)
#define PG8_MMA(ai, bj, At, Bt) do { __builtin_amdgcn_s_setprio(1); _Pragma("unroll") for (int m = 0; m < 4; ++m) _Pragma("unroll") for (int n = 0; n < 2; ++n) _Pragma("unroll") for (int k = 0; k < 2; ++k) \
        acc[ai][bj][m][n] = __builtin_amdgcn_mfma_f32_16x16x32_bf16(Bt[n][k], At[m][k], acc[ai][bj][m][n], 0, 0, 0); __builtin_amdgcn_s_setprio(0); } while (0)
#define PG8_WAIT_V(n) asm volatile("s_waitcnt vmcnt(" #n ")" ::: "memory")
#define PG8_WAIT_L(n) asm volatile("s_waitcnt lgkmcnt(" #n ")" ::: "memory")
#define PG8_BAR __builtin_amdgcn_s_barrier()
#define PG8_SCHED __builtin_amdgcn_sched_barrier(0)
    Unit cur, nxt; int ui = 0;
    if (!S.next(0, cur)) return;
    f32x4 acc[2][2][4][2];
#pragma unroll
    for (int a = 0; a < 2; ++a)
#pragma unroll
        for (int b = 0; b < 2; ++b)
#pragma unroll
            for (int m = 0; m < 4; ++m)
#pragma unroll
                for (int n = 0; n < 2; ++n) acc[a][b][m][n] = (f32x4){0.f, 0.f, 0.f, 0.f};
    bf16x8 At[4][2], B0[2][2], B1[2][2];
    const char* cA = (const char*)g.A + (size_t)cur.pm * tstepA; const char* cB = (const char*)g.Bt + (size_t)cur.pn * tstepB;
    PG8_STAGE(PG8_SB(0, 0), cB, voffB); PG8_STAGE(PG8_SB(0, 1), cB + hstepB, voffB); PG8_STAGE(PG8_SA(0, 0), cA, voffA); PG8_STAGE(PG8_SA(0, 1), cA + hstepA, voffA);
    if (wr == 1) PG8_BAR;
    PG8_WAIT_V(2); PG8_BAR;
    PG8_STAGE(PG8_SB(1, 0), cB + kstep, voffB); PG8_STAGE(PG8_SA(1, 0), cA + kstep, voffA); PG8_STAGE(PG8_SB(1, 1), cB + hstepB + kstep, voffB);
    PG8_WAIT_V(6); PG8_BAR;
    for (;;) {
        const bool has_next = S.next(ui + 1, nxt);
        const char* nA = has_next ? (const char*)g.A + (size_t)nxt.pm * tstepA : cA; const char* nB = has_next ? (const char*)g.Bt + (size_t)nxt.pn * tstepB : cB;
        for (int t = 0; t < nt; t += 2) {
            const bool last = (t == nt - 2);
            const char* a1 = cA + (size_t)(t + 1) * kstep;
            const char* a2 = last ? nA : cA + (size_t)(t + 2) * kstep; const char* b2 = last ? nB : cB + (size_t)(t + 2) * kstep;
            const char* a3 = a2 + kstep; const char* b3 = b2 + kstep;
            PG8_LDB(B0, 0, 0); PG8_LDB(B1, 0, 1); PG8_SCHED; PG8_LDA(At, 0, 0); PG8_STAGE(PG8_SA(1, 1), a1 + hstepA, voffA);
            PG8_WAIT_V(8); PG8_WAIT_L(0); PG8_BAR; PG8_MMA(0, 0, At, B0); PG8_MMA(0, 1, At, B1); PG8_BAR; PG8_SCHED;
            PG8_LDA(At, 0, 1); PG8_STAGE(PG8_SB(0, 0), b2, voffB); PG8_STAGE(PG8_SB(0, 1), b2 + hstepB, voffB); PG8_STAGE(PG8_SA(0, 0), a2, voffA);
            PG8_WAIT_V(8); PG8_WAIT_L(0); PG8_BAR; PG8_MMA(1, 0, At, B0); PG8_MMA(1, 1, At, B1); PG8_BAR; PG8_SCHED;
            PG8_LDB(B0, 1, 0); PG8_LDB(B1, 1, 1); PG8_SCHED; PG8_LDA(At, 1, 0); PG8_STAGE(PG8_SA(0, 1), a2 + hstepA, voffA);
            PG8_WAIT_V(8); PG8_WAIT_L(0); PG8_BAR; PG8_MMA(0, 0, At, B0); PG8_MMA(0, 1, At, B1); PG8_BAR; PG8_SCHED;
            PG8_LDA(At, 1, 1); PG8_STAGE(PG8_SB(1, 0), b3, voffB); PG8_STAGE(PG8_SB(1, 1), b3 + hstepB, voffB); PG8_STAGE(PG8_SA(1, 0), a3, voffA);
            PG8_WAIT_V(8); PG8_WAIT_L(0); PG8_BAR; PG8_MMA(1, 0, At, B0); PG8_MMA(1, 1, At, B1); PG8_BAR; PG8_SCHED;
        }
        if (wr == 0) PG8_BAR;
        run_epi(E, acc, cur, wr, wc, fr, fq);
        if (!has_next) break;
#pragma unroll
        for (int a = 0; a < 2; ++a)
#pragma unroll
            for (int b = 0; b < 2; ++b)
#pragma unroll
                for (int m = 0; m < 4; ++m)
#pragma unroll
                    for (int n = 0; n < 2; ++n) acc[a][b][m][n] = (f32x4){0.f, 0.f, 0.f, 0.f};
        cur = nxt; cA = nA; cB = nB; ++ui;
        if (wr == 1) PG8_BAR;
    }
    PG8_WAIT_V(0);
    PG8_BAR;
#undef PG8_SA
#undef PG8_SB
#undef PG8_STAGE
#undef PG8_LDA
#undef PG8_LDB
#undef PG8_MMA
#undef PG8_WAIT_V
#undef PG8_WAIT_L
#undef PG8_BAR
#undef PG8_SCHED
}
}

constexpr int LDS_BYTES = 147456;
template <class Epi>
__global__ void __launch_bounds__(512, 2) k_gemm(pg8::Gemm g, Epi E) {
    extern __shared__ __attribute__((aligned(16))) unsigned char lds[];
    pg8::StaticOrder S; S.init(g.M, g.N, gridDim.x, blockIdx.x);
    pg8::gemm_phase<Epi>((PG8_LAS unsigned char*)lds, g, S, E);
}

__global__ void __launch_bounds__(256) k_finalize(Ptrs p) {
    const int lane = threadIdx.x & 63, gw = (blockIdx.x * 256 + threadIdx.x) >> 6, nw = (gridDim.x * 256) >> 6;
    const bf16_t* LAT = (const bf16_t*)(p.ws + WS_LAT);
    bf16_t* Q = (bf16_t*)(p.ws + WS_Q); bf16_t* K = (bf16_t*)(p.ws + WS_K); const bf16_t* V = (const bf16_t*)(p.ws + WS_VRAW); bf16_t* VT = (bf16_t*)(p.ws + WS_VT);
    const float2* R16 = (const float2*)(p.ws + WS_ROPE16);
    const float* gq = p.in[8]; const float* gk = p.in[9];
    const int l = lane & 31, hh = lane >> 5;
    for (int r = gw; r < MP; r += nw) {
        const bf16_t* lr = LAT + (size_t)r * 768;
        float sa = 0.f, sb = 0.f;
#pragma unroll
        for (int j = 0; j < 6; ++j) { const float c = bf2f(lr[lane + 64 * j]); sa += c * c; }
#pragma unroll
        for (int j = 0; j < 4; ++j) { const float c = bf2f(lr[384 + lane + 64 * j]); sb += c * c; }
        sa = wave_sum(sa); sb = wave_sum(sb);
        const float alpha = rsqrtf(sa * (1.f / 384.f) + EPS), beta = rsqrtf(sb * (1.f / 256.f) + EPS);
        const float kpe = bf2f(lr[640 + l]);
        const float2 cs = R16[row_pos(r) * 16 + (l & 15)];
        for (int it = 0; it < 4; ++it) {
            const int h = it * 2 + hh;
            if (r < T) {
                bf16_t* qp = Q + (size_t)r * 768 + h * 96;
                float q0 = bf2f(qp[l]) * alpha, q1 = bf2f(qp[32 + l]) * alpha, q2 = bf2f(qp[64 + l]) * alpha;
                float ss = q0 * q0 + q1 * q1 + q2 * q2;
#pragma unroll
                for (int o = 1; o < 32; o <<= 1) ss += __shfl_xor(ss, o);
                const float rq = rsqrtf(ss * (1.f / 96.f) + EPS);
                q0 *= rq * gq[l]; q1 *= rq * gq[32 + l]; q2 *= rq * gq[64 + l];
                const float pr = __shfl_xor(q2, 16);
                const float q2r = (l < 16) ? (q2 * cs.x - pr * cs.y) : (pr * cs.y + q2 * cs.x);
                qp[l] = (bf16_t)f2bf(q0 * QSCALE); qp[32 + l] = (bf16_t)f2bf(q1 * QSCALE); qp[64 + l] = (bf16_t)f2bf(q2r * QSCALE);
            }
            {
                bf16_t* kp = K + (size_t)r * 768 + h * 96;
                float k0 = bf2f(kp[l]) * beta, k1 = bf2f(kp[32 + l]) * beta, k2 = kpe;
                float ss = k0 * k0 + k1 * k1 + k2 * k2;
#pragma unroll
                for (int o = 1; o < 32; o <<= 1) ss += __shfl_xor(ss, o);
                const float rk = rsqrtf(ss * (1.f / 96.f) + EPS);
                k0 *= rk * gk[l]; k1 *= rk * gk[32 + l]; k2 *= rk * gk[64 + l];
                const float pr = __shfl_xor(k2, 16);
                const float k2r = (l < 16) ? (k2 * cs.x - pr * cs.y) : (pr * cs.y + k2 * cs.x);
                kp[l] = (bf16_t)f2bf(k0); kp[32 + l] = (bf16_t)f2bf(k1); kp[64 + l] = (bf16_t)f2bf(k2r);
                const bf16_t* vp = V + (size_t)r * 512 + h * 64;
                const bf16_t v0 = (bf16_t)f2bf(bf2f(vp[l]) * beta), v1 = (bf16_t)f2bf(bf2f(vp[32 + l]) * beta);
                if (r < T) { const int b = r >> 12, sq = r & (SEQ - 1); bf16_t* vt = VT + ((size_t)(b * 8 + h) * 64) * VT_LEN + vt_pos(1 + (sq >> 6), sq & 63);
                    vt[(size_t)l * VT_LEN] = v0; vt[(size_t)(32 + l) * VT_LEN] = v1; }
                else if (r < T + 64) { for (int b = 0; b < BATCH; ++b) { bf16_t* vt = VT + ((size_t)(b * 8 + h) * 64) * VT_LEN + vt_pos(0, r - T);
                    vt[(size_t)l * VT_LEN] = v0; vt[(size_t)(32 + l) * VT_LEN] = v1; } }
            }
        }
    }
}

__global__ void __launch_bounds__(64) k_attn_naive(Ptrs p) {
    const bf16_t* Q = (const bf16_t*)(p.ws + WS_Q); const bf16_t* K = (const bf16_t*)(p.ws + WS_K); const bf16_t* VT = (const bf16_t*)(p.ws + WS_VT);
    bf16_t* AO = (bf16_t*)(p.ws + WS_AO);
    const int s = blockIdx.x * 64 + threadIdx.x, h = blockIdx.y, b = blockIdx.z;
    const int row = b * SEQ + s;
    float q[96], o[64];
#pragma unroll
    for (int d = 0; d < 96; d += 8) { float t[8]; ld8(Q + (size_t)row * 768 + h * 96 + d, t);
#pragma unroll
        for (int j = 0; j < 8; ++j) q[d + j] = t[j]; }
#pragma unroll
    for (int d = 0; d < 64; ++d) o[d] = 0.f;
    float m = -INFINITY, l = 0.f;
    const int smax = blockIdx.x * 64 + 63;
    for (int j = 0; j < NMETA + smax + 1; ++j) {
        const int krow = j < NMETA ? T + j : b * SEQ + (j - NMETA);
        const bf16_t* kp = K + (size_t)krow * 768 + h * 96;
        const bf16_t* vp = VT + ((size_t)(b * 8 + h) * 64) * VT_LEN + (j < NMETA ? vt_pos(0, j) : vt_pos(1 + ((j - NMETA) >> 6), (j - NMETA) & 63));
        float sc = 0.f;
#pragma unroll
        for (int d = 0; d < 96; d += 8) { float t[8]; ld8(kp + d, t);
#pragma unroll
            for (int jj = 0; jj < 8; ++jj) sc += q[d + jj] * t[jj]; }
        const bool valid = (j < NMETA) || (j - NMETA <= s);
        if (valid) {
            const float mn = fmaxf(m, sc); const float a = exp2f(m - mn), pp = exp2f(sc - mn);
            l = l * a + pp; m = mn;
#pragma unroll
            for (int d = 0; d < 64; ++d) o[d] = o[d] * a + pp * bf2f(vp[(size_t)d * VT_LEN]);
        }
    }
    const float il = 1.f / l;
#pragma unroll
    for (int d = 0; d < 64; d += 8) { float t[8];
#pragma unroll
        for (int jj = 0; jj < 8; ++jj) t[jj] = o[d + jj] * il;
        st8(AO + (size_t)row * 512 + h * 64 + d, t); }
}

#ifndef LAS
#define LAS __attribute__((address_space(3)))
#endif
typedef float f32x16_t __attribute__((ext_vector_type(16)));
typedef short bf16x8_t __attribute__((ext_vector_type(8)));
typedef float f32x2_t __attribute__((ext_vector_type(2)));
typedef __bf16 bf16x2v_t __attribute__((ext_vector_type(2)));
__device__ __forceinline__ unsigned cvtpk(float lo, float hi) { const f32x2_t v = {lo, hi}; return __builtin_bit_cast(unsigned, __builtin_convertvector(v, bf16x2v_t)); }
constexpr int ATT_KP = 208, ATT_VP = 144, ATT_KB = 64 * ATT_KP, ATT_VB = 64 * ATT_VP, ATT_BUF = ATT_KB + ATT_VB, ATT_LDS = 2 * ATT_BUF;
__device__ __forceinline__ void attn_unit(const Ptrs& p, LAS unsigned char* lds, int b, int h, int qb) {
    const bf16_t* Q = (const bf16_t*)(p.ws + WS_Q); const bf16_t* K = (const bf16_t*)(p.ws + WS_K); const bf16_t* VT = (const bf16_t*)(p.ws + WS_VT);
    bf16_t* AO = (bf16_t*)(p.ws + WS_AO);
    const int tid = threadIdx.x, lane = tid & 63, wid = __builtin_amdgcn_readfirstlane(tid >> 6), q = lane & 31, hi = lane >> 5;
    const int s0w = 256 * qb + 32 * wid, sq = s0w + q; const size_t rowq = (size_t)b * SEQ + sq;
    bf16x8_t qf[6];
#pragma unroll
    for (int st = 0; st < 6; ++st) qf[st] = *(const bf16x8_t*)(Q + rowq * 768 + h * 96 + 16 * st + 8 * hi);
    const int NT = 4 * qb + 5;
    const int k0key = tid / 12, k0ch = tid % 12, k1key = (tid + 512) / 12, k1ch = (tid + 512) % 12; const bool k1v = tid < 256;
    const int vd = tid >> 3, vch = tid & 7;
    const bf16_t* vtb = VT + ((size_t)(b * 8 + h) * 64 + vd) * VT_LEN + vch * 8;
    const bf16_t* kb0 = K + (size_t)h * 96 + k0ch * 8; const bf16_t* kb1 = K + (size_t)h * 96 + k1ch * 8;
    u32x4 kr0, kr1 = {}, vr;
#define ATT_KROW(t, key) ((t) == 0 ? (size_t)(T + (key)) : (size_t)b * SEQ + 64 * ((t) - 1) + (key))
#define ATT_LOAD(t) do { kr0 = *(const u32x4*)(kb0 + ATT_KROW(t, k0key) * 768); if (k1v) kr1 = *(const u32x4*)(kb1 + ATT_KROW(t, k1key) * 768); vr = *(const u32x4*)(vtb + 64 * (t)); } while (0)
#define ATT_STORE(buf) do { LAS unsigned char* bb = lds + (buf) * ATT_BUF; *(LAS u32x4*)(bb + k0key * ATT_KP + k0ch * 16) = kr0; if (k1v) *(LAS u32x4*)(bb + k1key * ATT_KP + k1ch * 16) = kr1; \
        *(LAS u32x4*)(bb + ATT_KB + vd * ATT_VP + vch * 16) = vr; } while (0)
    __syncthreads();
    ATT_LOAD(0); ATT_STORE(0); __syncthreads();
    float m = -1e30f, l = 0.f; f32x16_t o0 = {}, o1 = {};
    for (int t = 0; t < NT; ++t) {
        const int cur = t & 1;
        if (t + 1 < NT) ATT_LOAD(t + 1);
        const int ks = 64 * (t - 1);
        if (t == 0 || ks <= s0w + 31) {
            const LAS unsigned char* base = lds + cur * ATT_BUF;
            f32x16_t p0 = {}, p1 = {};
#pragma unroll
            for (int st = 0; st < 6; ++st) {
                const bf16x8_t a0 = *(const LAS bf16x8_t*)(base + q * ATT_KP + (16 * st + 8 * hi) * 2), a1 = *(const LAS bf16x8_t*)(base + (32 + q) * ATT_KP + (16 * st + 8 * hi) * 2);
                p0 = __builtin_amdgcn_mfma_f32_32x32x16_bf16(a0, qf[st], p0, 0, 0, 0); p1 = __builtin_amdgcn_mfma_f32_32x32x16_bf16(a1, qf[st], p1, 0, 0, 0); }
            float s0[16], s1[16];
#pragma unroll
            for (int r = 0; r < 16; ++r) { s0[r] = p0[r]; s1[r] = p1[r]; }
            if (t == 0) {
#pragma unroll
                for (int r = 0; r < 16; ++r) { if ((r & 3) + 8 * (r >> 2) + 4 * hi >= NMETA) s0[r] = -1e30f; s1[r] = -1e30f; }
            } else if (ks + 63 > s0w) {
#pragma unroll
                for (int r = 0; r < 16; ++r) { const int kk = ks + (r & 3) + 8 * (r >> 2) + 4 * hi; if (kk > sq) s0[r] = -1e30f; if (kk + 32 > sq) s1[r] = -1e30f; }
            }
            float mx = fmaxf(s0[0], s1[0]);
#pragma unroll
            for (int r = 1; r < 16; ++r) mx = fmaxf(mx, fmaxf(s0[r], s1[r]));
            mx = fmaxf(mx, __shfl_xor(mx, 32));
            if (__any(mx > m)) { const float mn = fmaxf(m, mx), al = __builtin_amdgcn_exp2f(m - mn); l *= al; m = mn;
#pragma unroll
                for (int r = 0; r < 16; ++r) { o0[r] *= al; o1[r] *= al; } }
            float ps = 0.f;
#pragma unroll
            for (int r = 0; r < 16; ++r) { s0[r] = __builtin_amdgcn_exp2f(s0[r] - m); s1[r] = __builtin_amdgcn_exp2f(s1[r] - m); ps += s0[r] + s1[r]; }
            l += ps;
            u32x4 pb[4];
            pb[0] = (u32x4){cvtpk(s0[0], s0[1]), cvtpk(s0[2], s0[3]), cvtpk(s0[4], s0[5]), cvtpk(s0[6], s0[7])};
            pb[1] = (u32x4){cvtpk(s0[8], s0[9]), cvtpk(s0[10], s0[11]), cvtpk(s0[12], s0[13]), cvtpk(s0[14], s0[15])};
            pb[2] = (u32x4){cvtpk(s1[0], s1[1]), cvtpk(s1[2], s1[3]), cvtpk(s1[4], s1[5]), cvtpk(s1[6], s1[7])};
            pb[3] = (u32x4){cvtpk(s1[8], s1[9]), cvtpk(s1[10], s1[11]), cvtpk(s1[12], s1[13]), cvtpk(s1[14], s1[15])};
#pragma unroll
            for (int kk = 0; kk < 4; ++kk) {
                const bf16x8_t v0 = *(const LAS bf16x8_t*)(base + ATT_KB + q * ATT_VP + (16 * kk + 8 * hi) * 2), v1 = *(const LAS bf16x8_t*)(base + ATT_KB + (32 + q) * ATT_VP + (16 * kk + 8 * hi) * 2);
                const bf16x8_t pf = __builtin_bit_cast(bf16x8_t, pb[kk]);
                o0 = __builtin_amdgcn_mfma_f32_32x32x16_bf16(v0, pf, o0, 0, 0, 0); o1 = __builtin_amdgcn_mfma_f32_32x32x16_bf16(v1, pf, o1, 0, 0, 0); }
        }
        if (t + 1 < NT) ATT_STORE(cur ^ 1);
        __syncthreads();
    }
    l += __shfl_xor(l, 32);
    const float il = 1.f / l;
    bf16_t* op = AO + rowq * 512 + h * 64 + 4 * hi;
#pragma unroll
    for (int g = 0; g < 4; ++g) {
        const float a0 = o0[4 * g], a1 = o0[4 * g + 1], a2 = o0[4 * g + 2], a3 = o0[4 * g + 3], b0 = o1[4 * g], b1 = o1[4 * g + 1], b2 = o1[4 * g + 2], b3 = o1[4 * g + 3];
        uint2 w0, w1; w0.x = cvtpk(a0 * il, a1 * il); w0.y = cvtpk(a2 * il, a3 * il); w1.x = cvtpk(b0 * il, b1 * il); w1.y = cvtpk(b2 * il, b3 * il);
        *(uint2*)(op + 8 * g) = w0; *(uint2*)(op + 32 + 8 * g) = w1; }
#undef ATT_KROW
#undef ATT_LOAD
#undef ATT_STORE
}
__device__ __forceinline__ void attn_phase(const Ptrs& p, LAS unsigned char* lds, int vcu, int ncu) {
    for (int v = vcu; v < 256; v += ncu) {
        const int bh = v >> 2, s = v & 3;
        attn_unit(p, lds, bh >> 3, bh & 7, 15 - s); attn_unit(p, lds, bh >> 3, bh & 7, 8 + s); attn_unit(p, lds, bh >> 3, bh & 7, 7 - s); attn_unit(p, lds, bh >> 3, bh & 7, s);
    }
}
__global__ void __launch_bounds__(512, 2) k_attn(Ptrs p) {
    extern __shared__ __attribute__((aligned(16))) unsigned char lds[];
    const int G = gridDim.x, bx = blockIdx.x; const int vcu = (G % 8 == 0) ? (bx % 8) * (G / 8) + bx / 8 : bx;
    attn_phase(p, (LAS unsigned char*)lds, vcu, G);
}

__global__ void __launch_bounds__(128) k_ret_naive(Ptrs p) {
    const bf16_t* RQ = (const bf16_t*)(p.ws + WS_RQ); const bf16_t* RK = (const bf16_t*)(p.ws + WS_RK); const bf16_t* RV = (const bf16_t*)(p.ws + WS_RV);
    const bf16_t* RG = (const bf16_t*)(p.ws + WS_RG); bf16_t* RET = (bf16_t*)(p.ws + WS_RET);
    const float* ggn = p.in[11];
    __shared__ float red[2][4];
    const int e = threadIdx.x, h = blockIdx.x & 7, b = blockIdx.x >> 3;
    const float gamma = 1.f - exp2f(-5.f - (float)h);
    float S[64];
#pragma unroll
    for (int d = 0; d < 64; ++d) S[d] = 0.f;
    const float gg = ggn[h * 128 + e];
    const float g128 = exp2f(128.f * __log2f(gamma)), g16 = exp2f(16.f * __log2f(gamma));
    for (int t = 0; t < NMETA + SEQ; ++t) {
        const int row = t < NMETA ? T + t : b * SEQ + (t - NMETA);
        if (t >= NMETA && ((t - NMETA) & 127) == 0) { const float f = t == NMETA ? g16 : g128;
#pragma unroll
            for (int d = 0; d < 64; ++d) S[d] *= f; }
        const bf16_t* qp = RQ + (size_t)row * 512 + h * 64; const bf16_t* kp = RK + (size_t)row * 512 + h * 64;
        const float v = bf2f(RV[(size_t)row * 1024 + h * 128 + e]);
        float y = 0.f;
#pragma unroll
        for (int d = 0; d < 64; d += 8) { float kq[8], qq[8]; ld8(kp + d, kq); ld8(qp + d, qq);
#pragma unroll
            for (int j = 0; j < 8; ++j) { S[d + j] = S[d + j] + kq[j] * v; y += qq[j] * S[d + j]; } }
        if (t >= NMETA) {
            const float s1 = wave_sum(y), s2 = wave_sum(y * y);
            const int buf = t & 1;
            if ((e & 63) == 0) { red[buf][(e >> 6) * 2] = s1; red[buf][(e >> 6) * 2 + 1] = s2; }
            __syncthreads();
            const float mu = (red[buf][0] + red[buf][2]) * (1.f / 128.f); const float ex2 = (red[buf][1] + red[buf][3]) * (1.f / 128.f);
            const float var = fmaxf(ex2 - mu * mu, 0.f);
            const float yn = (y - mu) * rsqrtf(var + EPS) * gg;
            const float g = bf2f(RG[(size_t)row * 1024 + h * 128 + e]);
            RET[(size_t)row * 1024 + h * 128 + e] = (bf16_t)f2bf(g * yn);
        }
    }
}

typedef unsigned u32x2 __attribute__((ext_vector_type(2)));
constexpr int RT_RP = 144, RT_TP = 272;
constexpr int RT_QT = 0, RT_KT = 128 * RT_RP, RT_KTT = RT_KT + 128 * RT_RP, RT_VTT = RT_KTT + 64 * RT_TP, RT_ST = RT_VTT + 128 * RT_TP, RT_STAT = RT_ST + 128 * RT_RP, RT_LDS = RT_STAT + 8 * 32 * 8;
static_assert(RT_LDS <= 147456, "retention LDS");
__device__ __forceinline__ void ret_unit(const Ptrs& p, LAS unsigned char* lds, int b, int h) {
    const bf16_t* RQ = (const bf16_t*)(p.ws + WS_RQ); const bf16_t* RK = (const bf16_t*)(p.ws + WS_RK); const bf16_t* RV = (const bf16_t*)(p.ws + WS_RV);
    const bf16_t* RG = (const bf16_t*)(p.ws + WS_RG); bf16_t* RET = (bf16_t*)(p.ws + WS_RET); const float* ggn = p.in[11];
    const int tid = threadIdx.x, lane = tid & 63, wid = __builtin_amdgcn_readfirstlane(tid >> 6), c = lane & 31, hi = lane >> 5;
    const int j = wid >> 1, ih = wid & 1;
    const float lgam = __log2f(1.f - exp2f(-5.f - (float)h)); const float g128 = exp2f(128.f * lgam), g16 = exp2f(16.f * lgam);
    const int nst = wid < 2 ? 2 : (wid < 6 ? 1 : 0);
    const int sti = wid < 2 ? wid : 2 + ((wid - 2) >> 1), std0 = wid < 2 ? 0 : ((wid - 2) & 1);
    f32x16_t st0 = {}, st1 = {};
    const int q_row0 = tid >> 3, q_ch = tid & 7;
    const int k_rb = tid >> 4, k_db = tid & 15;
    const int v_rb0 = tid >> 5, v_eb = tid & 31;
    u32x4 pq[2]; u32x2 pk[4], pv[2][4];
#define RT_MPOS(rb) (16 * ((rb) >> 2) + 4 * ((((rb) & 3) == 1) ? 2 : ((((rb) & 3) == 2) ? 1 : ((rb) & 3))))
#define RT_LOAD(R0) do { \
        pq[0] = *(const u32x4*)(RQ + (size_t)((R0) + q_row0) * 512 + h * 64 + q_ch * 8); pq[1] = *(const u32x4*)(RQ + (size_t)((R0) + q_row0 + 64) * 512 + h * 64 + q_ch * 8); \
        _Pragma("unroll") for (int i_ = 0; i_ < 4; ++i_) pk[i_] = *(const u32x2*)(RK + (size_t)((R0) + 4 * k_rb + i_) * 512 + h * 64 + 4 * k_db); \
        _Pragma("unroll") for (int u_ = 0; u_ < 2; ++u_) _Pragma("unroll") for (int i_ = 0; i_ < 4; ++i_) pv[u_][i_] = *(const u32x2*)(RV + (size_t)((R0) + 4 * (v_rb0 + 16 * u_) + i_) * 1024 + h * 128 + 4 * v_eb); } while (0)
#define RT_TR4(src, dstbase, colbase, pitch, mpos) do { \
        const unsigned a0_ = src[0].x, a1_ = src[1].x, a2_ = src[2].x, a3_ = src[3].x, b0_ = src[0].y, b1_ = src[1].y, b2_ = src[2].y, b3_ = src[3].y; \
        u32x2 t_; \
        t_.x = (a0_ & 0xffffu) | (a1_ << 16); t_.y = (a2_ & 0xffffu) | (a3_ << 16); *(LAS u32x2*)(lds + (dstbase) + ((colbase) + 0) * (pitch) + (mpos) * 2) = t_; \
        t_.x = (a0_ >> 16) | (a1_ & 0xffff0000u); t_.y = (a2_ >> 16) | (a3_ & 0xffff0000u); *(LAS u32x2*)(lds + (dstbase) + ((colbase) + 1) * (pitch) + (mpos) * 2) = t_; \
        t_.x = (b0_ & 0xffffu) | (b1_ << 16); t_.y = (b2_ & 0xffffu) | (b3_ << 16); *(LAS u32x2*)(lds + (dstbase) + ((colbase) + 2) * (pitch) + (mpos) * 2) = t_; \
        t_.x = (b0_ >> 16) | (b1_ & 0xffff0000u); t_.y = (b2_ >> 16) | (b3_ & 0xffff0000u); *(LAS u32x2*)(lds + (dstbase) + ((colbase) + 3) * (pitch) + (mpos) * 2) = t_; } while (0)
#define RT_STORE() do { \
        *(LAS u32x4*)(lds + RT_QT + q_row0 * RT_RP + q_ch * 16) = pq[0]; *(LAS u32x4*)(lds + RT_QT + (q_row0 + 64) * RT_RP + q_ch * 16) = pq[1]; \
        _Pragma("unroll") for (int i_ = 0; i_ < 4; ++i_) *(LAS u32x2*)(lds + RT_KT + (4 * k_rb + i_) * RT_RP + k_db * 8) = pk[i_]; \
        RT_TR4(pk, RT_KTT, 4 * k_db, RT_TP, RT_MPOS(k_rb)); \
        RT_TR4(pv[0], RT_VTT, 4 * v_eb, RT_TP, RT_MPOS(v_rb0)); RT_TR4(pv[1], RT_VTT, 4 * v_eb, RT_TP, RT_MPOS(v_rb0 + 16)); } while (0)
#define RT_PUT_ST(acc, it, dt) do { _Pragma("unroll") for (int r_ = 0; r_ < 16; ++r_) { const float v_ = acc[r_]; \
        *(LAS bf16_t*)(lds + RT_ST + (32 * (it) + (r_ & 3) + 8 * (r_ >> 2) + 4 * hi) * RT_RP + (32 * (dt) + c) * 2) = (bf16_t)f2bf(v_); } } while (0)
#define RT_STATE_UPD(acc, it, dt) do { _Pragma("unroll") for (int ks_ = 0; ks_ < 8; ++ks_) { \
        const bf16x8_t a_ = *(const LAS bf16x8_t*)(lds + RT_VTT + (32 * (it) + c) * RT_TP + (16 * ks_ + 8 * hi) * 2); \
        const bf16x8_t b_ = *(const LAS bf16x8_t*)(lds + RT_KTT + (32 * (dt) + c) * RT_TP + (16 * ks_ + 8 * hi) * 2); \
        acc = __builtin_amdgcn_mfma_f32_32x32x16_bf16(a_, b_, acc, 0, 0, 0); } } while (0)
    __syncthreads();
    RT_LOAD(T); RT_STORE(); __syncthreads();
    RT_LOAD(b * SEQ);
    if (nst >= 1) { RT_STATE_UPD(st0, sti, std0);
#pragma unroll
        for (int r = 0; r < 16; ++r) st0[r] *= g16; }
    if (nst == 2) { RT_STATE_UPD(st1, sti, 1);
#pragma unroll
        for (int r = 0; r < 16; ++r) st1[r] *= g16; }
    __syncthreads();
    RT_STORE();
    if (nst >= 1) RT_PUT_ST(st0, sti, std0);
    if (nst == 2) RT_PUT_ST(st1, sti, 1);
    __syncthreads();
    for (int n = 0; n < 32; ++n) {
        const int R0 = b * SEQ + 128 * n;
        if (n + 1 < 32) RT_LOAD(R0 + 128);
        bf16x8_t qf[4];
#pragma unroll
        for (int s4 = 0; s4 < 4; ++s4) qf[s4] = *(const LAS bf16x8_t*)(lds + RT_QT + (32 * j + c) * RT_RP + (16 * s4 + 8 * hi) * 2);
        f32x16_t y0 = {}, y1 = {};
#pragma unroll
        for (int s4 = 0; s4 < 4; ++s4) {
            const bf16x8_t a0 = *(const LAS bf16x8_t*)(lds + RT_ST + (64 * ih + c) * RT_RP + (16 * s4 + 8 * hi) * 2), a1 = *(const LAS bf16x8_t*)(lds + RT_ST + (64 * ih + 32 + c) * RT_RP + (16 * s4 + 8 * hi) * 2);
            y0 = __builtin_amdgcn_mfma_f32_32x32x16_bf16(a0, qf[s4], y0, 0, 0, 0); y1 = __builtin_amdgcn_mfma_f32_32x32x16_bf16(a1, qf[s4], y1, 0, 0, 0); }
        for (int a = 0; a <= j; ++a) {
            f32x16_t pa = {};
#pragma unroll
            for (int s4 = 0; s4 < 4; ++s4) { const bf16x8_t ka = *(const LAS bf16x8_t*)(lds + RT_KT + (32 * a + c) * RT_RP + (16 * s4 + 8 * hi) * 2);
                pa = __builtin_amdgcn_mfma_f32_32x32x16_bf16(ka, qf[s4], pa, 0, 0, 0); }
            float sv[16];
#pragma unroll
            for (int r = 0; r < 16; ++r) { const float v_ = pa[r]; sv[r] = (a == j && ((r & 3) + 8 * (r >> 2) + 4 * hi) > c) ? 0.f : v_; }
            u32x4 pb[2];
            pb[0] = (u32x4){cvtpk(sv[0], sv[1]), cvtpk(sv[2], sv[3]), cvtpk(sv[4], sv[5]), cvtpk(sv[6], sv[7])};
            pb[1] = (u32x4){cvtpk(sv[8], sv[9]), cvtpk(sv[10], sv[11]), cvtpk(sv[12], sv[13]), cvtpk(sv[14], sv[15])};
#pragma unroll
            for (int t2 = 0; t2 < 2; ++t2) {
                const bf16x8_t v0 = *(const LAS bf16x8_t*)(lds + RT_VTT + (64 * ih + c) * RT_TP + (32 * a + 16 * t2 + 8 * hi) * 2), v1 = *(const LAS bf16x8_t*)(lds + RT_VTT + (64 * ih + 32 + c) * RT_TP + (32 * a + 16 * t2 + 8 * hi) * 2);
                const bf16x8_t pf = __builtin_bit_cast(bf16x8_t, pb[t2]);
                y0 = __builtin_amdgcn_mfma_f32_32x32x16_bf16(v0, pf, y0, 0, 0, 0); y1 = __builtin_amdgcn_mfma_f32_32x32x16_bf16(v1, pf, y1, 0, 0, 0); }
        }
        if (nst >= 1) { RT_STATE_UPD(st0, sti, std0);
#pragma unroll
            for (int r = 0; r < 16; ++r) st0[r] *= g128; }
        if (nst == 2) { RT_STATE_UPD(st1, sti, 1);
#pragma unroll
            for (int r = 0; r < 16; ++r) st1[r] *= g128; }
        float s1 = 0.f, s2 = 0.f;
#pragma unroll
        for (int r = 0; r < 16; ++r) { const float a_ = y0[r], b_ = y1[r]; s1 += a_ + b_; s2 += a_ * a_ + b_ * b_; }
        s1 += __shfl_xor(s1, 32); s2 += __shfl_xor(s2, 32);
        if (hi == 0) *(LAS f32x2_t*)(lds + RT_STAT + (wid * 32 + c) * 8) = (f32x2_t){s1, s2};
        __syncthreads();
        { const f32x2_t o = *(const LAS f32x2_t*)(lds + RT_STAT + ((wid ^ 1) * 32 + c) * 8); s1 += o.x; s2 += o.y; }
        const float mu = s1 * (1.f / 128.f), var = fmaxf(s2 * (1.f / 128.f) - mu * mu, 0.f), rstd = rsqrtf(var + EPS);
        {
            const size_t row = (size_t)R0 + 32 * j + c;
#pragma unroll
            for (int i2 = 0; i2 < 2; ++i2)
#pragma unroll
                for (int g = 0; g < 4; ++g) {
                    const int e = 64 * ih + 32 * i2 + 8 * g + 4 * hi;
                    const u32x2 gw = *(const u32x2*)(RG + row * 1024 + h * 128 + e); const f32x4 gn = *(const f32x4*)(ggn + h * 128 + e);
                    float yv[4];
#pragma unroll
                    for (int x = 0; x < 4; ++x) yv[x] = i2 == 0 ? y0[4 * g + x] : y1[4 * g + x];
                    const float o0 = (yv[0] - mu) * rstd * gn.x * bf2f(gw.x & 0xffff), o1 = (yv[1] - mu) * rstd * gn.y * bf2f(gw.x >> 16);
                    const float o2 = (yv[2] - mu) * rstd * gn.z * bf2f(gw.y & 0xffff), o3 = (yv[3] - mu) * rstd * gn.w * bf2f(gw.y >> 16);
                    u32x2 ow; ow.x = cvtpk(o0, o1); ow.y = cvtpk(o2, o3);
                    *(u32x2*)(RET + row * 1024 + h * 128 + e) = ow;
                }
        }
        if (n + 1 < 32) {
            RT_STORE();
            if (nst >= 1) RT_PUT_ST(st0, sti, std0);
            if (nst == 2) RT_PUT_ST(st1, sti, 1);
        }
        __syncthreads();
    }
#undef RT_MPOS
#undef RT_LOAD
#undef RT_TR4
#undef RT_STORE
#undef RT_PUT_ST
#undef RT_STATE_UPD
}
__global__ void __launch_bounds__(512, 2) k_ret(Ptrs p) {
    extern __shared__ __attribute__((aligned(16))) unsigned char lds[];
    for (int u = blockIdx.x; u < 64; u += gridDim.x) ret_unit(p, (LAS unsigned char*)lds, u >> 3, u & 7);
}

__global__ void __launch_bounds__(256) k_rinv2(Ptrs p) {
    const int lane = threadIdx.x & 63, gw = (blockIdx.x * 256 + threadIdx.x) >> 6, nw = (gridDim.x * 256) >> 6;
    float* R = (float*)(p.ws + WS_RINV2);
    for (int r = gw; r < T; r += nw) {
        float ss = 0.f;
#pragma unroll
        for (int j = 0; j < 4; ++j) { const f32x4 v = *(const f32x4*)(p.out + (size_t)r * D + lane * 4 + 256 * j); ss += v.x * v.x + v.y * v.y + v.z * v.z + v.w * v.w; }
        ss = wave_sum(ss);
        if (lane == 0) R[r] = rsqrtf(ss * (1.f / D) + EPS);
    }
}

__global__ void __launch_bounds__(32) k_peer_select_naive(Ptrs p) {
    __shared__ float sc[256][32];
    __shared__ int ii[32][32];
    const bf16_t* PQ = (const bf16_t*)(p.ws + WS_PQ);
    const float* k1 = p.in[16]; const float* k2 = p.in[17];
    int* SELI = (int*)(p.ws + WS_SELI); float* SELG = (float*)(p.ws + WS_SELG);
    const int tid = threadIdx.x, gid = blockIdx.x * 32 + tid, tok = gid >> 3, hd = gid & 7;
    float q[128];
#pragma unroll
    for (int d = 0; d < 128; d += 8) { float t[8]; ld8(PQ + (size_t)tok * D + hd * 128 + d, t);
#pragma unroll
        for (int j = 0; j < 8; ++j) q[d + j] = t[j]; }
    for (int kk = 0; kk < 128; ++kk) {
        float a = 0.f, b = 0.f;
#pragma unroll
        for (int d = 0; d < 64; ++d) { a += q[d] * k1[kk * 64 + d]; b += q[64 + d] * k2[kk * 64 + d]; }
        sc[kk][tid] = a; sc[128 + kk][tid] = b;
    }
    float v1[16], v2[16];
#pragma unroll
    for (int r = 0; r < 16; ++r) {
        float best = -INFINITY; int bi = 0;
        for (int kk = 0; kk < 128; ++kk) { const float x = sc[kk][tid]; if (x > best) { best = x; bi = kk; } }
        sc[bi][tid] = -INFINITY; v1[r] = best; ii[r][tid] = bi;
        best = -INFINITY; bi = 0;
        for (int kk = 0; kk < 128; ++kk) { const float x = sc[128 + kk][tid]; if (x > best) { best = x; bi = kk; } }
        sc[128 + bi][tid] = -INFINITY; v2[r] = best; ii[16 + r][tid] = bi;
    }
#pragma unroll
    for (int i = 0; i < 16; ++i)
#pragma unroll
        for (int j = 0; j < 16; ++j) sc[i * 16 + j][tid] = v1[i] + v2[j];
    float sv[16]; int se[16];
#pragma unroll
    for (int r = 0; r < 16; ++r) {
        float best = -INFINITY; int bi = 0;
        for (int c = 0; c < 256; ++c) { const float x = sc[c][tid]; if (x > best) { best = x; bi = c; } }
        sc[bi][tid] = -INFINITY; sv[r] = best; se[r] = ii[bi >> 4][tid] * 128 + ii[16 + (bi & 15)][tid];
    }
    float den = 0.f; const float mx = sv[0];
#pragma unroll
    for (int r = 0; r < 16; ++r) { sv[r] = __expf(sv[r] - mx); den += sv[r]; }
    const float id = 1.f / den;
#pragma unroll
    for (int r = 0; r < 16; ++r) { SELI[(size_t)tok * 128 + hd * 16 + r] = se[r]; SELG[(size_t)tok * 128 + hd * 16 + r] = sv[r] * id; }
}

__global__ void __launch_bounds__(256) k_peer_gather_naive(Ptrs p) {
    __shared__ float wk[128];
    const int* SELI = (const int*)(p.ws + WS_SELI); const float* SELG = (const float*)(p.ws + WS_SELG);
    const float* RINV2 = (const float*)(p.ws + WS_RINV2); const float* gffn = p.in[14]; const float* U = p.in[18]; const float* Vt = p.in[19];
    const int tok = blockIdx.x, tid = threadIdx.x, lane = tid & 63, w = tid >> 6;
    const float r2 = RINV2[tok];
    f32x4 xr[4];
#pragma unroll
    for (int j = 0; j < 4; ++j) { const f32x4 hv = *(const f32x4*)(p.out + (size_t)tok * D + lane * 4 + 256 * j); const f32x4 g = *(const f32x4*)(gffn + lane * 4 + 256 * j); xr[j] = hv * g * r2; }
    for (int k = w * 32; k < w * 32 + 32; ++k) {
        const float* up = U + (size_t)SELI[(size_t)tok * 128 + k] * D;
        float dsum = 0.f;
#pragma unroll
        for (int j = 0; j < 4; ++j) { const f32x4 u = *(const f32x4*)(up + lane * 4 + 256 * j); dsum += u.x * xr[j].x + u.y * xr[j].y + u.z * xr[j].z + u.w * xr[j].w; }
        dsum = wave_sum(dsum);
        const float act = 0.5f * dsum * (1.f + erff(dsum * 0.70710678118654752f));
        if (lane == 0) wk[k] = SELG[(size_t)tok * 128 + k] * act;
    }
    __syncthreads();
    f32x4 acc = (f32x4){0.f, 0.f, 0.f, 0.f};
    for (int k = 0; k < 128; ++k) { const f32x4 v = *(const f32x4*)(Vt + (size_t)SELI[(size_t)tok * 128 + k] * D + tid * 4); acc += v * wk[k]; }
    f32x4* op = (f32x4*)(p.out + (size_t)tok * D + tid * 4); *op = *op + acc;
}

#define LAS __attribute__((address_space(3)))
typedef float f32x16 __attribute__((ext_vector_type(16)));
typedef short bf16x8 __attribute__((ext_vector_type(8)));
__device__ __forceinline__ int sortable(int b) { return b ^ ((b >> 31) & 0x7fffffff); }
__device__ __forceinline__ int imax(int a, int b) { return a > b ? a : b; }
__device__ __forceinline__ int imin(int a, int b) { return a < b ? a : b; }
template <int N, int K, int J> __device__ __forceinline__ void bstep(int (&v)[N]) {
#pragma unroll
    for (int i = 0; i < N; ++i) { const int l = i ^ J; if (l > i) { const int a = v[i], b = v[l]; const bool d = (i & K) == 0; v[i] = d ? imax(a, b) : imin(a, b); v[l] = d ? imin(a, b) : imax(a, b); } }
}
template <int N, int K, int J> __device__ __forceinline__ void bstep2(int (&v)[N], int (&q)[N]) {
#pragma unroll
    for (int i = 0; i < N; ++i) { const int l = i ^ J; if (l > i) { const int a = v[i], b = v[l], pa = q[i], pb = q[l]; const bool gt = a > b; const bool d = (i & K) == 0;
        const int hk = gt ? a : b, lk = gt ? b : a, hp = gt ? pa : pb, lp = gt ? pb : pa; v[i] = d ? hk : lk; v[l] = d ? lk : hk; q[i] = d ? hp : lp; q[l] = d ? lp : hp; } }
}
template <int N, int K, int J> struct BMerge { static __device__ __forceinline__ void run(int (&v)[N]) { bstep<N, K, J>(v); if constexpr (J > 1) BMerge<N, K, J / 2>::run(v); }
                                               static __device__ __forceinline__ void run2(int (&v)[N], int (&q)[N]) { bstep2<N, K, J>(v, q); if constexpr (J > 1) BMerge<N, K, J / 2>::run2(v, q); } };
template <int N, int K> struct BSort { static __device__ __forceinline__ void run(int (&v)[N]) { if constexpr (K > 2) BSort<N, K / 2>::run(v); BMerge<N, K, K / 2>::run(v); }
                                       static __device__ __forceinline__ void run2(int (&v)[N], int (&q)[N]) { if constexpr (K > 2) BSort<N, K / 2>::run2(v, q); BMerge<N, K, K / 2>::run2(v, q); } };
__device__ __forceinline__ void top16_merge(const int (&a)[16], const int (&b)[16], int (&o)[16]) {
#pragma unroll
    for (int i = 0; i < 16; ++i) o[i] = imax(a[i], b[15 - i]);
    BMerge<16, 16, 8>::run(o);
}
__device__ __forceinline__ void top16_merge2(const int (&a)[16], const int (&pa)[16], const int (&b)[16], const int (&pb)[16], int (&o)[16], int (&po)[16]) {
#pragma unroll
    for (int i = 0; i < 16; ++i) { const bool gt = a[i] > b[15 - i]; o[i] = gt ? a[i] : b[15 - i]; po[i] = gt ? pa[i] : pb[15 - i]; }
    BMerge<16, 16, 8>::run2(o, po);
}
__device__ __forceinline__ void top16_of_64(const int (&v)[64], int (&o)[16]) {
    int g[4][16];
#pragma unroll
    for (int q = 0; q < 4; ++q) {
#pragma unroll
        for (int i = 0; i < 16; ++i) g[q][i] = v[q * 16 + i];
        BSort<16, 16>::run(g[q]); }
    int m0[16], m1[16]; top16_merge(g[0], g[1], m0); top16_merge(g[2], g[3], m1); top16_merge(m0, m1, o);
}
__device__ __forceinline__ void top16_of_64p(const int (&v)[64], const int (&pv)[64], int (&o)[16], int (&po)[16]) {
    int g[4][16], h[4][16];
#pragma unroll
    for (int q = 0; q < 4; ++q) {
#pragma unroll
        for (int i = 0; i < 16; ++i) { g[q][i] = v[q * 16 + i]; h[q][i] = pv[q * 16 + i]; }
        BSort<16, 16>::run2(g[q], h[q]); }
    int m0[16], p0[16], m1[16], p1[16]; top16_merge2(g[0], h[0], g[1], h[1], m0, p0); top16_merge2(g[2], h[2], g[3], h[3], m1, p1); top16_merge2(m0, p0, m1, p1, o, po);
}
template <int M, int J, int N> __device__ __forceinline__ void cand_one(const int (&am)[8], const float (&f2)[16], const int (&M2)[16], int (&g)[16], int (&h)[16]) {
    const float f1 = __int_as_float(sortable(am[M] & ~0x7f)); g[N] = sortable(__float_as_int(f1 + f2[J])); h[N] = ((am[M] & 0x7f) << 7) | (M2[J] & 0x7f);
}
__device__ __forceinline__ void cand_rest(const int (&am)[8], const float (&f2)[16], const int (&M2)[16], int (&g)[16], int (&h)[16]) {
    cand_one<1, 0, 0>(am, f2, M2, g, h); cand_one<1, 1, 1>(am, f2, M2, g, h); cand_one<1, 2, 2>(am, f2, M2, g, h); cand_one<1, 3, 3>(am, f2, M2, g, h); cand_one<1, 4, 4>(am, f2, M2, g, h);
    cand_one<2, 0, 5>(am, f2, M2, g, h); cand_one<2, 1, 6>(am, f2, M2, g, h); cand_one<2, 2, 7>(am, f2, M2, g, h);
    cand_one<3, 0, 8>(am, f2, M2, g, h); cand_one<3, 1, 9>(am, f2, M2, g, h);
    cand_one<4, 0, 10>(am, f2, M2, g, h); cand_one<5, 0, 11>(am, f2, M2, g, h); cand_one<6, 0, 12>(am, f2, M2, g, h); cand_one<7, 0, 13>(am, f2, M2, g, h);
    g[14] = (int)0x80000000; h[14] = 0; g[15] = (int)0x80000000; h[15] = 0;
}
constexpr int KEY_PITCH = 144;
__device__ __forceinline__ void peer_select_phase(const Ptrs& p, LAS unsigned char* lds, int* SELI, float* SELG, int gw, int nw, int lane) {
    for (int i = threadIdx.x; i < 2 * 128 * 8; i += blockDim.x) { const int side = i >> 10, row = (i >> 3) & 127, ch = i & 7; const float* src = p.in[16 + side] + row * 64 + ch * 8;
        const f32x4 a = *(const f32x4*)src, b = *(const f32x4*)(src + 4); u32x4 w; w.x = pk2(a.x, a.y); w.y = pk2(a.z, a.w); w.z = pk2(b.x, b.y); w.w = pk2(b.z, b.w);
        *(LAS u32x4*)(lds + (side * 128 + row) * KEY_PITCH + ch * 16) = w; }
    __syncthreads();
    const bf16_t* PQ = (const bf16_t*)(p.ws + WS_PQ);
    const int c = lane & 31, hi = lane >> 5;
    for (int task = gw; task < 8192; task += nw) {
        const int tb = task >> 3, head = task & 7, tok = tb * 32 + c;
        int M1[16], M2[16];
#pragma unroll
        for (int side = 0; side < 2; ++side) {
            bf16x8 bq[4];
#pragma unroll
            for (int s = 0; s < 4; ++s) bq[s] = *(const bf16x8*)(PQ + (size_t)tok * D + head * 128 + side * 64 + 16 * s + 8 * hi);
            int L[16];
            {   int g[2][16], m[2][16];
#pragma unroll
                for (int kt = 0; kt < 4; ++kt) {
                    f32x16 acc = {};
#pragma unroll
                    for (int s = 0; s < 4; ++s) { const bf16x8 a = *(const LAS bf16x8*)(lds + (side * 128 + kt * 32 + c) * KEY_PITCH + (16 * s + 8 * hi) * 2);
                        acc = __builtin_amdgcn_mfma_f32_32x32x16_bf16(a, bq[s], acc, 0, 0, 0); }
#pragma unroll
                    for (int r = 0; r < 16; ++r) { const float fv = acc[r]; g[kt & 1][r] = (sortable(__float_as_int(fv)) & ~0x7f) | (kt * 32 + (r & 3) + 8 * (r >> 2) + 4 * hi); }
                    BSort<16, 16>::run(g[kt & 1]);
                    if (kt & 1) top16_merge(g[0], g[1], m[kt >> 1]);
                    __builtin_amdgcn_sched_barrier(0);
                }
                top16_merge(m[0], m[1], L);
            }
            int A_[16], B_[16];
#pragma unroll
            for (int i = 0; i < 16; ++i) { const int pr = __shfl_xor(L[i], 32); A_[i] = hi ? pr : L[i]; B_[i] = hi ? L[i] : pr; }
            if (side == 0) top16_merge(A_, B_, M1); else top16_merge(A_, B_, M2);
            __builtin_amdgcn_sched_barrier(0);
        }
        int K16[16], P16[16];
        {   int am[8];
#pragma unroll
            for (int m = 0; m < 8; ++m) am[m] = M1[2 * m] ^ ((M1[2 * m] ^ M1[2 * m + 1]) & -hi);
            float f2[16];
#pragma unroll
            for (int j = 0; j < 16; ++j) f2[j] = __int_as_float(sortable(M2[j] & ~0x7f));
            int g0[16], h0[16], g1[16], h1[16];
            { const float f1 = __int_as_float(sortable(am[0] & ~0x7f)); const int e1 = (am[0] & 0x7f) << 7;
#pragma unroll
              for (int j = 0; j < 16; ++j) { g0[j] = sortable(__float_as_int(f1 + f2[j])); h0[j] = e1 | (M2[j] & 0x7f); } }
            cand_rest(am, f2, M2, g1, h1);
            BSort<16, 16>::run2(g1, h1);
            int mk[16], mp[16]; top16_merge2(g0, h0, g1, h1, mk, mp);
            int Ak[16], Ap[16], Bk[16], Bp[16];
#pragma unroll
            for (int i = 0; i < 16; ++i) { const int pk = __shfl_xor(mk[i], 32), pp = __shfl_xor(mp[i], 32); Ak[i] = hi ? pk : mk[i]; Bk[i] = hi ? mk[i] : pk; Ap[i] = hi ? pp : mp[i]; Bp[i] = hi ? mp[i] : pp; }
            top16_merge2(Ak, Ap, Bk, Bp, K16, P16);
        }
        float ex[16], den = 0.f; const float mx = __int_as_float(sortable(K16[0]));
#pragma unroll
        for (int r = 0; r < 16; ++r) { ex[r] = __expf(__int_as_float(sortable(K16[r])) - mx); den += ex[r]; }
        const float id = 1.f / den;
        if (hi == 0) { int* ip = SELI + (size_t)tok * 128 + head * 16;
#pragma unroll
            for (int r = 0; r < 16; r += 4) *(u32x4*)(ip + r) = (u32x4){(unsigned)P16[r], (unsigned)P16[r + 1], (unsigned)P16[r + 2], (unsigned)P16[r + 3]}; }
        else { float* gp = SELG + (size_t)tok * 128 + head * 16;
#pragma unroll
            for (int r = 0; r < 16; r += 4) *(f32x4*)(gp + r) = (f32x4){ex[r] * id, ex[r + 1] * id, ex[r + 2] * id, ex[r + 3] * id}; }
    }
}
__global__ void __launch_bounds__(512, 2) k_peer_select(Ptrs p, int alt) {
    extern __shared__ __attribute__((aligned(16))) unsigned char lds[];
    int* si = (int*)(p.ws + (alt ? WS_RET : WS_SELI)); float* sg = (float*)(p.ws + (alt ? WS_RET + (size_t)T * 128 * 4 : WS_SELG));
    peer_select_phase(p, (LAS unsigned char*)lds, si, sg, blockIdx.x * 8 + (threadIdx.x >> 6), gridDim.x * 8, threadIdx.x & 63);
}
__global__ void __launch_bounds__(256) k_peer_select256(Ptrs p, int alt) {
    extern __shared__ __attribute__((aligned(16))) unsigned char lds[];
    int* si = (int*)(p.ws + (alt ? WS_RET : WS_SELI)); float* sg = (float*)(p.ws + (alt ? WS_RET + (size_t)T * 128 * 4 : WS_SELG));
    peer_select_phase(p, (LAS unsigned char*)lds, si, sg, blockIdx.x * 4 + (threadIdx.x >> 6), gridDim.x * 4, threadIdx.x & 63);
}
__global__ void k_dbg_cmp_sel(Ptrs p, int mode) {
    const int gid = blockIdx.x * blockDim.x + threadIdx.x; if (gid >= T * 8) return;
    const int* a = (const int*)(p.ws + WS_SELI) + (size_t)gid * 16; const int* b = (const int*)(p.ws + WS_RET) + (size_t)gid * 16;
    const float* ga = (const float*)(p.ws + WS_SELG) + (size_t)gid * 16; const float* gb = (const float*)(p.ws + WS_RET + (size_t)T * 128 * 4) + (size_t)gid * 16;
    int miss = 0; float gd = 0.f;
    for (int i = 0; i < 16; ++i) { bool f = false; for (int j = 0; j < 16; ++j) f |= (a[i] == b[j]); miss += f ? 0 : 1; gd += fabsf(ga[i] - gb[i]); }
    unsigned* ctl = (unsigned*)(p.ws + WS_CTL);
    if (mode == 0) { if (miss) atomicAdd(ctl, 1u); }
    else if (mode == 1) { if (a[0] != b[0]) atomicAdd(ctl, 1u); }
    else if (mode == 2) { atomicAdd(ctl, (unsigned)miss); }
    else { atomicAdd((float*)ctl + 1, gd); }
}
__global__ void k_dbg_cmp_scores(Ptrs p) {
    const int gid = blockIdx.x * blockDim.x + threadIdx.x; if (gid >= 1024 * 8 * 2 * 128) return;
    const int key = gid & 127, side = (gid >> 7) & 1, head = (gid >> 8) & 7, tok = gid >> 11;
    const bf16_t* PQ = (const bf16_t*)(p.ws + WS_PQ); const float* kk = p.in[16 + side] + key * 64;
    float a = 0.f; for (int d = 0; d < 64; ++d) a += bf2f(PQ[(size_t)tok * D + head * 128 + side * 64 + d]) * kk[d];
    const float b = ((const float*)(p.ws + WS_RET + (size_t)64 * 1024 * 1024))[gid];
#if DBG_SCORES == 2
    atomicAdd((float*)(p.ws + WS_CTL) + 1, fabsf(a - b) > 0.1f ? 1.f : 0.f);
#elif DBG_SCORES == 3
    if (fabsf(a - b) > 0.1f) { atomicAdd((float*)(p.ws + WS_CTL) + 1, (float)((key & 31) + 1) / 32.f); atomicAdd((float*)(p.ws + WS_CTL) + 2, 1.f); }
#elif DBG_SCORES == 4
    if (fabsf(a - b) > 0.1f) { atomicAdd((float*)(p.ws + WS_CTL) + 1, (float)((tok & 31) + 1) / 32.f); atomicAdd((float*)(p.ws + WS_CTL) + 2, 1.f); }
#elif DBG_SCORES == 5
    if (fabsf(a - b) > 0.1f) { atomicAdd((float*)(p.ws + WS_CTL) + 1, fminf(fabsf(b), 10.f) / 10.f); atomicAdd((float*)(p.ws + WS_CTL) + 2, 1.f); }
#else
    atomicAdd((float*)(p.ws + WS_CTL) + 1, fabsf(a - b));
#endif
}
__global__ void k_dbg_scale(Ptrs p, float denom, int mode) {
    const unsigned* ctl = (const unsigned*)(p.ws + WS_CTL);
#if defined(DBG_SCORES) && DBG_SCORES >= 3
    const float m = ((const float*)ctl)[1] / fmaxf(((const float*)ctl)[2], 1.f);
#else
    const float m = mode == 3 ? ((const float*)ctl)[1] / denom : (float)ctl[0] / denom;
#endif
    for (size_t i = (size_t)blockIdx.x * blockDim.x + threadIdx.x; i < (size_t)T * D; i += (size_t)gridDim.x * blockDim.x) p.out[i] *= (1.f + m);
}

typedef __bf16 bf16x2_t __attribute__((ext_vector_type(2)));
__device__ __forceinline__ float dot2bf(unsigned a, unsigned b, float c) { return __builtin_amdgcn_fdot2_f32_bf16(__builtin_bit_cast(bf16x2_t, a), __builtin_bit_cast(bf16x2_t, b), c, false); }
constexpr size_t WS_UB = WS_RQ, WS_VB = WS_RK;
static_assert((size_t)16384 * 1024 * 2 <= WS_RK - WS_RQ && (size_t)16384 * 1024 * 2 <= WS_RV - WS_RK, "peer table overlay");
__device__ __forceinline__ void prep_uv_part(const Ptrs& p, int gtid, int nthr) {
    const size_t n8 = (size_t)16384 * 1024 / 8;
    for (int t = 0; t < 2; ++t) {
        const float* src = p.in[18 + t]; bf16_t* dst = (bf16_t*)(p.ws + (t ? WS_VB : WS_UB));
        for (size_t i = gtid; i < n8; i += nthr) {
            const f32x4 a = *(const f32x4*)(src + i * 8), b = *(const f32x4*)(src + i * 8 + 4);
            u32x4 w; w.x = pk2(a.x, a.y); w.y = pk2(a.z, a.w); w.z = pk2(b.x, b.y); w.w = pk2(b.z, b.w);
            *(u32x4*)(dst + i * 8) = w;
        }
    }
}
__global__ void __launch_bounds__(512) k_prep_uv(Ptrs p) { prep_uv_part(p, blockIdx.x * 512 + threadIdx.x, gridDim.x * 512); }

__device__ __forceinline__ float gelu_erf(float x) { return 0.5f * x * (1.f + erff(x * 0.70710678118654752f)); }
__device__ __forceinline__ float treduce8(const float (&v)[8], int lane) {
    float w[4], x[2], y;
    const bool b0 = lane & 1, b1 = lane & 2, b2 = lane & 4;
#pragma unroll
    for (int i = 0; i < 4; ++i) { const float keep = b0 ? v[2 * i + 1] : v[2 * i], send = b0 ? v[2 * i] : v[2 * i + 1]; w[i] = keep + __shfl_xor(send, 1); }
#pragma unroll
    for (int i = 0; i < 2; ++i) { const float keep = b1 ? w[2 * i + 1] : w[2 * i], send = b1 ? w[2 * i] : w[2 * i + 1]; x[i] = keep + __shfl_xor(send, 2); }
    { const float keep = b2 ? x[1] : x[0], send = b2 ? x[0] : x[1]; y = keep + __shfl_xor(send, 4); }
    y += __shfl_xor(y, 8); y += __shfl_xor(y, 16); y += __shfl_xor(y, 32);
    return y;
}
__device__ __forceinline__ void peer_gather_phase(const Ptrs& p, int gw, int nw, int lane) {
    const int* SELI = (const int*)(p.ws + WS_SELI); const float* SELG = (const float*)(p.ws + WS_SELG);
    const float* RINV2 = (const float*)(p.ws + WS_RINV2); const float* gffn = p.in[14];
    const bf16_t* UB = (const bf16_t*)(p.ws + WS_UB); const bf16_t* VB = (const bf16_t*)(p.ws + WS_VB);
    for (int tok = gw; tok < T; tok += nw) {
        unsigned xp[2][4];
        { const float r2 = RINV2[tok];
#pragma unroll
          for (int j = 0; j < 2; ++j) { const float* hp = p.out + (size_t)tok * D + 512 * j + lane * 8; const float* gp = gffn + 512 * j + lane * 8;
              const f32x4 a = *(const f32x4*)hp, b = *(const f32x4*)(hp + 4), ga = *(const f32x4*)gp, gb = *(const f32x4*)(gp + 4);
              xp[j][0] = pk2(a.x * ga.x * r2, a.y * ga.y * r2); xp[j][1] = pk2(a.z * ga.z * r2, a.w * ga.w * r2);
              xp[j][2] = pk2(b.x * gb.x * r2, b.y * gb.y * r2); xp[j][3] = pk2(b.z * gb.z * r2, b.w * gb.w * r2); } }
        const int i0 = SELI[(size_t)tok * 128 + lane], i1 = SELI[(size_t)tok * 128 + 64 + lane];
        const float g0 = SELG[(size_t)tok * 128 + lane], g1 = SELG[(size_t)tok * 128 + 64 + lane];
        float a0 = 0.f, a1 = 0.f;
#pragma unroll 2
        for (int kb = 0; kb < 16; ++kb) {
            u32x4 r[8][2];
#pragma unroll
            for (int e = 0; e < 8; ++e) { const int k = kb * 8 + e; const int idx = __builtin_amdgcn_readlane(kb < 8 ? i0 : i1, k & 63);
                const bf16_t* up = UB + (size_t)idx * D + lane * 8; r[e][0] = *(const u32x4*)up; r[e][1] = *(const u32x4*)(up + 512); }
            float pz[8];
#pragma unroll
            for (int e = 0; e < 8; ++e) { float s = 0.f;
#pragma unroll
                for (int j = 0; j < 2; ++j) { s = dot2bf(r[e][j].x, xp[j][0], s); s = dot2bf(r[e][j].y, xp[j][1], s); s = dot2bf(r[e][j].z, xp[j][2], s); s = dot2bf(r[e][j].w, xp[j][3], s); }
                pz[e] = s; }
            const float y = treduce8(pz, lane);
            if ((kb & 7) == (lane >> 3)) { if (kb < 8) a0 = y; else a1 = y; }
        }
        const float w0 = g0 * gelu_erf(a0), w1 = g1 * gelu_erf(a1);
        float acc[2][8];
#pragma unroll
        for (int j = 0; j < 2; ++j)
#pragma unroll
            for (int e = 0; e < 8; ++e) acc[j][e] = 0.f;
#pragma unroll 2
        for (int kb = 0; kb < 16; ++kb) {
            u32x4 r[8][2];
#pragma unroll
            for (int e = 0; e < 8; ++e) { const int k = kb * 8 + e; const int idx = __builtin_amdgcn_readlane(kb < 8 ? i0 : i1, k & 63);
                const bf16_t* vp = VB + (size_t)idx * D + lane * 8; r[e][0] = *(const u32x4*)vp; r[e][1] = *(const u32x4*)(vp + 512); }
#pragma unroll
            for (int e = 0; e < 8; ++e) { const int k = kb * 8 + e; const float wk = __builtin_bit_cast(float, __builtin_amdgcn_readlane(__builtin_bit_cast(int, kb < 8 ? w0 : w1), k & 63));
#pragma unroll
                for (int j = 0; j < 2; ++j) {
                    acc[j][0] += wk * bf2f(r[e][j].x & 0xffff); acc[j][1] += wk * __builtin_bit_cast(float, r[e][j].x & 0xffff0000u);
                    acc[j][2] += wk * bf2f(r[e][j].y & 0xffff); acc[j][3] += wk * __builtin_bit_cast(float, r[e][j].y & 0xffff0000u);
                    acc[j][4] += wk * bf2f(r[e][j].z & 0xffff); acc[j][5] += wk * __builtin_bit_cast(float, r[e][j].z & 0xffff0000u);
                    acc[j][6] += wk * bf2f(r[e][j].w & 0xffff); acc[j][7] += wk * __builtin_bit_cast(float, r[e][j].w & 0xffff0000u); } }
        }
#pragma unroll
        for (int j = 0; j < 2; ++j) { float* hp = p.out + (size_t)tok * D + 512 * j + lane * 8;
            f32x4 a = *(const f32x4*)hp, b = *(const f32x4*)(hp + 4);
            a.x += acc[j][0]; a.y += acc[j][1]; a.z += acc[j][2]; a.w += acc[j][3]; b.x += acc[j][4]; b.y += acc[j][5]; b.z += acc[j][6]; b.w += acc[j][7];
            *(f32x4*)hp = a; *(f32x4*)(hp + 4) = b; }
    }
}
__global__ void __launch_bounds__(512, 2) k_peer_gather(Ptrs p) {
    peer_gather_phase(p, blockIdx.x * 8 + (threadIdx.x >> 6), gridDim.x * 8, threadIdx.x & 63);
}

#ifndef USE_REF_GEMM
#define USE_REF_GEMM 0
#endif
template <class Epi> static void launch_gemm(hipStream_t st, const bf16_t* A, int lda, const bf16_t* Bt, int ldb, int M, int N, int K, Epi E) {
    if (USE_REF_GEMM) { hipLaunchKernelGGL(gemm_ref<Epi>, dim3(N / 128, M / 64), dim3(256), 0, st, A, lda, Bt, ldb, K, E); return; }
    static bool attr_done = false;
    if (!attr_done) { (void)hipFuncSetAttribute((const void*)k_gemm<Epi>, hipFuncAttributeMaxDynamicSharedMemorySize, LDS_BYTES); attr_done = true; }
    pg8::Gemm g{A, Bt, lda, ldb, M, N, K, 0};
    hipLaunchKernelGGL(k_gemm<Epi>, dim3(256), dim3(512), LDS_BYTES, st, g, E);
}
extern "C" void kernel_launch(void* const* d_in, const int* in_sizes, int n_in, void* d_out, int out_size, void* d_ws, size_t ws_size, hipStream_t stream) {
    Ptrs p{}; for (int i = 0; i < 20; ++i) p.in[i] = (const float*)d_in[i]; p.out = (float*)d_out; p.ws = (unsigned char*)d_ws;
    unsigned char* ws = p.ws;
    bf16_t *WIN = (bf16_t*)(ws + WS_WIN), *WUQ = (bf16_t*)(ws + WS_WUQ), *WUKV = (bf16_t*)(ws + WS_WUKV), *WMLA = (bf16_t*)(ws + WS_WMLA), *WRET = (bf16_t*)(ws + WS_WRET),
           *WMIX = (bf16_t*)(ws + WS_WMIX), *WPQ = (bf16_t*)(ws + WS_WPQ);
    bf16_t *XB = (bf16_t*)(ws + WS_XB), *LAT = (bf16_t*)(ws + WS_LAT), *RQ = (bf16_t*)(ws + WS_RQ), *RK = (bf16_t*)(ws + WS_RK), *RV = (bf16_t*)(ws + WS_RV), *RG = (bf16_t*)(ws + WS_RG);
    bf16_t *SA = (bf16_t*)d_out, *SR = SA + (size_t)T * 1024;
    bf16_t *Q = (bf16_t*)(ws + WS_Q), *K = (bf16_t*)(ws + WS_K), *V = (bf16_t*)(ws + WS_VRAW), *AO = (bf16_t*)(ws + WS_AO), *RET = (bf16_t*)(ws + WS_RET), *MG = (bf16_t*)(ws + WS_MG),
           *H1B = (bf16_t*)(ws + WS_H1B), *PQ = (bf16_t*)(ws + WS_PQ);
    hipLaunchKernelGGL(k_prep_rows, dim3(1024), dim3(256), 0, stream, p);
    hipLaunchKernelGGL(k_prep_rope, dim3((4112 * 32 + 255) / 256), dim3(256), 0, stream, p);
    hipLaunchKernelGGL(k_prep_w<1>, dim3(NIN / 64, 1024 / 64), dim3(256), 0, stream, p.in[3], p.in[2], WIN, 1024, 5792, NIN);
    hipLaunchKernelGGL(k_prep_w<0>, dim3(768 / 64, 384 / 64), dim3(256), 0, stream, p.in[5], p.in[4], WUQ, 384, 768, 768);
    hipLaunchKernelGGL(k_prep_w<0>, dim3(1024 / 64, 256 / 64), dim3(256), 0, stream, p.in[7], p.in[6], WUKV, 256, 1024, 1024);
    hipLaunchKernelGGL(k_prep_w<0>, dim3(1024 / 64, 512 / 64), dim3(256), 0, stream, p.in[10], (const float*)nullptr, WMLA, 512, 1024, 1024);
    hipLaunchKernelGGL(k_prep_w<0>, dim3(1024 / 64, 1024 / 64), dim3(256), 0, stream, p.in[12], (const float*)nullptr, WRET, 1024, 1024, 1024);
    hipLaunchKernelGGL(k_prep_w<0>, dim3(1024 / 64, 1024 / 64), dim3(256), 0, stream, p.in[13], (const float*)nullptr, WMIX, 1024, 1024, 1024);
    hipLaunchKernelGGL(k_prep_w<0>, dim3(1024 / 64, 1024 / 64), dim3(256), 0, stream, p.in[15], p.in[14], WPQ, 1024, 1024, 1024);
    launch_gemm(stream, XB, 1024, WIN, 1024, MP, NIN, 1024, EpiIn{LAT, RQ, RK, RV, RG, SA, SR, (const float2*)(ws + WS_ROPE32)});
    launch_gemm(stream, LAT, 768, WUQ, 384, T, 768, 384, EpiQraw{Q});
    launch_gemm(stream, LAT + 384, 768, WUKV, 256, MP, 1024, 256, EpiKVraw{K, V});
    hipLaunchKernelGGL(k_finalize, dim3(1024), dim3(256), 0, stream, p);
#ifndef USE_REF_ATTN
#define USE_REF_ATTN 0
#endif
    if (USE_REF_ATTN) hipLaunchKernelGGL(k_attn_naive, dim3(SEQ / 64, 8, BATCH), dim3(64), 0, stream, p);
    else hipLaunchKernelGGL(k_attn, dim3(256), dim3(512), ATT_LDS, stream, p);
#ifndef USE_REF_RET
#define USE_REF_RET 0
#endif
    if (USE_REF_RET) hipLaunchKernelGGL(k_ret_naive, dim3(64), dim3(128), 0, stream, p);
    else { static bool ad = false; if (!ad) { (void)hipFuncSetAttribute((const void*)k_ret, hipFuncAttributeMaxDynamicSharedMemorySize, RT_LDS); ad = true; }
        hipLaunchKernelGGL(k_ret, dim3(64), dim3(512), RT_LDS, stream, p); }
    launch_gemm(stream, AO, 512, WMLA, 512, T, 1024, 512, EpiMerge1{MG, SA});
    launch_gemm(stream, RET, 1024, WRET, 1024, T, 1024, 1024, EpiMerge2{MG, SR});
    launch_gemm(stream, MG, 1024, WMIX, 1024, T, 1024, 1024, EpiMix{p.in[0], p.out, H1B});
    hipLaunchKernelGGL(k_rinv2, dim3(1024), dim3(256), 0, stream, p);
    launch_gemm(stream, H1B, 1024, WPQ, 1024, T, 1024, 1024, EpiPQ{PQ, (const float*)(ws + WS_RINV2)});
#ifndef USE_REF_SELECT
#define USE_REF_SELECT 0
#endif
    if (USE_REF_SELECT) hipLaunchKernelGGL(k_peer_select_naive, dim3(T * 8 / 32), dim3(32), 0, stream, p);
    else hipLaunchKernelGGL(k_peer_select, dim3(256), dim3(512), 2 * 128 * KEY_PITCH, stream, p, 0);
#ifdef DBG_SEL
    hipMemsetAsync(p.ws + WS_CTL, 0, 4096, stream);
    hipLaunchKernelGGL(k_peer_select256, dim3(512), dim3(256), 2 * 128 * KEY_PITCH, stream, p, 1);
    hipLaunchKernelGGL(k_dbg_cmp_sel, dim3(T * 8 / 256), dim3(256), 0, stream, p, DBG_SEL);
#ifdef DBG_SCORES
    hipLaunchKernelGGL(k_dbg_cmp_scores, dim3(1024 * 8 * 2 * 128 / 256), dim3(256), 0, stream, p);
#endif
#endif
#ifndef USE_REF_GATHER
#define USE_REF_GATHER 0
#endif
    if (USE_REF_GATHER) hipLaunchKernelGGL(k_peer_gather_naive, dim3(T), dim3(256), 0, stream, p);
    else { hipLaunchKernelGGL(k_prep_uv, dim3(512), dim3(512), 0, stream, p); hipLaunchKernelGGL(k_peer_gather, dim3(256), dim3(512), 0, stream, p); }
#ifdef DBG_SEL
    hipLaunchKernelGGL(k_dbg_scale, dim3(2048), dim3(256), 0, stream, p, DBG_SEL == 3 ? (float)(1024 * 8 * 2 * 128) : DBG_SEL == 2 ? (float)T * 128 : (float)T * 8, DBG_SEL);
#endif
}
```

```cpp
#include <hip/hip_runtime.h>
#include <stdint.h>
#include <math.h>
#include <utility>

typedef unsigned short bf16_t;
typedef float f32x4 __attribute__((ext_vector_type(4)));
typedef unsigned u32x4 __attribute__((ext_vector_type(4)));

constexpr int D = 1024, BATCH = 8, SEQ = 4096, NMETA = 16;
constexpr int T = BATCH * SEQ;
constexpr int MP = 33024;
constexpr float EPS = 1e-6f;
constexpr int NIN = 5888;
constexpr int C_LAT = 0, C_RQ = 768, C_RK = 1280, C_RV = 1792, C_RG = 2816, C_SA = 3840, C_SR = 4864;
constexpr float QSCALE = 1.4426950408889634f * 0.10206207261596575f;

constexpr size_t al(size_t x) { return (x + 255) & ~(size_t)255; }
constexpr size_t WS_CTL = 0;
constexpr size_t WS_WIN = 1u << 20;
constexpr size_t WS_WUQ = WS_WIN + al((size_t)NIN * 1024 * 2);
constexpr size_t WS_WUKV = WS_WUQ + al((size_t)768 * 384 * 2);
constexpr size_t WS_WMLA = WS_WUKV + al((size_t)1024 * 256 * 2);
constexpr size_t WS_WRET = WS_WMLA + al((size_t)1024 * 512 * 2);
constexpr size_t WS_WMIX = WS_WRET + al((size_t)1024 * 1024 * 2);
constexpr size_t WS_WPQ = WS_WMIX + al((size_t)1024 * 1024 * 2);
constexpr size_t WS_KEYS = WS_WPQ + al((size_t)1024 * 1024 * 2);
constexpr size_t WS_ROPE32 = WS_KEYS + al((size_t)2 * 128 * 64 * 2);
constexpr size_t WS_ROPE16 = WS_ROPE32 + al((size_t)4112 * 32 * 8);
constexpr size_t WS_RINV2 = WS_ROPE16 + al((size_t)4112 * 16 * 8);
constexpr size_t WS_XB = WS_RINV2 + al((size_t)T * 4);
constexpr size_t WS_LAT = WS_XB + al((size_t)MP * 1024 * 2);
constexpr size_t WS_RQ = WS_LAT + al((size_t)MP * 768 * 2);
constexpr size_t WS_RK = WS_RQ + al((size_t)MP * 512 * 2);
constexpr size_t WS_RV = WS_RK + al((size_t)MP * 512 * 2);
constexpr size_t WS_RG = WS_RV + al((size_t)MP * 1024 * 2);
constexpr size_t WS_K = WS_RG + al((size_t)T * 1024 * 2);
constexpr size_t WS_V = WS_K + al((size_t)MP * 768 * 2);
constexpr int VT_LEN = 4160;
constexpr size_t WS_RET = WS_V + al((size_t)64 * 64 * VT_LEN * 2);

constexpr size_t WS_END = WS_RET + al((size_t)T * 1024 * 2);
static_assert(WS_END <= 536870912ull, "workspace map exceeds 512 MiB");
constexpr size_t WS_Q = WS_XB, WS_MG = WS_XB, WS_AO = WS_LAT, WS_H1B = WS_RV, WS_PQ = WS_RG, WS_SELI = WS_RQ, WS_SELG = WS_RQ + (size_t)T * 128 * 4;
static_assert(WS_SELG + (size_t)T * 128 * 4 <= WS_RV, "SEL overlay");
constexpr size_t WS_VRAW = WS_RET, WS_VT = WS_V;
__host__ __device__ __forceinline__ int vt_pos(int tile, int k) { const int x = k & 15; return 64 * tile + (k & 48) + ((x >= 4 && x < 12) ? (x ^ 12) : x); }

__device__ __forceinline__ unsigned f2bf(float f) { unsigned u = __builtin_bit_cast(unsigned, f); return (u + 0x7fffu + ((u >> 16) & 1u)) >> 16; }
__device__ __forceinline__ float bf2f(unsigned h) { return __builtin_bit_cast(float, h << 16); }
__device__ __forceinline__ unsigned pk2(float lo, float hi) { return f2bf(lo) | (f2bf(hi) << 16); }
__device__ __forceinline__ float wave_sum(float v) {
#pragma unroll
    for (int o = 1; o < 64; o <<= 1) v += __shfl_xor(v, o);
    return v;
}
__device__ __forceinline__ int row_pos(int row) { return row < T ? NMETA + (row & (SEQ - 1)) : (row - T < NMETA ? row - T : 0); }
__device__ __forceinline__ float sigmoidf_(float x) { return 1.f / (1.f + __expf(-x)); }

__device__ __forceinline__ int opaque_tid() { int t = threadIdx.x; asm volatile("" : "+v"(t)); return t; }

struct Ptrs {
    const float* in[20];
    float* out;
    unsigned char* ws;
};

__global__ void __launch_bounds__(256) k_prep_rows(Ptrs p) {
    const int lane = threadIdx.x & 63, gw = (blockIdx.x * 256 + threadIdx.x) >> 6, nw = (gridDim.x * 256) >> 6;
    bf16_t* XB = (bf16_t*)(p.ws + WS_XB);
    for (int r = gw; r < MP; r += nw) {
        f32x4 v[4];
        if (r < T + NMETA) {
            const float* src = r < T ? p.in[0] + (size_t)r * D : p.in[1] + (size_t)(r - T) * D;
#pragma unroll
            for (int j = 0; j < 4; ++j) v[j] = *(const f32x4*)(src + lane * 4 + 256 * j);
        } else {
#pragma unroll
            for (int j = 0; j < 4; ++j) v[j] = (f32x4){0.f, 0.f, 0.f, 0.f};
        }
        float ss = 0.f;
#pragma unroll
        for (int j = 0; j < 4; ++j) ss += v[j].x * v[j].x + v[j].y * v[j].y + v[j].z * v[j].z + v[j].w * v[j].w;
        ss = wave_sum(ss);
        const float rinv = rsqrtf(ss * (1.f / D) + EPS);
#pragma unroll
        for (int j = 0; j < 4; ++j) {
            uint2 o; o.x = pk2(v[j].x * rinv, v[j].y * rinv); o.y = pk2(v[j].z * rinv, v[j].w * rinv);
            *(uint2*)(XB + (size_t)r * D + lane * 4 + 256 * j) = o;
        }
    }
}

__device__ __forceinline__ int win_src(int n) {
    if (n < 672) return n;
    if (n < 768) return -1;
    if (n < C_RV) { const int base = n < C_RK ? 672 : 1184, q = (n - (n < C_RK ? C_RQ : C_RK)), hh = q >> 6, pp = q & 63; return base + hh * 64 + (pp >> 1) + 32 * (pp & 1); }
    if (n < C_RG) return 1696 + (n - C_RV);
    if (n < C_SA) return 2720 + (n - C_RG);
    if (n < C_SR) return 3744 + (n - C_SA);
    return 4768 + (n - C_SR);
}
template <int MODE>
__global__ void __launch_bounds__(256) k_prep_w(const float* __restrict__ W, const float* __restrict__ gain, bf16_t* __restrict__ Wt, int K, int Nsrc, int Ndst) {
    __shared__ float tile[64][65];
    const int n0 = blockIdx.x * 64, k0 = blockIdx.y * 64, tx = threadIdx.x & 63, ty = threadIdx.x >> 6;
    const int n = n0 + tx; const int src = MODE == 1 ? win_src(n) : n;
    for (int kk = ty; kk < 64; kk += 4) {
        float v = 0.f;
        if (src >= 0 && n < Ndst) { v = W[(size_t)(k0 + kk) * Nsrc + src]; if (gain) v *= gain[k0 + kk]; }
        tile[kk][tx] = v;
    }
    __syncthreads();
    for (int nn = ty; nn < 64; nn += 4) if (n0 + nn < Ndst) Wt[(size_t)(n0 + nn) * K + k0 + tx] = (bf16_t)f2bf(tile[tx][nn]);
}
__global__ void k_prep_rope(Ptrs p) {
    const int i = blockIdx.x * blockDim.x + threadIdx.x;
    float2* R32 = (float2*)(p.ws + WS_ROPE32); float2* R16 = (float2*)(p.ws + WS_ROPE16);
    if (i < 4112 * 32) { const int pos = i >> 5, f = i & 31; const float inv = (float)pow(10000.0, -(double)f / 32.0); const float ang = (float)pos * inv; R32[i] = make_float2((float)cos((double)ang), (float)sin((double)ang)); }
    if (i < 4112 * 16) { const int pos = i >> 4, f = i & 15; const float inv = (float)pow(10000.0, -(double)f / 16.0); const float ang = (float)pos * inv; R16[i] = make_float2((float)cos((double)ang), (float)sin((double)ang)); }
}

__device__ __forceinline__ void st8(bf16_t* dst, const float (&v)[8]) {
    u32x4 w; w.x = pk2(v[0], v[1]); w.y = pk2(v[2], v[3]); w.z = pk2(v[4], v[5]); w.w = pk2(v[6], v[7]); *(u32x4*)dst = w;
}
struct EpiIn {
    bf16_t *LAT, *RQ, *RK, *RV, *RG, *SA, *SR; const float2* R32;
    __device__ __forceinline__ void apply(int row, int col0, const float (&v)[8]) const {
        if (col0 < C_RQ) { st8(LAT + (size_t)row * 768 + col0, v); return; }
        if (col0 < C_RV) {
            const bool isq = col0 < C_RK; const int c = col0 - (isq ? C_RQ : C_RK); const int i0 = (c & 63) >> 1;
            const int hh = c >> 6, cc = row < T ? (row & 127) : (row - T);
            const float lg = __log2f(1.f - exp2f(-5.f - (float)hh)) * (float)(cc + 1);
            const float2* rp = R32 + row_pos(row) * 32 + i0; const float sc = isq ? exp2f(lg) : 0.125f * exp2f(-lg);
            float o[8];
#pragma unroll
            for (int j = 0; j < 4; ++j) { const float2 cs = rp[j]; const float x1 = v[2 * j], x2 = v[2 * j + 1]; o[2 * j] = (x1 * cs.x - x2 * cs.y) * sc; o[2 * j + 1] = (x1 * cs.y + x2 * cs.x) * sc; }
            st8((isq ? RQ : RK) + (size_t)row * 512 + c, o); return;
        }
        if (col0 < C_RG) { st8(RV + (size_t)row * 1024 + (col0 - C_RV), v); return; }
        if (row >= T) return;
        float o[8];
        if (col0 < C_SA) {
#pragma unroll
            for (int j = 0; j < 8; ++j) o[j] = v[j] * sigmoidf_(v[j]);
            st8(RG + (size_t)row * 1024 + (col0 - C_RG), o); return;
        }
#pragma unroll
        for (int j = 0; j < 8; ++j) o[j] = sigmoidf_(v[j]);
        if (col0 < C_SR) st8(SA + (size_t)row * 1024 + (col0 - C_SA), o); else st8(SR + (size_t)row * 1024 + (col0 - C_SR), o);
    }
};
struct EpiQraw { bf16_t* Q; __device__ __forceinline__ void apply(int row, int col0, const float (&v)[8]) const { st8(Q + (size_t)row * 768 + col0, v); } };
struct EpiKVraw {
    bf16_t *K, *V;
    __device__ __forceinline__ void apply(int row, int col0, const float (&v)[8]) const {
        const int h = col0 >> 7, j = col0 & 127;
        if (j < 64) st8(K + (size_t)row * 768 + h * 96 + j, v); else st8(V + (size_t)row * 512 + h * 64 + (j - 64), v);
    }
};
__device__ __forceinline__ void ld8(const bf16_t* src, float (&o)[8]) {
    const u32x4 w = *(const u32x4*)src;
    o[0] = bf2f(w.x & 0xffff); o[1] = bf2f(w.x >> 16); o[2] = bf2f(w.y & 0xffff); o[3] = bf2f(w.y >> 16);
    o[4] = bf2f(w.z & 0xffff); o[5] = bf2f(w.z >> 16); o[6] = bf2f(w.w & 0xffff); o[7] = bf2f(w.w >> 16);
}
struct EpiMerge1 { bf16_t* MG; const bf16_t* SA;
    __device__ __forceinline__ void apply(int row, int col0, const float (&v)[8]) const {
        float g[8], o[8]; ld8(SA + (size_t)row * 1024 + col0, g);
#pragma unroll
        for (int j = 0; j < 8; ++j) o[j] = g[j] * v[j];
        st8(MG + (size_t)row * 1024 + col0, o); } };
struct EpiMerge2 { bf16_t* MG; const bf16_t* SR;
    __device__ __forceinline__ void apply(int row, int col0, const float (&v)[8]) const {
        float g[8], m[8], o[8]; ld8(SR + (size_t)row * 1024 + col0, g); ld8(MG + (size_t)row * 1024 + col0, m);
#pragma unroll
        for (int j = 0; j < 8; ++j) o[j] = m[j] + g[j] * v[j];
        st8(MG + (size_t)row * 1024 + col0, o); } };
struct EpiMix { const float* x; float* out; bf16_t* H1B; float* SS2;
    __device__ __forceinline__ void apply(int row, int col0, const float (&v)[8]) const {
        const f32x4 a = *(const f32x4*)(x + (size_t)row * D + col0), b = *(const f32x4*)(x + (size_t)row * D + col0 + 4);
        float o[8] = {a.x + v[0], a.y + v[1], a.z + v[2], a.w + v[3], b.x + v[4], b.y + v[5], b.z + v[6], b.w + v[7]};
        *(f32x4*)(out + (size_t)row * D + col0) = (f32x4){o[0], o[1], o[2], o[3]}; *(f32x4*)(out + (size_t)row * D + col0 + 4) = (f32x4){o[4], o[5], o[6], o[7]};
        st8(H1B + (size_t)row * D + col0, o);
        float ss = 0.f;
#pragma unroll
        for (int j = 0; j < 8; ++j) ss += o[j] * o[j];
        atomicAdd(SS2 + row, ss); } };
struct EpiPQ { bf16_t* PQ; const float* SS2;
    __device__ __forceinline__ void apply(int row, int col0, const float (&v)[8]) const {
        const float r = rsqrtf(SS2[row] * (1.f / D) + EPS); float o[8];
#pragma unroll
        for (int j = 0; j < 8; ++j) o[j] = v[j] * r;
        st8(PQ + (size_t)row * D + col0, o); } };

template <class Epi>
__global__ void __launch_bounds__(256) gemm_ref(const bf16_t* __restrict__ A, int lda, const bf16_t* __restrict__ Bt, int ldb, int K, Epi E) {
    __shared__ float As[32][64 + 4];
    __shared__ float Bs[32][128 + 4];
    const int tid = threadIdx.x, tx = tid & 15, ty = tid >> 4;
    const int m0 = blockIdx.y * 64, n0 = blockIdx.x * 128;
    float acc[4][8];
#pragma unroll
    for (int i = 0; i < 4; ++i)
#pragma unroll
        for (int j = 0; j < 8; ++j) acc[i][j] = 0.f;
    for (int k0 = 0; k0 < K; k0 += 32) {
        { const int m = tid & 63, kc = tid >> 6; float t[8]; ld8(A + (size_t)(m0 + m) * lda + k0 + kc * 8, t);
#pragma unroll
          for (int j = 0; j < 8; ++j) As[kc * 8 + j][m] = t[j]; }
#pragma unroll
        for (int i = 0; i < 2; ++i) { const int n = tid & 127, kc = (tid >> 7) + 2 * i; float t[8]; ld8(Bt + (size_t)(n0 + n) * ldb + k0 + kc * 8, t);
#pragma unroll
          for (int j = 0; j < 8; ++j) Bs[kc * 8 + j][n] = t[j]; }
        __syncthreads();
#pragma unroll 8
        for (int kk = 0; kk < 32; ++kk) {
            const f32x4 a = *(const f32x4*)&As[kk][ty * 4]; const f32x4 b0 = *(const f32x4*)&Bs[kk][tx * 8], b1 = *(const f32x4*)&Bs[kk][tx * 8 + 4];
            const float av[4] = {a.x, a.y, a.z, a.w}, bv[8] = {b0.x, b0.y, b0.z, b0.w, b1.x, b1.y, b1.z, b1.w};
#pragma unroll
            for (int i = 0; i < 4; ++i)
#pragma unroll
                for (int j = 0; j < 8; ++j) acc[i][j] += av[i] * bv[j];
        }
        __syncthreads();
    }
#pragma unroll
    for (int i = 0; i < 4; ++i) E.apply(m0 + ty * 4 + i, n0 + tx * 8, acc[i]);
}

namespace pg8 {
#define PG8_LAS __attribute__((address_space(3)))
typedef short bf16x8 __attribute__((ext_vector_type(8)));
constexpr int BM = 256, BK = 64, HALF = 128, HTB = HALF * BK * 2, STAGE_BYTES = 8 * HTB, NXCD = 8, WGM = 8;
__host__ __device__ __forceinline__ int lds_byte(int r, int c) { const int st = (r >> 4) * 2 + (c >> 5), rr = r & 15, cc = c & 31, ob = rr * 64 + cc * 2; return st * 1024 + (ob ^ (((ob >> 9) & 1) << 5)); }
__host__ __device__ __forceinline__ void stage_rc(int b, int& R, int& C) { const int st = b / 1024, sb = b % 1024, swz = sb ^ (((sb >> 9) & 1) << 5); R = (st >> 1) * 16 + swz / 64; C = (st & 1) * 32 + (swz % 64) / 2; }
__host__ __device__ __forceinline__ int perm32(int rho) { const int n = rho >> 4, i = rho & 15; return 8 * (i >> 2) + 4 * n + (i & 3); }
struct Unit { int pm, pn; };
struct Gemm { const bf16_t* A; const bf16_t* Bt; int lda, ldb, M, N, K, pad; };
struct StaticOrder {
    int nM, nN, nwg, G, c;
    __host__ __device__ void init(int M, int N, int G_, int c_) { nM = M / BM; nN = N / BM; nwg = nM * nN; G = G_; c = c_; }
    __host__ __device__ bool next(int i, Unit& u) const {
        const long L = (long)i * G + c; if (L >= nwg) return false;
        int wgid = (int)L; { const int q = nwg / NXCD, r = nwg % NXCD, xcd = wgid % NXCD, off = wgid / NXCD; wgid = (xcd < r ? xcd * (q + 1) : r * (q + 1) + (xcd - r) * q) + off; }
        const int nig = WGM * nN, gid = wgid / nig, fm = gid * WGM, gsz = (nM - fm) < WGM ? (nM - fm) : WGM;
        u.pm = fm + ((wgid % nig) % gsz); u.pn = (wgid % nig) / gsz; return true;
    }
};
template <class Epi>
__device__ __forceinline__ void run_epi(const Epi& E, const f32x4 (&acc)[2][2][4][2], const Unit& u, int wr, int wc, int fr, int fq) {
    const int row0 = u.pm * BM + wr * 64 + fr, col0 = u.pn * BM + wc * 32 + 8 * fq;
#pragma unroll
    for (int ai = 0; ai < 2; ++ai)
#pragma unroll
        for (int m = 0; m < 4; ++m)
#pragma unroll
            for (int bj = 0; bj < 2; ++bj) {
                const f32x4 a = acc[ai][bj][m][0], b = acc[ai][bj][m][1];
                const float v[8] = {a[0], a[1], a[2], a[3], b[0], b[1], b[2], b[3]};
                E.apply(row0 + ai * HALF + m * 16, col0 + bj * HALF, v);
            }
}
template <class Epi>
__device__ __forceinline__ void gemm_phase(PG8_LAS unsigned char* lds, const Gemm g, const StaticOrder& S, const Epi& E) {
    const int tid = opaque_tid(), wid = __builtin_amdgcn_readfirstlane(tid >> 6), lane = tid & 63, wr = wid >> 2, wc = wid & 3, fr = lane & 15, fq = lane >> 4;
    const int K = g.K, nt = K / BK;
    unsigned voffA[2], voffB[2];
#pragma unroll
    for (int i = 0; i < 2; ++i) { int R, C; stage_rc(tid * 16 + i * 8192, R, C); const int Rb = (R & ~31) + perm32(R & 31);
        voffA[i] = (unsigned)(R * g.lda + C) * 2u; voffB[i] = (unsigned)(Rb * g.ldb + C) * 2u; }
    const size_t kstep = (size_t)(BK * 2);
    const size_t hstepA = (size_t)HALF * g.lda * 2, hstepB = (size_t)HALF * g.ldb * 2;
    const size_t tstepA = 2 * hstepA, tstepB = 2 * hstepB;
    const unsigned ldsw = (unsigned)wid * 1024u;
    const int aoff = lds_byte(wr * 64 + fr, fq * 8), boff = lds_byte(wc * 32 + fr, fq * 8);
#define PG8_SA(b, h) (((b) * 2 + (h)) * HTB)
#define PG8_SB(b, h) ((4 + (b) * 2 + (h)) * HTB)
#define PG8_STAGE(bufoff, gbase, voff) do { _Pragma("unroll") for (int _i = 0; _i < 2; ++_i) \
        __builtin_amdgcn_global_load_lds((const unsigned*)((const char*)(gbase) + (voff)[_i]), (PG8_LAS unsigned*)(lds + (bufoff) + ldsw + _i * 8192), 16, 0, 0); } while (0)
#define PG8_LDA(dst, b, h) do { _Pragma("unroll") for (int m = 0; m < 4; ++m) _Pragma("unroll") for (int k = 0; k < 2; ++k) dst[m][k] = *(const PG8_LAS bf16x8*)(lds + PG8_SA(b, h) + aoff + m * 2048 + k * 1024); } while (0)
#define PG8_LDB(dst, b, h) do { _Pragma("unroll") for (int n = 0; n < 2; ++n) _Pragma("unroll") for (int k = 0; k < 2; ++k) dst[n][k] = *(const PG8_LAS bf16x8*)(lds + PG8_SB(b, h) + boff + n * 2048 + k * 1024); } while (0)
#define PG8_MMA(ai, bj, At, Bt) do { __builtin_amdgcn_s_setprio(1); _Pragma("unroll") for (int m = 0; m < 4; ++m) _Pragma("unroll") for (int n = 0; n < 2; ++n) _Pragma("unroll") for (int k = 0; k < 2; ++k) \
        acc[ai][bj][m][n] = __builtin_amdgcn_mfma_f32_16x16x32_bf16(Bt[n][k], At[m][k], acc[ai][bj][m][n], 0, 0, 0); __builtin_amdgcn_s_setprio(0); } while (0)
#define PG8_WAIT_V(n) asm volatile("s_waitcnt vmcnt(" #n ")" ::: "memory")
#define PG8_WAIT_L(n) asm volatile("s_waitcnt lgkmcnt(" #n ")" ::: "memory")
#define PG8_BAR __builtin_amdgcn_s_barrier()
#define PG8_SCHED __builtin_amdgcn_sched_barrier(0)
    Unit cur, nxt; int ui = 0;
    if (!S.next(0, cur)) return;
    f32x4 acc[2][2][4][2];
#pragma unroll
    for (int a = 0; a < 2; ++a)
#pragma unroll
        for (int b = 0; b < 2; ++b)
#pragma unroll
            for (int m = 0; m < 4; ++m)
#pragma unroll
                for (int n = 0; n < 2; ++n) acc[a][b][m][n] = (f32x4){0.f, 0.f, 0.f, 0.f};
    bf16x8 At[4][2], B0[2][2], B1[2][2];
    const char* cA = (const char*)g.A + (size_t)cur.pm * tstepA; const char* cB = (const char*)g.Bt + (size_t)cur.pn * tstepB;
    PG8_STAGE(PG8_SB(0, 0), cB, voffB); PG8_STAGE(PG8_SB(0, 1), cB + hstepB, voffB); PG8_STAGE(PG8_SA(0, 0), cA, voffA); PG8_STAGE(PG8_SA(0, 1), cA + hstepA, voffA);
    if (wr == 1) PG8_BAR;
    PG8_WAIT_V(2); PG8_BAR;
    PG8_STAGE(PG8_SB(1, 0), cB + kstep, voffB); PG8_STAGE(PG8_SA(1, 0), cA + kstep, voffA); PG8_STAGE(PG8_SB(1, 1), cB + hstepB + kstep, voffB);
    PG8_WAIT_V(6); PG8_BAR;
    for (;;) {
        const bool has_next = S.next(ui + 1, nxt);
        const char* nA = has_next ? (const char*)g.A + (size_t)nxt.pm * tstepA : cA; const char* nB = has_next ? (const char*)g.Bt + (size_t)nxt.pn * tstepB : cB;
        for (int t = 0; t < nt; t += 2) {
            const bool last = (t == nt - 2);
            const char* a1 = cA + (size_t)(t + 1) * kstep;
            const char* a2 = last ? nA : cA + (size_t)(t + 2) * kstep; const char* b2 = last ? nB : cB + (size_t)(t + 2) * kstep;
            const char* a3 = a2 + kstep; const char* b3 = b2 + kstep;
            PG8_LDB(B0, 0, 0); PG8_LDB(B1, 0, 1); PG8_SCHED; PG8_LDA(At, 0, 0); PG8_STAGE(PG8_SA(1, 1), a1 + hstepA, voffA);
            PG8_WAIT_V(8); PG8_WAIT_L(0); PG8_BAR; PG8_MMA(0, 0, At, B0); PG8_MMA(0, 1, At, B1); PG8_BAR; PG8_SCHED;
            PG8_LDA(At, 0, 1); PG8_STAGE(PG8_SB(0, 0), b2, voffB); PG8_STAGE(PG8_SB(0, 1), b2 + hstepB, voffB); PG8_STAGE(PG8_SA(0, 0), a2, voffA);
            PG8_WAIT_V(8); PG8_WAIT_L(0); PG8_BAR; PG8_MMA(1, 0, At, B0); PG8_MMA(1, 1, At, B1); PG8_BAR; PG8_SCHED;
            PG8_LDB(B0, 1, 0); PG8_LDB(B1, 1, 1); PG8_SCHED; PG8_LDA(At, 1, 0); PG8_STAGE(PG8_SA(0, 1), a2 + hstepA, voffA);
            PG8_WAIT_V(8); PG8_WAIT_L(0); PG8_BAR; PG8_MMA(0, 0, At, B0); PG8_MMA(0, 1, At, B1); PG8_BAR; PG8_SCHED;
            PG8_LDA(At, 1, 1); PG8_STAGE(PG8_SB(1, 0), b3, voffB); PG8_STAGE(PG8_SB(1, 1), b3 + hstepB, voffB); PG8_STAGE(PG8_SA(1, 0), a3, voffA);
            PG8_WAIT_V(8); PG8_WAIT_L(0); PG8_BAR; PG8_MMA(1, 0, At, B0); PG8_MMA(1, 1, At, B1); PG8_BAR; PG8_SCHED;
        }
        if (wr == 0) PG8_BAR;
        run_epi(E, acc, cur, wr, wc, fr, fq);
        if (!has_next) break;
#pragma unroll
        for (int a = 0; a < 2; ++a)
#pragma unroll
            for (int b = 0; b < 2; ++b)
#pragma unroll
                for (int m = 0; m < 4; ++m)
#pragma unroll
                    for (int n = 0; n < 2; ++n) acc[a][b][m][n] = (f32x4){0.f, 0.f, 0.f, 0.f};
        cur = nxt; cA = nA; cB = nB; ++ui;
        if (wr == 1) PG8_BAR;
    }
    PG8_WAIT_V(0);
    PG8_BAR;
#undef PG8_SA
#undef PG8_SB
#undef PG8_STAGE
#undef PG8_LDA
#undef PG8_LDB
#undef PG8_MMA
#undef PG8_WAIT_V
#undef PG8_WAIT_L
#undef PG8_BAR
#undef PG8_SCHED
}
}

constexpr int LDS_BYTES = 147456;
template <class Epi>
__global__ void __launch_bounds__(512, 2) k_gemm(pg8::Gemm g, Epi E) {
    extern __shared__ __attribute__((aligned(16))) unsigned char lds[];
    pg8::StaticOrder S; S.init(g.M, g.N, gridDim.x, blockIdx.x);
    pg8::gemm_phase<Epi>((PG8_LAS unsigned char*)lds, g, S, E);
}

__device__ __forceinline__ void finalize_phase(const Ptrs& p, int gw, int nw, int lane) {
    const bf16_t* LAT = (const bf16_t*)(p.ws + WS_LAT);
    bf16_t* Q = (bf16_t*)(p.ws + WS_Q); bf16_t* K = (bf16_t*)(p.ws + WS_K); const bf16_t* V = (const bf16_t*)(p.ws + WS_VRAW); bf16_t* VT = (bf16_t*)(p.ws + WS_VT);
    const float2* R16 = (const float2*)(p.ws + WS_ROPE16);
    const float* gq = p.in[8]; const float* gk = p.in[9];
    const int l = lane & 31, hh = lane >> 5;
    for (int r = gw; r < MP; r += nw) {
        const bf16_t* lr = LAT + (size_t)r * 768;
        float sa = 0.f, sb = 0.f;
#pragma unroll
        for (int j = 0; j < 6; ++j) { const float c = bf2f(lr[lane + 64 * j]); sa += c * c; }
#pragma unroll
        for (int j = 0; j < 4; ++j) { const float c = bf2f(lr[384 + lane + 64 * j]); sb += c * c; }
        sa = wave_sum(sa); sb = wave_sum(sb);
        const float alpha = rsqrtf(sa * (1.f / 384.f) + EPS), beta = rsqrtf(sb * (1.f / 256.f) + EPS);
        const float kpe = bf2f(lr[640 + l]);
        const float2 cs = R16[row_pos(r) * 16 + (l & 15)];
        for (int it = 0; it < 4; ++it) {
            const int h = it * 2 + hh;
            if (r < T) {
                bf16_t* qp = Q + (size_t)r * 768 + h * 96;
                float q0 = bf2f(qp[l]) * alpha, q1 = bf2f(qp[32 + l]) * alpha, q2 = bf2f(qp[64 + l]) * alpha;
                float ss = q0 * q0 + q1 * q1 + q2 * q2;
#pragma unroll
                for (int o = 1; o < 32; o <<= 1) ss += __shfl_xor(ss, o);
                const float rq = rsqrtf(ss * (1.f / 96.f) + EPS);
                q0 *= rq * gq[l]; q1 *= rq * gq[32 + l]; q2 *= rq * gq[64 + l];
                const float pr = __shfl_xor(q2, 16);
                const float q2r = (l < 16) ? (q2 * cs.x - pr * cs.y) : (pr * cs.y + q2 * cs.x);
                qp[l] = (bf16_t)f2bf(q0 * QSCALE); qp[32 + l] = (bf16_t)f2bf(q1 * QSCALE); qp[64 + l] = (bf16_t)f2bf(q2r * QSCALE);
            }
            {
                bf16_t* kp = K + (size_t)r * 768 + h * 96;
                float k0 = bf2f(kp[l]) * beta, k1 = bf2f(kp[32 + l]) * beta, k2 = kpe;
                float ss = k0 * k0 + k1 * k1 + k2 * k2;
#pragma unroll
                for (int o = 1; o < 32; o <<= 1) ss += __shfl_xor(ss, o);
                const float rk = rsqrtf(ss * (1.f / 96.f) + EPS);
                k0 *= rk * gk[l]; k1 *= rk * gk[32 + l]; k2 *= rk * gk[64 + l];
                const float pr = __shfl_xor(k2, 16);
                const float k2r = (l < 16) ? (k2 * cs.x - pr * cs.y) : (pr * cs.y + k2 * cs.x);
                kp[l] = (bf16_t)f2bf(k0); kp[32 + l] = (bf16_t)f2bf(k1); kp[64 + l] = (bf16_t)f2bf(k2r);
                const bf16_t* vp = V + (size_t)r * 512 + h * 64;
                const bf16_t v0 = (bf16_t)f2bf(bf2f(vp[l]) * beta), v1 = (bf16_t)f2bf(bf2f(vp[32 + l]) * beta);
                if (r < T) { const int b = r >> 12, sq = r & (SEQ - 1); bf16_t* vt = VT + ((size_t)(b * 8 + h) * 64) * VT_LEN + vt_pos(1 + (sq >> 6), sq & 63);
                    vt[(size_t)l * VT_LEN] = v0; vt[(size_t)(32 + l) * VT_LEN] = v1; }
                else if (r < T + 64) { for (int b = 0; b < BATCH; ++b) { bf16_t* vt = VT + ((size_t)(b * 8 + h) * 64) * VT_LEN + vt_pos(0, r - T);
                    vt[(size_t)l * VT_LEN] = v0; vt[(size_t)(32 + l) * VT_LEN] = v1; } }
            }
        }
    }
}
__global__ void __launch_bounds__(256) k_finalize(Ptrs p) { finalize_phase(p, (blockIdx.x * 256 + threadIdx.x) >> 6, (gridDim.x * 256) >> 6, threadIdx.x & 63); }

__global__ void __launch_bounds__(64) k_attn_naive(Ptrs p) {
    const bf16_t* Q = (const bf16_t*)(p.ws + WS_Q); const bf16_t* K = (const bf16_t*)(p.ws + WS_K); const bf16_t* VT = (const bf16_t*)(p.ws + WS_VT);
    bf16_t* AO = (bf16_t*)(p.ws + WS_AO);
    const int s = blockIdx.x * 64 + threadIdx.x, h = blockIdx.y, b = blockIdx.z;
    const int row = b * SEQ + s;
    float q[96], o[64];
#pragma unroll
    for (int d = 0; d < 96; d += 8) { float t[8]; ld8(Q + (size_t)row * 768 + h * 96 + d, t);
#pragma unroll
        for (int j = 0; j < 8; ++j) q[d + j] = t[j]; }
#pragma unroll
    for (int d = 0; d < 64; ++d) o[d] = 0.f;
    float m = -INFINITY, l = 0.f;
    const int smax = blockIdx.x * 64 + 63;
    for (int j = 0; j < NMETA + smax + 1; ++j) {
        const int krow = j < NMETA ? T + j : b * SEQ + (j - NMETA);
        const bf16_t* kp = K + (size_t)krow * 768 + h * 96;
        const bf16_t* vp = VT + ((size_t)(b * 8 + h) * 64) * VT_LEN + (j < NMETA ? vt_pos(0, j) : vt_pos(1 + ((j - NMETA) >> 6), (j - NMETA) & 63));
        float sc = 0.f;
#pragma unroll
        for (int d = 0; d < 96; d += 8) { float t[8]; ld8(kp + d, t);
#pragma unroll
            for (int jj = 0; jj < 8; ++jj) sc += q[d + jj] * t[jj]; }
        const bool valid = (j < NMETA) || (j - NMETA <= s);
        if (valid) {
            const float mn = fmaxf(m, sc); const float a = exp2f(m - mn), pp = exp2f(sc - mn);
            l = l * a + pp; m = mn;
#pragma unroll
            for (int d = 0; d < 64; ++d) o[d] = o[d] * a + pp * bf2f(vp[(size_t)d * VT_LEN]);
        }
    }
    const float il = 1.f / l;
#pragma unroll
    for (int d = 0; d < 64; d += 8) { float t[8];
#pragma unroll
        for (int jj = 0; jj < 8; ++jj) t[jj] = o[d + jj] * il;
        st8(AO + (size_t)row * 512 + h * 64 + d, t); }
}

#ifndef LAS
#define LAS __attribute__((address_space(3)))
#endif
typedef float f32x16_t __attribute__((ext_vector_type(16)));
typedef short bf16x8_t __attribute__((ext_vector_type(8)));
typedef float f32x2_t __attribute__((ext_vector_type(2)));
typedef __bf16 bf16x2v_t __attribute__((ext_vector_type(2)));
__device__ __forceinline__ unsigned cvtpk(float lo, float hi) { const f32x2_t v = {lo, hi}; return __builtin_bit_cast(unsigned, __builtin_convertvector(v, bf16x2v_t)); }
constexpr int ATT_KP = 208, ATT_VP = 144, ATT_KB = 64 * ATT_KP, ATT_VB = 64 * ATT_VP, ATT_BUF = ATT_KB + ATT_VB, ATT_LDS = 2 * ATT_BUF;
__device__ __forceinline__ void attn_unit(const Ptrs& p, LAS unsigned char* lds, int b, int h, int qb) {
    const bf16_t* Q = (const bf16_t*)(p.ws + WS_Q); const bf16_t* K = (const bf16_t*)(p.ws + WS_K); const bf16_t* VT = (const bf16_t*)(p.ws + WS_VT);
    bf16_t* AO = (bf16_t*)(p.ws + WS_AO);
    const int tid = opaque_tid(), lane = tid & 63, wid = __builtin_amdgcn_readfirstlane(tid >> 6), q = lane & 31, hi = lane >> 5;
    const int s0w = 256 * qb + 32 * wid, sq = s0w + q; const size_t rowq = (size_t)b * SEQ + sq;
    bf16x8_t qf[6];
#pragma unroll
    for (int st = 0; st < 6; ++st) qf[st] = *(const bf16x8_t*)(Q + rowq * 768 + h * 96 + 16 * st + 8 * hi);
    const int NT = 4 * qb + 5;
    const int k0key = tid / 12, k0ch = tid % 12, k1key = (tid + 512) / 12, k1ch = (tid + 512) % 12; const bool k1v = tid < 256;
    const int vd = tid >> 3, vch = tid & 7;
    const bf16_t* vtb = VT + ((size_t)(b * 8 + h) * 64 + vd) * VT_LEN + vch * 8;
    const bf16_t* kb0 = K + (size_t)h * 96 + k0ch * 8; const bf16_t* kb1 = K + (size_t)h * 96 + k1ch * 8;
    u32x4 kr0, kr1 = {}, vr;
#define ATT_KROW(t, key) ((t) == 0 ? (size_t)(T + (key)) : (size_t)b * SEQ + 64 * ((t) - 1) + (key))
#define ATT_LOAD(t) do { kr0 = *(const u32x4*)(kb0 + ATT_KROW(t, k0key) * 768); if (k1v) kr1 = *(const u32x4*)(kb1 + ATT_KROW(t, k1key) * 768); vr = *(const u32x4*)(vtb + 64 * (t)); } while (0)
#define ATT_STORE(buf) do { LAS unsigned char* bb = lds + (buf) * ATT_BUF; *(LAS u32x4*)(bb + k0key * ATT_KP + k0ch * 16) = kr0; if (k1v) *(LAS u32x4*)(bb + k1key * ATT_KP + k1ch * 16) = kr1; \
        *(LAS u32x4*)(bb + ATT_KB + vd * ATT_VP + vch * 16) = vr; } while (0)
    __syncthreads();
    ATT_LOAD(0); ATT_STORE(0); __syncthreads();
    float m = -1e30f, l = 0.f; f32x16_t o0 = {}, o1 = {};
    for (int t = 0; t < NT; ++t) {
        const int cur = t & 1;
        if (t + 1 < NT) ATT_LOAD(t + 1);
        const int ks = 64 * (t - 1);
        if (t == 0 || ks <= s0w + 31) {
            const LAS unsigned char* base = lds + cur * ATT_BUF;
            f32x16_t p0 = {}, p1 = {};
#pragma unroll
            for (int st = 0; st < 6; ++st) {
                const bf16x8_t a0 = *(const LAS bf16x8_t*)(base + q * ATT_KP + (16 * st + 8 * hi) * 2), a1 = *(const LAS bf16x8_t*)(base + (32 + q) * ATT_KP + (16 * st + 8 * hi) * 2);
                p0 = __builtin_amdgcn_mfma_f32_32x32x16_bf16(a0, qf[st], p0, 0, 0, 0); p1 = __builtin_amdgcn_mfma_f32_32x32x16_bf16(a1, qf[st], p1, 0, 0, 0); }
            float s0[16], s1[16];
#pragma unroll
            for (int r = 0; r < 16; ++r) { s0[r] = p0[r]; s1[r] = p1[r]; }
            if (t == 0) {
#pragma unroll
                for (int r = 0; r < 16; ++r) { if ((r & 3) + 8 * (r >> 2) + 4 * hi >= NMETA) s0[r] = -1e30f; s1[r] = -1e30f; }
            } else if (ks + 63 > s0w) {
#pragma unroll
                for (int r = 0; r < 16; ++r) { const int kk = ks + (r & 3) + 8 * (r >> 2) + 4 * hi; if (kk > sq) s0[r] = -1e30f; if (kk + 32 > sq) s1[r] = -1e30f; }
            }
            float mx = fmaxf(s0[0], s1[0]);
#pragma unroll
            for (int r = 1; r < 16; ++r) mx = fmaxf(mx, fmaxf(s0[r], s1[r]));
            mx = fmaxf(mx, __shfl_xor(mx, 32));
            if (__any(mx > m)) { const float mn = fmaxf(m, mx), al = __builtin_amdgcn_exp2f(m - mn); l *= al; m = mn;
#pragma unroll
                for (int r = 0; r < 16; ++r) { o0[r] *= al; o1[r] *= al; } }
            float ps = 0.f;
#pragma unroll
            for (int r = 0; r < 16; ++r) { s0[r] = __builtin_amdgcn_exp2f(s0[r] - m); s1[r] = __builtin_amdgcn_exp2f(s1[r] - m); ps += s0[r] + s1[r]; }
            l += ps;
            u32x4 pb[4];
            pb[0] = (u32x4){cvtpk(s0[0], s0[1]), cvtpk(s0[2], s0[3]), cvtpk(s0[4], s0[5]), cvtpk(s0[6], s0[7])};
            pb[1] = (u32x4){cvtpk(s0[8], s0[9]), cvtpk(s0[10], s0[11]), cvtpk(s0[12], s0[13]), cvtpk(s0[14], s0[15])};
            pb[2] = (u32x4){cvtpk(s1[0], s1[1]), cvtpk(s1[2], s1[3]), cvtpk(s1[4], s1[5]), cvtpk(s1[6], s1[7])};
            pb[3] = (u32x4){cvtpk(s1[8], s1[9]), cvtpk(s1[10], s1[11]), cvtpk(s1[12], s1[13]), cvtpk(s1[14], s1[15])};
#pragma unroll
            for (int kk = 0; kk < 4; ++kk) {
                const bf16x8_t v0 = *(const LAS bf16x8_t*)(base + ATT_KB + q * ATT_VP + (16 * kk + 8 * hi) * 2), v1 = *(const LAS bf16x8_t*)(base + ATT_KB + (32 + q) * ATT_VP + (16 * kk + 8 * hi) * 2);
                const bf16x8_t pf = __builtin_bit_cast(bf16x8_t, pb[kk]);
                o0 = __builtin_amdgcn_mfma_f32_32x32x16_bf16(v0, pf, o0, 0, 0, 0); o1 = __builtin_amdgcn_mfma_f32_32x32x16_bf16(v1, pf, o1, 0, 0, 0); }
        }
        if (t + 1 < NT) ATT_STORE(cur ^ 1);
        __syncthreads();
    }
    l += __shfl_xor(l, 32);
    const float il = 1.f / l;
    bf16_t* op = AO + rowq * 512 + h * 64 + 4 * hi;
#pragma unroll
    for (int g = 0; g < 4; ++g) {
        const float a0 = o0[4 * g], a1 = o0[4 * g + 1], a2 = o0[4 * g + 2], a3 = o0[4 * g + 3], b0 = o1[4 * g], b1 = o1[4 * g + 1], b2 = o1[4 * g + 2], b3 = o1[4 * g + 3];
        uint2 w0, w1; w0.x = cvtpk(a0 * il, a1 * il); w0.y = cvtpk(a2 * il, a3 * il); w1.x = cvtpk(b0 * il, b1 * il); w1.y = cvtpk(b2 * il, b3 * il);
        *(uint2*)(op + 8 * g) = w0; *(uint2*)(op + 32 + 8 * g) = w1; }
#undef ATT_KROW
#undef ATT_LOAD
#undef ATT_STORE
}
__device__ __forceinline__ void attn_phase(const Ptrs& p, LAS unsigned char* lds, int vcu, int ncu) {
    for (int v = vcu; v < 256; v += ncu) {
        const int bh = v >> 2, s = v & 3;
        attn_unit(p, lds, bh >> 3, bh & 7, 15 - s); attn_unit(p, lds, bh >> 3, bh & 7, 8 + s); attn_unit(p, lds, bh >> 3, bh & 7, 7 - s); attn_unit(p, lds, bh >> 3, bh & 7, s);
    }
}
__global__ void __launch_bounds__(512, 2) k_attn(Ptrs p) {
    extern __shared__ __attribute__((aligned(16))) unsigned char lds[];
    const int G = gridDim.x, bx = blockIdx.x; const int vcu = (G % 8 == 0) ? (bx % 8) * (G / 8) + bx / 8 : bx;
    attn_phase(p, (LAS unsigned char*)lds, vcu, G);
}

__global__ void __launch_bounds__(128) k_ret_naive(Ptrs p) {
    const bf16_t* RQ = (const bf16_t*)(p.ws + WS_RQ); const bf16_t* RK = (const bf16_t*)(p.ws + WS_RK); const bf16_t* RV = (const bf16_t*)(p.ws + WS_RV);
    const bf16_t* RG = (const bf16_t*)(p.ws + WS_RG); bf16_t* RET = (bf16_t*)(p.ws + WS_RET);
    const float* ggn = p.in[11];
    __shared__ float red[2][4];
    const int e = threadIdx.x, h = blockIdx.x & 7, b = blockIdx.x >> 3;
    const float gamma = 1.f - exp2f(-5.f - (float)h);
    float S[64];
#pragma unroll
    for (int d = 0; d < 64; ++d) S[d] = 0.f;
    const float gg = ggn[h * 128 + e];
    const float g128 = exp2f(128.f * __log2f(gamma)), g16 = exp2f(16.f * __log2f(gamma));
    for (int t = 0; t < NMETA + SEQ; ++t) {
        const int row = t < NMETA ? T + t : b * SEQ + (t - NMETA);
        if (t >= NMETA && ((t - NMETA) & 127) == 0) { const float f = t == NMETA ? g16 : g128;
#pragma unroll
            for (int d = 0; d < 64; ++d) S[d] *= f; }
        const bf16_t* qp = RQ + (size_t)row * 512 + h * 64; const bf16_t* kp = RK + (size_t)row * 512 + h * 64;
        const float v = bf2f(RV[(size_t)row * 1024 + h * 128 + e]);
        float y = 0.f;
#pragma unroll
        for (int d = 0; d < 64; d += 8) { float kq[8], qq[8]; ld8(kp + d, kq); ld8(qp + d, qq);
#pragma unroll
            for (int j = 0; j < 8; ++j) { S[d + j] = S[d + j] + kq[j] * v; y += qq[j] * S[d + j]; } }
        if (t >= NMETA) {
            const float s1 = wave_sum(y), s2 = wave_sum(y * y);
            const int buf = t & 1;
            if ((e & 63) == 0) { red[buf][(e >> 6) * 2] = s1; red[buf][(e >> 6) * 2 + 1] = s2; }
            __syncthreads();
            const float mu = (red[buf][0] + red[buf][2]) * (1.f / 128.f); const float ex2 = (red[buf][1] + red[buf][3]) * (1.f / 128.f);
            const float var = fmaxf(ex2 - mu * mu, 0.f);
            const float yn = (y - mu) * rsqrtf(var + EPS) * gg;
            const float g = bf2f(RG[(size_t)row * 1024 + h * 128 + e]);
            RET[(size_t)row * 1024 + h * 128 + e] = (bf16_t)f2bf(g * yn);
        }
    }
}

typedef unsigned u32x2 __attribute__((ext_vector_type(2)));
constexpr int RT_RP = 144, RT_TP = 272;
constexpr int RT_QT = 0, RT_KT = 128 * RT_RP, RT_KTT = RT_KT + 128 * RT_RP, RT_VTT = RT_KTT + 64 * RT_TP, RT_ST = RT_VTT + 128 * RT_TP, RT_STAT = RT_ST + 128 * RT_RP, RT_LDS = RT_STAT + 8 * 32 * 8;
static_assert(RT_LDS <= 147456, "retention LDS");
__device__ __forceinline__ void ret_unit(const Ptrs& p, LAS unsigned char* lds, int b, int h) {
    const bf16_t* RQ = (const bf16_t*)(p.ws + WS_RQ); const bf16_t* RK = (const bf16_t*)(p.ws + WS_RK); const bf16_t* RV = (const bf16_t*)(p.ws + WS_RV);
    const bf16_t* RG = (const bf16_t*)(p.ws + WS_RG); bf16_t* RET = (bf16_t*)(p.ws + WS_RET); const float* ggn = p.in[11];
    const int tid = opaque_tid(), lane = tid & 63, wid = __builtin_amdgcn_readfirstlane(tid >> 6), c = lane & 31, hi = lane >> 5;
    const int j = wid >> 1, ih = wid & 1;
    const float lgam = __log2f(1.f - exp2f(-5.f - (float)h)); const float g128 = exp2f(128.f * lgam), g16 = exp2f(16.f * lgam);
    const int nst = wid < 2 ? 2 : (wid < 6 ? 1 : 0);
    const int sti = wid < 2 ? wid : 2 + ((wid - 2) >> 1), std0 = wid < 2 ? 0 : ((wid - 2) & 1);
    f32x16_t st0 = {}, st1 = {};
    const int q_row0 = tid >> 3, q_ch = tid & 7;
    const int k_rb = tid >> 4, k_db = tid & 15;
    const int v_rb0 = tid >> 5, v_eb = tid & 31;
    u32x4 pq[2]; u32x2 pk[4], pv[2][4];
#define RT_MPOS(rb) (16 * ((rb) >> 2) + 4 * ((((rb) & 3) == 1) ? 2 : ((((rb) & 3) == 2) ? 1 : ((rb) & 3))))
#define RT_LOAD(R0) do { \
        pq[0] = *(const u32x4*)(RQ + (size_t)((R0) + q_row0) * 512 + h * 64 + q_ch * 8); pq[1] = *(const u32x4*)(RQ + (size_t)((R0) + q_row0 + 64) * 512 + h * 64 + q_ch * 8); \
        _Pragma("unroll") for (int i_ = 0; i_ < 4; ++i_) pk[i_] = *(const u32x2*)(RK + (size_t)((R0) + 4 * k_rb + i_) * 512 + h * 64 + 4 * k_db); \
        _Pragma("unroll") for (int u_ = 0; u_ < 2; ++u_) _Pragma("unroll") for (int i_ = 0; i_ < 4; ++i_) pv[u_][i_] = *(const u32x2*)(RV + (size_t)((R0) + 4 * (v_rb0 + 16 * u_) + i_) * 1024 + h * 128 + 4 * v_eb); } while (0)
#define RT_TR4(src, dstbase, colbase, pitch, mpos) do { \
        const unsigned a0_ = src[0].x, a1_ = src[1].x, a2_ = src[2].x, a3_ = src[3].x, b0_ = src[0].y, b1_ = src[1].y, b2_ = src[2].y, b3_ = src[3].y; \
        u32x2 t_; \
        t_.x = (a0_ & 0xffffu) | (a1_ << 16); t_.y = (a2_ & 0xffffu) | (a3_ << 16); *(LAS u32x2*)(lds + (dstbase) + ((colbase) + 0) * (pitch) + (mpos) * 2) = t_; \
        t_.x = (a0_ >> 16) | (a1_ & 0xffff0000u); t_.y = (a2_ >> 16) | (a3_ & 0xffff0000u); *(LAS u32x2*)(lds + (dstbase) + ((colbase) + 1) * (pitch) + (mpos) * 2) = t_; \
        t_.x = (b0_ & 0xffffu) | (b1_ << 16); t_.y = (b2_ & 0xffffu) | (b3_ << 16); *(LAS u32x2*)(lds + (dstbase) + ((colbase) + 2) * (pitch) + (mpos) * 2) = t_; \
        t_.x = (b0_ >> 16) | (b1_ & 0xffff0000u); t_.y = (b2_ >> 16) | (b3_ & 0xffff0000u); *(LAS u32x2*)(lds + (dstbase) + ((colbase) + 3) * (pitch) + (mpos) * 2) = t_; } while (0)
#define RT_STORE() do { \
        *(LAS u32x4*)(lds + RT_QT + q_row0 * RT_RP + q_ch * 16) = pq[0]; *(LAS u32x4*)(lds + RT_QT + (q_row0 + 64) * RT_RP + q_ch * 16) = pq[1]; \
        _Pragma("unroll") for (int i_ = 0; i_ < 4; ++i_) *(LAS u32x2*)(lds + RT_KT + (4 * k_rb + i_) * RT_RP + k_db * 8) = pk[i_]; \
        RT_TR4(pk, RT_KTT, 4 * k_db, RT_TP, RT_MPOS(k_rb)); \
        RT_TR4(pv[0], RT_VTT, 4 * v_eb, RT_TP, RT_MPOS(v_rb0)); RT_TR4(pv[1], RT_VTT, 4 * v_eb, RT_TP, RT_MPOS(v_rb0 + 16)); } while (0)
#define RT_PUT_ST(acc, it, dt) do { _Pragma("unroll") for (int r_ = 0; r_ < 16; ++r_) { const float v_ = acc[r_]; \
        *(LAS bf16_t*)(lds + RT_ST + (32 * (it) + (r_ & 3) + 8 * (r_ >> 2) + 4 * hi) * RT_RP + (32 * (dt) + c) * 2) = (bf16_t)f2bf(v_); } } while (0)
#define RT_STATE_UPD(acc, it, dt) do { _Pragma("unroll") for (int ks_ = 0; ks_ < 8; ++ks_) { \
        const bf16x8_t a_ = *(const LAS bf16x8_t*)(lds + RT_VTT + (32 * (it) + c) * RT_TP + (16 * ks_ + 8 * hi) * 2); \
        const bf16x8_t b_ = *(const LAS bf16x8_t*)(lds + RT_KTT + (32 * (dt) + c) * RT_TP + (16 * ks_ + 8 * hi) * 2); \
        acc = __builtin_amdgcn_mfma_f32_32x32x16_bf16(a_, b_, acc, 0, 0, 0); } } while (0)
    __syncthreads();
    RT_LOAD(T); RT_STORE(); __syncthreads();
    RT_LOAD(b * SEQ);
    if (nst >= 1) { RT_STATE_UPD(st0, sti, std0);
#pragma unroll
        for (int r = 0; r < 16; ++r) st0[r] *= g16; }
    if (nst == 2) { RT_STATE_UPD(st1, sti, 1);
#pragma unroll
        for (int r = 0; r < 16; ++r) st1[r] *= g16; }
    __syncthreads();
    RT_STORE();
    if (nst >= 1) RT_PUT_ST(st0, sti, std0);
    if (nst == 2) RT_PUT_ST(st1, sti, 1);
    __syncthreads();
    for (int n = 0; n < 32; ++n) {
        const int R0 = b * SEQ + 128 * n;
        if (n + 1 < 32) RT_LOAD(R0 + 128);
        bf16x8_t qf[4];
#pragma unroll
        for (int s4 = 0; s4 < 4; ++s4) qf[s4] = *(const LAS bf16x8_t*)(lds + RT_QT + (32 * j + c) * RT_RP + (16 * s4 + 8 * hi) * 2);
        f32x16_t y0 = {}, y1 = {};
#pragma unroll
        for (int s4 = 0; s4 < 4; ++s4) {
            const bf16x8_t a0 = *(const LAS bf16x8_t*)(lds + RT_ST + (64 * ih + c) * RT_RP + (16 * s4 + 8 * hi) * 2), a1 = *(const LAS bf16x8_t*)(lds + RT_ST + (64 * ih + 32 + c) * RT_RP + (16 * s4 + 8 * hi) * 2);
            y0 = __builtin_amdgcn_mfma_f32_32x32x16_bf16(a0, qf[s4], y0, 0, 0, 0); y1 = __builtin_amdgcn_mfma_f32_32x32x16_bf16(a1, qf[s4], y1, 0, 0, 0); }
        for (int a = 0; a <= j; ++a) {
            f32x16_t pa = {};
#pragma unroll
            for (int s4 = 0; s4 < 4; ++s4) { const bf16x8_t ka = *(const LAS bf16x8_t*)(lds + RT_KT + (32 * a + c) * RT_RP + (16 * s4 + 8 * hi) * 2);
                pa = __builtin_amdgcn_mfma_f32_32x32x16_bf16(ka, qf[s4], pa, 0, 0, 0); }
            float sv[16];
#pragma unroll
            for (int r = 0; r < 16; ++r) { const float v_ = pa[r]; sv[r] = (a == j && ((r & 3) + 8 * (r >> 2) + 4 * hi) > c) ? 0.f : v_; }
            u32x4 pb[2];
            pb[0] = (u32x4){cvtpk(sv[0], sv[1]), cvtpk(sv[2], sv[3]), cvtpk(sv[4], sv[5]), cvtpk(sv[6], sv[7])};
            pb[1] = (u32x4){cvtpk(sv[8], sv[9]), cvtpk(sv[10], sv[11]), cvtpk(sv[12], sv[13]), cvtpk(sv[14], sv[15])};
#pragma unroll
            for (int t2 = 0; t2 < 2; ++t2) {
                const bf16x8_t v0 = *(const LAS bf16x8_t*)(lds + RT_VTT + (64 * ih + c) * RT_TP + (32 * a + 16 * t2 + 8 * hi) * 2), v1 = *(const LAS bf16x8_t*)(lds + RT_VTT + (64 * ih + 32 + c) * RT_TP + (32 * a + 16 * t2 + 8 * hi) * 2);
                const bf16x8_t pf = __builtin_bit_cast(bf16x8_t, pb[t2]);
                y0 = __builtin_amdgcn_mfma_f32_32x32x16_bf16(v0, pf, y0, 0, 0, 0); y1 = __builtin_amdgcn_mfma_f32_32x32x16_bf16(v1, pf, y1, 0, 0, 0); }
        }
        if (nst >= 1) { RT_STATE_UPD(st0, sti, std0);
#pragma unroll
            for (int r = 0; r < 16; ++r) st0[r] *= g128; }
        if (nst == 2) { RT_STATE_UPD(st1, sti, 1);
#pragma unroll
            for (int r = 0; r < 16; ++r) st1[r] *= g128; }
        float s1 = 0.f, s2 = 0.f;
#pragma unroll
        for (int r = 0; r < 16; ++r) { const float a_ = y0[r], b_ = y1[r]; s1 += a_ + b_; s2 += a_ * a_ + b_ * b_; }
        s1 += __shfl_xor(s1, 32); s2 += __shfl_xor(s2, 32);
        if (hi == 0) *(LAS f32x2_t*)(lds + RT_STAT + (wid * 32 + c) * 8) = (f32x2_t){s1, s2};
        __syncthreads();
        { const f32x2_t o = *(const LAS f32x2_t*)(lds + RT_STAT + ((wid ^ 1) * 32 + c) * 8); s1 += o.x; s2 += o.y; }
        const float mu = s1 * (1.f / 128.f), var = fmaxf(s2 * (1.f / 128.f) - mu * mu, 0.f), rstd = rsqrtf(var + EPS);
        {
            const size_t row = (size_t)R0 + 32 * j + c;
#pragma unroll
            for (int i2 = 0; i2 < 2; ++i2)
#pragma unroll
                for (int g = 0; g < 4; ++g) {
                    const int e = 64 * ih + 32 * i2 + 8 * g + 4 * hi;
                    const u32x2 gw = *(const u32x2*)(RG + row * 1024 + h * 128 + e); const f32x4 gn = *(const f32x4*)(ggn + h * 128 + e);
                    float yv[4];
#pragma unroll
                    for (int x = 0; x < 4; ++x) yv[x] = i2 == 0 ? y0[4 * g + x] : y1[4 * g + x];
                    const float o0 = (yv[0] - mu) * rstd * gn.x * bf2f(gw.x & 0xffff), o1 = (yv[1] - mu) * rstd * gn.y * bf2f(gw.x >> 16);
                    const float o2 = (yv[2] - mu) * rstd * gn.z * bf2f(gw.y & 0xffff), o3 = (yv[3] - mu) * rstd * gn.w * bf2f(gw.y >> 16);
                    u32x2 ow; ow.x = cvtpk(o0, o1); ow.y = cvtpk(o2, o3);
                    *(u32x2*)(RET + row * 1024 + h * 128 + e) = ow;
                }
        }
        if (n + 1 < 32) {
            RT_STORE();
            if (nst >= 1) RT_PUT_ST(st0, sti, std0);
            if (nst == 2) RT_PUT_ST(st1, sti, 1);
        }
        __syncthreads();
    }
#undef RT_MPOS
#undef RT_LOAD
#undef RT_TR4
#undef RT_STORE
#undef RT_PUT_ST
#undef RT_STATE_UPD
}
__global__ void __launch_bounds__(512, 2) k_ret(Ptrs p) {
    extern __shared__ __attribute__((aligned(16))) unsigned char lds[];
    for (int u = blockIdx.x; u < 64; u += gridDim.x) ret_unit(p, (LAS unsigned char*)lds, u >> 3, u & 7);
}

__global__ void __launch_bounds__(256) k_zero_ss2(Ptrs p) {
    float* R = (float*)(p.ws + WS_RINV2);
    for (int i = blockIdx.x * 256 + threadIdx.x; i < T; i += gridDim.x * 256) R[i] = 0.f;
}

__global__ void __launch_bounds__(32) k_peer_select_naive(Ptrs p) {
    __shared__ float sc[256][32];
    __shared__ int ii[32][32];
    const bf16_t* PQ = (const bf16_t*)(p.ws + WS_PQ);
    const float* k1 = p.in[16]; const float* k2 = p.in[17];
    int* SELI = (int*)(p.ws + WS_SELI); float* SELG = (float*)(p.ws + WS_SELG);
    const int tid = threadIdx.x, gid = blockIdx.x * 32 + tid, tok = gid >> 3, hd = gid & 7;
    float q[128];
#pragma unroll
    for (int d = 0; d < 128; d += 8) { float t[8]; ld8(PQ + (size_t)tok * D + hd * 128 + d, t);
#pragma unroll
        for (int j = 0; j < 8; ++j) q[d + j] = t[j]; }
    for (int kk = 0; kk < 128; ++kk) {
        float a = 0.f, b = 0.f;
#pragma unroll
        for (int d = 0; d < 64; ++d) { a += q[d] * k1[kk * 64 + d]; b += q[64 + d] * k2[kk * 64 + d]; }
        sc[kk][tid] = a; sc[128 + kk][tid] = b;
    }
    float v1[16], v2[16];
#pragma unroll
    for (int r = 0; r < 16; ++r) {
        float best = -INFINITY; int bi = 0;
        for (int kk = 0; kk < 128; ++kk) { const float x = sc[kk][tid]; if (x > best) { best = x; bi = kk; } }
        sc[bi][tid] = -INFINITY; v1[r] = best; ii[r][tid] = bi;
        best = -INFINITY; bi = 0;
        for (int kk = 0; kk < 128; ++kk) { const float x = sc[128 + kk][tid]; if (x > best) { best = x; bi = kk; } }
        sc[128 + bi][tid] = -INFINITY; v2[r] = best; ii[16 + r][tid] = bi;
    }
#pragma unroll
    for (int i = 0; i < 16; ++i)
#pragma unroll
        for (int j = 0; j < 16; ++j) sc[i * 16 + j][tid] = v1[i] + v2[j];
    float sv[16]; int se[16];
#pragma unroll
    for (int r = 0; r < 16; ++r) {
        float best = -INFINITY; int bi = 0;
        for (int c = 0; c < 256; ++c) { const float x = sc[c][tid]; if (x > best) { best = x; bi = c; } }
        sc[bi][tid] = -INFINITY; sv[r] = best; se[r] = ii[bi >> 4][tid] * 128 + ii[16 + (bi & 15)][tid];
    }
    float den = 0.f; const float mx = sv[0];
#pragma unroll
    for (int r = 0; r < 16; ++r) { sv[r] = __expf(sv[r] - mx); den += sv[r]; }
    const float id = 1.f / den;
#pragma unroll
    for (int r = 0; r < 16; ++r) { SELI[(size_t)tok * 128 + hd * 16 + r] = se[r]; SELG[(size_t)tok * 128 + hd * 16 + r] = sv[r] * id; }
}

__global__ void __launch_bounds__(256) k_peer_gather_naive(Ptrs p) {
    __shared__ float wk[128];
    const int* SELI = (const int*)(p.ws + WS_SELI); const float* SELG = (const float*)(p.ws + WS_SELG);
    const float* RINV2 = (const float*)(p.ws + WS_RINV2); const float* gffn = p.in[14]; const float* U = p.in[18]; const float* Vt = p.in[19];
    const int tok = blockIdx.x, tid = threadIdx.x, lane = tid & 63, w = tid >> 6;
    const float r2 = rsqrtf(RINV2[tok] * (1.f / D) + EPS);
    f32x4 xr[4];
#pragma unroll
    for (int j = 0; j < 4; ++j) { const f32x4 hv = *(const f32x4*)(p.out + (size_t)tok * D + lane * 4 + 256 * j); const f32x4 g = *(const f32x4*)(gffn + lane * 4 + 256 * j); xr[j] = hv * g * r2; }
    for (int k = w * 32; k < w * 32 + 32; ++k) {
        const float* up = U + (size_t)SELI[(size_t)tok * 128 + k] * D;
        float dsum = 0.f;
#pragma unroll
        for (int j = 0; j < 4; ++j) { const f32x4 u = *(const f32x4*)(up + lane * 4 + 256 * j); dsum += u.x * xr[j].x + u.y * xr[j].y + u.z * xr[j].z + u.w * xr[j].w; }
        dsum = wave_sum(dsum);
        const float act = 0.5f * dsum * (1.f + erff(dsum * 0.70710678118654752f));
        if (lane == 0) wk[k] = SELG[(size_t)tok * 128 + k] * act;
    }
    __syncthreads();
    f32x4 acc = (f32x4){0.f, 0.f, 0.f, 0.f};
    for (int k = 0; k < 128; ++k) { const f32x4 v = *(const f32x4*)(Vt + (size_t)SELI[(size_t)tok * 128 + k] * D + tid * 4); acc += v * wk[k]; }
    f32x4* op = (f32x4*)(p.out + (size_t)tok * D + tid * 4); *op = *op + acc;
}

#define LAS __attribute__((address_space(3)))
typedef float f32x16 __attribute__((ext_vector_type(16)));
typedef short bf16x8 __attribute__((ext_vector_type(8)));
__device__ __forceinline__ int sortable(int b) { return b ^ ((b >> 31) & 0x7fffffff); }
__device__ __forceinline__ int imax(int a, int b) { return a > b ? a : b; }
__device__ __forceinline__ int imin(int a, int b) { return a < b ? a : b; }
template <int N, int K, int J> __device__ __forceinline__ void bstep(int (&v)[N]) {
#pragma unroll
    for (int i = 0; i < N; ++i) { const int l = i ^ J; if (l > i) { const int a = v[i], b = v[l]; const bool d = (i & K) == 0; v[i] = d ? imax(a, b) : imin(a, b); v[l] = d ? imin(a, b) : imax(a, b); } }
}
template <int N, int K, int J> __device__ __forceinline__ void bstep2(int (&v)[N], int (&q)[N]) {
#pragma unroll
    for (int i = 0; i < N; ++i) { const int l = i ^ J; if (l > i) { const int a = v[i], b = v[l], pa = q[i], pb = q[l]; const bool gt = a > b; const bool d = (i & K) == 0;
        const int hk = gt ? a : b, lk = gt ? b : a, hp = gt ? pa : pb, lp = gt ? pb : pa; v[i] = d ? hk : lk; v[l] = d ? lk : hk; q[i] = d ? hp : lp; q[l] = d ? lp : hp; } }
}
template <int N, int K, int J> struct BMerge { static __device__ __forceinline__ void run(int (&v)[N]) { bstep<N, K, J>(v); if constexpr (J > 1) BMerge<N, K, J / 2>::run(v); }
                                               static __device__ __forceinline__ void run2(int (&v)[N], int (&q)[N]) { bstep2<N, K, J>(v, q); if constexpr (J > 1) BMerge<N, K, J / 2>::run2(v, q); } };
template <int N, int K> struct BSort { static __device__ __forceinline__ void run(int (&v)[N]) { if constexpr (K > 2) BSort<N, K / 2>::run(v); BMerge<N, K, K / 2>::run(v); }
                                       static __device__ __forceinline__ void run2(int (&v)[N], int (&q)[N]) { if constexpr (K > 2) BSort<N, K / 2>::run2(v, q); BMerge<N, K, K / 2>::run2(v, q); } };
__device__ __forceinline__ void top16_merge(const int (&a)[16], const int (&b)[16], int (&o)[16]) {
#pragma unroll
    for (int i = 0; i < 16; ++i) o[i] = imax(a[i], b[15 - i]);
    BMerge<16, 16, 8>::run(o);
}
__device__ __forceinline__ void top16_merge2(const int (&a)[16], const int (&pa)[16], const int (&b)[16], const int (&pb)[16], int (&o)[16], int (&po)[16]) {
#pragma unroll
    for (int i = 0; i < 16; ++i) { const bool gt = a[i] > b[15 - i]; o[i] = gt ? a[i] : b[15 - i]; po[i] = gt ? pa[i] : pb[15 - i]; }
    BMerge<16, 16, 8>::run2(o, po);
}
__device__ __forceinline__ void top16_of_64(const int (&v)[64], int (&o)[16]) {
    int g[4][16];
#pragma unroll
    for (int q = 0; q < 4; ++q) {
#pragma unroll
        for (int i = 0; i < 16; ++i) g[q][i] = v[q * 16 + i];
        BSort<16, 16>::run(g[q]); }
    int m0[16], m1[16]; top16_merge(g[0], g[1], m0); top16_merge(g[2], g[3], m1); top16_merge(m0, m1, o);
}
__device__ __forceinline__ void top16_of_64p(const int (&v)[64], const int (&pv)[64], int (&o)[16], int (&po)[16]) {
    int g[4][16], h[4][16];
#pragma unroll
    for (int q = 0; q < 4; ++q) {
#pragma unroll
        for (int i = 0; i < 16; ++i) { g[q][i] = v[q * 16 + i]; h[q][i] = pv[q * 16 + i]; }
        BSort<16, 16>::run2(g[q], h[q]); }
    int m0[16], p0[16], m1[16], p1[16]; top16_merge2(g[0], h[0], g[1], h[1], m0, p0); top16_merge2(g[2], h[2], g[3], h[3], m1, p1); top16_merge2(m0, p0, m1, p1, o, po);
}
template <int M, int J, int N> __device__ __forceinline__ void cand_one(const int (&am)[8], const float (&f2)[16], const int (&M2)[16], int (&g)[16], int (&h)[16]) {
    const float f1 = __int_as_float(sortable(am[M] & ~0x7f)); g[N] = sortable(__float_as_int(f1 + f2[J])); h[N] = ((am[M] & 0x7f) << 7) | (M2[J] & 0x7f);
}
__device__ __forceinline__ void cand_rest(const int (&am)[8], const float (&f2)[16], const int (&M2)[16], int (&g)[16], int (&h)[16]) {
    cand_one<1, 0, 0>(am, f2, M2, g, h); cand_one<1, 1, 1>(am, f2, M2, g, h); cand_one<1, 2, 2>(am, f2, M2, g, h); cand_one<1, 3, 3>(am, f2, M2, g, h); cand_one<1, 4, 4>(am, f2, M2, g, h);
    cand_one<2, 0, 5>(am, f2, M2, g, h); cand_one<2, 1, 6>(am, f2, M2, g, h); cand_one<2, 2, 7>(am, f2, M2, g, h);
    cand_one<3, 0, 8>(am, f2, M2, g, h); cand_one<3, 1, 9>(am, f2, M2, g, h);
    cand_one<4, 0, 10>(am, f2, M2, g, h); cand_one<5, 0, 11>(am, f2, M2, g, h); cand_one<6, 0, 12>(am, f2, M2, g, h); cand_one<7, 0, 13>(am, f2, M2, g, h);
    g[14] = (int)0x80000000; h[14] = 0; g[15] = (int)0x80000000; h[15] = 0;
}
constexpr int KEY_PITCH = 144;
__device__ __forceinline__ void peer_keys_to_lds(const Ptrs& p, LAS unsigned char* lds) {
    for (int i = threadIdx.x; i < 2 * 128 * 8; i += blockDim.x) { const int side = i >> 10, row = (i >> 3) & 127, ch = i & 7; const float* src = p.in[16 + side] + row * 64 + ch * 8;
        const f32x4 a = *(const f32x4*)src, b = *(const f32x4*)(src + 4); u32x4 w; w.x = pk2(a.x, a.y); w.y = pk2(a.z, a.w); w.z = pk2(b.x, b.y); w.w = pk2(b.z, b.w);
        *(LAS u32x4*)(lds + (side * 128 + row) * KEY_PITCH + ch * 16) = w; }
}
template <class IP, class GP, class U4P, class F4P>
__device__ __forceinline__ void peer_select_unit(const Ptrs& p, const LAS unsigned char* lds, int tok0, int head, int lane, IP si, GP sg) {
    const bf16_t* PQ = (const bf16_t*)(p.ws + WS_PQ);
    const int c = lane & 31, hi = lane >> 5, tok = tok0 + c;
    {
        int M1[16], M2[16];
#pragma unroll
        for (int side = 0; side < 2; ++side) {
            bf16x8 bq[4];
#pragma unroll
            for (int s = 0; s < 4; ++s) bq[s] = *(const bf16x8*)(PQ + (size_t)tok * D + head * 128 + side * 64 + 16 * s + 8 * hi);
            int L[16];
            {   int g[2][16], m[2][16];
#pragma unroll
                for (int kt = 0; kt < 4; ++kt) {
                    f32x16 acc = {};
#pragma unroll
                    for (int s = 0; s < 4; ++s) { const bf16x8 a = *(const LAS bf16x8*)(lds + (side * 128 + kt * 32 + c) * KEY_PITCH + (16 * s + 8 * hi) * 2);
                        acc = __builtin_amdgcn_mfma_f32_32x32x16_bf16(a, bq[s], acc, 0, 0, 0); }
#pragma unroll
                    for (int r = 0; r < 16; ++r) { const float fv = acc[r]; g[kt & 1][r] = (sortable(__float_as_int(fv)) & ~0x7f) | (kt * 32 + (r & 3) + 8 * (r >> 2) + 4 * hi); }
                    BSort<16, 16>::run(g[kt & 1]);
                    if (kt & 1) top16_merge(g[0], g[1], m[kt >> 1]);
                    __builtin_amdgcn_sched_barrier(0);
                }
                top16_merge(m[0], m[1], L);
            }
            int A_[16], B_[16];
#pragma unroll
            for (int i = 0; i < 16; ++i) { const int pr = __shfl_xor(L[i], 32); A_[i] = hi ? pr : L[i]; B_[i] = hi ? L[i] : pr; }
            if (side == 0) top16_merge(A_, B_, M1); else top16_merge(A_, B_, M2);
            __builtin_amdgcn_sched_barrier(0);
        }
        int K16[16], P16[16];
        {   int am[8];
#pragma unroll
            for (int m = 0; m < 8; ++m) am[m] = M1[2 * m] ^ ((M1[2 * m] ^ M1[2 * m + 1]) & -hi);
            float f2[16];
#pragma unroll
            for (int j = 0; j < 16; ++j) f2[j] = __int_as_float(sortable(M2[j] & ~0x7f));
            int g0[16], h0[16], g1[16], h1[16];
            { const float f1 = __int_as_float(sortable(am[0] & ~0x7f)); const int e1 = (am[0] & 0x7f) << 7;
#pragma unroll
              for (int j = 0; j < 16; ++j) { g0[j] = sortable(__float_as_int(f1 + f2[j])); h0[j] = e1 | (M2[j] & 0x7f); } }
            cand_rest(am, f2, M2, g1, h1);
            BSort<16, 16>::run2(g1, h1);
            int mk[16], mp[16]; top16_merge2(g0, h0, g1, h1, mk, mp);
            int Ak[16], Ap[16], Bk[16], Bp[16];
#pragma unroll
            for (int i = 0; i < 16; ++i) { const int pk = __shfl_xor(mk[i], 32), pp = __shfl_xor(mp[i], 32); Ak[i] = hi ? pk : mk[i]; Bk[i] = hi ? mk[i] : pk; Ap[i] = hi ? pp : mp[i]; Bp[i] = hi ? mp[i] : pp; }
            top16_merge2(Ak, Ap, Bk, Bp, K16, P16);
        }
        float ex[16], den = 0.f; const float mx = __int_as_float(sortable(K16[0]));
#pragma unroll
        for (int r = 0; r < 16; ++r) { ex[r] = __expf(__int_as_float(sortable(K16[r])) - mx); den += ex[r]; }
        const float id = 1.f / den;
        if (hi == 0) { IP ip = si + (size_t)c * 128 + head * 16;
#pragma unroll
            for (int r = 0; r < 16; r += 4) *(U4P)(ip + r) = (u32x4){(unsigned)P16[r], (unsigned)P16[r + 1], (unsigned)P16[r + 2], (unsigned)P16[r + 3]}; }
        else { GP gp = sg + (size_t)c * 128 + head * 16;
#pragma unroll
            for (int r = 0; r < 16; r += 4) *(F4P)(gp + r) = (f32x4){ex[r] * id, ex[r + 1] * id, ex[r + 2] * id, ex[r + 3] * id}; }
    }
}
__device__ __forceinline__ void peer_select_phase(const Ptrs& p, LAS unsigned char* lds, int* SELI, float* SELG, int gw, int nw, int lane) {
    peer_keys_to_lds(p, lds); __syncthreads();
    for (int task = gw; task < 8192; task += nw) { const int tok0 = (task >> 3) * 32; peer_select_unit<int*, float*, u32x4*, f32x4*>(p, lds, tok0, task & 7, lane, SELI + (size_t)tok0 * 128, SELG + (size_t)tok0 * 128); }
}
__global__ void __launch_bounds__(512, 2) k_peer_select(Ptrs p, int alt) {
    extern __shared__ __attribute__((aligned(16))) unsigned char lds[];
    int* si = (int*)(p.ws + (alt ? WS_RET : WS_SELI)); float* sg = (float*)(p.ws + (alt ? WS_RET + (size_t)T * 128 * 4 : WS_SELG));
    peer_select_phase(p, (LAS unsigned char*)lds, si, sg, blockIdx.x * 8 + (threadIdx.x >> 6), gridDim.x * 8, threadIdx.x & 63);
}
__global__ void __launch_bounds__(256) k_peer_select256(Ptrs p, int alt) {
    extern __shared__ __attribute__((aligned(16))) unsigned char lds[];
    int* si = (int*)(p.ws + (alt ? WS_RET : WS_SELI)); float* sg = (float*)(p.ws + (alt ? WS_RET + (size_t)T * 128 * 4 : WS_SELG));
    peer_select_phase(p, (LAS unsigned char*)lds, si, sg, blockIdx.x * 4 + (threadIdx.x >> 6), gridDim.x * 4, threadIdx.x & 63);
}
__global__ void k_dbg_cmp_sel(Ptrs p, int mode) {
    const int gid = blockIdx.x * blockDim.x + threadIdx.x; if (gid >= T * 8) return;
    const int* a = (const int*)(p.ws + WS_SELI) + (size_t)gid * 16; const int* b = (const int*)(p.ws + WS_RET) + (size_t)gid * 16;
    const float* ga = (const float*)(p.ws + WS_SELG) + (size_t)gid * 16; const float* gb = (const float*)(p.ws + WS_RET + (size_t)T * 128 * 4) + (size_t)gid * 16;
    int miss = 0; float gd = 0.f;
    for (int i = 0; i < 16; ++i) { bool f = false; for (int j = 0; j < 16; ++j) f |= (a[i] == b[j]); miss += f ? 0 : 1; gd += fabsf(ga[i] - gb[i]); }
    unsigned* ctl = (unsigned*)(p.ws + WS_CTL);
    if (mode == 0) { if (miss) atomicAdd(ctl, 1u); }
    else if (mode == 1) { if (a[0] != b[0]) atomicAdd(ctl, 1u); }
    else if (mode == 2) { atomicAdd(ctl, (unsigned)miss); }
    else { atomicAdd((float*)ctl + 1, gd); }
}
__global__ void k_dbg_cmp_scores(Ptrs p) {
    const int gid = blockIdx.x * blockDim.x + threadIdx.x; if (gid >= 1024 * 8 * 2 * 128) return;
    const int key = gid & 127, side = (gid >> 7) & 1, head = (gid >> 8) & 7, tok = gid >> 11;
    const bf16_t* PQ = (const bf16_t*)(p.ws + WS_PQ); const float* kk = p.in[16 + side] + key * 64;
    float a = 0.f; for (int d = 0; d < 64; ++d) a += bf2f(PQ[(size_t)tok * D + head * 128 + side * 64 + d]) * kk[d];
    const float b = ((const float*)(p.ws + WS_RET + (size_t)64 * 1024 * 1024))[gid];
#if DBG_SCORES == 2
    atomicAdd((float*)(p.ws + WS_CTL) + 1, fabsf(a - b) > 0.1f ? 1.f : 0.f);
#elif DBG_SCORES == 3
    if (fabsf(a - b) > 0.1f) { atomicAdd((float*)(p.ws + WS_CTL) + 1, (float)((key & 31) + 1) / 32.f); atomicAdd((float*)(p.ws + WS_CTL) + 2, 1.f); }
#elif DBG_SCORES == 4
    if (fabsf(a - b) > 0.1f) { atomicAdd((float*)(p.ws + WS_CTL) + 1, (float)((tok & 31) + 1) / 32.f); atomicAdd((float*)(p.ws + WS_CTL) + 2, 1.f); }
#elif DBG_SCORES == 5
    if (fabsf(a - b) > 0.1f) { atomicAdd((float*)(p.ws + WS_CTL) + 1, fminf(fabsf(b), 10.f) / 10.f); atomicAdd((float*)(p.ws + WS_CTL) + 2, 1.f); }
#else
    atomicAdd((float*)(p.ws + WS_CTL) + 1, fabsf(a - b));
#endif
}
__global__ void k_dbg_scale(Ptrs p, float denom, int mode) {
    const unsigned* ctl = (const unsigned*)(p.ws + WS_CTL);
#if defined(DBG_SCORES) && DBG_SCORES >= 3
    const float m = ((const float*)ctl)[1] / fmaxf(((const float*)ctl)[2], 1.f);
#else
    const float m = mode == 3 ? ((const float*)ctl)[1] / denom : (float)ctl[0] / denom;
#endif
    for (size_t i = (size_t)blockIdx.x * blockDim.x + threadIdx.x; i < (size_t)T * D; i += (size_t)gridDim.x * blockDim.x) p.out[i] *= (1.f + m);
}

typedef __bf16 bf16x2_t __attribute__((ext_vector_type(2)));
__device__ __forceinline__ float dot2bf(unsigned a, unsigned b, float c) { return __builtin_amdgcn_fdot2_f32_bf16(__builtin_bit_cast(bf16x2_t, a), __builtin_bit_cast(bf16x2_t, b), c, false); }
constexpr size_t WS_UB = WS_K, WS_VB = WS_V;
static_assert((size_t)16384 * 1024 * 2 <= WS_V - WS_K && (size_t)16384 * 1024 * 2 <= WS_RET - WS_V, "peer table overlay");
__device__ __forceinline__ void prep_uv_part(const Ptrs& p, int gtid, int nthr) {
    const size_t n8 = (size_t)16384 * 1024 / 8;
    for (int t = 0; t < 2; ++t) {
        const float* src = p.in[18 + t]; bf16_t* dst = (bf16_t*)(p.ws + (t ? WS_VB : WS_UB));
        for (size_t i = gtid; i < n8; i += nthr) {
            const f32x4 a = *(const f32x4*)(src + i * 8), b = *(const f32x4*)(src + i * 8 + 4);
            u32x4 w; w.x = pk2(a.x, a.y); w.y = pk2(a.z, a.w); w.z = pk2(b.x, b.y); w.w = pk2(b.z, b.w);
            *(u32x4*)(dst + i * 8) = w;
        }
    }
}
__global__ void __launch_bounds__(512) k_prep_uv(Ptrs p) { prep_uv_part(p, blockIdx.x * 512 + threadIdx.x, gridDim.x * 512); }

__device__ __forceinline__ float gelu_erf(float x) { return 0.5f * x * (1.f + erff(x * 0.70710678118654752f)); }
__device__ __forceinline__ float treduce8(const float (&v)[8], int lane) {
    float w[4], x[2], y;
    const bool b0 = lane & 1, b1 = lane & 2, b2 = lane & 4;
#pragma unroll
    for (int i = 0; i < 4; ++i) { const float keep = b0 ? v[2 * i + 1] : v[2 * i], send = b0 ? v[2 * i] : v[2 * i + 1]; w[i] = keep + __shfl_xor(send, 1); }
#pragma unroll
    for (int i = 0; i < 2; ++i) { const float keep = b1 ? w[2 * i + 1] : w[2 * i], send = b1 ? w[2 * i] : w[2 * i + 1]; x[i] = keep + __shfl_xor(send, 2); }
    { const float keep = b2 ? x[1] : x[0], send = b2 ? x[0] : x[1]; y = keep + __shfl_xor(send, 4); }
    y += __shfl_xor(y, 8); y += __shfl_xor(y, 16); y += __shfl_xor(y, 32);
    return y;
}
__device__ __forceinline__ void peer_gather_token(const Ptrs& p, int tok, int i0, int i1, float g0, float g1, int lane) {
    const float* RINV2 = (const float*)(p.ws + WS_RINV2); const float* gffn = p.in[14];
    const bf16_t* UB = (const bf16_t*)(p.ws + WS_UB); const bf16_t* VB = (const bf16_t*)(p.ws + WS_VB);
    {
        unsigned xp[2][4];
        { const float r2 = rsqrtf(RINV2[tok] * (1.f / D) + EPS);
#pragma unroll
          for (int j = 0; j < 2; ++j) { const float* hp = p.out + (size_t)tok * D + 512 * j + lane * 8; const float* gp = gffn + 512 * j + lane * 8;
              const f32x4 a = *(const f32x4*)hp, b = *(const f32x4*)(hp + 4), ga = *(const f32x4*)gp, gb = *(const f32x4*)(gp + 4);
              xp[j][0] = pk2(a.x * ga.x * r2, a.y * ga.y * r2); xp[j][1] = pk2(a.z * ga.z * r2, a.w * ga.w * r2);
              xp[j][2] = pk2(b.x * gb.x * r2, b.y * gb.y * r2); xp[j][3] = pk2(b.z * gb.z * r2, b.w * gb.w * r2); } }
        float a0 = 0.f, a1 = 0.f;
#pragma unroll 2
        for (int kb = 0; kb < 16; ++kb) {
            u32x4 r[8][2];
#pragma unroll
            for (int e = 0; e < 8; ++e) { const int k = kb * 8 + e; const int idx = __builtin_amdgcn_readlane(kb < 8 ? i0 : i1, k & 63);
                const bf16_t* up = UB + (size_t)idx * D + lane * 8; r[e][0] = *(const u32x4*)up; r[e][1] = *(const u32x4*)(up + 512); }
            float pz[8];
#pragma unroll
            for (int e = 0; e < 8; ++e) { float s = 0.f;
#pragma unroll
                for (int j = 0; j < 2; ++j) { s = dot2bf(r[e][j].x, xp[j][0], s); s = dot2bf(r[e][j].y, xp[j][1], s); s = dot2bf(r[e][j].z, xp[j][2], s); s = dot2bf(r[e][j].w, xp[j][3], s); }
                pz[e] = s; }
            const float y = treduce8(pz, lane);
            if ((kb & 7) == (lane >> 3)) { if (kb < 8) a0 = y; else a1 = y; }
        }
        const float w0 = g0 * gelu_erf(a0), w1 = g1 * gelu_erf(a1);
        float acc[2][8];
#pragma unroll
        for (int j = 0; j < 2; ++j)
#pragma unroll
            for (int e = 0; e < 8; ++e) acc[j][e] = 0.f;
#pragma unroll 2
        for (int kb = 0; kb < 16; ++kb) {
            u32x4 r[8][2];
#pragma unroll
            for (int e = 0; e < 8; ++e) { const int k = kb * 8 + e; const int idx = __builtin_amdgcn_readlane(kb < 8 ? i0 : i1, k & 63);
                const bf16_t* vp = VB + (size_t)idx * D + lane * 8; r[e][0] = *(const u32x4*)vp; r[e][1] = *(const u32x4*)(vp + 512); }
#pragma unroll
            for (int e = 0; e < 8; ++e) { const int k = kb * 8 + e; const float wk = __builtin_bit_cast(float, __builtin_amdgcn_readlane(__builtin_bit_cast(int, kb < 8 ? w0 : w1), k & 63));
#pragma unroll
                for (int j = 0; j < 2; ++j) {
                    acc[j][0] += wk * bf2f(r[e][j].x & 0xffff); acc[j][1] += wk * __builtin_bit_cast(float, r[e][j].x & 0xffff0000u);
                    acc[j][2] += wk * bf2f(r[e][j].y & 0xffff); acc[j][3] += wk * __builtin_bit_cast(float, r[e][j].y & 0xffff0000u);
                    acc[j][4] += wk * bf2f(r[e][j].z & 0xffff); acc[j][5] += wk * __builtin_bit_cast(float, r[e][j].z & 0xffff0000u);
                    acc[j][6] += wk * bf2f(r[e][j].w & 0xffff); acc[j][7] += wk * __builtin_bit_cast(float, r[e][j].w & 0xffff0000u); } }
        }
#pragma unroll
        for (int j = 0; j < 2; ++j) { float* hp = p.out + (size_t)tok * D + 512 * j + lane * 8;
            f32x4 a = *(const f32x4*)hp, b = *(const f32x4*)(hp + 4);
            a.x += acc[j][0]; a.y += acc[j][1]; a.z += acc[j][2]; a.w += acc[j][3]; b.x += acc[j][4]; b.y += acc[j][5]; b.z += acc[j][6]; b.w += acc[j][7];
            *(f32x4*)hp = a; *(f32x4*)(hp + 4) = b; }
    }
}
__device__ __forceinline__ void peer_gather_phase(const Ptrs& p, int gw, int nw, int lane) {
    const int* SELI = (const int*)(p.ws + WS_SELI); const float* SELG = (const float*)(p.ws + WS_SELG);
    for (int tok = gw; tok < T; tok += nw)
        peer_gather_token(p, tok, SELI[(size_t)tok * 128 + lane], SELI[(size_t)tok * 128 + 64 + lane], SELG[(size_t)tok * 128 + lane], SELG[(size_t)tok * 128 + 64 + lane], lane);
}
__global__ void __launch_bounds__(512, 2) k_peer_gather(Ptrs p) {
    peer_gather_phase(p, blockIdx.x * 8 + (threadIdx.x >> 6), gridDim.x * 8, threadIdx.x & 63);
}

#include <hip/hip_cooperative_groups.h>
namespace cg = cooperative_groups;
constexpr int CW_Q3 = 64;
constexpr int MISC_OFF = LDS_BYTES - 64;

__device__ __forceinline__ void prep_w_tile(const float* __restrict__ W, const float* __restrict__ gain, bf16_t* __restrict__ Wt, int K, int Nsrc, int mode, int tn, int tk, LAS float* tile) {
    const int t_ = opaque_tid(), tx = t_ & 63, ty = t_ >> 6, n0 = tn * 64, k0 = tk * 64, n = n0 + tx; const int src = mode ? win_src(n) : n;
    for (int kk = ty; kk < 64; kk += 8) { float v = 0.f; if (src >= 0) { v = W[(size_t)(k0 + kk) * Nsrc + src]; if (gain) v *= gain[k0 + kk]; } tile[kk * 65 + tx] = v; }
    __syncthreads();
    for (int nn = ty; nn < 64; nn += 8) Wt[(size_t)(n0 + nn) * K + k0 + tx] = (bf16_t)f2bf(tile[tx * 65 + nn]);
    __syncthreads();
}
__device__ __forceinline__ void prep_phase(const Ptrs& p, LAS unsigned char* lds) {
    const int tid = opaque_tid(), lane = tid & 63, G = gridDim.x, bx = blockIdx.x;
    unsigned char* ws = p.ws;
    if (bx == 0 && tid == 0) ((unsigned*)(ws + WS_CTL))[CW_Q3] = 0u;
    { float* R = (float*)(ws + WS_RINV2); for (int i = bx * 512 + tid; i < T; i += G * 512) R[i] = 0.f; }
    {
        float2* R32 = (float2*)(ws + WS_ROPE32); float2* R16 = (float2*)(ws + WS_ROPE16);
        for (int i = bx * 512 + tid; i < 4112 * 32; i += G * 512) {
            { const int pos = i >> 5, f = i & 31; const float inv = (float)pow(10000.0, -(double)f / 32.0); const float ang = (float)pos * inv; R32[i] = make_float2((float)cos((double)ang), (float)sin((double)ang)); }
            if (i < 4112 * 16) { const int pos = i >> 4, f = i & 15; const float inv = (float)pow(10000.0, -(double)f / 16.0); const float ang = (float)pos * inv; R16[i] = make_float2((float)cos((double)ang), (float)sin((double)ang)); } }
    }
    {
        bf16_t* XB = (bf16_t*)(ws + WS_XB);
        for (int r = bx * 8 + (tid >> 6); r < MP; r += G * 8) {
            f32x4 v[4];
            if (r < T + NMETA) { const float* src = r < T ? p.in[0] + (size_t)r * D : p.in[1] + (size_t)(r - T) * D;
#pragma unroll
                for (int j = 0; j < 4; ++j) v[j] = *(const f32x4*)(src + lane * 4 + 256 * j); }
            else {
#pragma unroll
                for (int j = 0; j < 4; ++j) v[j] = (f32x4){0.f, 0.f, 0.f, 0.f}; }
            float ss = 0.f;
#pragma unroll
            for (int j = 0; j < 4; ++j) ss += v[j].x * v[j].x + v[j].y * v[j].y + v[j].z * v[j].z + v[j].w * v[j].w;
            ss = wave_sum(ss);
            const float rinv = rsqrtf(ss * (1.f / D) + EPS);
#pragma unroll
            for (int j = 0; j < 4; ++j) { uint2 o; o.x = pk2(v[j].x * rinv, v[j].y * rinv); o.y = pk2(v[j].z * rinv, v[j].w * rinv); *(uint2*)(XB + (size_t)r * D + lane * 4 + 256 * j) = o; }
        }
    }
    {
        LAS float* tile = (LAS float*)lds;
        constexpr int NT0 = (NIN / 64) * 16, NT1 = NT0 + 12 * 6, NT2 = NT1 + 16 * 4, NT3 = NT2 + 16 * 8, NT4 = NT3 + 256, NT5 = NT4 + 256, NT6 = NT5 + 256;
        for (int it = bx; it < NT6; it += G) {
            if (it < NT0) prep_w_tile(p.in[3], p.in[2], (bf16_t*)(ws + WS_WIN), 1024, 5792, 1, it / 16, it % 16, tile);
            else if (it < NT1) { const int r = it - NT0; prep_w_tile(p.in[5], p.in[4], (bf16_t*)(ws + WS_WUQ), 384, 768, 0, r / 6, r % 6, tile); }
            else if (it < NT2) { const int r = it - NT1; prep_w_tile(p.in[7], p.in[6], (bf16_t*)(ws + WS_WUKV), 256, 1024, 0, r / 4, r % 4, tile); }
            else if (it < NT3) { const int r = it - NT2; prep_w_tile(p.in[10], nullptr, (bf16_t*)(ws + WS_WMLA), 512, 1024, 0, r / 8, r % 8, tile); }
            else if (it < NT4) { const int r = it - NT3; prep_w_tile(p.in[12], nullptr, (bf16_t*)(ws + WS_WRET), 1024, 1024, 0, r / 16, r % 16, tile); }
            else if (it < NT5) { const int r = it - NT4; prep_w_tile(p.in[13], nullptr, (bf16_t*)(ws + WS_WMIX), 1024, 1024, 0, r / 16, r % 16, tile); }
            else { const int r = it - NT5; prep_w_tile(p.in[15], p.in[14], (bf16_t*)(ws + WS_WPQ), 1024, 1024, 0, r / 16, r % 16, tile); }
        }
    }
}
__device__ __forceinline__ void mixer_phase(const Ptrs& p, LAS unsigned char* lds) {
    unsigned* ctl = (unsigned*)(p.ws + WS_CTL);
    volatile LAS unsigned* bc = (volatile LAS unsigned*)(lds + MISC_OFF);
    for (;;) {
        __syncthreads();
        if (threadIdx.x == 0) *bc = __hip_atomic_fetch_add(ctl + CW_Q3, 1u, __ATOMIC_RELAXED, __HIP_MEMORY_SCOPE_AGENT);
        __syncthreads();
        const int it = (int)*bc;
        if (it >= 64 + 1024) break;
        if (it < 64) ret_unit(p, lds, it >> 3, it & 7);
        else { const int a = it - 64, qb = 15 - (a >> 6), bh = a & 63; attn_unit(p, lds, bh >> 3, bh & 7, qb); }
    }
}
constexpr int PL_SELI = 2 * 128 * KEY_PITCH, PL_SELG = PL_SELI + 32 * 128 * 4, PL_END = PL_SELG + 32 * 128 * 4;
static_assert(PL_END <= MISC_OFF, "peer LDS");
__device__ __forceinline__ void peer_phase(const Ptrs& p, LAS unsigned char* lds) {
    const int tid = opaque_tid(), lane = tid & 63, wid = __builtin_amdgcn_readfirstlane(tid >> 6);
    peer_keys_to_lds(p, lds);
    for (int u = blockIdx.x; u < T / 32; u += gridDim.x) {
        __syncthreads();
        peer_select_unit<LAS int*, LAS float*, LAS u32x4*, LAS f32x4*>(p, lds, u * 32, wid, lane, (LAS int*)(lds + PL_SELI), (LAS float*)(lds + PL_SELG));
        __syncthreads();
#pragma unroll 1
        for (int k = 0; k < 4; ++k) { const int tl = wid * 4 + k;
            const LAS int* ip = (const LAS int*)(lds + PL_SELI) + tl * 128; const LAS float* gp = (const LAS float*)(lds + PL_SELG) + tl * 128;
            peer_gather_token(p, u * 32 + tl, ip[lane], ip[64 + lane], gp[lane], gp[64 + lane], lane); }
    }
}

__global__ void __launch_bounds__(512, 2) k_mega(Ptrs p) {
    extern __shared__ __attribute__((aligned(16))) unsigned char lds_raw[];
    LAS unsigned char* lds = (LAS unsigned char*)lds_raw;
    cg::grid_group grid = cg::this_grid();
    unsigned char* ws = p.ws;
    const int G = gridDim.x, bx = blockIdx.x, nw = G * 8;
    bf16_t *WIN = (bf16_t*)(ws + WS_WIN), *WUQ = (bf16_t*)(ws + WS_WUQ), *WUKV = (bf16_t*)(ws + WS_WUKV), *WMLA = (bf16_t*)(ws + WS_WMLA), *WRET = (bf16_t*)(ws + WS_WRET),
           *WMIX = (bf16_t*)(ws + WS_WMIX), *WPQ = (bf16_t*)(ws + WS_WPQ);
    bf16_t *XB = (bf16_t*)(ws + WS_XB), *LAT = (bf16_t*)(ws + WS_LAT), *RQ = (bf16_t*)(ws + WS_RQ), *RK = (bf16_t*)(ws + WS_RK), *RV = (bf16_t*)(ws + WS_RV), *RG = (bf16_t*)(ws + WS_RG);
    bf16_t *SA = (bf16_t*)p.out, *SR = SA + (size_t)T * 1024;
    bf16_t *Q = (bf16_t*)(ws + WS_Q), *K = (bf16_t*)(ws + WS_K), *VRAW = (bf16_t*)(ws + WS_VRAW), *AO = (bf16_t*)(ws + WS_AO), *RET = (bf16_t*)(ws + WS_RET), *MG = (bf16_t*)(ws + WS_MG),
           *H1B = (bf16_t*)(ws + WS_H1B), *PQ = (bf16_t*)(ws + WS_PQ);
    pg8::StaticOrder S;
    prep_phase(p, lds);
    grid.sync();
    { pg8::Gemm g{XB, WIN, 1024, 1024, MP, NIN, 1024, 0}; S.init(MP, NIN, G, bx); pg8::gemm_phase(lds, g, S, EpiIn{LAT, RQ, RK, RV, RG, SA, SR, (const float2*)(ws + WS_ROPE32)}); }
    grid.sync();
    { pg8::Gemm g{LAT, WUQ, 768, 384, T, 768, 384, 0}; S.init(T, 768, G, bx); pg8::gemm_phase(lds, g, S, EpiQraw{Q}); }
    { pg8::Gemm g{LAT + 384, WUKV, 768, 256, MP, 1024, 256, 0}; S.init(MP, 1024, G, bx); pg8::gemm_phase(lds, g, S, EpiKVraw{K, VRAW}); }
    grid.sync();
    { const int t_ = opaque_tid(); finalize_phase(p, bx * 8 + (t_ >> 6), nw, t_ & 63); }
    grid.sync();
    mixer_phase(p, lds);
    grid.sync();
    prep_uv_part(p, bx * 512 + opaque_tid(), G * 512);
    { pg8::Gemm g{AO, WMLA, 512, 512, T, 1024, 512, 0}; S.init(T, 1024, G, bx); pg8::gemm_phase(lds, g, S, EpiMerge1{MG, SA}); }
    { pg8::Gemm g{RET, WRET, 1024, 1024, T, 1024, 1024, 0}; S.init(T, 1024, G, bx); pg8::gemm_phase(lds, g, S, EpiMerge2{MG, SR}); }
    grid.sync();
    { pg8::Gemm g{MG, WMIX, 1024, 1024, T, 1024, 1024, 0}; S.init(T, 1024, G, bx); pg8::gemm_phase(lds, g, S, EpiMix{p.in[0], p.out, H1B, (float*)(ws + WS_RINV2)}); }
    grid.sync();
    { pg8::Gemm g{H1B, WPQ, 1024, 1024, T, 1024, 1024, 0}; S.init(T, 1024, G, bx); pg8::gemm_phase(lds, g, S, EpiPQ{PQ, (const float*)(ws + WS_RINV2)}); }
    grid.sync();
    peer_phase(p, lds);
}

#ifndef USE_REF_GEMM
#define USE_REF_GEMM 0
#endif
template <class Epi> static void launch_gemm(hipStream_t st, const bf16_t* A, int lda, const bf16_t* Bt, int ldb, int M, int N, int K, Epi E) {
    if (USE_REF_GEMM) { hipLaunchKernelGGL(gemm_ref<Epi>, dim3(N / 128, M / 64), dim3(256), 0, st, A, lda, Bt, ldb, K, E); return; }
    static bool attr_done = false;
    if (!attr_done) { (void)hipFuncSetAttribute((const void*)k_gemm<Epi>, hipFuncAttributeMaxDynamicSharedMemorySize, LDS_BYTES); attr_done = true; }
    pg8::Gemm g{A, Bt, lda, ldb, M, N, K, 0};
    hipLaunchKernelGGL(k_gemm<Epi>, dim3(256), dim3(512), LDS_BYTES, st, g, E);
}
#ifndef MEGA
#define MEGA 1
#endif
extern "C" void kernel_launch(void* const* d_in, const int* in_sizes, int n_in, void* d_out, int out_size, void* d_ws, size_t ws_size, hipStream_t stream) {
    Ptrs p{}; for (int i = 0; i < 20; ++i) p.in[i] = (const float*)d_in[i]; p.out = (float*)d_out; p.ws = (unsigned char*)d_ws;
#if MEGA
    static int grid = 0;
    if (grid == 0) {
        int dev = 0, cus = 0, per_cu = 0;
        (void)hipGetDevice(&dev); (void)hipDeviceGetAttribute(&cus, hipDeviceAttributeMultiprocessorCount, dev);
        (void)hipFuncSetAttribute((const void*)k_mega, hipFuncAttributeMaxDynamicSharedMemorySize, LDS_BYTES);
        (void)hipOccupancyMaxActiveBlocksPerMultiprocessor(&per_cu, (const void*)k_mega, 512, LDS_BYTES);
        if (per_cu < 1) per_cu = 1;
        grid = cus * (per_cu > 1 ? 1 : per_cu);
        if (grid % 8) grid -= grid % 8;
    }
    void* args[] = {&p};
    (void)hipLaunchCooperativeKernel((const void*)k_mega, dim3(grid), dim3(512), args, LDS_BYTES, stream);
    return;
#endif
    unsigned char* ws = p.ws;
    bf16_t *WIN = (bf16_t*)(ws + WS_WIN), *WUQ = (bf16_t*)(ws + WS_WUQ), *WUKV = (bf16_t*)(ws + WS_WUKV), *WMLA = (bf16_t*)(ws + WS_WMLA), *WRET = (bf16_t*)(ws + WS_WRET),
           *WMIX = (bf16_t*)(ws + WS_WMIX), *WPQ = (bf16_t*)(ws + WS_WPQ);
    bf16_t *XB = (bf16_t*)(ws + WS_XB), *LAT = (bf16_t*)(ws + WS_LAT), *RQ = (bf16_t*)(ws + WS_RQ), *RK = (bf16_t*)(ws + WS_RK), *RV = (bf16_t*)(ws + WS_RV), *RG = (bf16_t*)(ws + WS_RG);
    bf16_t *SA = (bf16_t*)d_out, *SR = SA + (size_t)T * 1024;
    bf16_t *Q = (bf16_t*)(ws + WS_Q), *K = (bf16_t*)(ws + WS_K), *V = (bf16_t*)(ws + WS_VRAW), *AO = (bf16_t*)(ws + WS_AO), *RET = (bf16_t*)(ws + WS_RET), *MG = (bf16_t*)(ws + WS_MG),
           *H1B = (bf16_t*)(ws + WS_H1B), *PQ = (bf16_t*)(ws + WS_PQ);
    hipLaunchKernelGGL(k_prep_rows, dim3(1024), dim3(256), 0, stream, p);
    hipLaunchKernelGGL(k_prep_rope, dim3((4112 * 32 + 255) / 256), dim3(256), 0, stream, p);
    hipLaunchKernelGGL(k_prep_w<1>, dim3(NIN / 64, 1024 / 64), dim3(256), 0, stream, p.in[3], p.in[2], WIN, 1024, 5792, NIN);
    hipLaunchKernelGGL(k_prep_w<0>, dim3(768 / 64, 384 / 64), dim3(256), 0, stream, p.in[5], p.in[4], WUQ, 384, 768, 768);
    hipLaunchKernelGGL(k_prep_w<0>, dim3(1024 / 64, 256 / 64), dim3(256), 0, stream, p.in[7], p.in[6], WUKV, 256, 1024, 1024);
    hipLaunchKernelGGL(k_prep_w<0>, dim3(1024 / 64, 512 / 64), dim3(256), 0, stream, p.in[10], (const float*)nullptr, WMLA, 512, 1024, 1024);
    hipLaunchKernelGGL(k_prep_w<0>, dim3(1024 / 64, 1024 / 64), dim3(256), 0, stream, p.in[12], (const float*)nullptr, WRET, 1024, 1024, 1024);
    hipLaunchKernelGGL(k_prep_w<0>, dim3(1024 / 64, 1024 / 64), dim3(256), 0, stream, p.in[13], (const float*)nullptr, WMIX, 1024, 1024, 1024);
    hipLaunchKernelGGL(k_prep_w<0>, dim3(1024 / 64, 1024 / 64), dim3(256), 0, stream, p.in[15], p.in[14], WPQ, 1024, 1024, 1024);
    launch_gemm(stream, XB, 1024, WIN, 1024, MP, NIN, 1024, EpiIn{LAT, RQ, RK, RV, RG, SA, SR, (const float2*)(ws + WS_ROPE32)});
    launch_gemm(stream, LAT, 768, WUQ, 384, T, 768, 384, EpiQraw{Q});
    launch_gemm(stream, LAT + 384, 768, WUKV, 256, MP, 1024, 256, EpiKVraw{K, V});
    hipLaunchKernelGGL(k_finalize, dim3(1024), dim3(256), 0, stream, p);
#ifndef USE_REF_ATTN
#define USE_REF_ATTN 0
#endif
    if (USE_REF_ATTN) hipLaunchKernelGGL(k_attn_naive, dim3(SEQ / 64, 8, BATCH), dim3(64), 0, stream, p);
    else hipLaunchKernelGGL(k_attn, dim3(256), dim3(512), ATT_LDS, stream, p);
#ifndef USE_REF_RET
#define USE_REF_RET 0
#endif
    if (USE_REF_RET) hipLaunchKernelGGL(k_ret_naive, dim3(64), dim3(128), 0, stream, p);
    else { static bool ad = false; if (!ad) { (void)hipFuncSetAttribute((const void*)k_ret, hipFuncAttributeMaxDynamicSharedMemorySize, RT_LDS); ad = true; }
        hipLaunchKernelGGL(k_ret, dim3(64), dim3(512), RT_LDS, stream, p); }
    launch_gemm(stream, AO, 512, WMLA, 512, T, 1024, 512, EpiMerge1{MG, SA});
    launch_gemm(stream, RET, 1024, WRET, 1024, T, 1024, 1024, EpiMerge2{MG, SR});
    hipLaunchKernelGGL(k_zero_ss2, dim3(128), dim3(256), 0, stream, p);
    launch_gemm(stream, MG, 1024, WMIX, 1024, T, 1024, 1024, EpiMix{p.in[0], p.out, H1B, (float*)(ws + WS_RINV2)});
    launch_gemm(stream, H1B, 1024, WPQ, 1024, T, 1024, 1024, EpiPQ{PQ, (const float*)(ws + WS_RINV2)});
#ifndef USE_REF_SELECT
#define USE_REF_SELECT 0
#endif
    if (USE_REF_SELECT) hipLaunchKernelGGL(k_peer_select_naive, dim3(T * 8 / 32), dim3(32), 0, stream, p);
    else hipLaunchKernelGGL(k_peer_select, dim3(256), dim3(512), 2 * 128 * KEY_PITCH, stream, p, 0);
#ifdef DBG_SEL
    hipMemsetAsync(p.ws + WS_CTL, 0, 4096, stream);
    hipLaunchKernelGGL(k_peer_select256, dim3(512), dim3(256), 2 * 128 * KEY_PITCH, stream, p, 1);
    hipLaunchKernelGGL(k_dbg_cmp_sel, dim3(T * 8 / 256), dim3(256), 0, stream, p, DBG_SEL);
#ifdef DBG_SCORES
    hipLaunchKernelGGL(k_dbg_cmp_scores, dim3(1024 * 8 * 2 * 128 / 256), dim3(256), 0, stream, p);
#endif
#endif
#ifndef USE_REF_GATHER
#define USE_REF_GATHER 0
#endif
    if (USE_REF_GATHER) hipLaunchKernelGGL(k_peer_gather_naive, dim3(T), dim3(256), 0, stream, p);
    else { hipLaunchKernelGGL(k_prep_uv, dim3(512), dim3(512), 0, stream, p); hipLaunchKernelGGL(k_peer_gather, dim3(256), dim3(512), 0, stream, p); }
#ifdef DBG_SEL
    hipLaunchKernelGGL(k_dbg_scale, dim3(2048), dim3(256), 0, stream, p, DBG_SEL == 3 ? (float)(1024 * 8 * 2 * 128) : DBG_SEL == 2 ? (float)T * 128 : (float)T * 8, DBG_SEL);
#endif
}
```

```cpp
#include <hip/hip_runtime.h>
#include <stdint.h>
#include <math.h>
#include <utility>

typedef unsigned short bf16_t;
typedef float f32x4 __attribute__((ext_vector_type(4)));
typedef unsigned u32x4 __attribute__((ext_vector_type(4)));

constexpr int D = 1024, BATCH = 8, SEQ = 4096, NMETA = 16;
constexpr int T = BATCH * SEQ;
constexpr int MP = 33024;
constexpr float EPS = 1e-6f;
constexpr int NIN = 5888;
constexpr int C_LAT = 0, C_RQ = 768, C_RK = 1280, C_RV = 1792, C_RG = 2816, C_SA = 3840, C_SR = 4864;
constexpr float QSCALE = 1.4426950408889634f * 0.10206207261596575f;

constexpr size_t al(size_t x) { return (x + 255) & ~(size_t)255; }
constexpr size_t WS_CTL = 0;
constexpr size_t WS_WIN = 1u << 20;
constexpr size_t WS_WUQ = WS_WIN + al((size_t)NIN * 1024 * 2);
constexpr size_t WS_WUKV = WS_WUQ + al((size_t)768 * 384 * 2);
constexpr size_t WS_WMLA = WS_WUKV + al((size_t)1024 * 256 * 2);
constexpr size_t WS_WRET = WS_WMLA + al((size_t)1024 * 512 * 2);
constexpr size_t WS_WMIX = WS_WRET + al((size_t)1024 * 1024 * 2);
constexpr size_t WS_WPQ = WS_WMIX + al((size_t)1024 * 1024 * 2);
constexpr size_t WS_KEYS = WS_WPQ + al((size_t)1024 * 1024 * 2);
constexpr size_t WS_ROPE32 = WS_KEYS + al((size_t)2 * 128 * 64 * 2);
constexpr size_t WS_ROPE16 = WS_ROPE32 + al((size_t)4112 * 32 * 8);
constexpr size_t WS_RINV2 = WS_ROPE16 + al((size_t)4112 * 16 * 8);
constexpr size_t WS_XB = WS_RINV2 + al((size_t)T * 4);
constexpr size_t WS_LAT = WS_XB + al((size_t)MP * 1024 * 2);
constexpr size_t WS_RQ = WS_LAT + al((size_t)MP * 768 * 2);
constexpr size_t WS_RK = WS_RQ + al((size_t)MP * 512 * 2);
constexpr size_t WS_RV = WS_RK + al((size_t)MP * 512 * 2);
constexpr size_t WS_RG = WS_RV + al((size_t)MP * 1024 * 2);
constexpr size_t WS_K = WS_RG + al((size_t)T * 1024 * 2);
constexpr size_t WS_V = WS_K + al((size_t)MP * 768 * 2);
constexpr int VT_LEN = 4160;
constexpr size_t WS_RET = WS_V + al((size_t)64 * 64 * VT_LEN * 2);

constexpr size_t WS_END = WS_RET + al((size_t)T * 1024 * 2);
static_assert(WS_END <= 536870912ull, "workspace map exceeds 512 MiB");
constexpr size_t WS_Q = WS_XB, WS_MG = WS_XB, WS_AO = WS_LAT, WS_H1B = WS_RV, WS_PQ = WS_RG, WS_SELI = WS_RQ, WS_SELG = WS_RQ + (size_t)T * 128 * 4;
static_assert(WS_SELG + (size_t)T * 128 * 4 <= WS_RV, "SEL overlay");
constexpr size_t WS_VRAW = WS_RET, WS_VT = WS_V;
__host__ __device__ __forceinline__ int vt_pos(int tile, int k) { const int x = k & 15; return 64 * tile + (k & 48) + ((x >= 4 && x < 12) ? (x ^ 12) : x); }

__device__ __forceinline__ unsigned f2bf(float f) { unsigned u = __builtin_bit_cast(unsigned, f); return (u + 0x7fffu + ((u >> 16) & 1u)) >> 16; }
__device__ __forceinline__ float bf2f(unsigned h) { return __builtin_bit_cast(float, h << 16); }
__device__ __forceinline__ unsigned pk2(float lo, float hi) { return f2bf(lo) | (f2bf(hi) << 16); }
__device__ __forceinline__ float wave_sum(float v) {
#pragma unroll
    for (int o = 1; o < 64; o <<= 1) v += __shfl_xor(v, o);
    return v;
}
__device__ __forceinline__ int row_pos(int row) { return row < T ? NMETA + (row & (SEQ - 1)) : (row - T < NMETA ? row - T : 0); }
__device__ __forceinline__ float sigmoidf_(float x) { return 1.f / (1.f + __expf(-x)); }

__device__ __forceinline__ int opaque_tid() { int t = threadIdx.x; asm volatile("" : "+v"(t)); return t; }

struct Ptrs {
    const float* in[20];
    float* out;
    unsigned char* ws;
};

__global__ void __launch_bounds__(256) k_prep_rows(Ptrs p) {
    const int lane = threadIdx.x & 63, gw = (blockIdx.x * 256 + threadIdx.x) >> 6, nw = (gridDim.x * 256) >> 6;
    bf16_t* XB = (bf16_t*)(p.ws + WS_XB);
    for (int r = gw; r < MP; r += nw) {
        f32x4 v[4];
        if (r < T + NMETA) {
            const float* src = r < T ? p.in[0] + (size_t)r * D : p.in[1] + (size_t)(r - T) * D;
#pragma unroll
            for (int j = 0; j < 4; ++j) v[j] = *(const f32x4*)(src + lane * 4 + 256 * j);
        } else {
#pragma unroll
            for (int j = 0; j < 4; ++j) v[j] = (f32x4){0.f, 0.f, 0.f, 0.f};
        }
        float ss = 0.f;
#pragma unroll
        for (int j = 0; j < 4; ++j) ss += v[j].x * v[j].x + v[j].y * v[j].y + v[j].z * v[j].z + v[j].w * v[j].w;
        ss = wave_sum(ss);
        const float rinv = rsqrtf(ss * (1.f / D) + EPS);
#pragma unroll
        for (int j = 0; j < 4; ++j) {
            uint2 o; o.x = pk2(v[j].x * rinv, v[j].y * rinv); o.y = pk2(v[j].z * rinv, v[j].w * rinv);
            *(uint2*)(XB + (size_t)r * D + lane * 4 + 256 * j) = o;
        }
    }
}

__device__ __forceinline__ int win_src(int n) {
    if (n < 672) return n;
    if (n < 768) return -1;
    if (n < C_RV) { const int base = n < C_RK ? 672 : 1184, q = (n - (n < C_RK ? C_RQ : C_RK)), hh = q >> 6, pp = q & 63; return base + hh * 64 + (pp >> 1) + 32 * (pp & 1); }
    if (n < C_RG) return 1696 + (n - C_RV);
    if (n < C_SA) return 2720 + (n - C_RG);
    if (n < C_SR) return 3744 + (n - C_SA);
    return 4768 + (n - C_SR);
}
template <int MODE>
__global__ void __launch_bounds__(256) k_prep_w(const float* __restrict__ W, const float* __restrict__ gain, bf16_t* __restrict__ Wt, int K, int Nsrc, int Ndst) {
    __shared__ float tile[64][65];
    const int n0 = blockIdx.x * 64, k0 = blockIdx.y * 64, tx = threadIdx.x & 63, ty = threadIdx.x >> 6;
    const int n = n0 + tx; const int src = MODE == 1 ? win_src(n) : n;
    for (int kk = ty; kk < 64; kk += 4) {
        float v = 0.f;
        if (src >= 0 && n < Ndst) { v = W[(size_t)(k0 + kk) * Nsrc + src]; if (gain) v *= gain[k0 + kk]; }
        tile[kk][tx] = v;
    }
    __syncthreads();
    for (int nn = ty; nn < 64; nn += 4) if (n0 + nn < Ndst) Wt[(size_t)(n0 + nn) * K + k0 + tx] = (bf16_t)f2bf(tile[tx][nn]);
}
__global__ void k_prep_rope(Ptrs p) {
    const int i = blockIdx.x * blockDim.x + threadIdx.x;
    float2* R32 = (float2*)(p.ws + WS_ROPE32); float2* R16 = (float2*)(p.ws + WS_ROPE16);
    if (i < 4112 * 32) { const int pos = i >> 5, f = i & 31; const float inv = (float)pow(10000.0, -(double)f / 32.0); const float ang = (float)pos * inv; R32[i] = make_float2((float)cos((double)ang), (float)sin((double)ang)); }
    if (i < 4112 * 16) { const int pos = i >> 4, f = i & 15; const float inv = (float)pow(10000.0, -(double)f / 16.0); const float ang = (float)pos * inv; R16[i] = make_float2((float)cos((double)ang), (float)sin((double)ang)); }
}

__device__ __forceinline__ void st8(bf16_t* dst, const float (&v)[8]) {
    u32x4 w; w.x = pk2(v[0], v[1]); w.y = pk2(v[2], v[3]); w.z = pk2(v[4], v[5]); w.w = pk2(v[6], v[7]); *(u32x4*)dst = w;
}
struct EpiIn {
    bf16_t *LAT, *RQ, *RK, *RV, *RG, *SA, *SR; const float2* R32;
    __device__ __forceinline__ void apply(int row, int col0, const float (&v)[8]) const {
        if (col0 < C_RQ) { st8(LAT + (size_t)row * 768 + col0, v); return; }
        if (col0 < C_RV) {
            const bool isq = col0 < C_RK; const int c = col0 - (isq ? C_RQ : C_RK); const int i0 = (c & 63) >> 1;
            const int hh = c >> 6, cc = row < T ? (row & 127) : (row - T);
            const float lg = __log2f(1.f - exp2f(-5.f - (float)hh)) * (float)(cc + 1);
            const float2* rp = R32 + row_pos(row) * 32 + i0; const float sc = isq ? exp2f(lg) : 0.125f * exp2f(-lg);
            float o[8];
#pragma unroll
            for (int j = 0; j < 4; ++j) { const float2 cs = rp[j]; const float x1 = v[2 * j], x2 = v[2 * j + 1]; o[2 * j] = (x1 * cs.x - x2 * cs.y) * sc; o[2 * j + 1] = (x1 * cs.y + x2 * cs.x) * sc; }
            st8((isq ? RQ : RK) + (size_t)row * 512 + c, o); return;
        }
        if (col0 < C_RG) { st8(RV + (size_t)row * 1024 + (col0 - C_RV), v); return; }
        if (row >= T) return;
        float o[8];
        if (col0 < C_SA) {
#pragma unroll
            for (int j = 0; j < 8; ++j) o[j] = v[j] * sigmoidf_(v[j]);
            st8(RG + (size_t)row * 1024 + (col0 - C_RG), o); return;
        }
#pragma unroll
        for (int j = 0; j < 8; ++j) o[j] = sigmoidf_(v[j]);
        if (col0 < C_SR) st8(SA + (size_t)row * 1024 + (col0 - C_SA), o); else st8(SR + (size_t)row * 1024 + (col0 - C_SR), o);
    }
};
struct EpiQraw { bf16_t* Q; __device__ __forceinline__ void apply(int row, int col0, const float (&v)[8]) const { st8(Q + (size_t)row * 768 + col0, v); } };
struct EpiKVraw {
    bf16_t *K, *V;
    __device__ __forceinline__ void apply(int row, int col0, const float (&v)[8]) const {
        const int h = col0 >> 7, j = col0 & 127;
        if (j < 64) st8(K + (size_t)row * 768 + h * 96 + j, v); else st8(V + (size_t)row * 512 + h * 64 + (j - 64), v);
    }
};
__device__ __forceinline__ void ld8(const bf16_t* src, float (&o)[8]) {
    const u32x4 w = *(const u32x4*)src;
    o[0] = bf2f(w.x & 0xffff); o[1] = bf2f(w.x >> 16); o[2] = bf2f(w.y & 0xffff); o[3] = bf2f(w.y >> 16);
    o[4] = bf2f(w.z & 0xffff); o[5] = bf2f(w.z >> 16); o[6] = bf2f(w.w & 0xffff); o[7] = bf2f(w.w >> 16);
}
struct EpiMerge1 { bf16_t* MG; const bf16_t* SA;
    __device__ __forceinline__ void apply(int row, int col0, const float (&v)[8]) const {
        float g[8], o[8]; ld8(SA + (size_t)row * 1024 + col0, g);
#pragma unroll
        for (int j = 0; j < 8; ++j) o[j] = g[j] * v[j];
        st8(MG + (size_t)row * 1024 + col0, o); } };
struct EpiMerge2 { bf16_t* MG; const bf16_t* SR;
    __device__ __forceinline__ void apply(int row, int col0, const float (&v)[8]) const {
        float g[8], m[8], o[8]; ld8(SR + (size_t)row * 1024 + col0, g); ld8(MG + (size_t)row * 1024 + col0, m);
#pragma unroll
        for (int j = 0; j < 8; ++j) o[j] = m[j] + g[j] * v[j];
        st8(MG + (size_t)row * 1024 + col0, o); } };
struct EpiMix { const float* x; float* out; bf16_t* H1B; float* SS2;
    __device__ __forceinline__ void apply(int row, int col0, const float (&v)[8]) const {
        const f32x4 a = *(const f32x4*)(x + (size_t)row * D + col0), b = *(const f32x4*)(x + (size_t)row * D + col0 + 4);
        float o[8] = {a.x + v[0], a.y + v[1], a.z + v[2], a.w + v[3], b.x + v[4], b.y + v[5], b.z + v[6], b.w + v[7]};
        *(f32x4*)(out + (size_t)row * D + col0) = (f32x4){o[0], o[1], o[2], o[3]}; *(f32x4*)(out + (size_t)row * D + col0 + 4) = (f32x4){o[4], o[5], o[6], o[7]};
        st8(H1B + (size_t)row * D + col0, o);
        float ss = 0.f;
#pragma unroll
        for (int j = 0; j < 8; ++j) ss += o[j] * o[j];
        atomicAdd(SS2 + row, ss); } };
struct EpiPQ { bf16_t* PQ; const float* SS2;
    __device__ __forceinline__ void apply(int row, int col0, const float (&v)[8]) const {
        const float r = rsqrtf(SS2[row] * (1.f / D) + EPS); float o[8];
#pragma unroll
        for (int j = 0; j < 8; ++j) o[j] = v[j] * r;
        st8(PQ + (size_t)row * D + col0, o); } };

template <class Epi>
__global__ void __launch_bounds__(256) gemm_ref(const bf16_t* __restrict__ A, int lda, const bf16_t* __restrict__ Bt, int ldb, int K, Epi E) {
    __shared__ float As[32][64 + 4];
    __shared__ float Bs[32][128 + 4];
    const int tid = threadIdx.x, tx = tid & 15, ty = tid >> 4;
    const int m0 = blockIdx.y * 64, n0 = blockIdx.x * 128;
    float acc[4][8];
#pragma unroll
    for (int i = 0; i < 4; ++i)
#pragma unroll
        for (int j = 0; j < 8; ++j) acc[i][j] = 0.f;
    for (int k0 = 0; k0 < K; k0 += 32) {
        { const int m = tid & 63, kc = tid >> 6; float t[8]; ld8(A + (size_t)(m0 + m) * lda + k0 + kc * 8, t);
#pragma unroll
          for (int j = 0; j < 8; ++j) As[kc * 8 + j][m] = t[j]; }
#pragma unroll
        for (int i = 0; i < 2; ++i) { const int n = tid & 127, kc = (tid >> 7) + 2 * i; float t[8]; ld8(Bt + (size_t)(n0 + n) * ldb + k0 + kc * 8, t);
#pragma unroll
          for (int j = 0; j < 8; ++j) Bs[kc * 8 + j][n] = t[j]; }
        __syncthreads();
#pragma unroll 8
        for (int kk = 0; kk < 32; ++kk) {
            const f32x4 a = *(const f32x4*)&As[kk][ty * 4]; const f32x4 b0 = *(const f32x4*)&Bs[kk][tx * 8], b1 = *(const f32x4*)&Bs[kk][tx * 8 + 4];
            const float av[4] = {a.x, a.y, a.z, a.w}, bv[8] = {b0.x, b0.y, b0.z, b0.w, b1.x, b1.y, b1.z, b1.w};
#pragma unroll
            for (int i = 0; i < 4; ++i)
#pragma unroll
                for (int j = 0; j < 8; ++j) acc[i][j] += av[i] * bv[j];
        }
        __syncthreads();
    }
#pragma unroll
    for (int i = 0; i < 4; ++i) E.apply(m0 + ty * 4 + i, n0 + tx * 8, acc[i]);
}

namespace pg8 {
#define PG8_LAS __attribute__((address_space(3)))
typedef short bf16x8 __attribute__((ext_vector_type(8)));
constexpr int BM = 256, BK = 64, HALF = 128, HTB = HALF * BK * 2, STAGE_BYTES = 8 * HTB, NXCD = 8, WGM = 8;
__host__ __device__ __forceinline__ int lds_byte(int r, int c) { const int st = (r >> 4) * 2 + (c >> 5), rr = r & 15, cc = c & 31, ob = rr * 64 + cc * 2; return st * 1024 + (ob ^ (((ob >> 9) & 1) << 5)); }
__host__ __device__ __forceinline__ void stage_rc(int b, int& R, int& C) { const int st = b / 1024, sb = b % 1024, swz = sb ^ (((sb >> 9) & 1) << 5); R = (st >> 1) * 16 + swz / 64; C = (st & 1) * 32 + (swz % 64) / 2; }
__host__ __device__ __forceinline__ int perm32(int rho) { const int n = rho >> 4, i = rho & 15; return 8 * (i >> 2) + 4 * n + (i & 3); }
struct Unit { int pm, pn; };
struct Gemm { const bf16_t* A; const bf16_t* Bt; int lda, ldb, M, N, K, pad; };
struct StaticOrder {
    int nM, nN, nwg, G, c;
    __host__ __device__ void init(int M, int N, int G_, int c_) { nM = M / BM; nN = N / BM; nwg = nM * nN; G = G_; c = c_; }
    __host__ __device__ bool next(int i, Unit& u) const {
        const long L = (long)i * G + c; if (L >= nwg) return false;
        int wgid = (int)L; { const int q = nwg / NXCD, r = nwg % NXCD, xcd = wgid % NXCD, off = wgid / NXCD; wgid = (xcd < r ? xcd * (q + 1) : r * (q + 1) + (xcd - r) * q) + off; }
        const int nig = WGM * nN, gid = wgid / nig, fm = gid * WGM, gsz = (nM - fm) < WGM ? (nM - fm) : WGM;
        u.pm = fm + ((wgid % nig) % gsz); u.pn = (wgid % nig) / gsz; return true;
    }
};
template <class Epi>
__device__ __forceinline__ void run_epi(const Epi& E, const f32x4 (&acc)[2][2][4][2], const Unit& u, int wr, int wc, int fr, int fq) {
    const int row0 = u.pm * BM + wr * 64 + fr, col0 = u.pn * BM + wc * 32 + 8 * fq;
#pragma unroll
    for (int ai = 0; ai < 2; ++ai)
#pragma unroll
        for (int m = 0; m < 4; ++m)
#pragma unroll
            for (int bj = 0; bj < 2; ++bj) {
                const f32x4 a = acc[ai][bj][m][0], b = acc[ai][bj][m][1];
                const float v[8] = {a[0], a[1], a[2], a[3], b[0], b[1], b[2], b[3]};
                E.apply(row0 + ai * HALF + m * 16, col0 + bj * HALF, v);
            }
}
template <class Epi>
__device__ __forceinline__ void gemm_phase(PG8_LAS unsigned char* lds, const Gemm g, const StaticOrder& S, const Epi& E) {
    const int tid = opaque_tid(), wid = __builtin_amdgcn_readfirstlane(tid >> 6), lane = tid & 63, wr = wid >> 2, wc = wid & 3, fr = lane & 15, fq = lane >> 4;
    const int K = g.K, nt = K / BK;
    unsigned voffA[2], voffB[2];
#pragma unroll
    for (int i = 0; i < 2; ++i) { int R, C; stage_rc(tid * 16 + i * 8192, R, C); const int Rb = (R & ~31) + perm32(R & 31);
        voffA[i] = (unsigned)(R * g.lda + C) * 2u; voffB[i] = (unsigned)(Rb * g.ldb + C) * 2u; }
    const size_t kstep = (size_t)(BK * 2);
    const size_t hstepA = (size_t)HALF * g.lda * 2, hstepB = (size_t)HALF * g.ldb * 2;
    const size_t tstepA = 2 * hstepA, tstepB = 2 * hstepB;
    const unsigned ldsw = (unsigned)wid * 1024u;
    const int aoff = lds_byte(wr * 64 + fr, fq * 8), boff = lds_byte(wc * 32 + fr, fq * 8);
#define PG8_SA(b, h) (((b) * 2 + (h)) * HTB)
#define PG8_SB(b, h) ((4 + (b) * 2 + (h)) * HTB)
#define PG8_STAGE(bufoff, gbase, voff) do { _Pragma("unroll") for (int _i = 0; _i < 2; ++_i) \
        __builtin_amdgcn_global_load_lds((const unsigned*)((const char*)(gbase) + (voff)[_i]), (PG8_LAS unsigned*)(lds + (bufoff) + ldsw + _i * 8192), 16, 0, 0); } while (0)
#define PG8_LDA(dst, b, h) do { _Pragma("unroll") for (int m = 0; m < 4; ++m) _Pragma("unroll") for (int k = 0; k < 2; ++k) dst[m][k] = *(const PG8_LAS bf16x8*)(lds + PG8_SA(b, h) + aoff + m * 2048 + k * 1024); } while (0)
#define PG8_LDB(dst, b, h) do { _Pragma("unroll") for (int n = 0; n < 2; ++n) _Pragma("unroll") for (int k = 0; k < 2; ++k) dst[n][k] = *(const PG8_LAS bf16x8*)(lds + PG8_SB(b, h) + boff + n * 2048 + k * 1024); } while (0)
#define PG8_MMA(ai, bj, At, Bt) do { __builtin_amdgcn_s_setprio(1); _Pragma("unroll") for (int m = 0; m < 4; ++m) _Pragma("unroll") for (int n = 0; n < 2; ++n) _Pragma("unroll") for (int k = 0; k < 2; ++k) \
        acc[ai][bj][m][n] = __builtin_amdgcn_mfma_f32_16x16x32_bf16(Bt[n][k], At[m][k], acc[ai][bj][m][n], 0, 0, 0); __builtin_amdgcn_s_setprio(0); } while (0)
#define PG8_WAIT_V(n) asm volatile("s_waitcnt vmcnt(" #n ")" ::: "memory")
#define PG8_WAIT_L(n) asm volatile("s_waitcnt lgkmcnt(" #n ")" ::: "memory")
#define PG8_BAR __builtin_amdgcn_s_barrier()
#define PG8_SCHED __builtin_amdgcn_sched_barrier(0)
    Unit cur, nxt; int ui = 0;
    if (!S.next(0, cur)) return;
    f32x4 acc[2][2][4][2];
#pragma unroll
    for (int a = 0; a < 2; ++a)
#pragma unroll
        for (int b = 0; b < 2; ++b)
#pragma unroll
            for (int m = 0; m < 4; ++m)
#pragma unroll
                for (int n = 0; n < 2; ++n) acc[a][b][m][n] = (f32x4){0.f, 0.f, 0.f, 0.f};
    bf16x8 At[4][2], B0[2][2], B1[2][2];
    const char* cA = (const char*)g.A + (size_t)cur.pm * tstepA; const char* cB = (const char*)g.Bt + (size_t)cur.pn * tstepB;
    PG8_STAGE(PG8_SB(0, 0), cB, voffB); PG8_STAGE(PG8_SB(0, 1), cB + hstepB, voffB); PG8_STAGE(PG8_SA(0, 0), cA, voffA); PG8_STAGE(PG8_SA(0, 1), cA + hstepA, voffA);
    if (wr == 1) PG8_BAR;
    PG8_WAIT_V(2); PG8_BAR;
    PG8_STAGE(PG8_SB(1, 0), cB + kstep, voffB); PG8_STAGE(PG8_SA(1, 0), cA + kstep, voffA); PG8_STAGE(PG8_SB(1, 1), cB + hstepB + kstep, voffB);
    PG8_WAIT_V(6); PG8_BAR;
    for (;;) {
        const bool has_next = S.next(ui + 1, nxt);
        const char* nA = has_next ? (const char*)g.A + (size_t)nxt.pm * tstepA : cA; const char* nB = has_next ? (const char*)g.Bt + (size_t)nxt.pn * tstepB : cB;
        for (int t = 0; t < nt; t += 2) {
            const bool last = (t == nt - 2);
            const char* a1 = cA + (size_t)(t + 1) * kstep;
            const char* a2 = last ? nA : cA + (size_t)(t + 2) * kstep; const char* b2 = last ? nB : cB + (size_t)(t + 2) * kstep;
            const char* a3 = a2 + kstep; const char* b3 = b2 + kstep;
            PG8_LDB(B0, 0, 0); PG8_LDB(B1, 0, 1); PG8_SCHED; PG8_LDA(At, 0, 0); PG8_STAGE(PG8_SA(1, 1), a1 + hstepA, voffA);
            PG8_WAIT_V(8); PG8_WAIT_L(0); PG8_BAR; PG8_MMA(0, 0, At, B0); PG8_MMA(0, 1, At, B1); PG8_BAR; PG8_SCHED;
            PG8_LDA(At, 0, 1); PG8_STAGE(PG8_SB(0, 0), b2, voffB); PG8_STAGE(PG8_SB(0, 1), b2 + hstepB, voffB); PG8_STAGE(PG8_SA(0, 0), a2, voffA);
            PG8_WAIT_V(8); PG8_WAIT_L(0); PG8_BAR; PG8_MMA(1, 0, At, B0); PG8_MMA(1, 1, At, B1); PG8_BAR; PG8_SCHED;
            PG8_LDB(B0, 1, 0); PG8_LDB(B1, 1, 1); PG8_SCHED; PG8_LDA(At, 1, 0); PG8_STAGE(PG8_SA(0, 1), a2 + hstepA, voffA);
            PG8_WAIT_V(8); PG8_WAIT_L(0); PG8_BAR; PG8_MMA(0, 0, At, B0); PG8_MMA(0, 1, At, B1); PG8_BAR; PG8_SCHED;
            PG8_LDA(At, 1, 1); PG8_STAGE(PG8_SB(1, 0), b3, voffB); PG8_STAGE(PG8_SB(1, 1), b3 + hstepB, voffB); PG8_STAGE(PG8_SA(1, 0), a3, voffA);
            PG8_WAIT_V(8); PG8_WAIT_L(0); PG8_BAR; PG8_MMA(1, 0, At, B0); PG8_MMA(1, 1, At, B1); PG8_BAR; PG8_SCHED;
        }
        if (wr == 0) PG8_BAR;
        run_epi(E, acc, cur, wr, wc, fr, fq);
        if (!has_next) break;
#pragma unroll
        for (int a = 0; a < 2; ++a)
#pragma unroll
            for (int b = 0; b < 2; ++b)
#pragma unroll
                for (int m = 0; m < 4; ++m)
#pragma unroll
                    for (int n = 0; n < 2; ++n) acc[a][b][m][n] = (f32x4){0.f, 0.f, 0.f, 0.f};
        cur = nxt; cA = nA; cB = nB; ++ui;
        if (wr == 1) PG8_BAR;
    }
    PG8_WAIT_V(0);
    PG8_BAR;
#undef PG8_SA
#undef PG8_SB
#undef PG8_STAGE
#undef PG8_LDA
#undef PG8_LDB
#undef PG8_MMA
#undef PG8_WAIT_V
#undef PG8_WAIT_L
#undef PG8_BAR
#undef PG8_SCHED
}
}

constexpr int LDS_BYTES = 147456;
template <class Epi>
__global__ void __launch_bounds__(512, 2) k_gemm(pg8::Gemm g, Epi E) {
    extern __shared__ __attribute__((aligned(16))) unsigned char lds[];
    pg8::StaticOrder S; S.init(g.M, g.N, gridDim.x, blockIdx.x);
    pg8::gemm_phase<Epi>((PG8_LAS unsigned char*)lds, g, S, E);
}

__device__ __forceinline__ void finalize_phase(const Ptrs& p, int gw, int nw, int lane) {
    const bf16_t* LAT = (const bf16_t*)(p.ws + WS_LAT);
    bf16_t* Q = (bf16_t*)(p.ws + WS_Q); bf16_t* K = (bf16_t*)(p.ws + WS_K); const bf16_t* V = (const bf16_t*)(p.ws + WS_VRAW); bf16_t* VT = (bf16_t*)(p.ws + WS_VT);
    const float2* R16 = (const float2*)(p.ws + WS_ROPE16);
    const float* gq = p.in[8]; const float* gk = p.in[9];
    const int l = lane & 31, hh = lane >> 5;
    for (int r = gw; r < MP; r += nw) {
        const bf16_t* lr = LAT + (size_t)r * 768;
        float sa = 0.f, sb = 0.f;
#pragma unroll
        for (int j = 0; j < 6; ++j) { const float c = bf2f(lr[lane + 64 * j]); sa += c * c; }
#pragma unroll
        for (int j = 0; j < 4; ++j) { const float c = bf2f(lr[384 + lane + 64 * j]); sb += c * c; }
        sa = wave_sum(sa); sb = wave_sum(sb);
        const float alpha = rsqrtf(sa * (1.f / 384.f) + EPS), beta = rsqrtf(sb * (1.f / 256.f) + EPS);
        const float kpe = bf2f(lr[640 + l]);
        const float2 cs = R16[row_pos(r) * 16 + (l & 15)];
        for (int it = 0; it < 4; ++it) {
            const int h = it * 2 + hh;
            if (r < T) {
                bf16_t* qp = Q + (size_t)r * 768 + h * 96;
                float q0 = bf2f(qp[l]) * alpha, q1 = bf2f(qp[32 + l]) * alpha, q2 = bf2f(qp[64 + l]) * alpha;
                float ss = q0 * q0 + q1 * q1 + q2 * q2;
#pragma unroll
                for (int o = 1; o < 32; o <<= 1) ss += __shfl_xor(ss, o);
                const float rq = rsqrtf(ss * (1.f / 96.f) + EPS);
                q0 *= rq * gq[l]; q1 *= rq * gq[32 + l]; q2 *= rq * gq[64 + l];
                const float pr = __shfl_xor(q2, 16);
                const float q2r = (l < 16) ? (q2 * cs.x - pr * cs.y) : (pr * cs.y + q2 * cs.x);
                qp[l] = (bf16_t)f2bf(q0 * QSCALE); qp[32 + l] = (bf16_t)f2bf(q1 * QSCALE); qp[64 + l] = (bf16_t)f2bf(q2r * QSCALE);
            }
            {
                bf16_t* kp = K + (size_t)r * 768 + h * 96;
                float k0 = bf2f(kp[l]) * beta, k1 = bf2f(kp[32 + l]) * beta, k2 = kpe;
                float ss = k0 * k0 + k1 * k1 + k2 * k2;
#pragma unroll
                for (int o = 1; o < 32; o <<= 1) ss += __shfl_xor(ss, o);
                const float rk = rsqrtf(ss * (1.f / 96.f) + EPS);
                k0 *= rk * gk[l]; k1 *= rk * gk[32 + l]; k2 *= rk * gk[64 + l];
                const float pr = __shfl_xor(k2, 16);
                const float k2r = (l < 16) ? (k2 * cs.x - pr * cs.y) : (pr * cs.y + k2 * cs.x);
                kp[l] = (bf16_t)f2bf(k0); kp[32 + l] = (bf16_t)f2bf(k1); kp[64 + l] = (bf16_t)f2bf(k2r);
                const bf16_t* vp = V + (size_t)r * 512 + h * 64;
                const bf16_t v0 = (bf16_t)f2bf(bf2f(vp[l]) * beta), v1 = (bf16_t)f2bf(bf2f(vp[32 + l]) * beta);
                if (r < T) { const int b = r >> 12, sq = r & (SEQ - 1); bf16_t* vt = VT + ((size_t)(b * 8 + h) * 64) * VT_LEN + vt_pos(1 + (sq >> 6), sq & 63);
                    vt[(size_t)l * VT_LEN] = v0; vt[(size_t)(32 + l) * VT_LEN] = v1; }
                else if (r < T + 64) { for (int b = 0; b < BATCH; ++b) { bf16_t* vt = VT + ((size_t)(b * 8 + h) * 64) * VT_LEN + vt_pos(0, r - T);
                    vt[(size_t)l * VT_LEN] = v0; vt[(size_t)(32 + l) * VT_LEN] = v1; } }
            }
        }
    }
}
__global__ void __launch_bounds__(256) k_finalize(Ptrs p) { finalize_phase(p, (blockIdx.x * 256 + threadIdx.x) >> 6, (gridDim.x * 256) >> 6, threadIdx.x & 63); }

__global__ void __launch_bounds__(64) k_attn_naive(Ptrs p) {
    const bf16_t* Q = (const bf16_t*)(p.ws + WS_Q); const bf16_t* K = (const bf16_t*)(p.ws + WS_K); const bf16_t* VT = (const bf16_t*)(p.ws + WS_VT);
    bf16_t* AO = (bf16_t*)(p.ws + WS_AO);
    const int s = blockIdx.x * 64 + threadIdx.x, h = blockIdx.y, b = blockIdx.z;
    const int row = b * SEQ + s;
    float q[96], o[64];
#pragma unroll
    for (int d = 0; d < 96; d += 8) { float t[8]; ld8(Q + (size_t)row * 768 + h * 96 + d, t);
#pragma unroll
        for (int j = 0; j < 8; ++j) q[d + j] = t[j]; }
#pragma unroll
    for (int d = 0; d < 64; ++d) o[d] = 0.f;
    float m = -INFINITY, l = 0.f;
    const int smax = blockIdx.x * 64 + 63;
    for (int j = 0; j < NMETA + smax + 1; ++j) {
        const int krow = j < NMETA ? T + j : b * SEQ + (j - NMETA);
        const bf16_t* kp = K + (size_t)krow * 768 + h * 96;
        const bf16_t* vp = VT + ((size_t)(b * 8 + h) * 64) * VT_LEN + (j < NMETA ? vt_pos(0, j) : vt_pos(1 + ((j - NMETA) >> 6), (j - NMETA) & 63));
        float sc = 0.f;
#pragma unroll
        for (int d = 0; d < 96; d += 8) { float t[8]; ld8(kp + d, t);
#pragma unroll
            for (int jj = 0; jj < 8; ++jj) sc += q[d + jj] * t[jj]; }
        const bool valid = (j < NMETA) || (j - NMETA <= s);
        if (valid) {
            const float mn = fmaxf(m, sc); const float a = exp2f(m - mn), pp = exp2f(sc - mn);
            l = l * a + pp; m = mn;
#pragma unroll
            for (int d = 0; d < 64; ++d) o[d] = o[d] * a + pp * bf2f(vp[(size_t)d * VT_LEN]);
        }
    }
    const float il = 1.f / l;
#pragma unroll
    for (int d = 0; d < 64; d += 8) { float t[8];
#pragma unroll
        for (int jj = 0; jj < 8; ++jj) t[jj] = o[d + jj] * il;
        st8(AO + (size_t)row * 512 + h * 64 + d, t); }
}

#ifndef LAS
#define LAS __attribute__((address_space(3)))
#endif
typedef float f32x16_t __attribute__((ext_vector_type(16)));
typedef short bf16x8_t __attribute__((ext_vector_type(8)));
typedef float f32x2_t __attribute__((ext_vector_type(2)));
typedef __bf16 bf16x2v_t __attribute__((ext_vector_type(2)));
__device__ __forceinline__ unsigned cvtpk(float lo, float hi) { const f32x2_t v = {lo, hi}; return __builtin_bit_cast(unsigned, __builtin_convertvector(v, bf16x2v_t)); }
constexpr int ATT_KP = 208, ATT_VP = 144, ATT_KB = 64 * ATT_KP, ATT_VB = 64 * ATT_VP, ATT_BUF = ATT_KB + ATT_VB, ATT_LDS = 2 * ATT_BUF;
__device__ __forceinline__ void attn_unit(const Ptrs& p, LAS unsigned char* lds, int b, int h, int qb) {
    const bf16_t* Q = (const bf16_t*)(p.ws + WS_Q); const bf16_t* K = (const bf16_t*)(p.ws + WS_K); const bf16_t* VT = (const bf16_t*)(p.ws + WS_VT);
    bf16_t* AO = (bf16_t*)(p.ws + WS_AO);
    const int tid = opaque_tid(), lane = tid & 63, wid = __builtin_amdgcn_readfirstlane(tid >> 6), q = lane & 31, hi = lane >> 5;
    const int s0w = 256 * qb + 32 * wid, sq = s0w + q; const size_t rowq = (size_t)b * SEQ + sq;
    bf16x8_t qf[6];
#pragma unroll
    for (int st = 0; st < 6; ++st) qf[st] = *(const bf16x8_t*)(Q + rowq * 768 + h * 96 + 16 * st + 8 * hi);
    const int NT = 4 * qb + 5;
    const int k0key = tid / 12, k0ch = tid % 12, k1key = (tid + 512) / 12, k1ch = (tid + 512) % 12; const bool k1v = tid < 256;
    const int vd = tid >> 3, vch = tid & 7;
    const bf16_t* vtb = VT + ((size_t)(b * 8 + h) * 64 + vd) * VT_LEN + vch * 8;
    const bf16_t* kb0 = K + (size_t)h * 96 + k0ch * 8; const bf16_t* kb1 = K + (size_t)h * 96 + k1ch * 8;
    u32x4 kr0, kr1 = {}, vr;
#define ATT_KROW(t, key) ((t) == 0 ? (size_t)(T + (key)) : (size_t)b * SEQ + 64 * ((t) - 1) + (key))
#define ATT_LOAD(t) do { kr0 = *(const u32x4*)(kb0 + ATT_KROW(t, k0key) * 768); if (k1v) kr1 = *(const u32x4*)(kb1 + ATT_KROW(t, k1key) * 768); vr = *(const u32x4*)(vtb + 64 * (t)); } while (0)
#define ATT_STORE(buf) do { LAS unsigned char* bb = lds + (buf) * ATT_BUF; *(LAS u32x4*)(bb + k0key * ATT_KP + k0ch * 16) = kr0; if (k1v) *(LAS u32x4*)(bb + k1key * ATT_KP + k1ch * 16) = kr1; \
        *(LAS u32x4*)(bb + ATT_KB + vd * ATT_VP + vch * 16) = vr; } while (0)
    __syncthreads();
    ATT_LOAD(0); ATT_STORE(0); __syncthreads();
    float m = -1e30f, l = 0.f; f32x16_t o0 = {}, o1 = {};
    for (int t = 0; t < NT; ++t) {
        const int cur = t & 1;
        if (t + 1 < NT) ATT_LOAD(t + 1);
        const int ks = 64 * (t - 1);
        if (t == 0 || ks <= s0w + 31) {
            const LAS unsigned char* base = lds + cur * ATT_BUF;
            f32x16_t p0 = {}, p1 = {};
#pragma unroll
            for (int st = 0; st < 6; ++st) {
                const bf16x8_t a0 = *(const LAS bf16x8_t*)(base + q * ATT_KP + (16 * st + 8 * hi) * 2), a1 = *(const LAS bf16x8_t*)(base + (32 + q) * ATT_KP + (16 * st + 8 * hi) * 2);
                p0 = __builtin_amdgcn_mfma_f32_32x32x16_bf16(a0, qf[st], p0, 0, 0, 0); p1 = __builtin_amdgcn_mfma_f32_32x32x16_bf16(a1, qf[st], p1, 0, 0, 0); }
            float s0[16], s1[16];
#pragma unroll
            for (int r = 0; r < 16; ++r) { s0[r] = p0[r]; s1[r] = p1[r]; }
            if (t == 0) {
#pragma unroll
                for (int r = 0; r < 16; ++r) { if ((r & 3) + 8 * (r >> 2) + 4 * hi >= NMETA) s0[r] = -1e30f; s1[r] = -1e30f; }
            } else if (ks + 63 > s0w) {
#pragma unroll
                for (int r = 0; r < 16; ++r) { const int kk = ks + (r & 3) + 8 * (r >> 2) + 4 * hi; if (kk > sq) s0[r] = -1e30f; if (kk + 32 > sq) s1[r] = -1e30f; }
            }
            float mx = fmaxf(s0[0], s1[0]);
#pragma unroll
            for (int r = 1; r < 16; ++r) mx = fmaxf(mx, fmaxf(s0[r], s1[r]));
            mx = fmaxf(mx, __shfl_xor(mx, 32));
            if (__any(mx > m)) { const float mn = fmaxf(m, mx), al = __builtin_amdgcn_exp2f(m - mn); l *= al; m = mn;
#pragma unroll
                for (int r = 0; r < 16; ++r) { o0[r] *= al; o1[r] *= al; } }
            float ps = 0.f;
#pragma unroll
            for (int r = 0; r < 16; ++r) { s0[r] = __builtin_amdgcn_exp2f(s0[r] - m); s1[r] = __builtin_amdgcn_exp2f(s1[r] - m); ps += s0[r] + s1[r]; }
            l += ps;
            u32x4 pb[4];
            pb[0] = (u32x4){cvtpk(s0[0], s0[1]), cvtpk(s0[2], s0[3]), cvtpk(s0[4], s0[5]), cvtpk(s0[6], s0[7])};
            pb[1] = (u32x4){cvtpk(s0[8], s0[9]), cvtpk(s0[10], s0[11]), cvtpk(s0[12], s0[13]), cvtpk(s0[14], s0[15])};
            pb[2] = (u32x4){cvtpk(s1[0], s1[1]), cvtpk(s1[2], s1[3]), cvtpk(s1[4], s1[5]), cvtpk(s1[6], s1[7])};
            pb[3] = (u32x4){cvtpk(s1[8], s1[9]), cvtpk(s1[10], s1[11]), cvtpk(s1[12], s1[13]), cvtpk(s1[14], s1[15])};
#pragma unroll
            for (int kk = 0; kk < 4; ++kk) {
                const bf16x8_t v0 = *(const LAS bf16x8_t*)(base + ATT_KB + q * ATT_VP + (16 * kk + 8 * hi) * 2), v1 = *(const LAS bf16x8_t*)(base + ATT_KB + (32 + q) * ATT_VP + (16 * kk + 8 * hi) * 2);
                const bf16x8_t pf = __builtin_bit_cast(bf16x8_t, pb[kk]);
                o0 = __builtin_amdgcn_mfma_f32_32x32x16_bf16(v0, pf, o0, 0, 0, 0); o1 = __builtin_amdgcn_mfma_f32_32x32x16_bf16(v1, pf, o1, 0, 0, 0); }
        }
        if (t + 1 < NT) ATT_STORE(cur ^ 1);
        __syncthreads();
    }
    l += __shfl_xor(l, 32);
    const float il = 1.f / l;
    bf16_t* op = AO + rowq * 512 + h * 64 + 4 * hi;
#pragma unroll
    for (int g = 0; g < 4; ++g) {
        const float a0 = o0[4 * g], a1 = o0[4 * g + 1], a2 = o0[4 * g + 2], a3 = o0[4 * g + 3], b0 = o1[4 * g], b1 = o1[4 * g + 1], b2 = o1[4 * g + 2], b3 = o1[4 * g + 3];
        uint2 w0, w1; w0.x = cvtpk(a0 * il, a1 * il); w0.y = cvtpk(a2 * il, a3 * il); w1.x = cvtpk(b0 * il, b1 * il); w1.y = cvtpk(b2 * il, b3 * il);
        *(uint2*)(op + 8 * g) = w0; *(uint2*)(op + 32 + 8 * g) = w1; }
#undef ATT_KROW
#undef ATT_LOAD
#undef ATT_STORE
}
__device__ __forceinline__ void attn_phase(const Ptrs& p, LAS unsigned char* lds, int vcu, int ncu) {
    for (int v = vcu; v < 256; v += ncu) {
        const int bh = v >> 2, s = v & 3;
        attn_unit(p, lds, bh >> 3, bh & 7, 15 - s); attn_unit(p, lds, bh >> 3, bh & 7, 8 + s); attn_unit(p, lds, bh >> 3, bh & 7, 7 - s); attn_unit(p, lds, bh >> 3, bh & 7, s);
    }
}
__global__ void __launch_bounds__(512, 2) k_attn(Ptrs p) {
    extern __shared__ __attribute__((aligned(16))) unsigned char lds[];
    const int G = gridDim.x, bx = blockIdx.x; const int vcu = (G % 8 == 0) ? (bx % 8) * (G / 8) + bx / 8 : bx;
    attn_phase(p, (LAS unsigned char*)lds, vcu, G);
}

__global__ void __launch_bounds__(128) k_ret_naive(Ptrs p) {
    const bf16_t* RQ = (const bf16_t*)(p.ws + WS_RQ); const bf16_t* RK = (const bf16_t*)(p.ws + WS_RK); const bf16_t* RV = (const bf16_t*)(p.ws + WS_RV);
    const bf16_t* RG = (const bf16_t*)(p.ws + WS_RG); bf16_t* RET = (bf16_t*)(p.ws + WS_RET);
    const float* ggn = p.in[11];
    __shared__ float red[2][4];
    const int e = threadIdx.x, h = blockIdx.x & 7, b = blockIdx.x >> 3;
    const float gamma = 1.f - exp2f(-5.f - (float)h);
    float S[64];
#pragma unroll
    for (int d = 0; d < 64; ++d) S[d] = 0.f;
    const float gg = ggn[h * 128 + e];
    const float g128 = exp2f(128.f * __log2f(gamma)), g16 = exp2f(16.f * __log2f(gamma));
    for (int t = 0; t < NMETA + SEQ; ++t) {
        const int row = t < NMETA ? T + t : b * SEQ + (t - NMETA);
        if (t >= NMETA && ((t - NMETA) & 127) == 0) { const float f = t == NMETA ? g16 : g128;
#pragma unroll
            for (int d = 0; d < 64; ++d) S[d] *= f; }
        const bf16_t* qp = RQ + (size_t)row * 512 + h * 64; const bf16_t* kp = RK + (size_t)row * 512 + h * 64;
        const float v = bf2f(RV[(size_t)row * 1024 + h * 128 + e]);
        float y = 0.f;
#pragma unroll
        for (int d = 0; d < 64; d += 8) { float kq[8], qq[8]; ld8(kp + d, kq); ld8(qp + d, qq);
#pragma unroll
            for (int j = 0; j < 8; ++j) { S[d + j] = S[d + j] + kq[j] * v; y += qq[j] * S[d + j]; } }
        if (t >= NMETA) {
            const float s1 = wave_sum(y), s2 = wave_sum(y * y);
            const int buf = t & 1;
            if ((e & 63) == 0) { red[buf][(e >> 6) * 2] = s1; red[buf][(e >> 6) * 2 + 1] = s2; }
            __syncthreads();
            const float mu = (red[buf][0] + red[buf][2]) * (1.f / 128.f); const float ex2 = (red[buf][1] + red[buf][3]) * (1.f / 128.f);
            const float var = fmaxf(ex2 - mu * mu, 0.f);
            const float yn = (y - mu) * rsqrtf(var + EPS) * gg;
            const float g = bf2f(RG[(size_t)row * 1024 + h * 128 + e]);
            RET[(size_t)row * 1024 + h * 128 + e] = (bf16_t)f2bf(g * yn);
        }
    }
}

typedef unsigned u32x2 __attribute__((ext_vector_type(2)));
constexpr int RT_RP = 144, RT_TP = 272;
constexpr int RT_QT = 0, RT_KT = 128 * RT_RP, RT_KTT = RT_KT + 128 * RT_RP, RT_VTT = RT_KTT + 64 * RT_TP, RT_ST = RT_VTT + 128 * RT_TP, RT_STAT = RT_ST + 128 * RT_RP, RT_LDS = RT_STAT + 8 * 32 * 8;
static_assert(RT_LDS <= 147456, "retention LDS");
__device__ __forceinline__ void ret_unit(const Ptrs& p, LAS unsigned char* lds, int b, int h) {
    const bf16_t* RQ = (const bf16_t*)(p.ws + WS_RQ); const bf16_t* RK = (const bf16_t*)(p.ws + WS_RK); const bf16_t* RV = (const bf16_t*)(p.ws + WS_RV);
    const bf16_t* RG = (const bf16_t*)(p.ws + WS_RG); bf16_t* RET = (bf16_t*)(p.ws + WS_RET); const float* ggn = p.in[11];
    const int tid = opaque_tid(), lane = tid & 63, wid = __builtin_amdgcn_readfirstlane(tid >> 6), c = lane & 31, hi = lane >> 5;
    const int j = wid >> 1, ih = wid & 1;
    const float lgam = __log2f(1.f - exp2f(-5.f - (float)h)); const float g128 = exp2f(128.f * lgam), g16 = exp2f(16.f * lgam);
    const int nst = wid < 2 ? 2 : (wid < 6 ? 1 : 0);
    const int sti = wid < 2 ? wid : 2 + ((wid - 2) >> 1), std0 = wid < 2 ? 0 : ((wid - 2) & 1);
    f32x16_t st0 = {}, st1 = {};
    const int q_row0 = tid >> 3, q_ch = tid & 7;
    const int k_rb = tid >> 4, k_db = tid & 15;
    const int v_rb0 = tid >> 5, v_eb = tid & 31;
    u32x4 pq[2]; u32x2 pk[4], pv[2][4];
#define RT_MPOS(rb) (16 * ((rb) >> 2) + 4 * ((((rb) & 3) == 1) ? 2 : ((((rb) & 3) == 2) ? 1 : ((rb) & 3))))
#define RT_LOAD(R0) do { \
        pq[0] = *(const u32x4*)(RQ + (size_t)((R0) + q_row0) * 512 + h * 64 + q_ch * 8); pq[1] = *(const u32x4*)(RQ + (size_t)((R0) + q_row0 + 64) * 512 + h * 64 + q_ch * 8); \
        _Pragma("unroll") for (int i_ = 0; i_ < 4; ++i_) pk[i_] = *(const u32x2*)(RK + (size_t)((R0) + 4 * k_rb + i_) * 512 + h * 64 + 4 * k_db); \
        _Pragma("unroll") for (int u_ = 0; u_ < 2; ++u_) _Pragma("unroll") for (int i_ = 0; i_ < 4; ++i_) pv[u_][i_] = *(const u32x2*)(RV + (size_t)((R0) + 4 * (v_rb0 + 16 * u_) + i_) * 1024 + h * 128 + 4 * v_eb); } while (0)
#define RT_TR4(src, dstbase, colbase, pitch, mpos) do { \
        const unsigned a0_ = src[0].x, a1_ = src[1].x, a2_ = src[2].x, a3_ = src[3].x, b0_ = src[0].y, b1_ = src[1].y, b2_ = src[2].y, b3_ = src[3].y; \
        u32x2 t_; \
        t_.x = (a0_ & 0xffffu) | (a1_ << 16); t_.y = (a2_ & 0xffffu) | (a3_ << 16); *(LAS u32x2*)(lds + (dstbase) + ((colbase) + 0) * (pitch) + (mpos) * 2) = t_; \
        t_.x = (a0_ >> 16) | (a1_ & 0xffff0000u); t_.y = (a2_ >> 16) | (a3_ & 0xffff0000u); *(LAS u32x2*)(lds + (dstbase) + ((colbase) + 1) * (pitch) + (mpos) * 2) = t_; \
        t_.x = (b0_ & 0xffffu) | (b1_ << 16); t_.y = (b2_ & 0xffffu) | (b3_ << 16); *(LAS u32x2*)(lds + (dstbase) + ((colbase) + 2) * (pitch) + (mpos) * 2) = t_; \
        t_.x = (b0_ >> 16) | (b1_ & 0xffff0000u); t_.y = (b2_ >> 16) | (b3_ & 0xffff0000u); *(LAS u32x2*)(lds + (dstbase) + ((colbase) + 3) * (pitch) + (mpos) * 2) = t_; } while (0)
#define RT_STORE() do { \
        *(LAS u32x4*)(lds + RT_QT + q_row0 * RT_RP + q_ch * 16) = pq[0]; *(LAS u32x4*)(lds + RT_QT + (q_row0 + 64) * RT_RP + q_ch * 16) = pq[1]; \
        _Pragma("unroll") for (int i_ = 0; i_ < 4; ++i_) *(LAS u32x2*)(lds + RT_KT + (4 * k_rb + i_) * RT_RP + k_db * 8) = pk[i_]; \
        RT_TR4(pk, RT_KTT, 4 * k_db, RT_TP, RT_MPOS(k_rb)); \
        RT_TR4(pv[0], RT_VTT, 4 * v_eb, RT_TP, RT_MPOS(v_rb0)); RT_TR4(pv[1], RT_VTT, 4 * v_eb, RT_TP, RT_MPOS(v_rb0 + 16)); } while (0)
#define RT_PUT_ST(acc, it, dt) do { _Pragma("unroll") for (int r_ = 0; r_ < 16; ++r_) { const float v_ = acc[r_]; \
        *(LAS bf16_t*)(lds + RT_ST + (32 * (it) + (r_ & 3) + 8 * (r_ >> 2) + 4 * hi) * RT_RP + (32 * (dt) + c) * 2) = (bf16_t)f2bf(v_); } } while (0)
#define RT_STATE_UPD(acc, it, dt) do { _Pragma("unroll") for (int ks_ = 0; ks_ < 8; ++ks_) { \
        const bf16x8_t a_ = *(const LAS bf16x8_t*)(lds + RT_VTT + (32 * (it) + c) * RT_TP + (16 * ks_ + 8 * hi) * 2); \
        const bf16x8_t b_ = *(const LAS bf16x8_t*)(lds + RT_KTT + (32 * (dt) + c) * RT_TP + (16 * ks_ + 8 * hi) * 2); \
        acc = __builtin_amdgcn_mfma_f32_32x32x16_bf16(a_, b_, acc, 0, 0, 0); } } while (0)
    __syncthreads();
    RT_LOAD(T); RT_STORE(); __syncthreads();
    RT_LOAD(b * SEQ);
    if (nst >= 1) { RT_STATE_UPD(st0, sti, std0);
#pragma unroll
        for (int r = 0; r < 16; ++r) st0[r] *= g16; }
    if (nst == 2) { RT_STATE_UPD(st1, sti, 1);
#pragma unroll
        for (int r = 0; r < 16; ++r) st1[r] *= g16; }
    __syncthreads();
    RT_STORE();
    if (nst >= 1) RT_PUT_ST(st0, sti, std0);
    if (nst == 2) RT_PUT_ST(st1, sti, 1);
    __syncthreads();
    for (int n = 0; n < 32; ++n) {
        const int R0 = b * SEQ + 128 * n;
        if (n + 1 < 32) RT_LOAD(R0 + 128);
        bf16x8_t qf[4];
#pragma unroll
        for (int s4 = 0; s4 < 4; ++s4) qf[s4] = *(const LAS bf16x8_t*)(lds + RT_QT + (32 * j + c) * RT_RP + (16 * s4 + 8 * hi) * 2);
        f32x16_t y0 = {}, y1 = {};
#pragma unroll
        for (int s4 = 0; s4 < 4; ++s4) {
            const bf16x8_t a0 = *(const LAS bf16x8_t*)(lds + RT_ST + (64 * ih + c) * RT_RP + (16 * s4 + 8 * hi) * 2), a1 = *(const LAS bf16x8_t*)(lds + RT_ST + (64 * ih + 32 + c) * RT_RP + (16 * s4 + 8 * hi) * 2);
            y0 = __builtin_amdgcn_mfma_f32_32x32x16_bf16(a0, qf[s4], y0, 0, 0, 0); y1 = __builtin_amdgcn_mfma_f32_32x32x16_bf16(a1, qf[s4], y1, 0, 0, 0); }
        for (int a = 0; a <= j; ++a) {
            f32x16_t pa = {};
#pragma unroll
            for (int s4 = 0; s4 < 4; ++s4) { const bf16x8_t ka = *(const LAS bf16x8_t*)(lds + RT_KT + (32 * a + c) * RT_RP + (16 * s4 + 8 * hi) * 2);
                pa = __builtin_amdgcn_mfma_f32_32x32x16_bf16(ka, qf[s4], pa, 0, 0, 0); }
            float sv[16];
#pragma unroll
            for (int r = 0; r < 16; ++r) { const float v_ = pa[r]; sv[r] = (a == j && ((r & 3) + 8 * (r >> 2) + 4 * hi) > c) ? 0.f : v_; }
            u32x4 pb[2];
            pb[0] = (u32x4){cvtpk(sv[0], sv[1]), cvtpk(sv[2], sv[3]), cvtpk(sv[4], sv[5]), cvtpk(sv[6], sv[7])};
            pb[1] = (u32x4){cvtpk(sv[8], sv[9]), cvtpk(sv[10], sv[11]), cvtpk(sv[12], sv[13]), cvtpk(sv[14], sv[15])};
#pragma unroll
            for (int t2 = 0; t2 < 2; ++t2) {
                const bf16x8_t v0 = *(const LAS bf16x8_t*)(lds + RT_VTT + (64 * ih + c) * RT_TP + (32 * a + 16 * t2 + 8 * hi) * 2), v1 = *(const LAS bf16x8_t*)(lds + RT_VTT + (64 * ih + 32 + c) * RT_TP + (32 * a + 16 * t2 + 8 * hi) * 2);
                const bf16x8_t pf = __builtin_bit_cast(bf16x8_t, pb[t2]);
                y0 = __builtin_amdgcn_mfma_f32_32x32x16_bf16(v0, pf, y0, 0, 0, 0); y1 = __builtin_amdgcn_mfma_f32_32x32x16_bf16(v1, pf, y1, 0, 0, 0); }
        }
        if (nst >= 1) { RT_STATE_UPD(st0, sti, std0);
#pragma unroll
            for (int r = 0; r < 16; ++r) st0[r] *= g128; }
        if (nst == 2) { RT_STATE_UPD(st1, sti, 1);
#pragma unroll
            for (int r = 0; r < 16; ++r) st1[r] *= g128; }
        float s1 = 0.f, s2 = 0.f;
#pragma unroll
        for (int r = 0; r < 16; ++r) { const float a_ = y0[r], b_ = y1[r]; s1 += a_ + b_; s2 += a_ * a_ + b_ * b_; }
        s1 += __shfl_xor(s1, 32); s2 += __shfl_xor(s2, 32);
        if (hi == 0) *(LAS f32x2_t*)(lds + RT_STAT + (wid * 32 + c) * 8) = (f32x2_t){s1, s2};
        __syncthreads();
        { const f32x2_t o = *(const LAS f32x2_t*)(lds + RT_STAT + ((wid ^ 1) * 32 + c) * 8); s1 += o.x; s2 += o.y; }
        const float mu = s1 * (1.f / 128.f), var = fmaxf(s2 * (1.f / 128.f) - mu * mu, 0.f), rstd = rsqrtf(var + EPS);
        {
            const size_t row = (size_t)R0 + 32 * j + c;
#pragma unroll
            for (int i2 = 0; i2 < 2; ++i2)
#pragma unroll
                for (int g = 0; g < 4; ++g) {
                    const int e = 64 * ih + 32 * i2 + 8 * g + 4 * hi;
                    const u32x2 gw = *(const u32x2*)(RG + row * 1024 + h * 128 + e); const f32x4 gn = *(const f32x4*)(ggn + h * 128 + e);
                    float yv[4];
#pragma unroll
                    for (int x = 0; x < 4; ++x) yv[x] = i2 == 0 ? y0[4 * g + x] : y1[4 * g + x];
                    const float o0 = (yv[0] - mu) * rstd * gn.x * bf2f(gw.x & 0xffff), o1 = (yv[1] - mu) * rstd * gn.y * bf2f(gw.x >> 16);
                    const float o2 = (yv[2] - mu) * rstd * gn.z * bf2f(gw.y & 0xffff), o3 = (yv[3] - mu) * rstd * gn.w * bf2f(gw.y >> 16);
                    u32x2 ow; ow.x = cvtpk(o0, o1); ow.y = cvtpk(o2, o3);
                    *(u32x2*)(RET + row * 1024 + h * 128 + e) = ow;
                }
        }
        if (n + 1 < 32) {
            RT_STORE();
            if (nst >= 1) RT_PUT_ST(st0, sti, std0);
            if (nst == 2) RT_PUT_ST(st1, sti, 1);
        }
        __syncthreads();
    }
#undef RT_MPOS
#undef RT_LOAD
#undef RT_TR4
#undef RT_STORE
#undef RT_PUT_ST
#undef RT_STATE_UPD
}
__global__ void __launch_bounds__(512, 2) k_ret(Ptrs p) {
    extern __shared__ __attribute__((aligned(16))) unsigned char lds[];
    for (int u = blockIdx.x; u < 64; u += gridDim.x) ret_unit(p, (LAS unsigned char*)lds, u >> 3, u & 7);
}

__global__ void __launch_bounds__(256) k_zero_ss2(Ptrs p) {
    float* R = (float*)(p.ws + WS_RINV2);
    for (int i = blockIdx.x * 256 + threadIdx.x; i < T; i += gridDim.x * 256) R[i] = 0.f;
}

__global__ void __launch_bounds__(32) k_peer_select_naive(Ptrs p) {
    __shared__ float sc[256][32];
    __shared__ int ii[32][32];
    const bf16_t* PQ = (const bf16_t*)(p.ws + WS_PQ);
    const float* k1 = p.in[16]; const float* k2 = p.in[17];
    int* SELI = (int*)(p.ws + WS_SELI); float* SELG = (float*)(p.ws + WS_SELG);
    const int tid = threadIdx.x, gid = blockIdx.x * 32 + tid, tok = gid >> 3, hd = gid & 7;
    float q[128];
#pragma unroll
    for (int d = 0; d < 128; d += 8) { float t[8]; ld8(PQ + (size_t)tok * D + hd * 128 + d, t);
#pragma unroll
        for (int j = 0; j < 8; ++j) q[d + j] = t[j]; }
    for (int kk = 0; kk < 128; ++kk) {
        float a = 0.f, b = 0.f;
#pragma unroll
        for (int d = 0; d < 64; ++d) { a += q[d] * k1[kk * 64 + d]; b += q[64 + d] * k2[kk * 64 + d]; }
        sc[kk][tid] = a; sc[128 + kk][tid] = b;
    }
    float v1[16], v2[16];
#pragma unroll
    for (int r = 0; r < 16; ++r) {
        float best = -INFINITY; int bi = 0;
        for (int kk = 0; kk < 128; ++kk) { const float x = sc[kk][tid]; if (x > best) { best = x; bi = kk; } }
        sc[bi][tid] = -INFINITY; v1[r] = best; ii[r][tid] = bi;
        best = -INFINITY; bi = 0;
        for (int kk = 0; kk < 128; ++kk) { const float x = sc[128 + kk][tid]; if (x > best) { best = x; bi = kk; } }
        sc[128 + bi][tid] = -INFINITY; v2[r] = best; ii[16 + r][tid] = bi;
    }
#pragma unroll
    for (int i = 0; i < 16; ++i)
#pragma unroll
        for (int j = 0; j < 16; ++j) sc[i * 16 + j][tid] = v1[i] + v2[j];
    float sv[16]; int se[16];
#pragma unroll
    for (int r = 0; r < 16; ++r) {
        float best = -INFINITY; int bi = 0;
        for (int c = 0; c < 256; ++c) { const float x = sc[c][tid]; if (x > best) { best = x; bi = c; } }
        sc[bi][tid] = -INFINITY; sv[r] = best; se[r] = ii[bi >> 4][tid] * 128 + ii[16 + (bi & 15)][tid];
    }
    float den = 0.f; const float mx = sv[0];
#pragma unroll
    for (int r = 0; r < 16; ++r) { sv[r] = __expf(sv[r] - mx); den += sv[r]; }
    const float id = 1.f / den;
#pragma unroll
    for (int r = 0; r < 16; ++r) { SELI[(size_t)tok * 128 + hd * 16 + r] = se[r]; SELG[(size_t)tok * 128 + hd * 16 + r] = sv[r] * id; }
}

__global__ void __launch_bounds__(256) k_peer_gather_naive(Ptrs p) {
    __shared__ float wk[128];
    const int* SELI = (const int*)(p.ws + WS_SELI); const float* SELG = (const float*)(p.ws + WS_SELG);
    const float* RINV2 = (const float*)(p.ws + WS_RINV2); const float* gffn = p.in[14]; const float* U = p.in[18]; const float* Vt = p.in[19];
    const int tok = blockIdx.x, tid = threadIdx.x, lane = tid & 63, w = tid >> 6;
    const float r2 = rsqrtf(RINV2[tok] * (1.f / D) + EPS);
    f32x4 xr[4];
#pragma unroll
    for (int j = 0; j < 4; ++j) { const f32x4 hv = *(const f32x4*)(p.out + (size_t)tok * D + lane * 4 + 256 * j); const f32x4 g = *(const f32x4*)(gffn + lane * 4 + 256 * j); xr[j] = hv * g * r2; }
    for (int k = w * 32; k < w * 32 + 32; ++k) {
        const float* up = U + (size_t)SELI[(size_t)tok * 128 + k] * D;
        float dsum = 0.f;
#pragma unroll
        for (int j = 0; j < 4; ++j) { const f32x4 u = *(const f32x4*)(up + lane * 4 + 256 * j); dsum += u.x * xr[j].x + u.y * xr[j].y + u.z * xr[j].z + u.w * xr[j].w; }
        dsum = wave_sum(dsum);
        const float act = 0.5f * dsum * (1.f + erff(dsum * 0.70710678118654752f));
        if (lane == 0) wk[k] = SELG[(size_t)tok * 128 + k] * act;
    }
    __syncthreads();
    f32x4 acc = (f32x4){0.f, 0.f, 0.f, 0.f};
    for (int k = 0; k < 128; ++k) { const f32x4 v = *(const f32x4*)(Vt + (size_t)SELI[(size_t)tok * 128 + k] * D + tid * 4); acc += v * wk[k]; }
    f32x4* op = (f32x4*)(p.out + (size_t)tok * D + tid * 4); *op = *op + acc;
}

#define LAS __attribute__((address_space(3)))
typedef float f32x16 __attribute__((ext_vector_type(16)));
typedef short bf16x8 __attribute__((ext_vector_type(8)));
__device__ __forceinline__ int sortable(int b) { return b ^ ((b >> 31) & 0x7fffffff); }
__device__ __forceinline__ int imax(int a, int b) { return a > b ? a : b; }
__device__ __forceinline__ int imin(int a, int b) { return a < b ? a : b; }
template <int N, int K, int J> __device__ __forceinline__ void bstep(int (&v)[N]) {
#pragma unroll
    for (int i = 0; i < N; ++i) { const int l = i ^ J; if (l > i) { const int a = v[i], b = v[l]; const bool d = (i & K) == 0; v[i] = d ? imax(a, b) : imin(a, b); v[l] = d ? imin(a, b) : imax(a, b); } }
}
template <int N, int K, int J> __device__ __forceinline__ void bstep2(int (&v)[N], int (&q)[N]) {
#pragma unroll
    for (int i = 0; i < N; ++i) { const int l = i ^ J; if (l > i) { const int a = v[i], b = v[l], pa = q[i], pb = q[l]; const bool gt = a > b; const bool d = (i & K) == 0;
        const int hk = gt ? a : b, lk = gt ? b : a, hp = gt ? pa : pb, lp = gt ? pb : pa; v[i] = d ? hk : lk; v[l] = d ? lk : hk; q[i] = d ? hp : lp; q[l] = d ? lp : hp; } }
}
template <int N, int K, int J> struct BMerge { static __device__ __forceinline__ void run(int (&v)[N]) { bstep<N, K, J>(v); if constexpr (J > 1) BMerge<N, K, J / 2>::run(v); }
                                               static __device__ __forceinline__ void run2(int (&v)[N], int (&q)[N]) { bstep2<N, K, J>(v, q); if constexpr (J > 1) BMerge<N, K, J / 2>::run2(v, q); } };
template <int N, int K> struct BSort { static __device__ __forceinline__ void run(int (&v)[N]) { if constexpr (K > 2) BSort<N, K / 2>::run(v); BMerge<N, K, K / 2>::run(v); }
                                       static __device__ __forceinline__ void run2(int (&v)[N], int (&q)[N]) { if constexpr (K > 2) BSort<N, K / 2>::run2(v, q); BMerge<N, K, K / 2>::run2(v, q); } };
__device__ __forceinline__ void top16_merge(const int (&a)[16], const int (&b)[16], int (&o)[16]) {
#pragma unroll
    for (int i = 0; i < 16; ++i) o[i] = imax(a[i], b[15 - i]);
    BMerge<16, 16, 8>::run(o);
}
__device__ __forceinline__ void top16_merge2(const int (&a)[16], const int (&pa)[16], const int (&b)[16], const int (&pb)[16], int (&o)[16], int (&po)[16]) {
#pragma unroll
    for (int i = 0; i < 16; ++i) { const bool gt = a[i] > b[15 - i]; o[i] = gt ? a[i] : b[15 - i]; po[i] = gt ? pa[i] : pb[15 - i]; }
    BMerge<16, 16, 8>::run2(o, po);
}
__device__ __forceinline__ void top16_of_64(const int (&v)[64], int (&o)[16]) {
    int g[4][16];
#pragma unroll
    for (int q = 0; q < 4; ++q) {
#pragma unroll
        for (int i = 0; i < 16; ++i) g[q][i] = v[q * 16 + i];
        BSort<16, 16>::run(g[q]); }
    int m0[16], m1[16]; top16_merge(g[0], g[1], m0); top16_merge(g[2], g[3], m1); top16_merge(m0, m1, o);
}
__device__ __forceinline__ void top16_of_64p(const int (&v)[64], const int (&pv)[64], int (&o)[16], int (&po)[16]) {
    int g[4][16], h[4][16];
#pragma unroll
    for (int q = 0; q < 4; ++q) {
#pragma unroll
        for (int i = 0; i < 16; ++i) { g[q][i] = v[q * 16 + i]; h[q][i] = pv[q * 16 + i]; }
        BSort<16, 16>::run2(g[q], h[q]); }
    int m0[16], p0[16], m1[16], p1[16]; top16_merge2(g[0], h[0], g[1], h[1], m0, p0); top16_merge2(g[2], h[2], g[3], h[3], m1, p1); top16_merge2(m0, p0, m1, p1, o, po);
}
template <int M, int J, int N> __device__ __forceinline__ void cand_one(const int (&am)[8], const float (&f2)[16], const int (&M2)[16], int (&g)[16], int (&h)[16]) {
    const float f1 = __int_as_float(sortable(am[M] & ~0x7f)); g[N] = sortable(__float_as_int(f1 + f2[J])); h[N] = ((am[M] & 0x7f) << 7) | (M2[J] & 0x7f);
}
__device__ __forceinline__ void cand_rest(const int (&am)[8], const float (&f2)[16], const int (&M2)[16], int (&g)[16], int (&h)[16]) {
    cand_one<1, 0, 0>(am, f2, M2, g, h); cand_one<1, 1, 1>(am, f2, M2, g, h); cand_one<1, 2, 2>(am, f2, M2, g, h); cand_one<1, 3, 3>(am, f2, M2, g, h); cand_one<1, 4, 4>(am, f2, M2, g, h);
    cand_one<2, 0, 5>(am, f2, M2, g, h); cand_one<2, 1, 6>(am, f2, M2, g, h); cand_one<2, 2, 7>(am, f2, M2, g, h);
    cand_one<3, 0, 8>(am, f2, M2, g, h); cand_one<3, 1, 9>(am, f2, M2, g, h);
    cand_one<4, 0, 10>(am, f2, M2, g, h); cand_one<5, 0, 11>(am, f2, M2, g, h); cand_one<6, 0, 12>(am, f2, M2, g, h); cand_one<7, 0, 13>(am, f2, M2, g, h);
    g[14] = (int)0x80000000; h[14] = 0; g[15] = (int)0x80000000; h[15] = 0;
}
constexpr int KEY_PITCH = 144;
__device__ __forceinline__ void peer_keys_to_lds(const Ptrs& p, LAS unsigned char* lds) {
    for (int i = threadIdx.x; i < 2 * 128 * 8; i += blockDim.x) { const int side = i >> 10, row = (i >> 3) & 127, ch = i & 7; const float* src = p.in[16 + side] + row * 64 + ch * 8;
        const f32x4 a = *(const f32x4*)src, b = *(const f32x4*)(src + 4); u32x4 w; w.x = pk2(a.x, a.y); w.y = pk2(a.z, a.w); w.z = pk2(b.x, b.y); w.w = pk2(b.z, b.w);
        *(LAS u32x4*)(lds + (side * 128 + row) * KEY_PITCH + ch * 16) = w; }
}
template <class IP, class GP, class U4P, class F4P>
__device__ __forceinline__ void peer_select_unit(const Ptrs& p, const LAS unsigned char* lds, int tok0, int head, int lane, IP si, GP sg) {
    const bf16_t* PQ = (const bf16_t*)(p.ws + WS_PQ);
    const int c = lane & 31, hi = lane >> 5, tok = tok0 + c;
    {
        int M1[16], M2[16];
#pragma unroll
        for (int side = 0; side < 2; ++side) {
            bf16x8 bq[4];
#pragma unroll
            for (int s = 0; s < 4; ++s) bq[s] = *(const bf16x8*)(PQ + (size_t)tok * D + head * 128 + side * 64 + 16 * s + 8 * hi);
            int L[16];
            {   int g[2][16], m[2][16];
#pragma unroll
                for (int kt = 0; kt < 4; ++kt) {
                    f32x16 acc = {};
#pragma unroll
                    for (int s = 0; s < 4; ++s) { const bf16x8 a = *(const LAS bf16x8*)(lds + (side * 128 + kt * 32 + c) * KEY_PITCH + (16 * s + 8 * hi) * 2);
                        acc = __builtin_amdgcn_mfma_f32_32x32x16_bf16(a, bq[s], acc, 0, 0, 0); }
#pragma unroll
                    for (int r = 0; r < 16; ++r) { const float fv = acc[r]; g[kt & 1][r] = (sortable(__float_as_int(fv)) & ~0x7f) | (kt * 32 + (r & 3) + 8 * (r >> 2) + 4 * hi); }
                    BSort<16, 16>::run(g[kt & 1]);
                    if (kt & 1) top16_merge(g[0], g[1], m[kt >> 1]);
                    __builtin_amdgcn_sched_barrier(0);
                }
                top16_merge(m[0], m[1], L);
            }
            int A_[16], B_[16];
#pragma unroll
            for (int i = 0; i < 16; ++i) { const int pr = __shfl_xor(L[i], 32); A_[i] = hi ? pr : L[i]; B_[i] = hi ? L[i] : pr; }
            if (side == 0) top16_merge(A_, B_, M1); else top16_merge(A_, B_, M2);
            __builtin_amdgcn_sched_barrier(0);
        }
        int K16[16], P16[16];
        {   int am[8];
#pragma unroll
            for (int m = 0; m < 8; ++m) am[m] = M1[2 * m] ^ ((M1[2 * m] ^ M1[2 * m + 1]) & -hi);
            float f2[16];
#pragma unroll
            for (int j = 0; j < 16; ++j) f2[j] = __int_as_float(sortable(M2[j] & ~0x7f));
            int g0[16], h0[16], g1[16], h1[16];
            { const float f1 = __int_as_float(sortable(am[0] & ~0x7f)); const int e1 = (am[0] & 0x7f) << 7;
#pragma unroll
              for (int j = 0; j < 16; ++j) { g0[j] = sortable(__float_as_int(f1 + f2[j])); h0[j] = e1 | (M2[j] & 0x7f); } }
            cand_rest(am, f2, M2, g1, h1);
            BSort<16, 16>::run2(g1, h1);
            int mk[16], mp[16]; top16_merge2(g0, h0, g1, h1, mk, mp);
            int Ak[16], Ap[16], Bk[16], Bp[16];
#pragma unroll
            for (int i = 0; i < 16; ++i) { const int pk = __shfl_xor(mk[i], 32), pp = __shfl_xor(mp[i], 32); Ak[i] = hi ? pk : mk[i]; Bk[i] = hi ? mk[i] : pk; Ap[i] = hi ? pp : mp[i]; Bp[i] = hi ? mp[i] : pp; }
            top16_merge2(Ak, Ap, Bk, Bp, K16, P16);
        }
        float ex[16], den = 0.f; const float mx = __int_as_float(sortable(K16[0]));
#pragma unroll
        for (int r = 0; r < 16; ++r) { ex[r] = __expf(__int_as_float(sortable(K16[r])) - mx); den += ex[r]; }
        const float id = 1.f / den;
        if (hi == 0) { IP ip = si + (size_t)c * 128 + head * 16;
#pragma unroll
            for (int r = 0; r < 16; r += 4) *(U4P)(ip + r) = (u32x4){(unsigned)P16[r], (unsigned)P16[r + 1], (unsigned)P16[r + 2], (unsigned)P16[r + 3]}; }
        else { GP gp = sg + (size_t)c * 128 + head * 16;
#pragma unroll
            for (int r = 0; r < 16; r += 4) *(F4P)(gp + r) = (f32x4){ex[r] * id, ex[r + 1] * id, ex[r + 2] * id, ex[r + 3] * id}; }
    }
}
__device__ __forceinline__ void peer_select_phase(const Ptrs& p, LAS unsigned char* lds, int* SELI, float* SELG, int gw, int nw, int lane) {
    peer_keys_to_lds(p, lds); __syncthreads();
    for (int task = gw; task < 8192; task += nw) { const int tok0 = (task >> 3) * 32; peer_select_unit<int*, float*, u32x4*, f32x4*>(p, lds, tok0, task & 7, lane, SELI + (size_t)tok0 * 128, SELG + (size_t)tok0 * 128); }
}
__global__ void __launch_bounds__(512, 2) k_peer_select(Ptrs p, int alt) {
    extern __shared__ __attribute__((aligned(16))) unsigned char lds[];
    int* si = (int*)(p.ws + (alt ? WS_RET : WS_SELI)); float* sg = (float*)(p.ws + (alt ? WS_RET + (size_t)T * 128 * 4 : WS_SELG));
    peer_select_phase(p, (LAS unsigned char*)lds, si, sg, blockIdx.x * 8 + (threadIdx.x >> 6), gridDim.x * 8, threadIdx.x & 63);
}
__global__ void __launch_bounds__(256) k_peer_select256(Ptrs p, int alt) {
    extern __shared__ __attribute__((aligned(16))) unsigned char lds[];
    int* si = (int*)(p.ws + (alt ? WS_RET : WS_SELI)); float* sg = (float*)(p.ws + (alt ? WS_RET + (size_t)T * 128 * 4 : WS_SELG));
    peer_select_phase(p, (LAS unsigned char*)lds, si, sg, blockIdx.x * 4 + (threadIdx.x >> 6), gridDim.x * 4, threadIdx.x & 63);
}
__global__ void k_dbg_cmp_sel(Ptrs p, int mode) {
    const int gid = blockIdx.x * blockDim.x + threadIdx.x; if (gid >= T * 8) return;
    const int* a = (const int*)(p.ws + WS_SELI) + (size_t)gid * 16; const int* b = (const int*)(p.ws + WS_RET) + (size_t)gid * 16;
    const float* ga = (const float*)(p.ws + WS_SELG) + (size_t)gid * 16; const float* gb = (const float*)(p.ws + WS_RET + (size_t)T * 128 * 4) + (size_t)gid * 16;
    int miss = 0; float gd = 0.f;
    for (int i = 0; i < 16; ++i) { bool f = false; for (int j = 0; j < 16; ++j) f |= (a[i] == b[j]); miss += f ? 0 : 1; gd += fabsf(ga[i] - gb[i]); }
    unsigned* ctl = (unsigned*)(p.ws + WS_CTL);
    if (mode == 0) { if (miss) atomicAdd(ctl, 1u); }
    else if (mode == 1) { if (a[0] != b[0]) atomicAdd(ctl, 1u); }
    else if (mode == 2) { atomicAdd(ctl, (unsigned)miss); }
    else { atomicAdd((float*)ctl + 1, gd); }
}
__global__ void k_dbg_cmp_scores(Ptrs p) {
    const int gid = blockIdx.x * blockDim.x + threadIdx.x; if (gid >= 1024 * 8 * 2 * 128) return;
    const int key = gid & 127, side = (gid >> 7) & 1, head = (gid >> 8) & 7, tok = gid >> 11;
    const bf16_t* PQ = (const bf16_t*)(p.ws + WS_PQ); const float* kk = p.in[16 + side] + key * 64;
    float a = 0.f; for (int d = 0; d < 64; ++d) a += bf2f(PQ[(size_t)tok * D + head * 128 + side * 64 + d]) * kk[d];
    const float b = ((const float*)(p.ws + WS_RET + (size_t)64 * 1024 * 1024))[gid];
#if DBG_SCORES == 2
    atomicAdd((float*)(p.ws + WS_CTL) + 1, fabsf(a - b) > 0.1f ? 1.f : 0.f);
#elif DBG_SCORES == 3
    if (fabsf(a - b) > 0.1f) { atomicAdd((float*)(p.ws + WS_CTL) + 1, (float)((key & 31) + 1) / 32.f); atomicAdd((float*)(p.ws + WS_CTL) + 2, 1.f); }
#elif DBG_SCORES == 4
    if (fabsf(a - b) > 0.1f) { atomicAdd((float*)(p.ws + WS_CTL) + 1, (float)((tok & 31) + 1) / 32.f); atomicAdd((float*)(p.ws + WS_CTL) + 2, 1.f); }
#elif DBG_SCORES == 5
    if (fabsf(a - b) > 0.1f) { atomicAdd((float*)(p.ws + WS_CTL) + 1, fminf(fabsf(b), 10.f) / 10.f); atomicAdd((float*)(p.ws + WS_CTL) + 2, 1.f); }
#else
    atomicAdd((float*)(p.ws + WS_CTL) + 1, fabsf(a - b));
#endif
}
__global__ void k_dbg_scale(Ptrs p, float denom, int mode) {
    const unsigned* ctl = (const unsigned*)(p.ws + WS_CTL);
#if defined(DBG_SCORES) && DBG_SCORES >= 3
    const float m = ((const float*)ctl)[1] / fmaxf(((const float*)ctl)[2], 1.f);
#else
    const float m = mode == 3 ? ((const float*)ctl)[1] / denom : (float)ctl[0] / denom;
#endif
    for (size_t i = (size_t)blockIdx.x * blockDim.x + threadIdx.x; i < (size_t)T * D; i += (size_t)gridDim.x * blockDim.x) p.out[i] *= (1.f + m);
}

typedef __bf16 bf16x2_t __attribute__((ext_vector_type(2)));
__device__ __forceinline__ float dot2bf(unsigned a, unsigned b, float c) { return __builtin_amdgcn_fdot2_f32_bf16(__builtin_bit_cast(bf16x2_t, a), __builtin_bit_cast(bf16x2_t, b), c, false); }
constexpr size_t WS_U8 = WS_K, WS_V8 = WS_K + (size_t)16384 * 1024, WS_SU = WS_V, WS_SV = WS_V + 65536;
static_assert(WS_V8 + (size_t)16384 * 1024 <= WS_V && WS_SV + 65536 <= WS_RET, "peer table overlay");
__device__ __forceinline__ float wave_max(float v) {
#pragma unroll
    for (int o = 1; o < 64; o <<= 1) v = fmaxf(v, __shfl_xor(v, o));
    return v;
}
__device__ __forceinline__ void prep_uv_part(const Ptrs& p, int gw, int nw, int lane) {
    for (int row = gw; row < 2 * 16384; row += nw) {
        const int t = row >> 14, e = row & 16383;
        const float* src = p.in[18 + t] + (size_t)e * D + lane * 16;
        f32x4 v[4]; float am = 0.f;
#pragma unroll
        for (int j = 0; j < 4; ++j) { v[j] = *(const f32x4*)(src + 4 * j); am = fmaxf(am, fmaxf(fmaxf(fabsf(v[j].x), fabsf(v[j].y)), fmaxf(fabsf(v[j].z), fabsf(v[j].w)))); }
        am = fmaxf(wave_max(am), 1e-30f);
        const float inv = 127.f / am; const int off = t ? 128 : 0;
        u32x4 w;
#pragma unroll
        for (int j = 0; j < 4; ++j) { const int q0 = (int)rintf(v[j].x * inv) + off, q1 = (int)rintf(v[j].y * inv) + off, q2 = (int)rintf(v[j].z * inv) + off, q3 = (int)rintf(v[j].w * inv) + off;
            w[j] = (unsigned)(q0 & 0xff) | ((unsigned)(q1 & 0xff) << 8) | ((unsigned)(q2 & 0xff) << 16) | ((unsigned)(q3 & 0xff) << 24); }
        *(u32x4*)(p.ws + (t ? WS_V8 : WS_U8) + (size_t)e * D + lane * 16) = w;
        if (lane == 0) ((float*)(p.ws + (t ? WS_SV : WS_SU)))[e] = am * (1.f / 127.f);
    }
}
__global__ void __launch_bounds__(512) k_prep_uv(Ptrs p) { prep_uv_part(p, blockIdx.x * 8 + (threadIdx.x >> 6), gridDim.x * 8, threadIdx.x & 63); }

__device__ __forceinline__ float gelu_erf(float x) { return 0.5f * x * (1.f + erff(x * 0.70710678118654752f)); }
__device__ __forceinline__ float treduce8(const float (&v)[8], int lane) {
    float w[4], x[2], y;
    const bool b0 = lane & 1, b1 = lane & 2, b2 = lane & 4;
#pragma unroll
    for (int i = 0; i < 4; ++i) { const float keep = b0 ? v[2 * i + 1] : v[2 * i], send = b0 ? v[2 * i] : v[2 * i + 1]; w[i] = keep + __shfl_xor(send, 1); }
#pragma unroll
    for (int i = 0; i < 2; ++i) { const float keep = b1 ? w[2 * i + 1] : w[2 * i], send = b1 ? w[2 * i] : w[2 * i + 1]; x[i] = keep + __shfl_xor(send, 2); }
    { const float keep = b2 ? x[1] : x[0], send = b2 ? x[0] : x[1]; y = keep + __shfl_xor(send, 4); }
    y += __shfl_xor(y, 8); y += __shfl_xor(y, 16); y += __shfl_xor(y, 32);
    return y;
}
__device__ __forceinline__ int treduce8i(const int (&v)[8], int lane) {
    int w[4], x[2], y;
    const bool b0 = lane & 1, b1 = lane & 2, b2 = lane & 4;
#pragma unroll
    for (int i = 0; i < 4; ++i) { const int keep = b0 ? v[2 * i + 1] : v[2 * i], send = b0 ? v[2 * i] : v[2 * i + 1]; w[i] = keep + __shfl_xor(send, 1); }
#pragma unroll
    for (int i = 0; i < 2; ++i) { const int keep = b1 ? w[2 * i + 1] : w[2 * i], send = b1 ? w[2 * i] : w[2 * i + 1]; x[i] = keep + __shfl_xor(send, 2); }
    { const int keep = b2 ? x[1] : x[0], send = b2 ? x[0] : x[1]; y = keep + __shfl_xor(send, 4); }
    y += __shfl_xor(y, 8); y += __shfl_xor(y, 16); y += __shfl_xor(y, 32);
    return y;
}
__device__ __forceinline__ void peer_gather_token(const Ptrs& p, int tok, int i0, int i1, float g0, float g1, int lane, bool do_store = true) {
    const float* SS2 = (const float*)(p.ws + WS_RINV2); const float* gffn = p.in[14];
    const unsigned char* U8 = p.ws + WS_U8; const unsigned char* V8 = p.ws + WS_V8; const float* SU = (const float*)(p.ws + WS_SU); const float* SV = (const float*)(p.ws + WS_SV);
    int xq[4]; float xs;
    {   const float r2 = rsqrtf(SS2[tok] * (1.f / D) + EPS); const float* hp = p.out + (size_t)tok * D + lane * 16; const float* gp = gffn + lane * 16;
        f32x4 x[4]; float am = 0.f;
#pragma unroll
        for (int j = 0; j < 4; ++j) { x[j] = *(const f32x4*)(hp + 4 * j) * *(const f32x4*)(gp + 4 * j) * r2; am = fmaxf(am, fmaxf(fmaxf(fabsf(x[j].x), fabsf(x[j].y)), fmaxf(fabsf(x[j].z), fabsf(x[j].w)))); }
        am = fmaxf(wave_max(am), 1e-30f); xs = am * (1.f / 127.f); const float inv = 127.f / am;
#pragma unroll
        for (int j = 0; j < 4; ++j) xq[j] = (int)(((unsigned)((int)rintf(x[j].x * inv) & 0xff)) | ((unsigned)((int)rintf(x[j].y * inv) & 0xff) << 8) | ((unsigned)((int)rintf(x[j].z * inv) & 0xff) << 16) | ((unsigned)((int)rintf(x[j].w * inv) & 0xff) << 24));
    }
    const float su0 = SU[i0], su1 = SU[i1], sv0 = SV[i0], sv1 = SV[i1];
    int a0 = 0, a1 = 0;
#pragma unroll 1
    for (int kb = 0; kb < 8; ++kb) {
        u32x4 r[16];
#pragma unroll
        for (int e = 0; e < 16; ++e) { const int k = kb * 16 + e; const int idx = __builtin_amdgcn_readlane(kb < 4 ? i0 : i1, k & 63); r[e] = *(const u32x4*)(U8 + (size_t)idx * D + lane * 16); }
        int pa[8], pb[8];
#pragma unroll
        for (int e = 0; e < 16; ++e) { int d = __builtin_amdgcn_sdot4((int)r[e].x, xq[0], 0, false); d = __builtin_amdgcn_sdot4((int)r[e].y, xq[1], d, false); d = __builtin_amdgcn_sdot4((int)r[e].z, xq[2], d, false); d = __builtin_amdgcn_sdot4((int)r[e].w, xq[3], d, false);
            if (e < 8) pa[e] = d; else pb[e - 8] = d; }
        const int ya = treduce8i(pa, lane), yb = treduce8i(pb, lane);
        const int y = (lane & 8) ? yb : ya;
        if ((kb & 3) == ((lane >> 4) & 3)) { if (kb < 4) a0 = y; else a1 = y; }
    }
    const float wv0 = g0 * gelu_erf((float)a0 * su0 * xs) * sv0, wv1 = g1 * gelu_erf((float)a1 * su1 * xs) * sv1;
    const float corr = 128.f * wave_sum(wv0 + wv1);
    float acc[16];
#pragma unroll
    for (int e = 0; e < 16; ++e) acc[e] = 0.f;
#pragma unroll 1
    for (int kb = 0; kb < 8; ++kb) {
        u32x4 r[16];
#pragma unroll
        for (int e = 0; e < 16; ++e) { const int k = kb * 16 + e; const int idx = __builtin_amdgcn_readlane(kb < 4 ? i0 : i1, k & 63); r[e] = *(const u32x4*)(V8 + (size_t)idx * D + lane * 16); }
#pragma unroll
        for (int e = 0; e < 16; ++e) { const int k = kb * 16 + e; const float wk = __int_as_float(__builtin_amdgcn_readlane(__float_as_int(kb < 4 ? wv0 : wv1), k & 63));
#pragma unroll
            for (int j = 0; j < 4; ++j) { const unsigned w = r[e][j];
                acc[4 * j + 0] += wk * (float)(w & 0xffu); acc[4 * j + 1] += wk * (float)((w >> 8) & 0xffu); acc[4 * j + 2] += wk * (float)((w >> 16) & 0xffu); acc[4 * j + 3] += wk * (float)(w >> 24); } }
    }
    {   float* hp = p.out + (size_t)tok * D + lane * 16;
#pragma unroll
        for (int j = 0; j < 4; ++j) { f32x4 a = *(const f32x4*)(hp + 4 * j);
            a.x += acc[4 * j] - corr; a.y += acc[4 * j + 1] - corr; a.z += acc[4 * j + 2] - corr; a.w += acc[4 * j + 3] - corr;
            if (do_store || a.x == 1.2345e30f) *(f32x4*)(hp + 4 * j) = a; } }
}
__device__ __forceinline__ void peer_gather_phase(const Ptrs& p, int gw, int nw, int lane) {
    const int* SELI = (const int*)(p.ws + WS_SELI); const float* SELG = (const float*)(p.ws + WS_SELG);
    for (int tok = gw; tok < T; tok += nw)
        peer_gather_token(p, tok, SELI[(size_t)tok * 128 + lane], SELI[(size_t)tok * 128 + 64 + lane], SELG[(size_t)tok * 128 + lane], SELG[(size_t)tok * 128 + 64 + lane], lane);
}
__global__ void __launch_bounds__(512, 2) k_peer_gather(Ptrs p) {
    peer_gather_phase(p, blockIdx.x * 8 + (threadIdx.x >> 6), gridDim.x * 8, threadIdx.x & 63);
}

#include <hip/hip_cooperative_groups.h>
namespace cg = cooperative_groups;
constexpr int CW_Q3 = 64;
constexpr int MISC_OFF = LDS_BYTES - 64;

__device__ __forceinline__ void prep_w_tile(const float* __restrict__ W, const float* __restrict__ gain, bf16_t* __restrict__ Wt, int K, int Nsrc, int mode, int tn, int tk, LAS float* tile) {
    const int t_ = opaque_tid(), tx = t_ & 63, ty = t_ >> 6, n0 = tn * 64, k0 = tk * 64, n = n0 + tx; const int src = mode ? win_src(n) : n;
    for (int kk = ty; kk < 64; kk += 8) { float v = 0.f; if (src >= 0) { v = W[(size_t)(k0 + kk) * Nsrc + src]; if (gain) v *= gain[k0 + kk]; } tile[kk * 65 + tx] = v; }
    __syncthreads();
    for (int nn = ty; nn < 64; nn += 8) Wt[(size_t)(n0 + nn) * K + k0 + tx] = (bf16_t)f2bf(tile[tx * 65 + nn]);
    __syncthreads();
}
__device__ __forceinline__ void prep_phase(const Ptrs& p, LAS unsigned char* lds) {
    const int tid = opaque_tid(), lane = tid & 63, G = gridDim.x, bx = blockIdx.x;
    unsigned char* ws = p.ws;
    if (bx == 0 && tid == 0) ((unsigned*)(ws + WS_CTL))[CW_Q3] = 0u;
    { float* R = (float*)(ws + WS_RINV2); for (int i = bx * 512 + tid; i < T; i += G * 512) R[i] = 0.f; }
    {
        float2* R32 = (float2*)(ws + WS_ROPE32); float2* R16 = (float2*)(ws + WS_ROPE16);
        for (int i = bx * 512 + tid; i < 4112 * 32; i += G * 512) {
            { const int pos = i >> 5, f = i & 31; const float inv = (float)pow(10000.0, -(double)f / 32.0); const float ang = (float)pos * inv; R32[i] = make_float2((float)cos((double)ang), (float)sin((double)ang)); }
            if (i < 4112 * 16) { const int pos = i >> 4, f = i & 15; const float inv = (float)pow(10000.0, -(double)f / 16.0); const float ang = (float)pos * inv; R16[i] = make_float2((float)cos((double)ang), (float)sin((double)ang)); } }
    }
    {
        bf16_t* XB = (bf16_t*)(ws + WS_XB);
        for (int r = bx * 8 + (tid >> 6); r < MP; r += G * 8) {
            f32x4 v[4];
            if (r < T + NMETA) { const float* src = r < T ? p.in[0] + (size_t)r * D : p.in[1] + (size_t)(r - T) * D;
#pragma unroll
                for (int j = 0; j < 4; ++j) v[j] = *(const f32x4*)(src + lane * 4 + 256 * j); }
            else {
#pragma unroll
                for (int j = 0; j < 4; ++j) v[j] = (f32x4){0.f, 0.f, 0.f, 0.f}; }
            float ss = 0.f;
#pragma unroll
            for (int j = 0; j < 4; ++j) ss += v[j].x * v[j].x + v[j].y * v[j].y + v[j].z * v[j].z + v[j].w * v[j].w;
            ss = wave_sum(ss);
            const float rinv = rsqrtf(ss * (1.f / D) + EPS);
#pragma unroll
            for (int j = 0; j < 4; ++j) { uint2 o; o.x = pk2(v[j].x * rinv, v[j].y * rinv); o.y = pk2(v[j].z * rinv, v[j].w * rinv); *(uint2*)(XB + (size_t)r * D + lane * 4 + 256 * j) = o; }
        }
    }
    {
        LAS float* tile = (LAS float*)lds;
        constexpr int NT0 = (NIN / 64) * 16, NT1 = NT0 + 12 * 6, NT2 = NT1 + 16 * 4, NT3 = NT2 + 16 * 8, NT4 = NT3 + 256, NT5 = NT4 + 256, NT6 = NT5 + 256;
        for (int it = bx; it < NT6; it += G) {
            if (it < NT0) prep_w_tile(p.in[3], p.in[2], (bf16_t*)(ws + WS_WIN), 1024, 5792, 1, it / 16, it % 16, tile);
            else if (it < NT1) { const int r = it - NT0; prep_w_tile(p.in[5], p.in[4], (bf16_t*)(ws + WS_WUQ), 384, 768, 0, r / 6, r % 6, tile); }
            else if (it < NT2) { const int r = it - NT1; prep_w_tile(p.in[7], p.in[6], (bf16_t*)(ws + WS_WUKV), 256, 1024, 0, r / 4, r % 4, tile); }
            else if (it < NT3) { const int r = it - NT2; prep_w_tile(p.in[10], nullptr, (bf16_t*)(ws + WS_WMLA), 512, 1024, 0, r / 8, r % 8, tile); }
            else if (it < NT4) { const int r = it - NT3; prep_w_tile(p.in[12], nullptr, (bf16_t*)(ws + WS_WRET), 1024, 1024, 0, r / 16, r % 16, tile); }
            else if (it < NT5) { const int r = it - NT4; prep_w_tile(p.in[13], nullptr, (bf16_t*)(ws + WS_WMIX), 1024, 1024, 0, r / 16, r % 16, tile); }
            else { const int r = it - NT5; prep_w_tile(p.in[15], p.in[14], (bf16_t*)(ws + WS_WPQ), 1024, 1024, 0, r / 16, r % 16, tile); }
        }
    }
}
__device__ __forceinline__ void mixer_phase(const Ptrs& p, LAS unsigned char* lds) {
    unsigned* ctl = (unsigned*)(p.ws + WS_CTL);
    volatile LAS unsigned* bc = (volatile LAS unsigned*)(lds + MISC_OFF);
    for (;;) {
        __syncthreads();
        if (threadIdx.x == 0) *bc = __hip_atomic_fetch_add(ctl + CW_Q3, 1u, __ATOMIC_RELAXED, __HIP_MEMORY_SCOPE_AGENT);
        __syncthreads();
        const int it = (int)*bc;
        if (it >= 64 + 1024) break;
        if (it < 64) ret_unit(p, lds, it >> 3, it & 7);
        else { const int a = it - 64, qb = 15 - (a >> 6), bh = a & 63; attn_unit(p, lds, bh >> 3, bh & 7, qb); }
    }
}
constexpr int PL_SELI = 2 * 128 * KEY_PITCH, PL_SELG = PL_SELI + 32 * 128 * 4, PL_END = PL_SELG + 32 * 128 * 4;
static_assert(PL_END <= MISC_OFF, "peer LDS");
__device__ __forceinline__ void peer_phase(const Ptrs& p, LAS unsigned char* lds, bool do_store = true) {
    const int tid = opaque_tid(), lane = tid & 63, wid = __builtin_amdgcn_readfirstlane(tid >> 6);
    peer_keys_to_lds(p, lds);
    for (int u = blockIdx.x; u < T / 32; u += gridDim.x) {
        __syncthreads();
        peer_select_unit<LAS int*, LAS float*, LAS u32x4*, LAS f32x4*>(p, lds, u * 32, wid, lane, (LAS int*)(lds + PL_SELI), (LAS float*)(lds + PL_SELG));
        __syncthreads();
#pragma unroll 1
        for (int k = 0; k < 4; ++k) { const int tl = wid * 4 + k;
            const LAS int* ip = (const LAS int*)(lds + PL_SELI) + tl * 128; const LAS float* gp = (const LAS float*)(lds + PL_SELG) + tl * 128;
            peer_gather_token(p, u * 32 + tl, ip[lane], ip[64 + lane], gp[lane], gp[64 + lane], lane, do_store); }
    }
}

__global__ void __launch_bounds__(512, 2) k_mega(Ptrs p) {
    extern __shared__ __attribute__((aligned(16))) unsigned char lds_raw[];
    LAS unsigned char* lds = (LAS unsigned char*)lds_raw;
    cg::grid_group grid = cg::this_grid();
    unsigned char* ws = p.ws;
    const int G = gridDim.x, bx = blockIdx.x, nw = G * 8;
    bf16_t *WIN = (bf16_t*)(ws + WS_WIN), *WUQ = (bf16_t*)(ws + WS_WUQ), *WUKV = (bf16_t*)(ws + WS_WUKV), *WMLA = (bf16_t*)(ws + WS_WMLA), *WRET = (bf16_t*)(ws + WS_WRET),
           *WMIX = (bf16_t*)(ws + WS_WMIX), *WPQ = (bf16_t*)(ws + WS_WPQ);
    bf16_t *XB = (bf16_t*)(ws + WS_XB), *LAT = (bf16_t*)(ws + WS_LAT), *RQ = (bf16_t*)(ws + WS_RQ), *RK = (bf16_t*)(ws + WS_RK), *RV = (bf16_t*)(ws + WS_RV), *RG = (bf16_t*)(ws + WS_RG);
    bf16_t *SA = (bf16_t*)p.out, *SR = SA + (size_t)T * 1024;
    bf16_t *Q = (bf16_t*)(ws + WS_Q), *K = (bf16_t*)(ws + WS_K), *VRAW = (bf16_t*)(ws + WS_VRAW), *AO = (bf16_t*)(ws + WS_AO), *RET = (bf16_t*)(ws + WS_RET), *MG = (bf16_t*)(ws + WS_MG),
           *H1B = (bf16_t*)(ws + WS_H1B), *PQ = (bf16_t*)(ws + WS_PQ);
    pg8::StaticOrder S;
#ifndef PROBE_DUP
#define PROBE_DUP 0
#endif
    prep_phase(p, lds);
    if (PROBE_DUP == 4) { __syncthreads(); prep_phase(p, lds); }
    if (PROBE_DUP == 5) { for (int i_ = 0; i_ < 8; ++i_) grid.sync(); }
    grid.sync();
    { pg8::Gemm g{XB, WIN, 1024, 1024, MP, NIN, 1024, 0}; S.init(MP, NIN, G, bx); pg8::gemm_phase(lds, g, S, EpiIn{LAT, RQ, RK, RV, RG, SA, SR, (const float2*)(ws + WS_ROPE32)}); }
    if (PROBE_DUP == 3) { pg8::Gemm g{XB, WIN, 1024, 1024, MP, NIN, 1024, 0}; S.init(MP, NIN, G, bx); pg8::gemm_phase(lds, g, S, EpiIn{LAT, RQ, RK, RV, RG, SA, SR, (const float2*)(ws + WS_ROPE32)}); }
    grid.sync();
    { pg8::Gemm g{LAT, WUQ, 768, 384, T, 768, 384, 0}; S.init(T, 768, G, bx); pg8::gemm_phase(lds, g, S, EpiQraw{Q}); }
    { pg8::Gemm g{LAT + 384, WUKV, 768, 256, MP, 1024, 256, 0}; S.init(MP, 1024, G, bx); pg8::gemm_phase(lds, g, S, EpiKVraw{K, VRAW}); }
    grid.sync();
    { const int t_ = opaque_tid(); finalize_phase(p, bx * 8 + (t_ >> 6), nw, t_ & 63); }
    grid.sync();
    mixer_phase(p, lds);
    grid.sync();
    if (PROBE_DUP == 2) { if (bx == 0 && threadIdx.x == 0) ((unsigned*)(ws + WS_CTL))[CW_Q3] = 0u; grid.sync(); mixer_phase(p, lds); grid.sync(); }
    { const int t_ = opaque_tid(); prep_uv_part(p, bx * 8 + (t_ >> 6), nw, t_ & 63); }
    { pg8::Gemm g{AO, WMLA, 512, 512, T, 1024, 512, 0}; S.init(T, 1024, G, bx); pg8::gemm_phase(lds, g, S, EpiMerge1{MG, SA}); }
    { pg8::Gemm g{RET, WRET, 1024, 1024, T, 1024, 1024, 0}; S.init(T, 1024, G, bx); pg8::gemm_phase(lds, g, S, EpiMerge2{MG, SR}); }
    grid.sync();
    { pg8::Gemm g{MG, WMIX, 1024, 1024, T, 1024, 1024, 0}; S.init(T, 1024, G, bx); pg8::gemm_phase(lds, g, S, EpiMix{p.in[0], p.out, H1B, (float*)(ws + WS_RINV2)}); }
    grid.sync();
    { pg8::Gemm g{H1B, WPQ, 1024, 1024, T, 1024, 1024, 0}; S.init(T, 1024, G, bx); pg8::gemm_phase(lds, g, S, EpiPQ{PQ, (const float*)(ws + WS_RINV2)}); }
    grid.sync();
    if (PROBE_DUP == 1) { peer_phase(p, lds, false); __syncthreads(); }
    peer_phase(p, lds);
}

#ifndef USE_REF_GEMM
#define USE_REF_GEMM 0
#endif
template <class Epi> static void launch_gemm(hipStream_t st, const bf16_t* A, int lda, const bf16_t* Bt, int ldb, int M, int N, int K, Epi E) {
    if (USE_REF_GEMM) { hipLaunchKernelGGL(gemm_ref<Epi>, dim3(N / 128, M / 64), dim3(256), 0, st, A, lda, Bt, ldb, K, E); return; }
    static bool attr_done = false;
    if (!attr_done) { (void)hipFuncSetAttribute((const void*)k_gemm<Epi>, hipFuncAttributeMaxDynamicSharedMemorySize, LDS_BYTES); attr_done = true; }
    pg8::Gemm g{A, Bt, lda, ldb, M, N, K, 0};
    hipLaunchKernelGGL(k_gemm<Epi>, dim3(256), dim3(512), LDS_BYTES, st, g, E);
}
#ifndef MEGA
#define MEGA 1
#endif
extern "C" void kernel_launch(void* const* d_in, const int* in_sizes, int n_in, void* d_out, int out_size, void* d_ws, size_t ws_size, hipStream_t stream) {
    Ptrs p{}; for (int i = 0; i < 20; ++i) p.in[i] = (const float*)d_in[i]; p.out = (float*)d_out; p.ws = (unsigned char*)d_ws;
#if MEGA
    static int grid = 0;
    if (grid == 0) {
        int dev = 0, cus = 0, per_cu = 0;
        (void)hipGetDevice(&dev); (void)hipDeviceGetAttribute(&cus, hipDeviceAttributeMultiprocessorCount, dev);
        (void)hipFuncSetAttribute((const void*)k_mega, hipFuncAttributeMaxDynamicSharedMemorySize, LDS_BYTES);
        (void)hipOccupancyMaxActiveBlocksPerMultiprocessor(&per_cu, (const void*)k_mega, 512, LDS_BYTES);
        if (per_cu < 1) per_cu = 1;
        grid = cus * (per_cu > 1 ? 1 : per_cu);
        if (grid % 8) grid -= grid % 8;
    }
    void* args[] = {&p};
    (void)hipLaunchCooperativeKernel((const void*)k_mega, dim3(grid), dim3(512), args, LDS_BYTES, stream);
    return;
#endif
    unsigned char* ws = p.ws;
    bf16_t *WIN = (bf16_t*)(ws + WS_WIN), *WUQ = (bf16_t*)(ws + WS_WUQ), *WUKV = (bf16_t*)(ws + WS_WUKV), *WMLA = (bf16_t*)(ws + WS_WMLA), *WRET = (bf16_t*)(ws + WS_WRET),
           *WMIX = (bf16_t*)(ws + WS_WMIX), *WPQ = (bf16_t*)(ws + WS_WPQ);
    bf16_t *XB = (bf16_t*)(ws + WS_XB), *LAT = (bf16_t*)(ws + WS_LAT), *RQ = (bf16_t*)(ws + WS_RQ), *RK = (bf16_t*)(ws + WS_RK), *RV = (bf16_t*)(ws + WS_RV), *RG = (bf16_t*)(ws + WS_RG);
    bf16_t *SA = (bf16_t*)d_out, *SR = SA + (size_t)T * 1024;
    bf16_t *Q = (bf16_t*)(ws + WS_Q), *K = (bf16_t*)(ws + WS_K), *V = (bf16_t*)(ws + WS_VRAW), *AO = (bf16_t*)(ws + WS_AO), *RET = (bf16_t*)(ws + WS_RET), *MG = (bf16_t*)(ws + WS_MG),
           *H1B = (bf16_t*)(ws + WS_H1B), *PQ = (bf16_t*)(ws + WS_PQ);
    hipLaunchKernelGGL(k_prep_rows, dim3(1024), dim3(256), 0, stream, p);
    hipLaunchKernelGGL(k_prep_rope, dim3((4112 * 32 + 255) / 256), dim3(256), 0, stream, p);
    hipLaunchKernelGGL(k_prep_w<1>, dim3(NIN / 64, 1024 / 64), dim3(256), 0, stream, p.in[3], p.in[2], WIN, 1024, 5792, NIN);
    hipLaunchKernelGGL(k_prep_w<0>, dim3(768 / 64, 384 / 64), dim3(256), 0, stream, p.in[5], p.in[4], WUQ, 384, 768, 768);
    hipLaunchKernelGGL(k_prep_w<0>, dim3(1024 / 64, 256 / 64), dim3(256), 0, stream, p.in[7], p.in[6], WUKV, 256, 1024, 1024);
    hipLaunchKernelGGL(k_prep_w<0>, dim3(1024 / 64, 512 / 64), dim3(256), 0, stream, p.in[10], (const float*)nullptr, WMLA, 512, 1024, 1024);
    hipLaunchKernelGGL(k_prep_w<0>, dim3(1024 / 64, 1024 / 64), dim3(256), 0, stream, p.in[12], (const float*)nullptr, WRET, 1024, 1024, 1024);
    hipLaunchKernelGGL(k_prep_w<0>, dim3(1024 / 64, 1024 / 64), dim3(256), 0, stream, p.in[13], (const float*)nullptr, WMIX, 1024, 1024, 1024);
    hipLaunchKernelGGL(k_prep_w<0>, dim3(1024 / 64, 1024 / 64), dim3(256), 0, stream, p.in[15], p.in[14], WPQ, 1024, 1024, 1024);
    launch_gemm(stream, XB, 1024, WIN, 1024, MP, NIN, 1024, EpiIn{LAT, RQ, RK, RV, RG, SA, SR, (const float2*)(ws + WS_ROPE32)});
    launch_gemm(stream, LAT, 768, WUQ, 384, T, 768, 384, EpiQraw{Q});
    launch_gemm(stream, LAT + 384, 768, WUKV, 256, MP, 1024, 256, EpiKVraw{K, V});
    hipLaunchKernelGGL(k_finalize, dim3(1024), dim3(256), 0, stream, p);
#ifndef USE_REF_ATTN
#define USE_REF_ATTN 0
#endif
    if (USE_REF_ATTN) hipLaunchKernelGGL(k_attn_naive, dim3(SEQ / 64, 8, BATCH), dim3(64), 0, stream, p);
    else hipLaunchKernelGGL(k_attn, dim3(256), dim3(512), ATT_LDS, stream, p);
#ifndef USE_REF_RET
#define USE_REF_RET 0
#endif
    if (USE_REF_RET) hipLaunchKernelGGL(k_ret_naive, dim3(64), dim3(128), 0, stream, p);
    else { static bool ad = false; if (!ad) { (void)hipFuncSetAttribute((const void*)k_ret, hipFuncAttributeMaxDynamicSharedMemorySize, RT_LDS); ad = true; }
        hipLaunchKernelGGL(k_ret, dim3(64), dim3(512), RT_LDS, stream, p); }
    launch_gemm(stream, AO, 512, WMLA, 512, T, 1024, 512, EpiMerge1{MG, SA});
    launch_gemm(stream, RET, 1024, WRET, 1024, T, 1024, 1024, EpiMerge2{MG, SR});
    hipLaunchKernelGGL(k_zero_ss2, dim3(128), dim3(256), 0, stream, p);
    launch_gemm(stream, MG, 1024, WMIX, 1024, T, 1024, 1024, EpiMix{p.in[0], p.out, H1B, (float*)(ws + WS_RINV2)});
    launch_gemm(stream, H1B, 1024, WPQ, 1024, T, 1024, 1024, EpiPQ{PQ, (const float*)(ws + WS_RINV2)});
#ifndef USE_REF_SELECT
#define USE_REF_SELECT 0
#endif
    if (USE_REF_SELECT) hipLaunchKernelGGL(k_peer_select_naive, dim3(T * 8 / 32), dim3(32), 0, stream, p);
    else hipLaunchKernelGGL(k_peer_select, dim3(256), dim3(512), 2 * 128 * KEY_PITCH, stream, p, 0);
#ifdef DBG_SEL
    hipMemsetAsync(p.ws + WS_CTL, 0, 4096, stream);
    hipLaunchKernelGGL(k_peer_select256, dim3(512), dim3(256), 2 * 128 * KEY_PITCH, stream, p, 1);
    hipLaunchKernelGGL(k_dbg_cmp_sel, dim3(T * 8 / 256), dim3(256), 0, stream, p, DBG_SEL);
#ifdef DBG_SCORES
    hipLaunchKernelGGL(k_dbg_cmp_scores, dim3(1024 * 8 * 2 * 128 / 256), dim3(256), 0, stream, p);
#endif
#endif
#ifndef USE_REF_GATHER
#define USE_REF_GATHER 0
#endif
    if (USE_REF_GATHER) hipLaunchKernelGGL(k_peer_gather_naive, dim3(T), dim3(256), 0, stream, p);
    else { hipLaunchKernelGGL(k_prep_uv, dim3(512), dim3(512), 0, stream, p); hipLaunchKernelGGL(k_peer_gather, dim3(256), dim3(512), 0, stream, p); }
#ifdef DBG_SEL
    hipLaunchKernelGGL(k_dbg_scale, dim3(2048), dim3(256), 0, stream, p, DBG_SEL == 3 ? (float)(1024 * 8 * 2 * 128) : DBG_SEL == 2 ? (float)T * 128 : (float)T * 8, DBG_SEL);
#endif
}
```

```cpp
#include <hip/hip_runtime.h>
#include <stdint.h>
#include <math.h>
#include <utility>

typedef unsigned short bf16_t;
typedef float f32x4 __attribute__((ext_vector_type(4)));
typedef unsigned u32x4 __attribute__((ext_vector_type(4)));

constexpr int D = 1024, BATCH = 8, SEQ = 4096, NMETA = 16;
constexpr int T = BATCH * SEQ;
constexpr int MP = 33024;
constexpr float EPS = 1e-6f;
constexpr int NIN = 5888;
constexpr int C_LAT = 0, C_RQ = 768, C_RK = 1280, C_RV = 1792, C_RG = 2816, C_SA = 3840, C_SR = 4864;
constexpr float QSCALE = 1.4426950408889634f * 0.10206207261596575f;

constexpr size_t al(size_t x) { return (x + 255) & ~(size_t)255; }
constexpr size_t WS_CTL = 0;
constexpr size_t WS_WIN = 1u << 20;
constexpr size_t WS_WUQ = WS_WIN + al((size_t)NIN * 1024 * 2);
constexpr size_t WS_WUKV = WS_WUQ + al((size_t)768 * 384 * 2);
constexpr size_t WS_WMLA = WS_WUKV + al((size_t)1024 * 256 * 2);
constexpr size_t WS_WRET = WS_WMLA + al((size_t)1024 * 512 * 2);
constexpr size_t WS_WMIX = WS_WRET + al((size_t)1024 * 1024 * 2);
constexpr size_t WS_WPQ = WS_WMIX + al((size_t)1024 * 1024 * 2);
constexpr size_t WS_KEYS = WS_WPQ + al((size_t)1024 * 1024 * 2);
constexpr size_t WS_ROPE32 = WS_KEYS + al((size_t)2 * 128 * 64 * 2);
constexpr size_t WS_ROPE16 = WS_ROPE32 + al((size_t)4112 * 32 * 8);
constexpr size_t WS_DEC = WS_ROPE16 + al((size_t)4112 * 16 * 8);
constexpr size_t WS_RINV2 = WS_DEC + al((size_t)8 * 256 * 4);
constexpr size_t WS_XB = WS_RINV2 + al((size_t)T * 4);
constexpr size_t WS_LAT = WS_XB + al((size_t)MP * 1024 * 2);
constexpr size_t WS_RQ = WS_LAT + al((size_t)MP * 768 * 2);
constexpr size_t WS_RK = WS_RQ + al((size_t)MP * 512 * 2);
constexpr size_t WS_RV = WS_RK + al((size_t)MP * 512 * 2);
constexpr size_t WS_RG = WS_RV + al((size_t)MP * 1024 * 2);
constexpr size_t WS_K = WS_RG + al((size_t)T * 1024 * 2);
constexpr size_t WS_V = WS_K + al((size_t)MP * 768 * 2);
constexpr int VT_LEN = 4160;
constexpr size_t WS_RET = WS_V + al((size_t)64 * 64 * VT_LEN * 2);

constexpr size_t WS_END = WS_RET + al((size_t)T * 1024 * 2);
static_assert(WS_END <= 536870912ull, "workspace map exceeds 512 MiB");
constexpr size_t WS_Q = WS_XB, WS_MG = WS_XB, WS_AO = WS_LAT, WS_H1B = WS_RV, WS_PQ = WS_RG, WS_SELI = WS_RQ, WS_SELG = WS_RQ + (size_t)T * 128 * 4;
static_assert(WS_SELG + (size_t)T * 128 * 4 <= WS_RV, "SEL overlay");
constexpr size_t WS_VRAW = WS_RET, WS_VT = WS_V;
__host__ __device__ __forceinline__ int vt_pos(int tile, int k) { const int x = k & 15; return 64 * tile + (k & 48) + ((x >= 4 && x < 12) ? (x ^ 12) : x); }

__device__ __forceinline__ unsigned f2bf(float f) { unsigned u = __builtin_bit_cast(unsigned, f); return (u + 0x7fffu + ((u >> 16) & 1u)) >> 16; }
__device__ __forceinline__ float bf2f(unsigned h) { return __builtin_bit_cast(float, h << 16); }
__device__ __forceinline__ unsigned pk2(float lo, float hi) { return f2bf(lo) | (f2bf(hi) << 16); }
__device__ __forceinline__ float wave_sum(float v) {
#pragma unroll
    for (int o = 1; o < 64; o <<= 1) v += __shfl_xor(v, o);
    return v;
}
__device__ __forceinline__ int row_pos(int row) { return row < T ? NMETA + (row & (SEQ - 1)) : (row - T < NMETA ? row - T : 0); }
__device__ __forceinline__ float sigmoidf_(float x) { return __builtin_amdgcn_rcpf(1.f + __builtin_amdgcn_exp2f(-1.4426950408889634f * x)); }

__device__ __forceinline__ int opaque_tid() { int t = threadIdx.x; asm volatile("" : "+v"(t)); return t; }

struct Ptrs {
    const float* in[20];
    float* out;
    unsigned char* ws;
};

__global__ void __launch_bounds__(256) k_prep_rows(Ptrs p) {
    const int lane = threadIdx.x & 63, gw = (blockIdx.x * 256 + threadIdx.x) >> 6, nw = (gridDim.x * 256) >> 6;
    bf16_t* XB = (bf16_t*)(p.ws + WS_XB);
    for (int r = gw; r < MP; r += nw) {
        f32x4 v[4];
        if (r < T + NMETA) {
            const float* src = r < T ? p.in[0] + (size_t)r * D : p.in[1] + (size_t)(r - T) * D;
#pragma unroll
            for (int j = 0; j < 4; ++j) v[j] = *(const f32x4*)(src + lane * 4 + 256 * j);
        } else {
#pragma unroll
            for (int j = 0; j < 4; ++j) v[j] = (f32x4){0.f, 0.f, 0.f, 0.f};
        }
        float ss = 0.f;
#pragma unroll
        for (int j = 0; j < 4; ++j) ss += v[j].x * v[j].x + v[j].y * v[j].y + v[j].z * v[j].z + v[j].w * v[j].w;
        ss = wave_sum(ss);
        const float rinv = rsqrtf(ss * (1.f / D) + EPS);
#pragma unroll
        for (int j = 0; j < 4; ++j) {
            uint2 o; o.x = pk2(v[j].x * rinv, v[j].y * rinv); o.y = pk2(v[j].z * rinv, v[j].w * rinv);
            *(uint2*)(XB + (size_t)r * D + lane * 4 + 256 * j) = o;
        }
    }
}

__device__ __forceinline__ int win_src(int n) {
    if (n < 672) return n;
    if (n < 768) return -1;
    if (n < C_RV) { const int base = n < C_RK ? 672 : 1184, q = (n - (n < C_RK ? C_RQ : C_RK)), hh = q >> 6, pp = q & 63; return base + hh * 64 + (pp >> 1) + 32 * (pp & 1); }
    if (n < C_RG) return 1696 + (n - C_RV);
    if (n < C_SA) return 2720 + (n - C_RG);
    if (n < C_SR) return 3744 + (n - C_SA);
    return 4768 + (n - C_SR);
}
template <int MODE>
__global__ void __launch_bounds__(256) k_prep_w(const float* __restrict__ W, const float* __restrict__ gain, bf16_t* __restrict__ Wt, int K, int Nsrc, int Ndst) {
    __shared__ float tile[64][65];
    const int n0 = blockIdx.x * 64, k0 = blockIdx.y * 64, tx = threadIdx.x & 63, ty = threadIdx.x >> 6;
    const int n = n0 + tx; const int src = MODE == 1 ? win_src(n) : n;
    for (int kk = ty; kk < 64; kk += 4) {
        float v = 0.f;
        if (src >= 0 && n < Ndst) { v = W[(size_t)(k0 + kk) * Nsrc + src]; if (gain) v *= gain[k0 + kk]; }
        tile[kk][tx] = v;
    }
    __syncthreads();
    for (int nn = ty; nn < 64; nn += 4) if (n0 + nn < Ndst) Wt[(size_t)(n0 + nn) * K + k0 + tx] = (bf16_t)f2bf(tile[tx][nn]);
}
__global__ void k_prep_rope(Ptrs p) {
    const int i = blockIdx.x * blockDim.x + threadIdx.x;
    float2* R32 = (float2*)(p.ws + WS_ROPE32); float2* R16 = (float2*)(p.ws + WS_ROPE16);
    if (i < 4112 * 32) { const int pos = i >> 5, f = i & 31; const float inv = (float)pow(10000.0, -(double)f / 32.0); const float ang = (float)pos * inv; R32[i] = make_float2((float)cos((double)ang), (float)sin((double)ang)); }
    if (i < 4112 * 16) { const int pos = i >> 4, f = i & 15; const float inv = (float)pow(10000.0, -(double)f / 16.0); const float ang = (float)pos * inv; R16[i] = make_float2((float)cos((double)ang), (float)sin((double)ang)); }
    if (i < 8 * 256) ((float*)(p.ws + WS_DEC))[i] = (float)pow(1.0 - exp2(-5.0 - (double)(i >> 8)), (double)((i & 255) + 1));
}

typedef float f32x2_t __attribute__((ext_vector_type(2)));
typedef __bf16 bf16x2v_t __attribute__((ext_vector_type(2)));
__device__ __forceinline__ unsigned cvtpk(float lo, float hi) { const f32x2_t v = {lo, hi}; return __builtin_bit_cast(unsigned, __builtin_convertvector(v, bf16x2v_t)); }
__device__ __forceinline__ void st8(bf16_t* dst, const float (&v)[8]) {
    u32x4 w; w.x = cvtpk(v[0], v[1]); w.y = cvtpk(v[2], v[3]); w.z = cvtpk(v[4], v[5]); w.w = cvtpk(v[6], v[7]); *(u32x4*)dst = w;
}
struct EpiIn {
    bf16_t *LAT, *RQ, *RK, *RV, *RG, *SA, *SR; const float2* R32; const float* DEC;
    __device__ __forceinline__ void apply(int row, int col0, const float (&v)[8]) const {
        if (col0 < C_RQ) { st8(LAT + (size_t)row * 768 + col0, v); return; }
        if (col0 < C_RV) {
            const bool isq = col0 < C_RK; const int c = col0 - (isq ? C_RQ : C_RK); const int i0 = (c & 63) >> 1;
            const int hh = c >> 6, cc = row < T ? (row & 127) : (row - T);
            const float dq = DEC[hh * 256 + cc];
            const float2* rp = R32 + row_pos(row) * 32 + i0; const float sc = isq ? dq : 0.125f * __builtin_amdgcn_rcpf(dq);
            float o[8];
#pragma unroll
            for (int j = 0; j < 4; ++j) { const float2 cs = rp[j]; const float x1 = v[2 * j], x2 = v[2 * j + 1]; o[2 * j] = (x1 * cs.x - x2 * cs.y) * sc; o[2 * j + 1] = (x1 * cs.y + x2 * cs.x) * sc; }
            st8((isq ? RQ : RK) + (size_t)row * 512 + c, o); return;
        }
        if (col0 < C_RG) { st8(RV + (size_t)row * 1024 + (col0 - C_RV), v); return; }
        if (row >= T) return;
        float o[8];
        if (col0 < C_SA) {
#pragma unroll
            for (int j = 0; j < 8; ++j) o[j] = v[j] * sigmoidf_(v[j]);
            st8(RG + (size_t)row * 1024 + (col0 - C_RG), o); return;
        }
#pragma unroll
        for (int j = 0; j < 8; ++j) o[j] = sigmoidf_(v[j]);
        if (col0 < C_SR) st8(SA + (size_t)row * 1024 + (col0 - C_SA), o); else st8(SR + (size_t)row * 1024 + (col0 - C_SR), o);
    }
};
struct EpiNull { float* sink; __device__ __forceinline__ void apply(int row, int col0, const float (&v)[8]) const { if (v[0] == 1.2345e30f) sink[row] = v[1] + v[2] + v[3] + v[4] + v[5] + v[6] + v[7]; } };
struct EpiQraw { bf16_t* Q; __device__ __forceinline__ void apply(int row, int col0, const float (&v)[8]) const { st8(Q + (size_t)row * 768 + col0, v); } };
struct EpiKVraw {
    bf16_t *K, *V;
    __device__ __forceinline__ void apply(int row, int col0, const float (&v)[8]) const {
        const int h = col0 >> 7, j = col0 & 127;
        if (j < 64) st8(K + (size_t)row * 768 + h * 96 + j, v); else st8(V + (size_t)row * 512 + h * 64 + (j - 64), v);
    }
};
__device__ __forceinline__ void ld8(const bf16_t* src, float (&o)[8]) {
    const u32x4 w = *(const u32x4*)src;
    o[0] = bf2f(w.x & 0xffff); o[1] = bf2f(w.x >> 16); o[2] = bf2f(w.y & 0xffff); o[3] = bf2f(w.y >> 16);
    o[4] = bf2f(w.z & 0xffff); o[5] = bf2f(w.z >> 16); o[6] = bf2f(w.w & 0xffff); o[7] = bf2f(w.w >> 16);
}
struct EpiMerge1 { bf16_t* MG; const bf16_t* SA;
    __device__ __forceinline__ void apply(int row, int col0, const float (&v)[8]) const {
        float g[8], o[8]; ld8(SA + (size_t)row * 1024 + col0, g);
#pragma unroll
        for (int j = 0; j < 8; ++j) o[j] = g[j] * v[j];
        st8(MG + (size_t)row * 1024 + col0, o); } };
struct EpiMerge2 { bf16_t* MG; const bf16_t* SR;
    __device__ __forceinline__ void apply(int row, int col0, const float (&v)[8]) const {
        float g[8], m[8], o[8]; ld8(SR + (size_t)row * 1024 + col0, g); ld8(MG + (size_t)row * 1024 + col0, m);
#pragma unroll
        for (int j = 0; j < 8; ++j) o[j] = m[j] + g[j] * v[j];
        st8(MG + (size_t)row * 1024 + col0, o); } };
struct EpiMix { const float* x; float* out; bf16_t* H1B; float* SS2;
    __device__ __forceinline__ void apply(int row, int col0, const float (&v)[8]) const {
        const f32x4 a = *(const f32x4*)(x + (size_t)row * D + col0), b = *(const f32x4*)(x + (size_t)row * D + col0 + 4);
        float o[8] = {a.x + v[0], a.y + v[1], a.z + v[2], a.w + v[3], b.x + v[4], b.y + v[5], b.z + v[6], b.w + v[7]};
        *(f32x4*)(out + (size_t)row * D + col0) = (f32x4){o[0], o[1], o[2], o[3]}; *(f32x4*)(out + (size_t)row * D + col0 + 4) = (f32x4){o[4], o[5], o[6], o[7]};
        st8(H1B + (size_t)row * D + col0, o);
        float ss = 0.f;
#pragma unroll
        for (int j = 0; j < 8; ++j) ss += o[j] * o[j];
        atomicAdd(SS2 + row, ss); } };
struct EpiPQ { bf16_t* PQ; const float* SS2;
    __device__ __forceinline__ void apply(int row, int col0, const float (&v)[8]) const {
        const float r = rsqrtf(SS2[row] * (1.f / D) + EPS); float o[8];
#pragma unroll
        for (int j = 0; j < 8; ++j) o[j] = v[j] * r;
        st8(PQ + (size_t)row * D + col0, o); } };

template <class Epi>
__global__ void __launch_bounds__(256) gemm_ref(const bf16_t* __restrict__ A, int lda, const bf16_t* __restrict__ Bt, int ldb, int K, Epi E) {
    __shared__ float As[32][64 + 4];
    __shared__ float Bs[32][128 + 4];
    const int tid = threadIdx.x, tx = tid & 15, ty = tid >> 4;
    const int m0 = blockIdx.y * 64, n0 = blockIdx.x * 128;
    float acc[4][8];
#pragma unroll
    for (int i = 0; i < 4; ++i)
#pragma unroll
        for (int j = 0; j < 8; ++j) acc[i][j] = 0.f;
    for (int k0 = 0; k0 < K; k0 += 32) {
        { const int m = tid & 63, kc = tid >> 6; float t[8]; ld8(A + (size_t)(m0 + m) * lda + k0 + kc * 8, t);
#pragma unroll
          for (int j = 0; j < 8; ++j) As[kc * 8 + j][m] = t[j]; }
#pragma unroll
        for (int i = 0; i < 2; ++i) { const int n = tid & 127, kc = (tid >> 7) + 2 * i; float t[8]; ld8(Bt + (size_t)(n0 + n) * ldb + k0 + kc * 8, t);
#pragma unroll
          for (int j = 0; j < 8; ++j) Bs[kc * 8 + j][n] = t[j]; }
        __syncthreads();
#pragma unroll 8
        for (int kk = 0; kk < 32; ++kk) {
            const f32x4 a = *(const f32x4*)&As[kk][ty * 4]; const f32x4 b0 = *(const f32x4*)&Bs[kk][tx * 8], b1 = *(const f32x4*)&Bs[kk][tx * 8 + 4];
            const float av[4] = {a.x, a.y, a.z, a.w}, bv[8] = {b0.x, b0.y, b0.z, b0.w, b1.x, b1.y, b1.z, b1.w};
#pragma unroll
            for (int i = 0; i < 4; ++i)
#pragma unroll
                for (int j = 0; j < 8; ++j) acc[i][j] += av[i] * bv[j];
        }
        __syncthreads();
    }
#pragma unroll
    for (int i = 0; i < 4; ++i) E.apply(m0 + ty * 4 + i, n0 + tx * 8, acc[i]);
}

namespace pg8 {
#define PG8_LAS __attribute__((address_space(3)))
typedef short bf16x8 __attribute__((ext_vector_type(8)));
constexpr int BM = 256, BK = 64, HALF = 128, HTB = HALF * BK * 2, STAGE_BYTES = 8 * HTB, NXCD = 8, WGM = 8;
__host__ __device__ __forceinline__ int lds_byte(int r, int c) { const int st = (r >> 4) * 2 + (c >> 5), rr = r & 15, cc = c & 31, ob = rr * 64 + cc * 2; return st * 1024 + (ob ^ (((ob >> 9) & 1) << 5)); }
__host__ __device__ __forceinline__ void stage_rc(int b, int& R, int& C) { const int st = b / 1024, sb = b % 1024, swz = sb ^ (((sb >> 9) & 1) << 5); R = (st >> 1) * 16 + swz / 64; C = (st & 1) * 32 + (swz % 64) / 2; }
__host__ __device__ __forceinline__ int perm32(int rho) { const int n = rho >> 4, i = rho & 15; return 8 * (i >> 2) + 4 * n + (i & 3); }
struct Unit { int pm, pn; };
struct Gemm { const bf16_t* A; const bf16_t* Bt; int lda, ldb, M, N, K, pad; };
struct StaticOrder {
    int nM, nN, nwg, G, c;
    __host__ __device__ void init(int M, int N, int G_, int c_) { nM = M / BM; nN = N / BM; nwg = nM * nN; G = G_; c = c_; }
    __host__ __device__ bool next(int i, Unit& u) const {
        const long L = (long)i * G + c; if (L >= nwg) return false;
        int wgid = (int)L; { const int q = nwg / NXCD, r = nwg % NXCD, xcd = wgid % NXCD, off = wgid / NXCD; wgid = (xcd < r ? xcd * (q + 1) : r * (q + 1) + (xcd - r) * q) + off; }
        const int nig = WGM * nN, gid = wgid / nig, fm = gid * WGM, gsz = (nM - fm) < WGM ? (nM - fm) : WGM;
        u.pm = fm + ((wgid % nig) % gsz); u.pn = (wgid % nig) / gsz; return true;
    }
};
template <class Epi>
__device__ __forceinline__ void run_epi(const Epi& E, const f32x4 (&acc)[2][2][4][2], const Unit& u, int wr, int wc, int fr, int fq) {
    const int row0 = u.pm * BM + wr * 64 + fr, col0 = u.pn * BM + wc * 32 + 8 * fq;
#pragma unroll
    for (int ai = 0; ai < 2; ++ai)
#pragma unroll
        for (int m = 0; m < 4; ++m)
#pragma unroll
            for (int bj = 0; bj < 2; ++bj) {
                const f32x4 a = acc[ai][bj][m][0], b = acc[ai][bj][m][1];
                const float v[8] = {a[0], a[1], a[2], a[3], b[0], b[1], b[2], b[3]};
                E.apply(row0 + ai * HALF + m * 16, col0 + bj * HALF, v);
            }
}
template <class Epi>
__device__ __forceinline__ void gemm_phase(PG8_LAS unsigned char* lds, const Gemm g, const StaticOrder& S, const Epi& E) {
    const int tid = opaque_tid(), wid = __builtin_amdgcn_readfirstlane(tid >> 6), lane = tid & 63, wr = wid >> 2, wc = wid & 3, fr = lane & 15, fq = lane >> 4;
    const int K = g.K, nt = K / BK;
    unsigned voffA[2], voffB[2];
#pragma unroll
    for (int i = 0; i < 2; ++i) { int R, C; stage_rc(tid * 16 + i * 8192, R, C); const int Rb = (R & ~31) + perm32(R & 31);
        voffA[i] = (unsigned)(R * g.lda + C) * 2u; voffB[i] = (unsigned)(Rb * g.ldb + C) * 2u; }
    const size_t kstep = (size_t)(BK * 2);
    const size_t hstepA = (size_t)HALF * g.lda * 2, hstepB = (size_t)HALF * g.ldb * 2;
    const size_t tstepA = 2 * hstepA, tstepB = 2 * hstepB;
    const unsigned ldsw = (unsigned)wid * 1024u;
    const int aoff = lds_byte(wr * 64 + fr, fq * 8), boff = lds_byte(wc * 32 + fr, fq * 8);
#define PG8_SA(b, h) (((b) * 2 + (h)) * HTB)
#define PG8_SB(b, h) ((4 + (b) * 2 + (h)) * HTB)
#define PG8_STAGE(bufoff, gbase, voff) do { _Pragma("unroll") for (int _i = 0; _i < 2; ++_i) \
        __builtin_amdgcn_global_load_lds((const unsigned*)((const char*)(gbase) + (voff)[_i]), (PG8_LAS unsigned*)(lds + (bufoff) + ldsw + _i * 8192), 16, 0, 0); } while (0)
#define PG8_LDA(dst, b, h) do { _Pragma("unroll") for (int m = 0; m < 4; ++m) _Pragma("unroll") for (int k = 0; k < 2; ++k) dst[m][k] = *(const PG8_LAS bf16x8*)(lds + PG8_SA(b, h) + aoff + m * 2048 + k * 1024); } while (0)
#define PG8_LDB(dst, b, h) do { _Pragma("unroll") for (int n = 0; n < 2; ++n) _Pragma("unroll") for (int k = 0; k < 2; ++k) dst[n][k] = *(const PG8_LAS bf16x8*)(lds + PG8_SB(b, h) + boff + n * 2048 + k * 1024); } while (0)
#define PG8_MMA(ai, bj, At, Bt) do { __builtin_amdgcn_s_setprio(1); _Pragma("unroll") for (int m = 0; m < 4; ++m) _Pragma("unroll") for (int n = 0; n < 2; ++n) _Pragma("unroll") for (int k = 0; k < 2; ++k) \
        acc[ai][bj][m][n] = __builtin_amdgcn_mfma_f32_16x16x32_bf16(Bt[n][k], At[m][k], acc[ai][bj][m][n], 0, 0, 0); __builtin_amdgcn_s_setprio(0); } while (0)
#define PG8_WAIT_V(n) asm volatile("s_waitcnt vmcnt(" #n ")" ::: "memory")
#define PG8_WAIT_L(n) asm volatile("s_waitcnt lgkmcnt(" #n ")" ::: "memory")
#define PG8_BAR __builtin_amdgcn_s_barrier()
#define PG8_SCHED __builtin_amdgcn_sched_barrier(0)
    Unit cur, nxt; int ui = 0;
    if (!S.next(0, cur)) return;
    f32x4 acc[2][2][4][2];
#pragma unroll
    for (int a = 0; a < 2; ++a)
#pragma unroll
        for (int b = 0; b < 2; ++b)
#pragma unroll
            for (int m = 0; m < 4; ++m)
#pragma unroll
                for (int n = 0; n < 2; ++n) acc[a][b][m][n] = (f32x4){0.f, 0.f, 0.f, 0.f};
    bf16x8 At[4][2], B0[2][2], B1[2][2];
    const char* cA = (const char*)g.A + (size_t)cur.pm * tstepA; const char* cB = (const char*)g.Bt + (size_t)cur.pn * tstepB;
    PG8_STAGE(PG8_SB(0, 0), cB, voffB); PG8_STAGE(PG8_SB(0, 1), cB + hstepB, voffB); PG8_STAGE(PG8_SA(0, 0), cA, voffA); PG8_STAGE(PG8_SA(0, 1), cA + hstepA, voffA);
    if (wr == 1) PG8_BAR;
    PG8_WAIT_V(2); PG8_BAR;
    PG8_STAGE(PG8_SB(1, 0), cB + kstep, voffB); PG8_STAGE(PG8_SA(1, 0), cA + kstep, voffA); PG8_STAGE(PG8_SB(1, 1), cB + hstepB + kstep, voffB);
    PG8_WAIT_V(6); PG8_BAR;
    for (;;) {
        const bool has_next = S.next(ui + 1, nxt);
        const char* nA = has_next ? (const char*)g.A + (size_t)nxt.pm * tstepA : cA; const char* nB = has_next ? (const char*)g.Bt + (size_t)nxt.pn * tstepB : cB;
        for (int t = 0; t < nt; t += 2) {
            const bool last = (t == nt - 2);
            const char* a1 = cA + (size_t)(t + 1) * kstep;
            const char* a2 = last ? nA : cA + (size_t)(t + 2) * kstep; const char* b2 = last ? nB : cB + (size_t)(t + 2) * kstep;
            const char* a3 = a2 + kstep; const char* b3 = b2 + kstep;
            PG8_LDB(B0, 0, 0); PG8_LDB(B1, 0, 1); PG8_SCHED; PG8_LDA(At, 0, 0); PG8_STAGE(PG8_SA(1, 1), a1 + hstepA, voffA);
            PG8_WAIT_V(8); PG8_WAIT_L(0); PG8_BAR; PG8_MMA(0, 0, At, B0); PG8_MMA(0, 1, At, B1); PG8_BAR; PG8_SCHED;
            PG8_LDA(At, 0, 1); PG8_STAGE(PG8_SB(0, 0), b2, voffB); PG8_STAGE(PG8_SB(0, 1), b2 + hstepB, voffB); PG8_STAGE(PG8_SA(0, 0), a2, voffA);
            PG8_WAIT_V(8); PG8_WAIT_L(0); PG8_BAR; PG8_MMA(1, 0, At, B0); PG8_MMA(1, 1, At, B1); PG8_BAR; PG8_SCHED;
            PG8_LDB(B0, 1, 0); PG8_LDB(B1, 1, 1); PG8_SCHED; PG8_LDA(At, 1, 0); PG8_STAGE(PG8_SA(0, 1), a2 + hstepA, voffA);
            PG8_WAIT_V(8); PG8_WAIT_L(0); PG8_BAR; PG8_MMA(0, 0, At, B0); PG8_MMA(0, 1, At, B1); PG8_BAR; PG8_SCHED;
            PG8_LDA(At, 1, 1); PG8_STAGE(PG8_SB(1, 0), b3, voffB); PG8_STAGE(PG8_SB(1, 1), b3 + hstepB, voffB); PG8_STAGE(PG8_SA(1, 0), a3, voffA);
            PG8_WAIT_V(8); PG8_WAIT_L(0); PG8_BAR; PG8_MMA(1, 0, At, B0); PG8_MMA(1, 1, At, B1); PG8_BAR; PG8_SCHED;
        }
        if (wr == 0) PG8_BAR;
        run_epi(E, acc, cur, wr, wc, fr, fq);
        if (!has_next) break;
#pragma unroll
        for (int a = 0; a < 2; ++a)
#pragma unroll
            for (int b = 0; b < 2; ++b)
#pragma unroll
                for (int m = 0; m < 4; ++m)
#pragma unroll
                    for (int n = 0; n < 2; ++n) acc[a][b][m][n] = (f32x4){0.f, 0.f, 0.f, 0.f};
        cur = nxt; cA = nA; cB = nB; ++ui;
        if (wr == 1) PG8_BAR;
    }
    PG8_WAIT_V(0);
    PG8_BAR;
#undef PG8_SA
#undef PG8_SB
#undef PG8_STAGE
#undef PG8_LDA
#undef PG8_LDB
#undef PG8_MMA
#undef PG8_WAIT_V
#undef PG8_WAIT_L
#undef PG8_BAR
#undef PG8_SCHED
}
}

constexpr int LDS_BYTES = 147456;
template <class Epi>
__global__ void __launch_bounds__(512, 2) k_gemm(pg8::Gemm g, Epi E) {
    extern __shared__ __attribute__((aligned(16))) unsigned char lds[];
    pg8::StaticOrder S; S.init(g.M, g.N, gridDim.x, blockIdx.x);
    pg8::gemm_phase<Epi>((PG8_LAS unsigned char*)lds, g, S, E);
}

__device__ __forceinline__ void finalize_phase(const Ptrs& p, int gw, int nw, int lane) {
    const bf16_t* LAT = (const bf16_t*)(p.ws + WS_LAT);
    bf16_t* Q = (bf16_t*)(p.ws + WS_Q); bf16_t* K = (bf16_t*)(p.ws + WS_K); const bf16_t* V = (const bf16_t*)(p.ws + WS_VRAW); bf16_t* VT = (bf16_t*)(p.ws + WS_VT);
    const float2* R16 = (const float2*)(p.ws + WS_ROPE16);
    const float* gq = p.in[8]; const float* gk = p.in[9];
    const int l = lane & 31, hh = lane >> 5;
    for (int r = gw; r < MP; r += nw) {
        const bf16_t* lr = LAT + (size_t)r * 768;
        float sa = 0.f, sb = 0.f;
#pragma unroll
        for (int j = 0; j < 6; ++j) { const float c = bf2f(lr[lane + 64 * j]); sa += c * c; }
#pragma unroll
        for (int j = 0; j < 4; ++j) { const float c = bf2f(lr[384 + lane + 64 * j]); sb += c * c; }
        sa = wave_sum(sa); sb = wave_sum(sb);
        const float alpha = rsqrtf(sa * (1.f / 384.f) + EPS), beta = rsqrtf(sb * (1.f / 256.f) + EPS);
        const float kpe = bf2f(lr[640 + l]);
        const float2 cs = R16[row_pos(r) * 16 + (l & 15)];
        for (int it = 0; it < 4; ++it) {
            const int h = it * 2 + hh;
            if (r < T) {
                bf16_t* qp = Q + (size_t)r * 768 + h * 96;
                float q0 = bf2f(qp[l]) * alpha, q1 = bf2f(qp[32 + l]) * alpha, q2 = bf2f(qp[64 + l]) * alpha;
                float ss = q0 * q0 + q1 * q1 + q2 * q2;
#pragma unroll
                for (int o = 1; o < 32; o <<= 1) ss += __shfl_xor(ss, o);
                const float rq = rsqrtf(ss * (1.f / 96.f) + EPS);
                q0 *= rq * gq[l]; q1 *= rq * gq[32 + l]; q2 *= rq * gq[64 + l];
                const float pr = __shfl_xor(q2, 16);
                const float q2r = (l < 16) ? (q2 * cs.x - pr * cs.y) : (pr * cs.y + q2 * cs.x);
                qp[l] = (bf16_t)f2bf(q0 * QSCALE); qp[32 + l] = (bf16_t)f2bf(q1 * QSCALE); qp[64 + l] = (bf16_t)f2bf(q2r * QSCALE);
            }
            {
                bf16_t* kp = K + (size_t)r * 768 + h * 96;
                float k0 = bf2f(kp[l]) * beta, k1 = bf2f(kp[32 + l]) * beta, k2 = kpe;
                float ss = k0 * k0 + k1 * k1 + k2 * k2;
#pragma unroll
                for (int o = 1; o < 32; o <<= 1) ss += __shfl_xor(ss, o);
                const float rk = rsqrtf(ss * (1.f / 96.f) + EPS);
                k0 *= rk * gk[l]; k1 *= rk * gk[32 + l]; k2 *= rk * gk[64 + l];
                const float pr = __shfl_xor(k2, 16);
                const float k2r = (l < 16) ? (k2 * cs.x - pr * cs.y) : (pr * cs.y + k2 * cs.x);
                kp[l] = (bf16_t)f2bf(k0); kp[32 + l] = (bf16_t)f2bf(k1); kp[64 + l] = (bf16_t)f2bf(k2r);
                const bf16_t* vp = V + (size_t)r * 512 + h * 64;
                const bf16_t v0 = (bf16_t)f2bf(bf2f(vp[l]) * beta), v1 = (bf16_t)f2bf(bf2f(vp[32 + l]) * beta);
                if (r < T) { const int b = r >> 12, sq = r & (SEQ - 1); bf16_t* vt = VT + ((size_t)(b * 8 + h) * 64) * VT_LEN + vt_pos(1 + (sq >> 6), sq & 63);
                    vt[(size_t)l * VT_LEN] = v0; vt[(size_t)(32 + l) * VT_LEN] = v1; }
                else if (r < T + 64) { for (int b = 0; b < BATCH; ++b) { bf16_t* vt = VT + ((size_t)(b * 8 + h) * 64) * VT_LEN + vt_pos(0, r - T);
                    vt[(size_t)l * VT_LEN] = v0; vt[(size_t)(32 + l) * VT_LEN] = v1; } }
            }
        }
    }
}
__global__ void __launch_bounds__(256) k_finalize(Ptrs p) { finalize_phase(p, (blockIdx.x * 256 + threadIdx.x) >> 6, (gridDim.x * 256) >> 6, threadIdx.x & 63); }

__global__ void __launch_bounds__(64) k_attn_naive(Ptrs p) {
    const bf16_t* Q = (const bf16_t*)(p.ws + WS_Q); const bf16_t* K = (const bf16_t*)(p.ws + WS_K); const bf16_t* VT = (const bf16_t*)(p.ws + WS_VT);
    bf16_t* AO = (bf16_t*)(p.ws + WS_AO);
    const int s = blockIdx.x * 64 + threadIdx.x, h = blockIdx.y, b = blockIdx.z;
    const int row = b * SEQ + s;
    float q[96], o[64];
#pragma unroll
    for (int d = 0; d < 96; d += 8) { float t[8]; ld8(Q + (size_t)row * 768 + h * 96 + d, t);
#pragma unroll
        for (int j = 0; j < 8; ++j) q[d + j] = t[j]; }
#pragma unroll
    for (int d = 0; d < 64; ++d) o[d] = 0.f;
    float m = -INFINITY, l = 0.f;
    const int smax = blockIdx.x * 64 + 63;
    for (int j = 0; j < NMETA + smax + 1; ++j) {
        const int krow = j < NMETA ? T + j : b * SEQ + (j - NMETA);
        const bf16_t* kp = K + (size_t)krow * 768 + h * 96;
        const bf16_t* vp = VT + ((size_t)(b * 8 + h) * 64) * VT_LEN + (j < NMETA ? vt_pos(0, j) : vt_pos(1 + ((j - NMETA) >> 6), (j - NMETA) & 63));
        float sc = 0.f;
#pragma unroll
        for (int d = 0; d < 96; d += 8) { float t[8]; ld8(kp + d, t);
#pragma unroll
            for (int jj = 0; jj < 8; ++jj) sc += q[d + jj] * t[jj]; }
        const bool valid = (j < NMETA) || (j - NMETA <= s);
        if (valid) {
            const float mn = fmaxf(m, sc); const float a = exp2f(m - mn), pp = exp2f(sc - mn);
            l = l * a + pp; m = mn;
#pragma unroll
            for (int d = 0; d < 64; ++d) o[d] = o[d] * a + pp * bf2f(vp[(size_t)d * VT_LEN]);
        }
    }
    const float il = 1.f / l;
#pragma unroll
    for (int d = 0; d < 64; d += 8) { float t[8];
#pragma unroll
        for (int jj = 0; jj < 8; ++jj) t[jj] = o[d + jj] * il;
        st8(AO + (size_t)row * 512 + h * 64 + d, t); }
}

#ifndef LAS
#define LAS __attribute__((address_space(3)))
#endif
typedef float f32x16_t __attribute__((ext_vector_type(16)));
typedef short bf16x8_t __attribute__((ext_vector_type(8)));
constexpr int ATT_KP = 208, ATT_VP = 144, ATT_KB = 64 * ATT_KP, ATT_VB = 64 * ATT_VP, ATT_BUF = ATT_KB + ATT_VB, ATT_LDS = 2 * ATT_BUF;
__device__ __forceinline__ void attn_unit(const Ptrs& p, LAS unsigned char* lds, int b, int h, int qb) {
    const bf16_t* Q = (const bf16_t*)(p.ws + WS_Q); const bf16_t* K = (const bf16_t*)(p.ws + WS_K); const bf16_t* VT = (const bf16_t*)(p.ws + WS_VT);
    bf16_t* AO = (bf16_t*)(p.ws + WS_AO);
    const int tid = opaque_tid(), lane = tid & 63, wid = __builtin_amdgcn_readfirstlane(tid >> 6), q = lane & 31, hi = lane >> 5;
    const int s0w = 256 * qb + 32 * wid, sq = s0w + q; const size_t rowq = (size_t)b * SEQ + sq;
    bf16x8_t qf[6];
#pragma unroll
    for (int st = 0; st < 6; ++st) qf[st] = *(const bf16x8_t*)(Q + rowq * 768 + h * 96 + 16 * st + 8 * hi);
    const int NT = 4 * qb + 5;
    const int k0key = tid / 12, k0ch = tid % 12, k1key = (tid + 512) / 12, k1ch = (tid + 512) % 12; const bool k1v = tid < 256;
    const int vd = tid >> 3, vch = tid & 7;
    const bf16_t* vtb = VT + ((size_t)(b * 8 + h) * 64 + vd) * VT_LEN + vch * 8;
    const bf16_t* kb0 = K + (size_t)h * 96 + k0ch * 8; const bf16_t* kb1 = K + (size_t)h * 96 + k1ch * 8;
    u32x4 kr0, kr1 = {}, vr;
#define ATT_KROW(t, key) ((t) == 0 ? (size_t)(T + (key)) : (size_t)b * SEQ + 64 * ((t) - 1) + (key))
#define ATT_LOAD(t) do { kr0 = *(const u32x4*)(kb0 + ATT_KROW(t, k0key) * 768); if (k1v) kr1 = *(const u32x4*)(kb1 + ATT_KROW(t, k1key) * 768); vr = *(const u32x4*)(vtb + 64 * (t)); } while (0)
#define ATT_STORE(buf) do { LAS unsigned char* bb = lds + (buf) * ATT_BUF; *(LAS u32x4*)(bb + k0key * ATT_KP + k0ch * 16) = kr0; if (k1v) *(LAS u32x4*)(bb + k1key * ATT_KP + k1ch * 16) = kr1; \
        *(LAS u32x4*)(bb + ATT_KB + vd * ATT_VP + vch * 16) = vr; } while (0)
    __syncthreads();
    ATT_LOAD(0); ATT_STORE(0); __syncthreads();
    float m = -1e30f, l = 0.f; f32x16_t o0 = {}, o1 = {};
    for (int t = 0; t < NT; ++t) {
        const int cur = t & 1;
        if (t + 1 < NT) ATT_LOAD(t + 1);
        const int ks = 64 * (t - 1);
        if (t == 0 || ks <= s0w + 31) {
            const LAS unsigned char* base = lds + cur * ATT_BUF;
            f32x16_t p0 = {}, p1 = {};
#pragma unroll
            for (int st = 0; st < 6; ++st) {
                const bf16x8_t a0 = *(const LAS bf16x8_t*)(base + q * ATT_KP + (16 * st + 8 * hi) * 2), a1 = *(const LAS bf16x8_t*)(base + (32 + q) * ATT_KP + (16 * st + 8 * hi) * 2);
                p0 = __builtin_amdgcn_mfma_f32_32x32x16_bf16(a0, qf[st], p0, 0, 0, 0); p1 = __builtin_amdgcn_mfma_f32_32x32x16_bf16(a1, qf[st], p1, 0, 0, 0); }
            float s0[16], s1[16];
#pragma unroll
            for (int r = 0; r < 16; ++r) { s0[r] = p0[r]; s1[r] = p1[r]; }
            if (t == 0) {
#pragma unroll
                for (int r = 0; r < 16; ++r) { if ((r & 3) + 8 * (r >> 2) + 4 * hi >= NMETA) s0[r] = -1e30f; s1[r] = -1e30f; }
            } else if (ks + 63 > s0w) {
#pragma unroll
                for (int r = 0; r < 16; ++r) { const int kk = ks + (r & 3) + 8 * (r >> 2) + 4 * hi; if (kk > sq) s0[r] = -1e30f; if (kk + 32 > sq) s1[r] = -1e30f; }
            }
            float mx = fmaxf(s0[0], s1[0]);
#pragma unroll
            for (int r = 1; r < 16; ++r) mx = fmaxf(mx, fmaxf(s0[r], s1[r]));
            mx = fmaxf(mx, __shfl_xor(mx, 32));
            if (__any(mx > m)) { const float mn = fmaxf(m, mx), al = __builtin_amdgcn_exp2f(m - mn); l *= al; m = mn;
#pragma unroll
                for (int r = 0; r < 16; ++r) { o0[r] *= al; o1[r] *= al; } }
            float ps = 0.f;
#pragma unroll
            for (int r = 0; r < 16; ++r) { s0[r] = __builtin_amdgcn_exp2f(s0[r] - m); s1[r] = __builtin_amdgcn_exp2f(s1[r] - m); ps += s0[r] + s1[r]; }
            l += ps;
            u32x4 pb[4];
            pb[0] = (u32x4){cvtpk(s0[0], s0[1]), cvtpk(s0[2], s0[3]), cvtpk(s0[4], s0[5]), cvtpk(s0[6], s0[7])};
            pb[1] = (u32x4){cvtpk(s0[8], s0[9]), cvtpk(s0[10], s0[11]), cvtpk(s0[12], s0[13]), cvtpk(s0[14], s0[15])};
            pb[2] = (u32x4){cvtpk(s1[0], s1[1]), cvtpk(s1[2], s1[3]), cvtpk(s1[4], s1[5]), cvtpk(s1[6], s1[7])};
            pb[3] = (u32x4){cvtpk(s1[8], s1[9]), cvtpk(s1[10], s1[11]), cvtpk(s1[12], s1[13]), cvtpk(s1[14], s1[15])};
#pragma unroll
            for (int kk = 0; kk < 4; ++kk) {
                const bf16x8_t v0 = *(const LAS bf16x8_t*)(base + ATT_KB + q * ATT_VP + (16 * kk + 8 * hi) * 2), v1 = *(const LAS bf16x8_t*)(base + ATT_KB + (32 + q) * ATT_VP + (16 * kk + 8 * hi) * 2);
                const bf16x8_t pf = __builtin_bit_cast(bf16x8_t, pb[kk]);
                o0 = __builtin_amdgcn_mfma_f32_32x32x16_bf16(v0, pf, o0, 0, 0, 0); o1 = __builtin_amdgcn_mfma_f32_32x32x16_bf16(v1, pf, o1, 0, 0, 0); }
        }
        if (t + 1 < NT) ATT_STORE(cur ^ 1);
        __syncthreads();
    }
    l += __shfl_xor(l, 32);
    const float il = 1.f / l;
    bf16_t* op = AO + rowq * 512 + h * 64 + 4 * hi;
#pragma unroll
    for (int g = 0; g < 4; ++g) {
        const float a0 = o0[4 * g], a1 = o0[4 * g + 1], a2 = o0[4 * g + 2], a3 = o0[4 * g + 3], b0 = o1[4 * g], b1 = o1[4 * g + 1], b2 = o1[4 * g + 2], b3 = o1[4 * g + 3];
        uint2 w0, w1; w0.x = cvtpk(a0 * il, a1 * il); w0.y = cvtpk(a2 * il, a3 * il); w1.x = cvtpk(b0 * il, b1 * il); w1.y = cvtpk(b2 * il, b3 * il);
        *(uint2*)(op + 8 * g) = w0; *(uint2*)(op + 32 + 8 * g) = w1; }
#undef ATT_KROW
#undef ATT_LOAD
#undef ATT_STORE
}
__device__ __forceinline__ void attn_phase(const Ptrs& p, LAS unsigned char* lds, int vcu, int ncu) {
    for (int v = vcu; v < 256; v += ncu) {
        const int bh = v >> 2, s = v & 3;
        attn_unit(p, lds, bh >> 3, bh & 7, 15 - s); attn_unit(p, lds, bh >> 3, bh & 7, 8 + s); attn_unit(p, lds, bh >> 3, bh & 7, 7 - s); attn_unit(p, lds, bh >> 3, bh & 7, s);
    }
}
__global__ void __launch_bounds__(512, 2) k_attn(Ptrs p) {
    extern __shared__ __attribute__((aligned(16))) unsigned char lds[];
    const int G = gridDim.x, bx = blockIdx.x; const int vcu = (G % 8 == 0) ? (bx % 8) * (G / 8) + bx / 8 : bx;
    attn_phase(p, (LAS unsigned char*)lds, vcu, G);
}

__global__ void __launch_bounds__(128) k_ret_naive(Ptrs p) {
    const bf16_t* RQ = (const bf16_t*)(p.ws + WS_RQ); const bf16_t* RK = (const bf16_t*)(p.ws + WS_RK); const bf16_t* RV = (const bf16_t*)(p.ws + WS_RV);
    const bf16_t* RG = (const bf16_t*)(p.ws + WS_RG); bf16_t* RET = (bf16_t*)(p.ws + WS_RET);
    const float* ggn = p.in[11];
    __shared__ float red[2][4];
    const int e = threadIdx.x, h = blockIdx.x & 7, b = blockIdx.x >> 3;
    const float gamma = 1.f - exp2f(-5.f - (float)h);
    float S[64];
#pragma unroll
    for (int d = 0; d < 64; ++d) S[d] = 0.f;
    const float gg = ggn[h * 128 + e];
    const float g128 = exp2f(128.f * __log2f(gamma)), g16 = exp2f(16.f * __log2f(gamma));
    for (int t = 0; t < NMETA + SEQ; ++t) {
        const int row = t < NMETA ? T + t : b * SEQ + (t - NMETA);
        if (t >= NMETA && ((t - NMETA) & 127) == 0) { const float f = t == NMETA ? g16 : g128;
#pragma unroll
            for (int d = 0; d < 64; ++d) S[d] *= f; }
        const bf16_t* qp = RQ + (size_t)row * 512 + h * 64; const bf16_t* kp = RK + (size_t)row * 512 + h * 64;
        const float v = bf2f(RV[(size_t)row * 1024 + h * 128 + e]);
        float y = 0.f;
#pragma unroll
        for (int d = 0; d < 64; d += 8) { float kq[8], qq[8]; ld8(kp + d, kq); ld8(qp + d, qq);
#pragma unroll
            for (int j = 0; j < 8; ++j) { S[d + j] = S[d + j] + kq[j] * v; y += qq[j] * S[d + j]; } }
        if (t >= NMETA) {
            const float s1 = wave_sum(y), s2 = wave_sum(y * y);
            const int buf = t & 1;
            if ((e & 63) == 0) { red[buf][(e >> 6) * 2] = s1; red[buf][(e >> 6) * 2 + 1] = s2; }
            __syncthreads();
            const float mu = (red[buf][0] + red[buf][2]) * (1.f / 128.f); const float ex2 = (red[buf][1] + red[buf][3]) * (1.f / 128.f);
            const float var = fmaxf(ex2 - mu * mu, 0.f);
            const float yn = (y - mu) * rsqrtf(var + EPS) * gg;
            const float g = bf2f(RG[(size_t)row * 1024 + h * 128 + e]);
            RET[(size_t)row * 1024 + h * 128 + e] = (bf16_t)f2bf(g * yn);
        }
    }
}

typedef unsigned u32x2 __attribute__((ext_vector_type(2)));
constexpr int RT_RP = 144, RT_TP = 272;
constexpr int RT_QT = 0, RT_KT = 128 * RT_RP, RT_KTT = RT_KT + 128 * RT_RP, RT_VTT = RT_KTT + 64 * RT_TP, RT_ST = RT_VTT + 128 * RT_TP, RT_STAT = RT_ST + 128 * RT_RP, RT_LDS = RT_STAT + 8 * 32 * 8;
static_assert(RT_LDS <= 147456, "retention LDS");
__device__ __forceinline__ void ret_unit(const Ptrs& p, LAS unsigned char* lds, int b, int h) {
    const bf16_t* RQ = (const bf16_t*)(p.ws + WS_RQ); const bf16_t* RK = (const bf16_t*)(p.ws + WS_RK); const bf16_t* RV = (const bf16_t*)(p.ws + WS_RV);
    const bf16_t* RG = (const bf16_t*)(p.ws + WS_RG); bf16_t* RET = (bf16_t*)(p.ws + WS_RET); const float* ggn = p.in[11];
    const int tid = opaque_tid(), lane = tid & 63, wid = __builtin_amdgcn_readfirstlane(tid >> 6), c = lane & 31, hi = lane >> 5;
    const int j = wid >> 1, ih = wid & 1;
    const float lgam = __log2f(1.f - exp2f(-5.f - (float)h)); const float g128 = exp2f(128.f * lgam), g16 = exp2f(16.f * lgam);
    const int nst = wid < 2 ? 2 : (wid < 6 ? 1 : 0);
    const int sti = wid < 2 ? wid : 2 + ((wid - 2) >> 1), std0 = wid < 2 ? 0 : ((wid - 2) & 1);
    f32x16_t st0 = {}, st1 = {};
    const int q_row0 = tid >> 3, q_ch = tid & 7;
    const int k_rb = tid >> 4, k_db = tid & 15;
    const int v_rb0 = tid >> 5, v_eb = tid & 31;
    u32x4 pq[2]; u32x2 pk[4], pv[2][4];
#define RT_MPOS(rb) (16 * ((rb) >> 2) + 4 * ((((rb) & 3) == 1) ? 2 : ((((rb) & 3) == 2) ? 1 : ((rb) & 3))))
#define RT_LOAD(R0) do { \
        pq[0] = *(const u32x4*)(RQ + (size_t)((R0) + q_row0) * 512 + h * 64 + q_ch * 8); pq[1] = *(const u32x4*)(RQ + (size_t)((R0) + q_row0 + 64) * 512 + h * 64 + q_ch * 8); \
        _Pragma("unroll") for (int i_ = 0; i_ < 4; ++i_) pk[i_] = *(const u32x2*)(RK + (size_t)((R0) + 4 * k_rb + i_) * 512 + h * 64 + 4 * k_db); \
        _Pragma("unroll") for (int u_ = 0; u_ < 2; ++u_) _Pragma("unroll") for (int i_ = 0; i_ < 4; ++i_) pv[u_][i_] = *(const u32x2*)(RV + (size_t)((R0) + 4 * (v_rb0 + 16 * u_) + i_) * 1024 + h * 128 + 4 * v_eb); } while (0)
#define RT_TR4(src, dstbase, colbase, pitch, mpos) do { \
        const unsigned a0_ = src[0].x, a1_ = src[1].x, a2_ = src[2].x, a3_ = src[3].x, b0_ = src[0].y, b1_ = src[1].y, b2_ = src[2].y, b3_ = src[3].y; \
        u32x2 t_; \
        t_.x = (a0_ & 0xffffu) | (a1_ << 16); t_.y = (a2_ & 0xffffu) | (a3_ << 16); *(LAS u32x2*)(lds + (dstbase) + ((colbase) + 0) * (pitch) + (mpos) * 2) = t_; \
        t_.x = (a0_ >> 16) | (a1_ & 0xffff0000u); t_.y = (a2_ >> 16) | (a3_ & 0xffff0000u); *(LAS u32x2*)(lds + (dstbase) + ((colbase) + 1) * (pitch) + (mpos) * 2) = t_; \
        t_.x = (b0_ & 0xffffu) | (b1_ << 16); t_.y = (b2_ & 0xffffu) | (b3_ << 16); *(LAS u32x2*)(lds + (dstbase) + ((colbase) + 2) * (pitch) + (mpos) * 2) = t_; \
        t_.x = (b0_ >> 16) | (b1_ & 0xffff0000u); t_.y = (b2_ >> 16) | (b3_ & 0xffff0000u); *(LAS u32x2*)(lds + (dstbase) + ((colbase) + 3) * (pitch) + (mpos) * 2) = t_; } while (0)
#define RT_STORE() do { \
        *(LAS u32x4*)(lds + RT_QT + q_row0 * RT_RP + q_ch * 16) = pq[0]; *(LAS u32x4*)(lds + RT_QT + (q_row0 + 64) * RT_RP + q_ch * 16) = pq[1]; \
        _Pragma("unroll") for (int i_ = 0; i_ < 4; ++i_) *(LAS u32x2*)(lds + RT_KT + (4 * k_rb + i_) * RT_RP + k_db * 8) = pk[i_]; \
        RT_TR4(pk, RT_KTT, 4 * k_db, RT_TP, RT_MPOS(k_rb)); \
        RT_TR4(pv[0], RT_VTT, 4 * v_eb, RT_TP, RT_MPOS(v_rb0)); RT_TR4(pv[1], RT_VTT, 4 * v_eb, RT_TP, RT_MPOS(v_rb0 + 16)); } while (0)
#define RT_PUT_ST(acc, it, dt) do { _Pragma("unroll") for (int r_ = 0; r_ < 16; ++r_) { const float v_ = acc[r_]; \
        *(LAS bf16_t*)(lds + RT_ST + (32 * (it) + (r_ & 3) + 8 * (r_ >> 2) + 4 * hi) * RT_RP + (32 * (dt) + c) * 2) = (bf16_t)f2bf(v_); } } while (0)
#define RT_STATE_UPD(acc, it, dt) do { _Pragma("unroll") for (int ks_ = 0; ks_ < 8; ++ks_) { \
        const bf16x8_t a_ = *(const LAS bf16x8_t*)(lds + RT_VTT + (32 * (it) + c) * RT_TP + (16 * ks_ + 8 * hi) * 2); \
        const bf16x8_t b_ = *(const LAS bf16x8_t*)(lds + RT_KTT + (32 * (dt) + c) * RT_TP + (16 * ks_ + 8 * hi) * 2); \
        acc = __builtin_amdgcn_mfma_f32_32x32x16_bf16(a_, b_, acc, 0, 0, 0); } } while (0)
    __syncthreads();
    RT_LOAD(T); RT_STORE(); __syncthreads();
    RT_LOAD(b * SEQ);
    if (nst >= 1) { RT_STATE_UPD(st0, sti, std0);
#pragma unroll
        for (int r = 0; r < 16; ++r) st0[r] *= g16; }
    if (nst == 2) { RT_STATE_UPD(st1, sti, 1);
#pragma unroll
        for (int r = 0; r < 16; ++r) st1[r] *= g16; }
    __syncthreads();
    RT_STORE();
    if (nst >= 1) RT_PUT_ST(st0, sti, std0);
    if (nst == 2) RT_PUT_ST(st1, sti, 1);
    __syncthreads();
    for (int n = 0; n < 32; ++n) {
        const int R0 = b * SEQ + 128 * n;
        if (n + 1 < 32) RT_LOAD(R0 + 128);
        bf16x8_t qf[4];
#pragma unroll
        for (int s4 = 0; s4 < 4; ++s4) qf[s4] = *(const LAS bf16x8_t*)(lds + RT_QT + (32 * j + c) * RT_RP + (16 * s4 + 8 * hi) * 2);
        f32x16_t y0 = {}, y1 = {};
#pragma unroll
        for (int s4 = 0; s4 < 4; ++s4) {
            const bf16x8_t a0 = *(const LAS bf16x8_t*)(lds + RT_ST + (64 * ih + c) * RT_RP + (16 * s4 + 8 * hi) * 2), a1 = *(const LAS bf16x8_t*)(lds + RT_ST + (64 * ih + 32 + c) * RT_RP + (16 * s4 + 8 * hi) * 2);
            y0 = __builtin_amdgcn_mfma_f32_32x32x16_bf16(a0, qf[s4], y0, 0, 0, 0); y1 = __builtin_amdgcn_mfma_f32_32x32x16_bf16(a1, qf[s4], y1, 0, 0, 0); }
        for (int a = 0; a <= j; ++a) {
            f32x16_t pa = {};
#pragma unroll
            for (int s4 = 0; s4 < 4; ++s4) { const bf16x8_t ka = *(const LAS bf16x8_t*)(lds + RT_KT + (32 * a + c) * RT_RP + (16 * s4 + 8 * hi) * 2);
                pa = __builtin_amdgcn_mfma_f32_32x32x16_bf16(ka, qf[s4], pa, 0, 0, 0); }
            float sv[16];
#pragma unroll
            for (int r = 0; r < 16; ++r) { const float v_ = pa[r]; sv[r] = (a == j && ((r & 3) + 8 * (r >> 2) + 4 * hi) > c) ? 0.f : v_; }
            u32x4 pb[2];
            pb[0] = (u32x4){cvtpk(sv[0], sv[1]), cvtpk(sv[2], sv[3]), cvtpk(sv[4], sv[5]), cvtpk(sv[6], sv[7])};
            pb[1] = (u32x4){cvtpk(sv[8], sv[9]), cvtpk(sv[10], sv[11]), cvtpk(sv[12], sv[13]), cvtpk(sv[14], sv[15])};
#pragma unroll
            for (int t2 = 0; t2 < 2; ++t2) {
                const bf16x8_t v0 = *(const LAS bf16x8_t*)(lds + RT_VTT + (64 * ih + c) * RT_TP + (32 * a + 16 * t2 + 8 * hi) * 2), v1 = *(const LAS bf16x8_t*)(lds + RT_VTT + (64 * ih + 32 + c) * RT_TP + (32 * a + 16 * t2 + 8 * hi) * 2);
                const bf16x8_t pf = __builtin_bit_cast(bf16x8_t, pb[t2]);
                y0 = __builtin_amdgcn_mfma_f32_32x32x16_bf16(v0, pf, y0, 0, 0, 0); y1 = __builtin_amdgcn_mfma_f32_32x32x16_bf16(v1, pf, y1, 0, 0, 0); }
        }
        if (nst >= 1) { RT_STATE_UPD(st0, sti, std0);
#pragma unroll
            for (int r = 0; r < 16; ++r) st0[r] *= g128; }
        if (nst == 2) { RT_STATE_UPD(st1, sti, 1);
#pragma unroll
            for (int r = 0; r < 16; ++r) st1[r] *= g128; }
        float s1 = 0.f, s2 = 0.f;
#pragma unroll
        for (int r = 0; r < 16; ++r) { const float a_ = y0[r], b_ = y1[r]; s1 += a_ + b_; s2 += a_ * a_ + b_ * b_; }
        s1 += __shfl_xor(s1, 32); s2 += __shfl_xor(s2, 32);
        if (hi == 0) *(LAS f32x2_t*)(lds + RT_STAT + (wid * 32 + c) * 8) = (f32x2_t){s1, s2};
        __syncthreads();
        { const f32x2_t o = *(const LAS f32x2_t*)(lds + RT_STAT + ((wid ^ 1) * 32 + c) * 8); s1 += o.x; s2 += o.y; }
        const float mu = s1 * (1.f / 128.f), var = fmaxf(s2 * (1.f / 128.f) - mu * mu, 0.f), rstd = rsqrtf(var + EPS);
        {
            const size_t row = (size_t)R0 + 32 * j + c;
#pragma unroll
            for (int i2 = 0; i2 < 2; ++i2)
#pragma unroll
                for (int g = 0; g < 4; ++g) {
                    const int e = 64 * ih + 32 * i2 + 8 * g + 4 * hi;
                    const u32x2 gw = *(const u32x2*)(RG + row * 1024 + h * 128 + e); const f32x4 gn = *(const f32x4*)(ggn + h * 128 + e);
                    float yv[4];
#pragma unroll
                    for (int x = 0; x < 4; ++x) yv[x] = i2 == 0 ? y0[4 * g + x] : y1[4 * g + x];
                    const float o0 = (yv[0] - mu) * rstd * gn.x * bf2f(gw.x & 0xffff), o1 = (yv[1] - mu) * rstd * gn.y * bf2f(gw.x >> 16);
                    const float o2 = (yv[2] - mu) * rstd * gn.z * bf2f(gw.y & 0xffff), o3 = (yv[3] - mu) * rstd * gn.w * bf2f(gw.y >> 16);
                    u32x2 ow; ow.x = cvtpk(o0, o1); ow.y = cvtpk(o2, o3);
                    *(u32x2*)(RET + row * 1024 + h * 128 + e) = ow;
                }
        }
        if (n + 1 < 32) {
            RT_STORE();
            if (nst >= 1) RT_PUT_ST(st0, sti, std0);
            if (nst == 2) RT_PUT_ST(st1, sti, 1);
        }
        __syncthreads();
    }
#undef RT_MPOS
#undef RT_LOAD
#undef RT_TR4
#undef RT_STORE
#undef RT_PUT_ST
#undef RT_STATE_UPD
}
__global__ void __launch_bounds__(512, 2) k_ret(Ptrs p) {
    extern __shared__ __attribute__((aligned(16))) unsigned char lds[];
    for (int u = blockIdx.x; u < 64; u += gridDim.x) ret_unit(p, (LAS unsigned char*)lds, u >> 3, u & 7);
}

__global__ void __launch_bounds__(256) k_zero_ss2(Ptrs p) {
    float* R = (float*)(p.ws + WS_RINV2);
    for (int i = blockIdx.x * 256 + threadIdx.x; i < T; i += gridDim.x * 256) R[i] = 0.f;
}

__global__ void __launch_bounds__(32) k_peer_select_naive(Ptrs p) {
    __shared__ float sc[256][32];
    __shared__ int ii[32][32];
    const bf16_t* PQ = (const bf16_t*)(p.ws + WS_PQ);
    const float* k1 = p.in[16]; const float* k2 = p.in[17];
    int* SELI = (int*)(p.ws + WS_SELI); float* SELG = (float*)(p.ws + WS_SELG);
    const int tid = threadIdx.x, gid = blockIdx.x * 32 + tid, tok = gid >> 3, hd = gid & 7;
    float q[128];
#pragma unroll
    for (int d = 0; d < 128; d += 8) { float t[8]; ld8(PQ + (size_t)tok * D + hd * 128 + d, t);
#pragma unroll
        for (int j = 0; j < 8; ++j) q[d + j] = t[j]; }
    for (int kk = 0; kk < 128; ++kk) {
        float a = 0.f, b = 0.f;
#pragma unroll
        for (int d = 0; d < 64; ++d) { a += q[d] * k1[kk * 64 + d]; b += q[64 + d] * k2[kk * 64 + d]; }
        sc[kk][tid] = a; sc[128 + kk][tid] = b;
    }
    float v1[16], v2[16];
#pragma unroll
    for (int r = 0; r < 16; ++r) {
        float best = -INFINITY; int bi = 0;
        for (int kk = 0; kk < 128; ++kk) { const float x = sc[kk][tid]; if (x > best) { best = x; bi = kk; } }
        sc[bi][tid] = -INFINITY; v1[r] = best; ii[r][tid] = bi;
        best = -INFINITY; bi = 0;
        for (int kk = 0; kk < 128; ++kk) { const float x = sc[128 + kk][tid]; if (x > best) { best = x; bi = kk; } }
        sc[128 + bi][tid] = -INFINITY; v2[r] = best; ii[16 + r][tid] = bi;
    }
#pragma unroll
    for (int i = 0; i < 16; ++i)
#pragma unroll
        for (int j = 0; j < 16; ++j) sc[i * 16 + j][tid] = v1[i] + v2[j];
    float sv[16]; int se[16];
#pragma unroll
    for (int r = 0; r < 16; ++r) {
        float best = -INFINITY; int bi = 0;
        for (int c = 0; c < 256; ++c) { const float x = sc[c][tid]; if (x > best) { best = x; bi = c; } }
        sc[bi][tid] = -INFINITY; sv[r] = best; se[r] = ii[bi >> 4][tid] * 128 + ii[16 + (bi & 15)][tid];
    }
    float den = 0.f; const float mx = sv[0];
#pragma unroll
    for (int r = 0; r < 16; ++r) { sv[r] = __expf(sv[r] - mx); den += sv[r]; }
    const float id = 1.f / den;
#pragma unroll
    for (int r = 0; r < 16; ++r) { SELI[(size_t)tok * 128 + hd * 16 + r] = se[r]; SELG[(size_t)tok * 128 + hd * 16 + r] = sv[r] * id; }
}

__global__ void __launch_bounds__(256) k_peer_gather_naive(Ptrs p) {
    __shared__ float wk[128];
    const int* SELI = (const int*)(p.ws + WS_SELI); const float* SELG = (const float*)(p.ws + WS_SELG);
    const float* RINV2 = (const float*)(p.ws + WS_RINV2); const float* gffn = p.in[14]; const float* U = p.in[18]; const float* Vt = p.in[19];
    const int tok = blockIdx.x, tid = threadIdx.x, lane = tid & 63, w = tid >> 6;
    const float r2 = rsqrtf(RINV2[tok] * (1.f / D) + EPS);
    f32x4 xr[4];
#pragma unroll
    for (int j = 0; j < 4; ++j) { const f32x4 hv = *(const f32x4*)(p.out + (size_t)tok * D + lane * 4 + 256 * j); const f32x4 g = *(const f32x4*)(gffn + lane * 4 + 256 * j); xr[j] = hv * g * r2; }
    for (int k = w * 32; k < w * 32 + 32; ++k) {
        const float* up = U + (size_t)SELI[(size_t)tok * 128 + k] * D;
        float dsum = 0.f;
#pragma unroll
        for (int j = 0; j < 4; ++j) { const f32x4 u = *(const f32x4*)(up + lane * 4 + 256 * j); dsum += u.x * xr[j].x + u.y * xr[j].y + u.z * xr[j].z + u.w * xr[j].w; }
        dsum = wave_sum(dsum);
        const float act = 0.5f * dsum * (1.f + erff(dsum * 0.70710678118654752f));
        if (lane == 0) wk[k] = SELG[(size_t)tok * 128 + k] * act;
    }
    __syncthreads();
    f32x4 acc = (f32x4){0.f, 0.f, 0.f, 0.f};
    for (int k = 0; k < 128; ++k) { const f32x4 v = *(const f32x4*)(Vt + (size_t)SELI[(size_t)tok * 128 + k] * D + tid * 4); acc += v * wk[k]; }
    f32x4* op = (f32x4*)(p.out + (size_t)tok * D + tid * 4); *op = *op + acc;
}

#define LAS __attribute__((address_space(3)))
typedef float f32x16 __attribute__((ext_vector_type(16)));
typedef short bf16x8 __attribute__((ext_vector_type(8)));
__device__ __forceinline__ int sortable(int b) { return b ^ ((b >> 31) & 0x7fffffff); }
__device__ __forceinline__ int imax(int a, int b) { return a > b ? a : b; }
__device__ __forceinline__ int imin(int a, int b) { return a < b ? a : b; }
template <int N, int K, int J> __device__ __forceinline__ void bstep(int (&v)[N]) {
#pragma unroll
    for (int i = 0; i < N; ++i) { const int l = i ^ J; if (l > i) { const int a = v[i], b = v[l]; const bool d = (i & K) == 0; v[i] = d ? imax(a, b) : imin(a, b); v[l] = d ? imin(a, b) : imax(a, b); } }
}
template <int N, int K, int J> __device__ __forceinline__ void bstep2(int (&v)[N], int (&q)[N]) {
#pragma unroll
    for (int i = 0; i < N; ++i) { const int l = i ^ J; if (l > i) { const int a = v[i], b = v[l], pa = q[i], pb = q[l]; const bool gt = a > b; const bool d = (i & K) == 0;
        const int hk = gt ? a : b, lk = gt ? b : a, hp = gt ? pa : pb, lp = gt ? pb : pa; v[i] = d ? hk : lk; v[l] = d ? lk : hk; q[i] = d ? hp : lp; q[l] = d ? lp : hp; } }
}
template <int N, int K, int J> struct BMerge { static __device__ __forceinline__ void run(int (&v)[N]) { bstep<N, K, J>(v); if constexpr (J > 1) BMerge<N, K, J / 2>::run(v); }
                                               static __device__ __forceinline__ void run2(int (&v)[N], int (&q)[N]) { bstep2<N, K, J>(v, q); if constexpr (J > 1) BMerge<N, K, J / 2>::run2(v, q); } };
template <int N, int K> struct BSort { static __device__ __forceinline__ void run(int (&v)[N]) { if constexpr (K > 2) BSort<N, K / 2>::run(v); BMerge<N, K, K / 2>::run(v); }
                                       static __device__ __forceinline__ void run2(int (&v)[N], int (&q)[N]) { if constexpr (K > 2) BSort<N, K / 2>::run2(v, q); BMerge<N, K, K / 2>::run2(v, q); } };
__device__ __forceinline__ void top16_merge(const int (&a)[16], const int (&b)[16], int (&o)[16]) {
#pragma unroll
    for (int i = 0; i < 16; ++i) o[i] = imax(a[i], b[15 - i]);
    BMerge<16, 16, 8>::run(o);
}
__device__ __forceinline__ void top16_merge2(const int (&a)[16], const int (&pa)[16], const int (&b)[16], const int (&pb)[16], int (&o)[16], int (&po)[16]) {
#pragma unroll
    for (int i = 0; i < 16; ++i) { const bool gt = a[i] > b[15 - i]; o[i] = gt ? a[i] : b[15 - i]; po[i] = gt ? pa[i] : pb[15 - i]; }
    BMerge<16, 16, 8>::run2(o, po);
}
__device__ __forceinline__ void top16_of_64(const int (&v)[64], int (&o)[16]) {
    int g[4][16];
#pragma unroll
    for (int q = 0; q < 4; ++q) {
#pragma unroll
        for (int i = 0; i < 16; ++i) g[q][i] = v[q * 16 + i];
        BSort<16, 16>::run(g[q]); }
    int m0[16], m1[16]; top16_merge(g[0], g[1], m0); top16_merge(g[2], g[3], m1); top16_merge(m0, m1, o);
}
__device__ __forceinline__ void top16_of_64p(const int (&v)[64], const int (&pv)[64], int (&o)[16], int (&po)[16]) {
    int g[4][16], h[4][16];
#pragma unroll
    for (int q = 0; q < 4; ++q) {
#pragma unroll
        for (int i = 0; i < 16; ++i) { g[q][i] = v[q * 16 + i]; h[q][i] = pv[q * 16 + i]; }
        BSort<16, 16>::run2(g[q], h[q]); }
    int m0[16], p0[16], m1[16], p1[16]; top16_merge2(g[0], h[0], g[1], h[1], m0, p0); top16_merge2(g[2], h[2], g[3], h[3], m1, p1); top16_merge2(m0, p0, m1, p1, o, po);
}
template <int M, int J, int N> __device__ __forceinline__ void cand_one(const int (&am)[8], const float (&f2)[16], const int (&M2)[16], int (&g)[16], int (&h)[16]) {
    const float f1 = __int_as_float(sortable(am[M] & ~0x7f)); g[N] = sortable(__float_as_int(f1 + f2[J])); h[N] = ((am[M] & 0x7f) << 7) | (M2[J] & 0x7f);
}
__device__ __forceinline__ void cand_rest(const int (&am)[8], const float (&f2)[16], const int (&M2)[16], int (&g)[16], int (&h)[16]) {
    cand_one<1, 0, 0>(am, f2, M2, g, h); cand_one<1, 1, 1>(am, f2, M2, g, h); cand_one<1, 2, 2>(am, f2, M2, g, h); cand_one<1, 3, 3>(am, f2, M2, g, h); cand_one<1, 4, 4>(am, f2, M2, g, h);
    cand_one<2, 0, 5>(am, f2, M2, g, h); cand_one<2, 1, 6>(am, f2, M2, g, h); cand_one<2, 2, 7>(am, f2, M2, g, h);
    cand_one<3, 0, 8>(am, f2, M2, g, h); cand_one<3, 1, 9>(am, f2, M2, g, h);
    cand_one<4, 0, 10>(am, f2, M2, g, h); cand_one<5, 0, 11>(am, f2, M2, g, h); cand_one<6, 0, 12>(am, f2, M2, g, h); cand_one<7, 0, 13>(am, f2, M2, g, h);
    g[14] = (int)0x80000000; h[14] = 0; g[15] = (int)0x80000000; h[15] = 0;
}
constexpr int KEY_PITCH = 144;
__device__ __forceinline__ void peer_keys_to_lds(const Ptrs& p, LAS unsigned char* lds) {
    for (int i = threadIdx.x; i < 2 * 128 * 8; i += blockDim.x) { const int side = i >> 10, row = (i >> 3) & 127, ch = i & 7; const float* src = p.in[16 + side] + row * 64 + ch * 8;
        const f32x4 a = *(const f32x4*)src, b = *(const f32x4*)(src + 4); u32x4 w; w.x = pk2(a.x, a.y); w.y = pk2(a.z, a.w); w.z = pk2(b.x, b.y); w.w = pk2(b.z, b.w);
        *(LAS u32x4*)(lds + (side * 128 + row) * KEY_PITCH + ch * 16) = w; }
}
__device__ __forceinline__ void peer_select_core(const Ptrs& p, const LAS unsigned char* lds, int tok0, int head, int lane, int (&P16o)[16], float (&gate)[16]) {
    const bf16_t* PQ = (const bf16_t*)(p.ws + WS_PQ);
    const int c = lane & 31, hi = lane >> 5, tok = tok0 + c;
    {
        int M1[16], M2[16];
#pragma unroll
        for (int side = 0; side < 2; ++side) {
            bf16x8 bq[4];
#pragma unroll
            for (int s = 0; s < 4; ++s) bq[s] = *(const bf16x8*)(PQ + (size_t)tok * D + head * 128 + side * 64 + 16 * s + 8 * hi);
            int L[16];
            {   int g[2][16], m[2][16];
#pragma unroll
                for (int kt = 0; kt < 4; ++kt) {
                    f32x16 acc = {};
#pragma unroll
                    for (int s = 0; s < 4; ++s) { const bf16x8 a = *(const LAS bf16x8*)(lds + (side * 128 + kt * 32 + c) * KEY_PITCH + (16 * s + 8 * hi) * 2);
                        acc = __builtin_amdgcn_mfma_f32_32x32x16_bf16(a, bq[s], acc, 0, 0, 0); }
#pragma unroll
                    for (int r = 0; r < 16; ++r) { const float fv = acc[r]; g[kt & 1][r] = (sortable(__float_as_int(fv)) & ~0x7f) | (kt * 32 + (r & 3) + 8 * (r >> 2) + 4 * hi); }
                    BSort<16, 16>::run(g[kt & 1]);
                    if (kt & 1) top16_merge(g[0], g[1], m[kt >> 1]);
                    __builtin_amdgcn_sched_barrier(0);
                }
                top16_merge(m[0], m[1], L);
            }
            int A_[16], B_[16];
#pragma unroll
            for (int i = 0; i < 16; ++i) { const int pr = __shfl_xor(L[i], 32); A_[i] = hi ? pr : L[i]; B_[i] = hi ? L[i] : pr; }
            if (side == 0) top16_merge(A_, B_, M1); else top16_merge(A_, B_, M2);
            __builtin_amdgcn_sched_barrier(0);
        }
        int K16[16], P16[16];
        {   int am[8];
#pragma unroll
            for (int m = 0; m < 8; ++m) am[m] = M1[2 * m] ^ ((M1[2 * m] ^ M1[2 * m + 1]) & -hi);
            float f2[16];
#pragma unroll
            for (int j = 0; j < 16; ++j) f2[j] = __int_as_float(sortable(M2[j] & ~0x7f));
            int g0[16], h0[16], g1[16], h1[16];
            { const float f1 = __int_as_float(sortable(am[0] & ~0x7f)); const int e1 = (am[0] & 0x7f) << 7;
#pragma unroll
              for (int j = 0; j < 16; ++j) { g0[j] = sortable(__float_as_int(f1 + f2[j])); h0[j] = e1 | (M2[j] & 0x7f); } }
            cand_rest(am, f2, M2, g1, h1);
            BSort<16, 16>::run2(g1, h1);
            int mk[16], mp[16]; top16_merge2(g0, h0, g1, h1, mk, mp);
            int Ak[16], Ap[16], Bk[16], Bp[16];
#pragma unroll
            for (int i = 0; i < 16; ++i) { const int pk = __shfl_xor(mk[i], 32), pp = __shfl_xor(mp[i], 32); Ak[i] = hi ? pk : mk[i]; Bk[i] = hi ? mk[i] : pk; Ap[i] = hi ? pp : mp[i]; Bp[i] = hi ? mp[i] : pp; }
            top16_merge2(Ak, Ap, Bk, Bp, K16, P16);
        }
        float ex[16], den = 0.f; const float mx = __int_as_float(sortable(K16[0]));
#pragma unroll
        for (int r = 0; r < 16; ++r) { ex[r] = __expf(__int_as_float(sortable(K16[r])) - mx); den += ex[r]; }
        const float id = 1.f / den;
#pragma unroll
        for (int r = 0; r < 16; ++r) { P16o[r] = P16[r]; gate[r] = ex[r] * id; }
    }
}
template <class IP, class GP, class U4P, class F4P>
__device__ __forceinline__ void peer_select_unit(const Ptrs& p, const LAS unsigned char* lds, int tok0, int head, int lane, IP si, GP sg) {
    int P16[16]; float gt[16]; peer_select_core(p, lds, tok0, head, lane, P16, gt);
    const int c = lane & 31, hi = lane >> 5;
    if (hi == 0) { IP ip = si + (size_t)c * 128 + head * 16;
#pragma unroll
        for (int r = 0; r < 16; r += 4) *(U4P)(ip + r) = (u32x4){(unsigned)P16[r], (unsigned)P16[r + 1], (unsigned)P16[r + 2], (unsigned)P16[r + 3]}; }
    else { GP gp = sg + (size_t)c * 128 + head * 16;
#pragma unroll
        for (int r = 0; r < 16; r += 4) *(F4P)(gp + r) = (f32x4){gt[r], gt[r + 1], gt[r + 2], gt[r + 3]}; }
}
__device__ __forceinline__ void peer_select_phase(const Ptrs& p, LAS unsigned char* lds, int* SELI, float* SELG, int gw, int nw, int lane) {
    peer_keys_to_lds(p, lds); __syncthreads();
    for (int task = gw; task < 8192; task += nw) { const int tok0 = (task >> 3) * 32; peer_select_unit<int*, float*, u32x4*, f32x4*>(p, lds, tok0, task & 7, lane, SELI + (size_t)tok0 * 128, SELG + (size_t)tok0 * 128); }
}
__global__ void __launch_bounds__(512, 2) k_peer_select(Ptrs p, int alt) {
    extern __shared__ __attribute__((aligned(16))) unsigned char lds[];
    int* si = (int*)(p.ws + (alt ? WS_RET : WS_SELI)); float* sg = (float*)(p.ws + (alt ? WS_RET + (size_t)T * 128 * 4 : WS_SELG));
    peer_select_phase(p, (LAS unsigned char*)lds, si, sg, blockIdx.x * 8 + (threadIdx.x >> 6), gridDim.x * 8, threadIdx.x & 63);
}
__global__ void __launch_bounds__(256) k_peer_select256(Ptrs p, int alt) {
    extern __shared__ __attribute__((aligned(16))) unsigned char lds[];
    int* si = (int*)(p.ws + (alt ? WS_RET : WS_SELI)); float* sg = (float*)(p.ws + (alt ? WS_RET + (size_t)T * 128 * 4 : WS_SELG));
    peer_select_phase(p, (LAS unsigned char*)lds, si, sg, blockIdx.x * 4 + (threadIdx.x >> 6), gridDim.x * 4, threadIdx.x & 63);
}
__global__ void k_dbg_cmp_sel(Ptrs p, int mode) {
    const int gid = blockIdx.x * blockDim.x + threadIdx.x; if (gid >= T * 8) return;
    const int* a = (const int*)(p.ws + WS_SELI) + (size_t)gid * 16; const int* b = (const int*)(p.ws + WS_RET) + (size_t)gid * 16;
    const float* ga = (const float*)(p.ws + WS_SELG) + (size_t)gid * 16; const float* gb = (const float*)(p.ws + WS_RET + (size_t)T * 128 * 4) + (size_t)gid * 16;
    int miss = 0; float gd = 0.f;
    for (int i = 0; i < 16; ++i) { bool f = false; for (int j = 0; j < 16; ++j) f |= (a[i] == b[j]); miss += f ? 0 : 1; gd += fabsf(ga[i] - gb[i]); }
    unsigned* ctl = (unsigned*)(p.ws + WS_CTL);
    if (mode == 0) { if (miss) atomicAdd(ctl, 1u); }
    else if (mode == 1) { if (a[0] != b[0]) atomicAdd(ctl, 1u); }
    else if (mode == 2) { atomicAdd(ctl, (unsigned)miss); }
    else { atomicAdd((float*)ctl + 1, gd); }
}
__global__ void k_dbg_cmp_scores(Ptrs p) {
    const int gid = blockIdx.x * blockDim.x + threadIdx.x; if (gid >= 1024 * 8 * 2 * 128) return;
    const int key = gid & 127, side = (gid >> 7) & 1, head = (gid >> 8) & 7, tok = gid >> 11;
    const bf16_t* PQ = (const bf16_t*)(p.ws + WS_PQ); const float* kk = p.in[16 + side] + key * 64;
    float a = 0.f; for (int d = 0; d < 64; ++d) a += bf2f(PQ[(size_t)tok * D + head * 128 + side * 64 + d]) * kk[d];
    const float b = ((const float*)(p.ws + WS_RET + (size_t)64 * 1024 * 1024))[gid];
#if DBG_SCORES == 2
    atomicAdd((float*)(p.ws + WS_CTL) + 1, fabsf(a - b) > 0.1f ? 1.f : 0.f);
#elif DBG_SCORES == 3
    if (fabsf(a - b) > 0.1f) { atomicAdd((float*)(p.ws + WS_CTL) + 1, (float)((key & 31) + 1) / 32.f); atomicAdd((float*)(p.ws + WS_CTL) + 2, 1.f); }
#elif DBG_SCORES == 4
    if (fabsf(a - b) > 0.1f) { atomicAdd((float*)(p.ws + WS_CTL) + 1, (float)((tok & 31) + 1) / 32.f); atomicAdd((float*)(p.ws + WS_CTL) + 2, 1.f); }
#elif DBG_SCORES == 5
    if (fabsf(a - b) > 0.1f) { atomicAdd((float*)(p.ws + WS_CTL) + 1, fminf(fabsf(b), 10.f) / 10.f); atomicAdd((float*)(p.ws + WS_CTL) + 2, 1.f); }
#else
    atomicAdd((float*)(p.ws + WS_CTL) + 1, fabsf(a - b));
#endif
}
__global__ void k_dbg_scale(Ptrs p, float denom, int mode) {
    const unsigned* ctl = (const unsigned*)(p.ws + WS_CTL);
#if defined(DBG_SCORES) && DBG_SCORES >= 3
    const float m = ((const float*)ctl)[1] / fmaxf(((const float*)ctl)[2], 1.f);
#else
    const float m = mode == 3 ? ((const float*)ctl)[1] / denom : (float)ctl[0] / denom;
#endif
    for (size_t i = (size_t)blockIdx.x * blockDim.x + threadIdx.x; i < (size_t)T * D; i += (size_t)gridDim.x * blockDim.x) p.out[i] *= (1.f + m);
}

typedef __bf16 bf16x2_t __attribute__((ext_vector_type(2)));
__device__ __forceinline__ float dot2bf(unsigned a, unsigned b, float c) { return __builtin_amdgcn_fdot2_f32_bf16(__builtin_bit_cast(bf16x2_t, a), __builtin_bit_cast(bf16x2_t, b), c, false); }
constexpr size_t WS_U8 = WS_K, WS_V8 = WS_K + (size_t)16384 * 1024, WS_SU = WS_V, WS_SV = WS_V + 65536;
static_assert(WS_V8 + (size_t)16384 * 1024 <= WS_V && WS_SV + 65536 <= WS_RET, "peer table overlay");
__device__ __forceinline__ float wave_max(float v) {
#pragma unroll
    for (int o = 1; o < 64; o <<= 1) v = fmaxf(v, __shfl_xor(v, o));
    return v;
}
__device__ __forceinline__ void prep_uv_part(const Ptrs& p, int gw, int nw, int lane) {
    for (int row = gw; row < 2 * 16384; row += nw) {
        const int t = row >> 14, e = row & 16383;
        const float* src = p.in[18 + t] + (size_t)e * D + lane * 16;
        f32x4 v[4]; float am = 0.f;
#pragma unroll
        for (int j = 0; j < 4; ++j) { v[j] = *(const f32x4*)(src + 4 * j); am = fmaxf(am, fmaxf(fmaxf(fabsf(v[j].x), fabsf(v[j].y)), fmaxf(fabsf(v[j].z), fabsf(v[j].w)))); }
        am = fmaxf(wave_max(am), 1e-30f);
        const float inv = 127.f / am; const int off = 0;
        u32x4 w;
#pragma unroll
        for (int j = 0; j < 4; ++j) { const int q0 = (int)rintf(v[j].x * inv) + off, q1 = (int)rintf(v[j].y * inv) + off, q2 = (int)rintf(v[j].z * inv) + off, q3 = (int)rintf(v[j].w * inv) + off;
            w[j] = (unsigned)(q0 & 0xff) | ((unsigned)(q1 & 0xff) << 8) | ((unsigned)(q2 & 0xff) << 16) | ((unsigned)(q3 & 0xff) << 24); }
        *(u32x4*)(p.ws + (t ? WS_V8 : WS_U8) + (size_t)e * D + lane * 16) = w;
        if (lane == 0) ((float*)(p.ws + (t ? WS_SV : WS_SU)))[e] = am * (1.f / 127.f);
    }
}
__global__ void __launch_bounds__(512) k_prep_uv(Ptrs p) { prep_uv_part(p, blockIdx.x * 8 + (threadIdx.x >> 6), gridDim.x * 8, threadIdx.x & 63); }

__device__ __forceinline__ float gelu_erf(float x) { return 0.5f * x * (1.f + erff(x * 0.70710678118654752f)); }
__device__ __forceinline__ float treduce8(const float (&v)[8], int lane) {
    float w[4], x[2], y;
    const bool b0 = lane & 1, b1 = lane & 2, b2 = lane & 4;
#pragma unroll
    for (int i = 0; i < 4; ++i) { const float keep = b0 ? v[2 * i + 1] : v[2 * i], send = b0 ? v[2 * i] : v[2 * i + 1]; w[i] = keep + __shfl_xor(send, 1); }
#pragma unroll
    for (int i = 0; i < 2; ++i) { const float keep = b1 ? w[2 * i + 1] : w[2 * i], send = b1 ? w[2 * i] : w[2 * i + 1]; x[i] = keep + __shfl_xor(send, 2); }
    { const float keep = b2 ? x[1] : x[0], send = b2 ? x[0] : x[1]; y = keep + __shfl_xor(send, 4); }
    y += __shfl_xor(y, 8); y += __shfl_xor(y, 16); y += __shfl_xor(y, 32);
    return y;
}
__device__ __forceinline__ int treduce8i(const int (&v)[8], int lane) {
    int w[4], x[2], y;
    const bool b0 = lane & 1, b1 = lane & 2, b2 = lane & 4;
#pragma unroll
    for (int i = 0; i < 4; ++i) { const int keep = b0 ? v[2 * i + 1] : v[2 * i], send = b0 ? v[2 * i] : v[2 * i + 1]; w[i] = keep + __shfl_xor(send, 1); }
#pragma unroll
    for (int i = 0; i < 2; ++i) { const int keep = b1 ? w[2 * i + 1] : w[2 * i], send = b1 ? w[2 * i] : w[2 * i + 1]; x[i] = keep + __shfl_xor(send, 2); }
    { const int keep = b2 ? x[1] : x[0], send = b2 ? x[0] : x[1]; y = keep + __shfl_xor(send, 4); }
    y += __shfl_xor(y, 8); y += __shfl_xor(y, 16); y += __shfl_xor(y, 32);
    return y;
}
__device__ __forceinline__ void peer_gather_token(const Ptrs& p, int tok, int i0, int i1, float g0, float g1, int lane, bool do_store = true) {
    const float* SS2 = (const float*)(p.ws + WS_RINV2); const float* gffn = p.in[14];
    const unsigned char* U8 = p.ws + WS_U8; const unsigned char* V8 = p.ws + WS_V8; const float* SU = (const float*)(p.ws + WS_SU); const float* SV = (const float*)(p.ws + WS_SV);
    int xq[4]; float xs;
    {   const float r2 = rsqrtf(SS2[tok] * (1.f / D) + EPS); const float* hp = p.out + (size_t)tok * D + lane * 16; const float* gp = gffn + lane * 16;
        f32x4 x[4]; float am = 0.f;
#pragma unroll
        for (int j = 0; j < 4; ++j) { x[j] = *(const f32x4*)(hp + 4 * j) * *(const f32x4*)(gp + 4 * j) * r2; am = fmaxf(am, fmaxf(fmaxf(fabsf(x[j].x), fabsf(x[j].y)), fmaxf(fabsf(x[j].z), fabsf(x[j].w)))); }
        am = fmaxf(wave_max(am), 1e-30f); xs = am * (1.f / 127.f); const float inv = 127.f / am;
#pragma unroll
        for (int j = 0; j < 4; ++j) xq[j] = (int)(((unsigned)((int)rintf(x[j].x * inv) & 0xff)) | ((unsigned)((int)rintf(x[j].y * inv) & 0xff) << 8) | ((unsigned)((int)rintf(x[j].z * inv) & 0xff) << 16) | ((unsigned)((int)rintf(x[j].w * inv) & 0xff) << 24));
    }
    const float su0 = SU[i0], su1 = SU[i1], sv0 = SV[i0], sv1 = SV[i1];
    int a0 = 0, a1 = 0;
#pragma unroll 1
    for (int kb = 0; kb < 8; ++kb) {
        u32x4 r[16];
#pragma unroll
        for (int e = 0; e < 16; ++e) { const int k = kb * 16 + e; const int idx = __builtin_amdgcn_readlane(kb < 4 ? i0 : i1, k & 63); r[e] = *(const u32x4*)(U8 + (size_t)idx * D + lane * 16); }
        int pa[8], pb[8];
#pragma unroll
        for (int e = 0; e < 16; ++e) { int d = __builtin_amdgcn_sdot4((int)r[e].x, xq[0], 0, false); d = __builtin_amdgcn_sdot4((int)r[e].y, xq[1], d, false); d = __builtin_amdgcn_sdot4((int)r[e].z, xq[2], d, false); d = __builtin_amdgcn_sdot4((int)r[e].w, xq[3], d, false);
            if (e < 8) pa[e] = d; else pb[e - 8] = d; }
        const int ya = treduce8i(pa, lane), yb = treduce8i(pb, lane);
        const int y = (lane & 8) ? yb : ya;
        if ((kb & 3) == ((lane >> 4) & 3)) { if (kb < 4) a0 = y; else a1 = y; }
    }
    const float wv0 = g0 * gelu_erf((float)a0 * su0 * xs) * sv0, wv1 = g1 * gelu_erf((float)a1 * su1 * xs) * sv1;
    const float corr = 0.f;
    float acc[16];
#pragma unroll
    for (int e = 0; e < 16; ++e) acc[e] = 0.f;
#pragma unroll 1
    for (int kb = 0; kb < 8; ++kb) {
        u32x4 r[16];
#pragma unroll
        for (int e = 0; e < 16; ++e) { const int k = kb * 16 + e; const int idx = __builtin_amdgcn_readlane(kb < 4 ? i0 : i1, k & 63); r[e] = *(const u32x4*)(V8 + (size_t)idx * D + lane * 16); }
#pragma unroll
        for (int e = 0; e < 16; ++e) { const int k = kb * 16 + e; const float wk = __int_as_float(__builtin_amdgcn_readlane(__float_as_int(kb < 4 ? wv0 : wv1), k & 63));
#pragma unroll
            for (int j = 0; j < 4; ++j) { const unsigned w = r[e][j];
                acc[4 * j + 0] += wk * (float)((int)(w << 24) >> 24); acc[4 * j + 1] += wk * (float)((int)(w << 16) >> 24); acc[4 * j + 2] += wk * (float)((int)(w << 8) >> 24); acc[4 * j + 3] += wk * (float)((int)w >> 24); } }
    }
    {   float* hp = p.out + (size_t)tok * D + lane * 16;
#pragma unroll
        for (int j = 0; j < 4; ++j) { f32x4 a = *(const f32x4*)(hp + 4 * j);
            a.x += acc[4 * j] - corr; a.y += acc[4 * j + 1] - corr; a.z += acc[4 * j + 2] - corr; a.w += acc[4 * j + 3] - corr;
            if (do_store || a.x == 1.2345e30f) *(f32x4*)(hp + 4 * j) = a; } }
}
__device__ __forceinline__ void peer_gather_phase(const Ptrs& p, int gw, int nw, int lane) {
    const int* SELI = (const int*)(p.ws + WS_SELI); const float* SELG = (const float*)(p.ws + WS_SELG);
    for (int tok = gw; tok < T; tok += nw)
        peer_gather_token(p, tok, SELI[(size_t)tok * 128 + lane], SELI[(size_t)tok * 128 + 64 + lane], SELG[(size_t)tok * 128 + lane], SELG[(size_t)tok * 128 + 64 + lane], lane);
}
__global__ void __launch_bounds__(512, 2) k_peer_gather(Ptrs p) {
    peer_gather_phase(p, blockIdx.x * 8 + (threadIdx.x >> 6), gridDim.x * 8, threadIdx.x & 63);
}

#include <hip/hip_cooperative_groups.h>
namespace cg = cooperative_groups;
constexpr int CW_Q3 = 64;
constexpr int MISC_OFF = LDS_BYTES - 64;

constexpr int CW_BAR = 4096;
#define XB_TMO      128
#define XB_XCNT(j)  (256  + 64 * (j))
#define XB_XSUB(j)  (1280 + 64 * (j))
#define XB_XGEN(j)  (2304 + 64 * (j))
#define XB_TOP      3328
#define XB_TOPGEN   3392
#define XCD_BAR_WORDS 3456
#define XB_SPIN_CAP (1u << 18)
__device__ __forceinline__ unsigned xb_ld(unsigned* p)              { return __hip_atomic_load(p, __ATOMIC_RELAXED, __HIP_MEMORY_SCOPE_AGENT); }
__device__ __forceinline__ unsigned xb_add(unsigned* p, unsigned v) { return __hip_atomic_fetch_add(p, v, __ATOMIC_RELAXED, __HIP_MEMORY_SCOPE_AGENT); }
__device__ __forceinline__ unsigned xb_xcc_id() { return (unsigned)__builtin_amdgcn_s_getreg((3 << 11) | 20) & 0xFu; }
#define XB_SPIN(cond, bar) do { unsigned _sp = 0; while (cond) { __builtin_amdgcn_s_sleep(1); \
    if ((++_sp & 255u) == 0u) { if (xb_ld(&(bar)[XB_TMO])) break; if (_sp > XB_SPIN_CAP) { atomicAdd(&(bar)[XB_TMO], 1u); break; } } } } while (0)
struct XcdBarrier { unsigned* bar; unsigned x; volatile LAS unsigned* st; };
__device__ __forceinline__ XcdBarrier xcd_barrier_post(unsigned* bar, volatile LAS unsigned* st) {
    XcdBarrier b; b.bar = bar; b.x = xb_xcc_id(); b.st = st;
    if (threadIdx.x == 0) (void)xb_add(&bar[XB_XCNT(b.x)], 1u);
    return b;
}
__device__ __forceinline__ void xcd_barrier_complete(unsigned* bar, unsigned x, unsigned& nloc, unsigned& nx) {
    const unsigned G = gridDim.x * gridDim.y * gridDim.z;
    unsigned sum, cnt, mine, sp = 0u;
    for (;;) {
        sum = 0u; cnt = 0u; mine = 0u;
#pragma unroll
        for (unsigned j = 0; j < 16; ++j) { const unsigned c = xb_ld(&bar[XB_XCNT(j)]); sum += c; cnt += (c > 0u) ? 1u : 0u; mine = (j == x) ? c : mine; }
        if (sum == G) break;
        __builtin_amdgcn_s_sleep(1);
        if ((++sp & 255u) == 0u) { if (xb_ld(&bar[XB_TMO])) break; if (sp > XB_SPIN_CAP) { atomicAdd(&bar[XB_TMO], 1u); break; } }
    }
    nloc = mine > 0u ? mine : 1u; nx = cnt > 0u ? cnt : 1u;
}
__device__ __forceinline__ void xcd_barrier(const XcdBarrier& b) {
    asm volatile("s_waitcnt vmcnt(0)" ::: "memory");
    __syncthreads();
    if (threadIdx.x == 0) {
        unsigned* bar = b.bar;
        __builtin_amdgcn_s_waitcnt(0);
        unsigned nloc = b.st[0], nx = b.st[1];
        if (nloc == 0u) { xcd_barrier_complete(bar, b.x, nloc, nx); b.st[0] = nloc; b.st[1] = nx; }
        const unsigned old = xb_add(&bar[XB_XSUB(b.x)], 1u);
        const unsigned gen = old / nloc;
        if (old + 1u == (gen + 1u) * nloc) {
            __builtin_amdgcn_fence(__ATOMIC_RELEASE, "agent");
            asm volatile("s_waitcnt vmcnt(0)" ::: "memory");
            const unsigned og = xb_add(&bar[XB_TOP], 1u);
            const unsigned tg = og / nx;
            if (og + 1u == (tg + 1u) * nx) xb_add(&bar[XB_TOPGEN], 1u);
            else XB_SPIN(xb_ld(&bar[XB_TOPGEN]) == tg, bar);
            __builtin_amdgcn_fence(__ATOMIC_ACQUIRE, "agent");
            xb_add(&bar[XB_XGEN(b.x)], 1u);
            asm volatile("s_waitcnt vmcnt(0)" ::: "memory");
        } else {
            XB_SPIN(xb_ld(&bar[XB_XGEN(b.x)]) == gen, bar);
            __builtin_amdgcn_fence(__ATOMIC_ACQUIRE, "agent");
            asm volatile("s_waitcnt vmcnt(0)" ::: "memory");
        }
    }
    __syncthreads();
}

__device__ __forceinline__ void prep_w_tile(const float* __restrict__ W, const float* __restrict__ gain, bf16_t* __restrict__ Wt, int K, int Nsrc, int mode, int tn, int tk, LAS float* tile) {
    const int t_ = opaque_tid(), tx = t_ & 63, ty = t_ >> 6, n0 = tn * 64, k0 = tk * 64, n = n0 + tx; const int src = mode ? win_src(n) : n;
    for (int kk = ty; kk < 64; kk += 8) { float v = 0.f; if (src >= 0) { v = W[(size_t)(k0 + kk) * Nsrc + src]; if (gain) v *= gain[k0 + kk]; } tile[kk * 65 + tx] = v; }
    __syncthreads();
    for (int nn = ty; nn < 64; nn += 8) Wt[(size_t)(n0 + nn) * K + k0 + tx] = (bf16_t)f2bf(tile[tx * 65 + nn]);
    __syncthreads();
}
__device__ __forceinline__ void prep_phase(const Ptrs& p, LAS unsigned char* lds) {
    const int tid = opaque_tid(), lane = tid & 63, G = gridDim.x, bx = blockIdx.x;
    unsigned char* ws = p.ws;
    if (bx == 0 && tid == 0) ((unsigned*)(ws + WS_CTL))[CW_Q3] = 0u;
    { float* R = (float*)(ws + WS_RINV2); for (int i = bx * 512 + tid; i < T; i += G * 512) R[i] = 0.f; }
    {
        float2* R32 = (float2*)(ws + WS_ROPE32); float2* R16 = (float2*)(ws + WS_ROPE16);
        for (int i = bx * 512 + tid; i < 4112 * 32; i += G * 512) {
            { const int pos = i >> 5, f = i & 31; const float inv = (float)pow(10000.0, -(double)f / 32.0); const float ang = (float)pos * inv; R32[i] = make_float2((float)cos((double)ang), (float)sin((double)ang)); }
            if (i < 4112 * 16) { const int pos = i >> 4, f = i & 15; const float inv = (float)pow(10000.0, -(double)f / 16.0); const float ang = (float)pos * inv; R16[i] = make_float2((float)cos((double)ang), (float)sin((double)ang)); }
            if (i < 8 * 256) ((float*)(ws + WS_DEC))[i] = (float)pow(1.0 - exp2(-5.0 - (double)(i >> 8)), (double)((i & 255) + 1)); }
    }
    {
        bf16_t* XB = (bf16_t*)(ws + WS_XB);
        for (int r = bx * 8 + (tid >> 6); r < MP; r += G * 8) {
            f32x4 v[4];
            if (r < T + NMETA) { const float* src = r < T ? p.in[0] + (size_t)r * D : p.in[1] + (size_t)(r - T) * D;
#pragma unroll
                for (int j = 0; j < 4; ++j) v[j] = *(const f32x4*)(src + lane * 4 + 256 * j); }
            else {
#pragma unroll
                for (int j = 0; j < 4; ++j) v[j] = (f32x4){0.f, 0.f, 0.f, 0.f}; }
            float ss = 0.f;
#pragma unroll
            for (int j = 0; j < 4; ++j) ss += v[j].x * v[j].x + v[j].y * v[j].y + v[j].z * v[j].z + v[j].w * v[j].w;
            ss = wave_sum(ss);
            const float rinv = rsqrtf(ss * (1.f / D) + EPS);
#pragma unroll
            for (int j = 0; j < 4; ++j) { uint2 o; o.x = pk2(v[j].x * rinv, v[j].y * rinv); o.y = pk2(v[j].z * rinv, v[j].w * rinv); *(uint2*)(XB + (size_t)r * D + lane * 4 + 256 * j) = o; }
        }
    }
    {
        LAS float* tile = (LAS float*)lds;
        constexpr int NT0 = (NIN / 64) * 16, NT1 = NT0 + 12 * 6, NT2 = NT1 + 16 * 4, NT3 = NT2 + 16 * 8, NT4 = NT3 + 256, NT5 = NT4 + 256, NT6 = NT5 + 256;
        for (int it = bx; it < NT6; it += G) {
            if (it < NT0) prep_w_tile(p.in[3], p.in[2], (bf16_t*)(ws + WS_WIN), 1024, 5792, 1, it / 16, it % 16, tile);
            else if (it < NT1) { const int r = it - NT0; prep_w_tile(p.in[5], p.in[4], (bf16_t*)(ws + WS_WUQ), 384, 768, 0, r / 6, r % 6, tile); }
            else if (it < NT2) { const int r = it - NT1; prep_w_tile(p.in[7], p.in[6], (bf16_t*)(ws + WS_WUKV), 256, 1024, 0, r / 4, r % 4, tile); }
            else if (it < NT3) { const int r = it - NT2; prep_w_tile(p.in[10], nullptr, (bf16_t*)(ws + WS_WMLA), 512, 1024, 0, r / 8, r % 8, tile); }
            else if (it < NT4) { const int r = it - NT3; prep_w_tile(p.in[12], nullptr, (bf16_t*)(ws + WS_WRET), 1024, 1024, 0, r / 16, r % 16, tile); }
            else if (it < NT5) { const int r = it - NT4; prep_w_tile(p.in[13], nullptr, (bf16_t*)(ws + WS_WMIX), 1024, 1024, 0, r / 16, r % 16, tile); }
            else { const int r = it - NT5; prep_w_tile(p.in[15], p.in[14], (bf16_t*)(ws + WS_WPQ), 1024, 1024, 0, r / 16, r % 16, tile); }
        }
    }
}
__device__ __forceinline__ void mixer_phase(const Ptrs& p, LAS unsigned char* lds, int lo = 0, int hi_ = 64 + 1024) {
    unsigned* ctl = (unsigned*)(p.ws + WS_CTL);
    volatile LAS unsigned* bc = (volatile LAS unsigned*)(lds + MISC_OFF);
    for (;;) {
        __syncthreads();
        if (threadIdx.x == 0) *bc = __hip_atomic_fetch_add(ctl + CW_Q3, 1u, __ATOMIC_RELAXED, __HIP_MEMORY_SCOPE_AGENT);
        __syncthreads();
        const int it = (int)*bc + lo;
        if (it >= hi_) break;
        if (it < 64) ret_unit(p, lds, it >> 3, it & 7);
        else { const int a = it - 64, qb = 15 - (a >> 6), bh = a & 63; attn_unit(p, lds, bh >> 3, bh & 7, qb); }
    }
}
constexpr int PL_SELI = 2 * 128 * KEY_PITCH, PL_SELG = PL_SELI + 32 * 128 * 4, PL_END = PL_SELG + 32 * 128 * 4;
static_assert(PL_END <= MISC_OFF, "peer LDS");
__device__ __forceinline__ void peer_phase(const Ptrs& p, LAS unsigned char* lds, bool do_store = true) {
    const int tid = opaque_tid(), lane = tid & 63, wid = __builtin_amdgcn_readfirstlane(tid >> 6);
    peer_keys_to_lds(p, lds);
    for (int u = blockIdx.x; u < T / 32; u += gridDim.x) {
        __syncthreads();
        peer_select_unit<LAS int*, LAS float*, LAS u32x4*, LAS f32x4*>(p, lds, u * 32, wid, lane, (LAS int*)(lds + PL_SELI), (LAS float*)(lds + PL_SELG));
        __syncthreads();
#pragma unroll 1
        for (int k = 0; k < 4; ++k) { const int tl = wid * 4 + k;
            const LAS int* ip = (const LAS int*)(lds + PL_SELI) + tl * 128; const LAS float* gp = (const LAS float*)(lds + PL_SELG) + tl * 128;
            peer_gather_token(p, u * 32 + tl, ip[lane], ip[64 + lane], gp[lane], gp[64 + lane], lane, do_store); }
    }
}

constexpr size_t WS_IDXP = WS_RQ, WS_GATEP = WS_RQ + (size_t)T * 128 * 2;
constexpr size_t WS_XQ = WS_XB, WS_XS = WS_XB + (size_t)T * 1024;
constexpr size_t WS_PP = WS_RV;
constexpr size_t WS_WVP = WS_LAT, WS_CORR = WS_LAT + (size_t)T * 128 * 4;
static_assert(WS_GATEP + (size_t)T * 128 * 4 <= WS_RV && WS_XS + (size_t)T * 4 <= WS_LAT && WS_PP + (size_t)T * 8 * 128 * 4 <= WS_K && WS_CORR + (size_t)T * 4 <= WS_RQ, "sliced PEER overlay");
__device__ __forceinline__ void peer_pre_phase(const Ptrs& p, LAS unsigned char* lds) {
    const int tid = opaque_tid(), lane = tid & 63, wid = __builtin_amdgcn_readfirstlane(tid >> 6), G = gridDim.x, bx = blockIdx.x;
    peer_keys_to_lds(p, lds);
    {
        const float* SS2 = (const float*)(p.ws + WS_RINV2); const float* gffn = p.in[14];
        for (int tok = bx * 8 + wid; tok < T; tok += G * 8) {
            const float r2 = rsqrtf(SS2[tok] * (1.f / D) + EPS); const float* hp = p.out + (size_t)tok * D + lane * 16; const float* gp = gffn + lane * 16;
            f32x4 x[4]; float am = 0.f;
#pragma unroll
            for (int j = 0; j < 4; ++j) { x[j] = *(const f32x4*)(hp + 4 * j) * *(const f32x4*)(gp + 4 * j) * r2; am = fmaxf(am, fmaxf(fmaxf(fabsf(x[j].x), fabsf(x[j].y)), fmaxf(fabsf(x[j].z), fabsf(x[j].w)))); }
            am = fmaxf(wave_max(am), 1e-30f); const float inv = 127.f / am; u32x4 w;
#pragma unroll
            for (int j = 0; j < 4; ++j) w[j] = ((unsigned)((int)rintf(x[j].x * inv) & 0xff)) | ((unsigned)((int)rintf(x[j].y * inv) & 0xff) << 8) | ((unsigned)((int)rintf(x[j].z * inv) & 0xff) << 16) | ((unsigned)((int)rintf(x[j].w * inv) & 0xff) << 24);
            *(u32x4*)(p.ws + WS_XQ + (size_t)tok * D + lane * 16) = w;
            if (lane == 0) ((float*)(p.ws + WS_XS))[tok] = am * (1.f / 127.f);
        }
    }
    __syncthreads();
    unsigned short* IDXP = (unsigned short*)(p.ws + WS_IDXP); float* GATEP = (float*)(p.ws + WS_GATEP);
    for (int u = bx; u < T / 32; u += G) {
        int P16[16]; float gt[16]; peer_select_core(p, lds, u * 32, wid, lane, P16, gt);
        const int tok = u * 32 + (lane & 31);
        if ((lane >> 5) == 0) {
#pragma unroll
            for (int r = 0; r < 8; ++r) *(unsigned*)(IDXP + (size_t)tok * 128 + r * 16 + 2 * wid) = (unsigned)P16[r] | ((unsigned)P16[r + 8] << 16); }
        else {
#pragma unroll
            for (int r = 0; r < 8; ++r) *(f32x2_t*)(GATEP + (size_t)tok * 128 + r * 16 + 2 * wid) = (f32x2_t){gt[r], gt[r + 8]}; }
    }
}
__device__ __forceinline__ int treduce8g(const int (&v)[8], int lane) {
    int w[4], x[2];
    const bool b0 = lane & 1, b1 = lane & 2, b2 = lane & 4;
#pragma unroll
    for (int i = 0; i < 4; ++i) { const int keep = b0 ? v[2 * i + 1] : v[2 * i], send = b0 ? v[2 * i] : v[2 * i + 1]; w[i] = keep + __shfl_xor(send, 1); }
#pragma unroll
    for (int i = 0; i < 2; ++i) { const int keep = b1 ? w[2 * i + 1] : w[2 * i], send = b1 ? w[2 * i] : w[2 * i + 1]; x[i] = keep + __shfl_xor(send, 2); }
    const int keep = b2 ? x[1] : x[0], send = b2 ? x[0] : x[1];
    return keep + __shfl_xor(send, 4);
}
#define PEER_IDX16(ia, ib, i) ((int)((((i) < 8 ? ia : ib)[((i) & 7) >> 1] >> (16 * ((i) & 1))) & 0xffffu))
__device__ __forceinline__ void peer_u_phase(const Ptrs& p) {
    const int tid = opaque_tid(), lane = tid & 63, wid = __builtin_amdgcn_readfirstlane(tid >> 6), G = gridDim.x, bx = blockIdx.x;
    const int j = bx & 7, wg = (bx >> 3) * 8 + wid, nwg = (G >> 3) * 8, g = lane >> 3, s = lane & 7;
    const unsigned char* U8 = p.ws + WS_U8 + 128 * j + 16 * s; const unsigned short* IDXP = (const unsigned short*)(p.ws + WS_IDXP); int* PP = (int*)(p.ws + WS_PP);
    int tok = wg; if (tok >= T) return;
    u32x4 ia = *(const u32x4*)(IDXP + (size_t)tok * 128 + g * 16), ib = *(const u32x4*)(IDXP + (size_t)tok * 128 + g * 16 + 8);
    u32x4 xq = *(const u32x4*)(p.ws + WS_XQ + (size_t)tok * D + 128 * j + 16 * s);
    for (; tok < T; tok += nwg) {
        u32x4 r[16];
#pragma unroll
        for (int i = 0; i < 16; ++i) r[i] = *(const u32x4*)(U8 + (size_t)PEER_IDX16(ia, ib, i) * D);
        const u32x4 xc = xq; const int tn = tok + nwg;
        if (tn < T) { ia = *(const u32x4*)(IDXP + (size_t)tn * 128 + g * 16); ib = *(const u32x4*)(IDXP + (size_t)tn * 128 + g * 16 + 8); xq = *(const u32x4*)(p.ws + WS_XQ + (size_t)tn * D + 128 * j + 16 * s); }
        int pa[8], pb[8];
#pragma unroll
        for (int i = 0; i < 16; ++i) { int d = __builtin_amdgcn_sdot4((int)r[i].x, (int)xc.x, 0, false); d = __builtin_amdgcn_sdot4((int)r[i].y, (int)xc.y, d, false); d = __builtin_amdgcn_sdot4((int)r[i].z, (int)xc.z, d, false); d = __builtin_amdgcn_sdot4((int)r[i].w, (int)xc.w, d, false);
            if (i < 8) pa[i] = d; else pb[i - 8] = d; }
        const int ya = treduce8g(pa, lane), yb = treduce8g(pb, lane);
        int* pp = PP + ((size_t)tok * 8 + j) * 128 + 16 * g + s; pp[0] = ya; pp[8] = yb;
    }
}
__device__ __forceinline__ void peer_reduce_phase(const Ptrs& p, int gw, int nw, int lane) {
    const unsigned short* IDXP = (const unsigned short*)(p.ws + WS_IDXP); const float* GATEP = (const float*)(p.ws + WS_GATEP); const int* PP = (const int*)(p.ws + WS_PP);
    const float* SU = (const float*)(p.ws + WS_SU); const float* SV = (const float*)(p.ws + WS_SV); const float* XS = (const float*)(p.ws + WS_XS);
    unsigned char* WQ = p.ws + WS_WVP; float* WSC = (float*)(p.ws + WS_CORR);
    for (int tok = gw; tok < T; tok += nw) {
        const float xs = XS[tok]; float wv[2];
#pragma unroll
        for (int hf = 0; hf < 2; ++hf) { const int pos = lane + 64 * hf; int sum = 0;
#pragma unroll
            for (int j = 0; j < 8; ++j) sum += PP[((size_t)tok * 8 + j) * 128 + pos];
            const int idx = IDXP[(size_t)tok * 128 + pos];
            wv[hf] = GATEP[(size_t)tok * 128 + pos] * gelu_erf((float)sum * SU[idx] * xs) * SV[idx]; }
        const float am = fmaxf(wave_max(fmaxf(fabsf(wv[0]), fabsf(wv[1]))), 1e-30f), inv = 127.f / am;
        WQ[(size_t)tok * 128 + lane] = (unsigned char)((int)rintf(wv[0] * inv) & 0xff); WQ[(size_t)tok * 128 + 64 + lane] = (unsigned char)((int)rintf(wv[1] * inv) & 0xff);
        if (lane == 0) WSC[tok] = am * (1.f / 127.f);
    }
}
__device__ __forceinline__ void tr4x4(unsigned a, unsigned b, unsigned c, unsigned d, unsigned (&t)[4]) {
    const unsigned ab01 = __builtin_amdgcn_perm(b, a, 0x05010400u), ab23 = __builtin_amdgcn_perm(b, a, 0x07030602u), cd01 = __builtin_amdgcn_perm(d, c, 0x05010400u), cd23 = __builtin_amdgcn_perm(d, c, 0x07030602u);
    t[0] = __builtin_amdgcn_perm(cd01, ab01, 0x05040100u); t[1] = __builtin_amdgcn_perm(cd01, ab01, 0x07060302u); t[2] = __builtin_amdgcn_perm(cd23, ab23, 0x05040100u); t[3] = __builtin_amdgcn_perm(cd23, ab23, 0x07060302u);
}
__device__ __forceinline__ void peer_v_phase(const Ptrs& p, bool do_store = true) {
    const int tid = opaque_tid(), lane = tid & 63, wid = __builtin_amdgcn_readfirstlane(tid >> 6), G = gridDim.x, bx = blockIdx.x;
    const int j = bx & 7, wg = (bx >> 3) * 8 + wid, nwg = (G >> 3) * 8, g = lane >> 3, s = lane & 7;
    const unsigned char* V8 = p.ws + WS_V8 + 128 * j + 16 * s; const unsigned short* IDXP = (const unsigned short*)(p.ws + WS_IDXP); const unsigned char* WQ = p.ws + WS_WVP;
    const float* WSC = (const float*)(p.ws + WS_CORR);
    const bool g0 = lane & 8, g1 = lane & 16, g2 = lane & 32;
    const int fsel = 8 * (g0 ? 1 : 0) + 4 * (g1 ? 1 : 0) + 2 * (g2 ? 1 : 0);
    int tok = wg; if (tok >= T) return;
    u32x4 ia = *(const u32x4*)(IDXP + (size_t)tok * 128 + g * 16), ib = *(const u32x4*)(IDXP + (size_t)tok * 128 + g * 16 + 8);
    u32x4 wq = *(const u32x4*)(WQ + (size_t)tok * 128 + g * 16);
    for (; tok < T; tok += nwg) {
        u32x4 r[16];
#pragma unroll
        for (int i = 0; i < 16; ++i) r[i] = *(const u32x4*)(V8 + (size_t)PEER_IDX16(ia, ib, i) * D);
        const u32x4 wc = wq; const int tn = tok + nwg;
        if (tn < T) { ia = *(const u32x4*)(IDXP + (size_t)tn * 128 + g * 16); ib = *(const u32x4*)(IDXP + (size_t)tn * 128 + g * 16 + 8); wq = *(const u32x4*)(WQ + (size_t)tn * 128 + g * 16); }
        float* op = p.out + (size_t)tok * D + 128 * j + 16 * s + fsel;
        const f32x2_t hv = *(const f32x2_t*)op; const float wsc = WSC[tok];
        int acc[16];
#pragma unroll
        for (int e = 0; e < 16; ++e) acc[e] = 0;
#pragma unroll
        for (int m = 0; m < 4; ++m)
#pragma unroll
            for (int q = 0; q < 4; ++q) { unsigned t4[4]; tr4x4(r[4 * m][q], r[4 * m + 1][q], r[4 * m + 2][q], r[4 * m + 3][q], t4);
#pragma unroll
                for (int f = 0; f < 4; ++f) acc[4 * q + f] = __builtin_amdgcn_sdot4((int)t4[f], (int)wc[m], acc[4 * q + f], false); }
        int w8[8], x4[4], y2[2];
#pragma unroll
        for (int m = 0; m < 8; ++m) { const int keep = g0 ? acc[8 + m] : acc[m], send = g0 ? acc[m] : acc[8 + m]; w8[m] = keep + __shfl_xor(send, 8); }
#pragma unroll
        for (int m = 0; m < 4; ++m) { const int keep = g1 ? w8[4 + m] : w8[m], send = g1 ? w8[m] : w8[4 + m]; x4[m] = keep + __shfl_xor(send, 16); }
#pragma unroll
        for (int m = 0; m < 2; ++m) { const int keep = g2 ? x4[2 + m] : x4[m], send = g2 ? x4[m] : x4[2 + m]; y2[m] = keep + __shfl_xor(send, 32); }
        if (do_store || y2[0] == 0x7fffffff) *(f32x2_t*)op = (f32x2_t){hv.x + (float)y2[0] * wsc, hv.y + (float)y2[1] * wsc};
    }
}

__global__ void __launch_bounds__(512, 2) k_mega(Ptrs p) {
    extern __shared__ __attribute__((aligned(16))) unsigned char lds_raw[];
    LAS unsigned char* lds = (LAS unsigned char*)lds_raw;
    cg::grid_group grid = cg::this_grid();
    if (threadIdx.x < 16) ((volatile LAS unsigned*)(lds + MISC_OFF))[threadIdx.x] = 0u;
    __syncthreads();
    const XcdBarrier xbar = xcd_barrier_post((unsigned*)(p.ws + WS_CTL) + CW_BAR, (volatile LAS unsigned*)(lds + MISC_OFF + 16));
    unsigned char* ws = p.ws;
    const int G = gridDim.x, bx = blockIdx.x, nw = G * 8;
    bf16_t *WIN = (bf16_t*)(ws + WS_WIN), *WUQ = (bf16_t*)(ws + WS_WUQ), *WUKV = (bf16_t*)(ws + WS_WUKV), *WMLA = (bf16_t*)(ws + WS_WMLA), *WRET = (bf16_t*)(ws + WS_WRET),
           *WMIX = (bf16_t*)(ws + WS_WMIX), *WPQ = (bf16_t*)(ws + WS_WPQ);
    bf16_t *XB = (bf16_t*)(ws + WS_XB), *LAT = (bf16_t*)(ws + WS_LAT), *RQ = (bf16_t*)(ws + WS_RQ), *RK = (bf16_t*)(ws + WS_RK), *RV = (bf16_t*)(ws + WS_RV), *RG = (bf16_t*)(ws + WS_RG);
    bf16_t *SA = (bf16_t*)p.out, *SR = SA + (size_t)T * 1024;
    bf16_t *Q = (bf16_t*)(ws + WS_Q), *K = (bf16_t*)(ws + WS_K), *VRAW = (bf16_t*)(ws + WS_VRAW), *AO = (bf16_t*)(ws + WS_AO), *RET = (bf16_t*)(ws + WS_RET), *MG = (bf16_t*)(ws + WS_MG),
           *H1B = (bf16_t*)(ws + WS_H1B), *PQ = (bf16_t*)(ws + WS_PQ);
    pg8::StaticOrder S;
#ifndef PROBE_DUP
#define PROBE_DUP 0
#endif
    prep_phase(p, lds);
    if (PROBE_DUP == 4) { __syncthreads(); prep_phase(p, lds); }
    if (PROBE_DUP == 5) { for (int i_ = 0; i_ < 8; ++i_) grid.sync(); }
    grid.sync();
    { pg8::Gemm g{XB, WIN, 1024, 1024, MP, NIN, 1024, 0}; S.init(MP, NIN, G, bx); pg8::gemm_phase(lds, g, S, EpiIn{LAT, RQ, RK, RV, RG, SA, SR, (const float2*)(ws + WS_ROPE32), (const float*)(ws + WS_DEC)}); }
    if (PROBE_DUP == 8) { pg8::Gemm g{XB, WIN, 1024, 1024, MP, NIN, 1024, 0}; S.init(MP, NIN, G, bx); pg8::gemm_phase(lds, g, S, EpiNull{(float*)(ws + WS_RINV2)}); }
    if (PROBE_DUP == 3) { pg8::Gemm g{XB, WIN, 1024, 1024, MP, NIN, 1024, 0}; S.init(MP, NIN, G, bx); pg8::gemm_phase(lds, g, S, EpiIn{LAT, RQ, RK, RV, RG, SA, SR, (const float2*)(ws + WS_ROPE32), (const float*)(ws + WS_DEC)}); }
    xcd_barrier(xbar);
    { pg8::Gemm g{LAT, WUQ, 768, 384, T, 768, 384, 0}; S.init(T, 768, G, bx); pg8::gemm_phase(lds, g, S, EpiQraw{Q}); }
    { pg8::Gemm g{LAT + 384, WUKV, 768, 256, MP, 1024, 256, 0}; S.init(MP, 1024, G, bx); pg8::gemm_phase(lds, g, S, EpiKVraw{K, VRAW}); }
    xcd_barrier(xbar);
    { const int t_ = opaque_tid(); finalize_phase(p, bx * 8 + (t_ >> 6), nw, t_ & 63); }
    xcd_barrier(xbar);
    mixer_phase(p, lds);
    xcd_barrier(xbar);
    if (PROBE_DUP == 2 || PROBE_DUP == 6 || PROBE_DUP == 7) { if (bx == 0 && threadIdx.x == 0) ((unsigned*)(ws + WS_CTL))[CW_Q3] = 0u; xcd_barrier(xbar); mixer_phase(p, lds, PROBE_DUP == 6 ? 64 : 0, PROBE_DUP == 7 ? 64 : 64 + 1024); xcd_barrier(xbar); }
    { const int t_ = opaque_tid(); prep_uv_part(p, bx * 8 + (t_ >> 6), nw, t_ & 63); }
    { pg8::Gemm g{AO, WMLA, 512, 512, T, 1024, 512, 0}; S.init(T, 1024, G, bx); pg8::gemm_phase(lds, g, S, EpiMerge1{MG, SA}); }
    { pg8::Gemm g{RET, WRET, 1024, 1024, T, 1024, 1024, 0}; S.init(T, 1024, G, bx); pg8::gemm_phase(lds, g, S, EpiMerge2{MG, SR}); }
    xcd_barrier(xbar);
    { pg8::Gemm g{MG, WMIX, 1024, 1024, T, 1024, 1024, 0}; S.init(T, 1024, G, bx); pg8::gemm_phase(lds, g, S, EpiMix{p.in[0], p.out, H1B, (float*)(ws + WS_RINV2)}); }
    xcd_barrier(xbar);
    { pg8::Gemm g{H1B, WPQ, 1024, 1024, T, 1024, 1024, 0}; S.init(T, 1024, G, bx); pg8::gemm_phase(lds, g, S, EpiPQ{PQ, (const float*)(ws + WS_RINV2)}); }
    xcd_barrier(xbar);
#ifndef PEER_SLICED
#define PEER_SLICED 1
#endif
    if (PEER_SLICED) {
        peer_pre_phase(p, lds);
        if (PROBE_DUP == 10) { __syncthreads(); peer_pre_phase(p, lds); }
        xcd_barrier(xbar);
        peer_u_phase(p);
        if (PROBE_DUP == 11) peer_u_phase(p);
        xcd_barrier(xbar);
        { const int t_ = opaque_tid(); peer_reduce_phase(p, bx * 8 + (t_ >> 6), nw, t_ & 63); }
        if (PROBE_DUP == 12) { const int t_ = opaque_tid(); peer_reduce_phase(p, bx * 8 + (t_ >> 6), nw, t_ & 63); }
        xcd_barrier(xbar);
        if (PROBE_DUP == 13) peer_v_phase(p, false);
        peer_v_phase(p);
    } else {
        if (PROBE_DUP == 1) { peer_phase(p, lds, false); __syncthreads(); }
        peer_phase(p, lds);
    }
}

#ifndef USE_REF_GEMM
#define USE_REF_GEMM 0
#endif
template <class Epi> static void launch_gemm(hipStream_t st, const bf16_t* A, int lda, const bf16_t* Bt, int ldb, int M, int N, int K, Epi E) {
    if (USE_REF_GEMM) { hipLaunchKernelGGL(gemm_ref<Epi>, dim3(N / 128, M / 64), dim3(256), 0, st, A, lda, Bt, ldb, K, E); return; }
    static bool attr_done = false;
    if (!attr_done) { (void)hipFuncSetAttribute((const void*)k_gemm<Epi>, hipFuncAttributeMaxDynamicSharedMemorySize, LDS_BYTES); attr_done = true; }
    pg8::Gemm g{A, Bt, lda, ldb, M, N, K, 0};
    hipLaunchKernelGGL(k_gemm<Epi>, dim3(256), dim3(512), LDS_BYTES, st, g, E);
}
#ifndef MEGA
#define MEGA 1
#endif
extern "C" void kernel_launch(void* const* d_in, const int* in_sizes, int n_in, void* d_out, int out_size, void* d_ws, size_t ws_size, hipStream_t stream) {
    Ptrs p{}; for (int i = 0; i < 20; ++i) p.in[i] = (const float*)d_in[i]; p.out = (float*)d_out; p.ws = (unsigned char*)d_ws;
#if MEGA
    static int grid = 0;
    if (grid == 0) {
        int dev = 0, cus = 0, per_cu = 0;
        (void)hipGetDevice(&dev); (void)hipDeviceGetAttribute(&cus, hipDeviceAttributeMultiprocessorCount, dev);
        (void)hipFuncSetAttribute((const void*)k_mega, hipFuncAttributeMaxDynamicSharedMemorySize, LDS_BYTES);
        (void)hipOccupancyMaxActiveBlocksPerMultiprocessor(&per_cu, (const void*)k_mega, 512, LDS_BYTES);
        if (per_cu < 1) per_cu = 1;
        grid = cus * (per_cu > 1 ? 1 : per_cu);
        if (grid % 8) grid -= grid % 8;
    }
    (void)hipMemsetAsync(d_ws, 0, 65536, stream);
    void* args[] = {&p};
    (void)hipLaunchCooperativeKernel((const void*)k_mega, dim3(grid), dim3(512), args, LDS_BYTES, stream);
    return;
#endif
    unsigned char* ws = p.ws;
    bf16_t *WIN = (bf16_t*)(ws + WS_WIN), *WUQ = (bf16_t*)(ws + WS_WUQ), *WUKV = (bf16_t*)(ws + WS_WUKV), *WMLA = (bf16_t*)(ws + WS_WMLA), *WRET = (bf16_t*)(ws + WS_WRET),
           *WMIX = (bf16_t*)(ws + WS_WMIX), *WPQ = (bf16_t*)(ws + WS_WPQ);
    bf16_t *XB = (bf16_t*)(ws + WS_XB), *LAT = (bf16_t*)(ws + WS_LAT), *RQ = (bf16_t*)(ws + WS_RQ), *RK = (bf16_t*)(ws + WS_RK), *RV = (bf16_t*)(ws + WS_RV), *RG = (bf16_t*)(ws + WS_RG);
    bf16_t *SA = (bf16_t*)d_out, *SR = SA + (size_t)T * 1024;
    bf16_t *Q = (bf16_t*)(ws + WS_Q), *K = (bf16_t*)(ws + WS_K), *V = (bf16_t*)(ws + WS_VRAW), *AO = (bf16_t*)(ws + WS_AO), *RET = (bf16_t*)(ws + WS_RET), *MG = (bf16_t*)(ws + WS_MG),
           *H1B = (bf16_t*)(ws + WS_H1B), *PQ = (bf16_t*)(ws + WS_PQ);
    hipLaunchKernelGGL(k_prep_rows, dim3(1024), dim3(256), 0, stream, p);
    hipLaunchKernelGGL(k_prep_rope, dim3((4112 * 32 + 255) / 256), dim3(256), 0, stream, p);
    hipLaunchKernelGGL(k_prep_w<1>, dim3(NIN / 64, 1024 / 64), dim3(256), 0, stream, p.in[3], p.in[2], WIN, 1024, 5792, NIN);
    hipLaunchKernelGGL(k_prep_w<0>, dim3(768 / 64, 384 / 64), dim3(256), 0, stream, p.in[5], p.in[4], WUQ, 384, 768, 768);
    hipLaunchKernelGGL(k_prep_w<0>, dim3(1024 / 64, 256 / 64), dim3(256), 0, stream, p.in[7], p.in[6], WUKV, 256, 1024, 1024);
    hipLaunchKernelGGL(k_prep_w<0>, dim3(1024 / 64, 512 / 64), dim3(256), 0, stream, p.in[10], (const float*)nullptr, WMLA, 512, 1024, 1024);
    hipLaunchKernelGGL(k_prep_w<0>, dim3(1024 / 64, 1024 / 64), dim3(256), 0, stream, p.in[12], (const float*)nullptr, WRET, 1024, 1024, 1024);
    hipLaunchKernelGGL(k_prep_w<0>, dim3(1024 / 64, 1024 / 64), dim3(256), 0, stream, p.in[13], (const float*)nullptr, WMIX, 1024, 1024, 1024);
    hipLaunchKernelGGL(k_prep_w<0>, dim3(1024 / 64, 1024 / 64), dim3(256), 0, stream, p.in[15], p.in[14], WPQ, 1024, 1024, 1024);
    launch_gemm(stream, XB, 1024, WIN, 1024, MP, NIN, 1024, EpiIn{LAT, RQ, RK, RV, RG, SA, SR, (const float2*)(ws + WS_ROPE32), (const float*)(ws + WS_DEC)});
    launch_gemm(stream, LAT, 768, WUQ, 384, T, 768, 384, EpiQraw{Q});
    launch_gemm(stream, LAT + 384, 768, WUKV, 256, MP, 1024, 256, EpiKVraw{K, V});
    hipLaunchKernelGGL(k_finalize, dim3(1024), dim3(256), 0, stream, p);
#ifndef USE_REF_ATTN
#define USE_REF_ATTN 0
#endif
    if (USE_REF_ATTN) hipLaunchKernelGGL(k_attn_naive, dim3(SEQ / 64, 8, BATCH), dim3(64), 0, stream, p);
    else hipLaunchKernelGGL(k_attn, dim3(256), dim3(512), ATT_LDS, stream, p);
#ifndef USE_REF_RET
#define USE_REF_RET 0
#endif
    if (USE_REF_RET) hipLaunchKernelGGL(k_ret_naive, dim3(64), dim3(128), 0, stream, p);
    else { static bool ad = false; if (!ad) { (void)hipFuncSetAttribute((const void*)k_ret, hipFuncAttributeMaxDynamicSharedMemorySize, RT_LDS); ad = true; }
        hipLaunchKernelGGL(k_ret, dim3(64), dim3(512), RT_LDS, stream, p); }
    launch_gemm(stream, AO, 512, WMLA, 512, T, 1024, 512, EpiMerge1{MG, SA});
    launch_gemm(stream, RET, 1024, WRET, 1024, T, 1024, 1024, EpiMerge2{MG, SR});
    hipLaunchKernelGGL(k_zero_ss2, dim3(128), dim3(256), 0, stream, p);
    launch_gemm(stream, MG, 1024, WMIX, 1024, T, 1024, 1024, EpiMix{p.in[0], p.out, H1B, (float*)(ws + WS_RINV2)});
    launch_gemm(stream, H1B, 1024, WPQ, 1024, T, 1024, 1024, EpiPQ{PQ, (const float*)(ws + WS_RINV2)});
#ifndef USE_REF_SELECT
#define USE_REF_SELECT 0
#endif
    if (USE_REF_SELECT) hipLaunchKernelGGL(k_peer_select_naive, dim3(T * 8 / 32), dim3(32), 0, stream, p);
    else hipLaunchKernelGGL(k_peer_select, dim3(256), dim3(512), 2 * 128 * KEY_PITCH, stream, p, 0);
#ifdef DBG_SEL
    hipMemsetAsync(p.ws + WS_CTL, 0, 4096, stream);
    hipLaunchKernelGGL(k_peer_select256, dim3(512), dim3(256), 2 * 128 * KEY_PITCH, stream, p, 1);
    hipLaunchKernelGGL(k_dbg_cmp_sel, dim3(T * 8 / 256), dim3(256), 0, stream, p, DBG_SEL);
#ifdef DBG_SCORES
    hipLaunchKernelGGL(k_dbg_cmp_scores, dim3(1024 * 8 * 2 * 128 / 256), dim3(256), 0, stream, p);
#endif
#endif
#ifndef USE_REF_GATHER
#define USE_REF_GATHER 0
#endif
    if (USE_REF_GATHER) hipLaunchKernelGGL(k_peer_gather_naive, dim3(T), dim3(256), 0, stream, p);
    else { hipLaunchKernelGGL(k_prep_uv, dim3(512), dim3(512), 0, stream, p); hipLaunchKernelGGL(k_peer_gather, dim3(256), dim3(512), 0, stream, p); }
#ifdef DBG_SEL
    hipLaunchKernelGGL(k_dbg_scale, dim3(2048), dim3(256), 0, stream, p, DBG_SEL == 3 ? (float)(1024 * 8 * 2 * 128) : DBG_SEL == 2 ? (float)T * 128 : (float)T * 8, DBG_SEL);
#endif
}
```

```cpp
#include <hip/hip_runtime.h>
#include <stdint.h>
#include <math.h>
#include <utility>

typedef unsigned short bf16_t;
#define LAS __attribute__((address_space(3)))
#define LDS_BARRIER() do { asm volatile("s_waitcnt lgkmcnt(0)" ::: "memory"); __builtin_amdgcn_s_barrier(); asm volatile("" ::: "memory"); } while (0)
typedef float f32x4 __attribute__((ext_vector_type(4)));
typedef unsigned u32x4 __attribute__((ext_vector_type(4)));
typedef unsigned u32x2 __attribute__((ext_vector_type(2)));

constexpr int D = 1024, BATCH = 8, SEQ = 4096, NMETA = 16;
constexpr int T = BATCH * SEQ;
constexpr int MP = 33024;
constexpr float EPS = 1e-6f;
constexpr int NIN = 5888;
constexpr int C_LAT = 0, C_RQ = 768, C_RK = 1280, C_RV = 1792, C_RG = 2816, C_SA = 3840, C_SR = 4864;
constexpr float QSCALE = 1.4426950408889634f * 0.10206207261596575f;

constexpr size_t al(size_t x) { return (x + 255) & ~(size_t)255; }
constexpr size_t WS_CTL = 0;
constexpr size_t WS_WIN = 1u << 20;
constexpr size_t WS_WUQ = WS_WIN + al((size_t)NIN * 1024 * 2);
constexpr size_t WS_WUKV = WS_WUQ + al((size_t)768 * 384 * 2);
constexpr size_t WS_WMLA = WS_WUKV + al((size_t)1024 * 256 * 2);
constexpr size_t WS_WRET = WS_WMLA + al((size_t)1024 * 512 * 2);
constexpr size_t WS_WMIX = WS_WRET + al((size_t)1024 * 1024 * 2);
constexpr size_t WS_WPQ = WS_WMIX + al((size_t)1024 * 1024 * 2);
constexpr size_t WS_KEYS = WS_WPQ + al((size_t)1024 * 1024 * 2);
constexpr size_t WS_ROPE32 = WS_KEYS + al((size_t)2 * 128 * 64 * 2);
constexpr size_t WS_ROPE16 = WS_ROPE32 + al((size_t)4112 * 32 * 8);
constexpr size_t WS_DEC = WS_ROPE16 + al((size_t)4112 * 16 * 8);
constexpr size_t WS_RINV2 = WS_DEC + al((size_t)8 * 256 * 4);
constexpr size_t WS_XB = WS_RINV2 + al((size_t)T * 4);
constexpr size_t WS_LAT = WS_XB + al((size_t)MP * 1024 * 2);
constexpr size_t WS_RQ = WS_LAT + al((size_t)MP * 768 * 2);
constexpr size_t WS_RK = WS_RQ + al((size_t)MP * 512 * 2);
constexpr size_t WS_RV = WS_RK + al((size_t)MP * 512 * 2);
constexpr size_t WS_RG = WS_RV + al((size_t)MP * 1024 * 2);
constexpr size_t WS_K = WS_RG + al((size_t)T * 1024 * 2);
constexpr size_t WS_V = WS_K + al((size_t)MP * 768 * 2);
constexpr int VT_LEN = 4160;
constexpr size_t WS_RET = WS_V + al((size_t)64 * 64 * VT_LEN * 2);

constexpr size_t WS_END = WS_RET + al((size_t)T * 1024 * 2);
static_assert(WS_END <= 536870912ull, "workspace map exceeds 512 MiB");
constexpr size_t WS_Q = WS_XB, WS_MG = WS_XB, WS_AO = WS_LAT, WS_H1B = WS_RV, WS_PQ = WS_RG, WS_SELI = WS_RQ, WS_SELG = WS_RQ + (size_t)T * 128 * 4;
static_assert(WS_SELG + (size_t)T * 128 * 4 <= WS_RV, "SEL overlay");
constexpr size_t WS_VRAW = WS_RET, WS_VT = WS_V;
__host__ __device__ __forceinline__ int vt_pos(int tile, int k) { const int x = k & 15; return 64 * tile + (k & 48) + ((x >= 4 && x < 12) ? (x ^ 12) : x); }

__device__ __forceinline__ unsigned f2bf(float f) { unsigned u = __builtin_bit_cast(unsigned, f); return (u + 0x7fffu + ((u >> 16) & 1u)) >> 16; }
__device__ __forceinline__ float bf2f(unsigned h) { return __builtin_bit_cast(float, h << 16); }
__device__ __forceinline__ unsigned pk2(float lo, float hi) { return f2bf(lo) | (f2bf(hi) << 16); }
__device__ __forceinline__ float wave_sum(float v) {
#pragma unroll
    for (int o = 1; o < 64; o <<= 1) v += __shfl_xor(v, o);
    return v;
}
__device__ __forceinline__ int row_pos(int row) { return row < T ? NMETA + (row & (SEQ - 1)) : (row - T < NMETA ? row - T : 0); }
__device__ __forceinline__ float sigmoidf_(float x) { return __builtin_amdgcn_rcpf(1.f + __builtin_amdgcn_exp2f(-1.4426950408889634f * x)); }

__device__ __forceinline__ int opaque_tid() { int t = threadIdx.x; asm volatile("" : "+v"(t)); return t; }

struct Ptrs {
    const float* in[20];
    float* out;
    unsigned char* ws;
};

__global__ void __launch_bounds__(256) k_prep_rows(Ptrs p) {
    const int lane = threadIdx.x & 63, gw = (blockIdx.x * 256 + threadIdx.x) >> 6, nw = (gridDim.x * 256) >> 6;
    bf16_t* XB = (bf16_t*)(p.ws + WS_XB);
    for (int r = gw; r < MP; r += nw) {
        f32x4 v[4];
        if (r < T + NMETA) {
            const float* src = r < T ? p.in[0] + (size_t)r * D : p.in[1] + (size_t)(r - T) * D;
#pragma unroll
            for (int j = 0; j < 4; ++j) v[j] = *(const f32x4*)(src + lane * 4 + 256 * j);
        } else {
#pragma unroll
            for (int j = 0; j < 4; ++j) v[j] = (f32x4){0.f, 0.f, 0.f, 0.f};
        }
        float ss = 0.f;
#pragma unroll
        for (int j = 0; j < 4; ++j) ss += v[j].x * v[j].x + v[j].y * v[j].y + v[j].z * v[j].z + v[j].w * v[j].w;
        ss = wave_sum(ss);
        const float rinv = rsqrtf(ss * (1.f / D) + EPS);
#pragma unroll
        for (int j = 0; j < 4; ++j) {
            uint2 o; o.x = pk2(v[j].x * rinv, v[j].y * rinv); o.y = pk2(v[j].z * rinv, v[j].w * rinv);
            *(uint2*)(XB + (size_t)r * D + lane * 4 + 256 * j) = o;
        }
    }
}

__device__ __forceinline__ int win_src(int n) {
    if (n < 672) return n;
    if (n < 768) return -1;
    if (n < C_RV) { const int base = n < C_RK ? 672 : 1184, q = (n - (n < C_RK ? C_RQ : C_RK)), hh = q >> 6, pp = q & 63; return base + hh * 64 + (pp >> 1) + 32 * (pp & 1); }
    if (n < C_RG) return 1696 + (n - C_RV);
    if (n < C_SA) return 2720 + (n - C_RG);
    if (n < C_SR) return 3744 + (n - C_SA);
    return 4768 + (n - C_SR);
}
template <int MODE>
__global__ void __launch_bounds__(256) k_prep_w(const float* __restrict__ W, const float* __restrict__ gain, bf16_t* __restrict__ Wt, int K, int Nsrc, int Ndst) {
    __shared__ float tile[64][65];
    const int n0 = blockIdx.x * 64, k0 = blockIdx.y * 64, tx = threadIdx.x & 63, ty = threadIdx.x >> 6;
    const int n = n0 + tx; const int src = MODE == 1 ? win_src(n) : n;
    for (int kk = ty; kk < 64; kk += 4) {
        float v = 0.f;
        if (src >= 0 && n < Ndst) { v = W[(size_t)(k0 + kk) * Nsrc + src]; if (gain) v *= gain[k0 + kk]; }
        tile[kk][tx] = v;
    }
    __syncthreads();
    for (int nn = ty; nn < 64; nn += 4) if (n0 + nn < Ndst) Wt[(size_t)(n0 + nn) * K + k0 + tx] = (bf16_t)f2bf(tile[tx][nn]);
}
__global__ void k_prep_rope(Ptrs p) {
    const int i = blockIdx.x * blockDim.x + threadIdx.x;
    float2* R32 = (float2*)(p.ws + WS_ROPE32); float2* R16 = (float2*)(p.ws + WS_ROPE16);
    if (i < 4112 * 32) { const int pos = i >> 5, f = i & 31; const float inv = (float)pow(10000.0, -(double)f / 32.0); const float ang = (float)pos * inv; R32[i] = make_float2((float)cos((double)ang), (float)sin((double)ang)); }
    if (i < 4112 * 16) { const int pos = i >> 4, f = i & 15; const float inv = (float)pow(10000.0, -(double)f / 16.0); const float ang = (float)pos * inv; R16[i] = make_float2((float)cos((double)ang), (float)sin((double)ang)); }
    if (i < 8 * 256) ((float*)(p.ws + WS_DEC))[i] = (float)pow(1.0 - exp2(-5.0 - (double)(i >> 8)), (double)((i & 255) + 1));
}

typedef float f32x2_t __attribute__((ext_vector_type(2)));
typedef __bf16 bf16x2v_t __attribute__((ext_vector_type(2)));
__device__ __forceinline__ unsigned cvtpk(float lo, float hi) { const f32x2_t v = {lo, hi}; return __builtin_bit_cast(unsigned, __builtin_convertvector(v, bf16x2v_t)); }
__device__ __forceinline__ void st8(bf16_t* dst, const float (&v)[8]) {
    u32x4 w; w.x = cvtpk(v[0], v[1]); w.y = cvtpk(v[2], v[3]); w.z = cvtpk(v[4], v[5]); w.w = cvtpk(v[6], v[7]);
#ifdef NT_STORE
    __builtin_nontemporal_store(w, (u32x4*)dst);
#else
    *(u32x4*)dst = w;
#endif
}
struct EpiIn {
    bf16_t *LAT, *RQ, *RK, *RV, *RG, *SA, *SR; const float2* R32; const float* DEC;
    __device__ __forceinline__ void apply(int row, int col0, const float (&v)[8]) const {
        if (col0 < C_RQ) { st8(LAT + (size_t)row * 768 + col0, v); return; }
        if (col0 < C_RV) {
            const bool isq = col0 < C_RK; const int c = col0 - (isq ? C_RQ : C_RK); const int i0 = (c & 63) >> 1;
            const int hh = c >> 6, cc = row < T ? (row & 127) : (row - T);
            const float dq = DEC[hh * 256 + cc];
            const float2* rp = R32 + row_pos(row) * 32 + i0; const float sc = isq ? dq : 0.125f * __builtin_amdgcn_rcpf(dq);
            float o[8];
#pragma unroll
            for (int j = 0; j < 4; ++j) { const float2 cs = rp[j]; const float x1 = v[2 * j], x2 = v[2 * j + 1]; o[2 * j] = (x1 * cs.x - x2 * cs.y) * sc; o[2 * j + 1] = (x1 * cs.y + x2 * cs.x) * sc; }
            st8((isq ? RQ : RK) + (size_t)row * 512 + c, o); return;
        }
        if (col0 < C_RG) { st8(RV + (size_t)row * 1024 + (col0 - C_RV), v); return; }
        if (row >= T) return;
        float o[8];
        if (col0 < C_SA) {
#pragma unroll
            for (int j = 0; j < 8; ++j) o[j] = v[j] * sigmoidf_(v[j]);
            st8(RG + (size_t)row * 1024 + (col0 - C_RG), o); return;
        }
#pragma unroll
        for (int j = 0; j < 8; ++j) o[j] = sigmoidf_(v[j]);
        if (col0 < C_SR) st8(SA + (size_t)row * 1024 + (col0 - C_SA), o); else st8(SR + (size_t)row * 1024 + (col0 - C_SR), o);
    }
};
struct EpiNull { float* sink; __device__ __forceinline__ void apply(int row, int col0, const float (&v)[8]) const { if (v[0] == 1.2345e30f) sink[row] = v[1] + v[2] + v[3] + v[4] + v[5] + v[6] + v[7]; } };
struct EpiQraw { bf16_t* Q; __device__ __forceinline__ void apply(int row, int col0, const float (&v)[8]) const { st8(Q + (size_t)row * 768 + col0, v); } };
struct EpiKVraw {
    bf16_t *K, *V;
    __device__ __forceinline__ void apply(int row, int col0, const float (&v)[8]) const {
        const int h = col0 >> 7, j = col0 & 127;
        if (j < 64) st8(K + (size_t)row * 768 + h * 96 + j, v); else st8(V + (size_t)row * 512 + h * 64 + (j - 64), v);
    }
};
__device__ __forceinline__ void ld8(const bf16_t* src, float (&o)[8]) {
    const u32x4 w = *(const u32x4*)src;
    o[0] = bf2f(w.x & 0xffff); o[1] = bf2f(w.x >> 16); o[2] = bf2f(w.y & 0xffff); o[3] = bf2f(w.y >> 16);
    o[4] = bf2f(w.z & 0xffff); o[5] = bf2f(w.z >> 16); o[6] = bf2f(w.w & 0xffff); o[7] = bf2f(w.w >> 16);
}
struct EpiMerge1 { bf16_t* MG; const bf16_t* SA;
    __device__ __forceinline__ void apply(int row, int col0, const float (&v)[8]) const {
        float g[8], o[8]; ld8(SA + (size_t)row * 1024 + col0, g);
#pragma unroll
        for (int j = 0; j < 8; ++j) o[j] = g[j] * v[j];
        st8(MG + (size_t)row * 1024 + col0, o); } };
struct EpiMerge2 { bf16_t* MG; const bf16_t* SR;
    __device__ __forceinline__ void apply(int row, int col0, const float (&v)[8]) const {
        float g[8], m[8], o[8]; ld8(SR + (size_t)row * 1024 + col0, g); ld8(MG + (size_t)row * 1024 + col0, m);
#pragma unroll
        for (int j = 0; j < 8; ++j) o[j] = m[j] + g[j] * v[j];
        st8(MG + (size_t)row * 1024 + col0, o); } };
struct EpiMix { const float* x; float* out; bf16_t* H1B; float* SS2;
    __device__ __forceinline__ void apply(int row, int col0, const float (&v)[8]) const {
        const f32x4 a = *(const f32x4*)(x + (size_t)row * D + col0), b = *(const f32x4*)(x + (size_t)row * D + col0 + 4);
        float o[8] = {a.x + v[0], a.y + v[1], a.z + v[2], a.w + v[3], b.x + v[4], b.y + v[5], b.z + v[6], b.w + v[7]};
        *(f32x4*)(out + (size_t)row * D + col0) = (f32x4){o[0], o[1], o[2], o[3]}; *(f32x4*)(out + (size_t)row * D + col0 + 4) = (f32x4){o[4], o[5], o[6], o[7]};
        st8(H1B + (size_t)row * D + col0, o);
        float ss = 0.f;
#pragma unroll
        for (int j = 0; j < 8; ++j) ss += o[j] * o[j];
        atomicAdd(SS2 + row, ss); } };
struct EpiPQ { bf16_t* PQ; const float* SS2;
    __device__ __forceinline__ void apply(int row, int col0, const float (&v)[8]) const {
        const float r = rsqrtf(SS2[row] * (1.f / D) + EPS); float o[8];
#pragma unroll
        for (int j = 0; j < 8; ++j) o[j] = v[j] * r;
        st8(PQ + (size_t)row * D + col0, o); } };

template <class Epi>
__global__ void __launch_bounds__(256) gemm_ref(const bf16_t* __restrict__ A, int lda, const bf16_t* __restrict__ Bt, int ldb, int K, Epi E) {
    __shared__ float As[32][64 + 4];
    __shared__ float Bs[32][128 + 4];
    const int tid = threadIdx.x, tx = tid & 15, ty = tid >> 4;
    const int m0 = blockIdx.y * 64, n0 = blockIdx.x * 128;
    float acc[4][8];
#pragma unroll
    for (int i = 0; i < 4; ++i)
#pragma unroll
        for (int j = 0; j < 8; ++j) acc[i][j] = 0.f;
    for (int k0 = 0; k0 < K; k0 += 32) {
        { const int m = tid & 63, kc = tid >> 6; float t[8]; ld8(A + (size_t)(m0 + m) * lda + k0 + kc * 8, t);
#pragma unroll
          for (int j = 0; j < 8; ++j) As[kc * 8 + j][m] = t[j]; }
#pragma unroll
        for (int i = 0; i < 2; ++i) { const int n = tid & 127, kc = (tid >> 7) + 2 * i; float t[8]; ld8(Bt + (size_t)(n0 + n) * ldb + k0 + kc * 8, t);
#pragma unroll
          for (int j = 0; j < 8; ++j) Bs[kc * 8 + j][n] = t[j]; }
        __syncthreads();
#pragma unroll 8
        for (int kk = 0; kk < 32; ++kk) {
            const f32x4 a = *(const f32x4*)&As[kk][ty * 4]; const f32x4 b0 = *(const f32x4*)&Bs[kk][tx * 8], b1 = *(const f32x4*)&Bs[kk][tx * 8 + 4];
            const float av[4] = {a.x, a.y, a.z, a.w}, bv[8] = {b0.x, b0.y, b0.z, b0.w, b1.x, b1.y, b1.z, b1.w};
#pragma unroll
            for (int i = 0; i < 4; ++i)
#pragma unroll
                for (int j = 0; j < 8; ++j) acc[i][j] += av[i] * bv[j];
        }
        __syncthreads();
    }
#pragma unroll
    for (int i = 0; i < 4; ++i) E.apply(m0 + ty * 4 + i, n0 + tx * 8, acc[i]);
}

namespace pg8 {
#define PG8_LAS __attribute__((address_space(3)))
typedef short bf16x8 __attribute__((ext_vector_type(8)));
constexpr int BM = 256, BK = 64, HALF = 128, HTB = HALF * BK * 2, STAGE_BYTES = 8 * HTB, NXCD = 8, WGM = 8;
__host__ __device__ __forceinline__ int lds_byte(int r, int c) { const int st = (r >> 4) * 2 + (c >> 5), rr = r & 15, cc = c & 31, ob = rr * 64 + cc * 2; return st * 1024 + (ob ^ (((ob >> 9) & 1) << 5)); }
__host__ __device__ __forceinline__ void stage_rc(int b, int& R, int& C) { const int st = b / 1024, sb = b % 1024, swz = sb ^ (((sb >> 9) & 1) << 5); R = (st >> 1) * 16 + swz / 64; C = (st & 1) * 32 + (swz % 64) / 2; }
__host__ __device__ __forceinline__ int perm32(int rho) { const int n = rho >> 4, i = rho & 15; return 8 * (i >> 2) + 4 * n + (i & 3); }
struct Unit { int pm, pn; };
struct Gemm { const bf16_t* A; const bf16_t* Bt; int lda, ldb, M, N, K, pad; };
struct StaticOrder {
    int nM, nN, nwg, G, c;
    __host__ __device__ void init(int M, int N, int G_, int c_) { nM = M / BM; nN = N / BM; nwg = nM * nN; G = G_; c = c_; }
    __host__ __device__ bool next(int i, Unit& u) const {
        const long L = (long)i * G + c; if (L >= nwg) return false;
        int wgid = (int)L; { const int q = nwg / NXCD, r = nwg % NXCD, xcd = wgid % NXCD, off = wgid / NXCD; wgid = (xcd < r ? xcd * (q + 1) : r * (q + 1) + (xcd - r) * q) + off; }
        const int nig = WGM * nN, gid = wgid / nig, fm = gid * WGM, gsz = (nM - fm) < WGM ? (nM - fm) : WGM;
        u.pm = fm + ((wgid % nig) % gsz); u.pn = (wgid % nig) / gsz; return true;
    }
};
template <class Epi>
__device__ __forceinline__ void run_epi(const Epi& E, const f32x4 (&acc)[2][2][4][2], const Unit& u, int wr, int wc, int fr, int fq) {
    const int row0 = u.pm * BM + wr * 64 + fr, col0 = u.pn * BM + wc * 32 + 8 * fq;
#pragma unroll
    for (int ai = 0; ai < 2; ++ai)
#pragma unroll
        for (int m = 0; m < 4; ++m)
#pragma unroll
            for (int bj = 0; bj < 2; ++bj) {
                const f32x4 a = acc[ai][bj][m][0], b = acc[ai][bj][m][1];
                const float v[8] = {a[0], a[1], a[2], a[3], b[0], b[1], b[2], b[3]};
                E.apply(row0 + ai * HALF + m * 16, col0 + bj * HALF, v);
            }
}
template <class Epi>
__device__ __forceinline__ void gemm_phase(PG8_LAS unsigned char* lds, const Gemm g, const StaticOrder& S, const Epi& E) {
    const int tid = opaque_tid(), wid = __builtin_amdgcn_readfirstlane(tid >> 6), lane = tid & 63, wr = wid >> 2, wc = wid & 3, fr = lane & 15, fq = lane >> 4;
    const int K = g.K, nt = K / BK;
    unsigned voffA[2], voffB[2];
#pragma unroll
    for (int i = 0; i < 2; ++i) { int R, C; stage_rc(tid * 16 + i * 8192, R, C); const int Rb = (R & ~31) + perm32(R & 31);
        voffA[i] = (unsigned)(R * g.lda + C) * 2u; voffB[i] = (unsigned)(Rb * g.ldb + C) * 2u; }
    const size_t kstep = (size_t)(BK * 2);
    const size_t hstepA = (size_t)HALF * g.lda * 2, hstepB = (size_t)HALF * g.ldb * 2;
    const size_t tstepA = 2 * hstepA, tstepB = 2 * hstepB;
    const unsigned ldsw = (unsigned)wid * 1024u;
    const int aoff = lds_byte(wr * 64 + fr, fq * 8), boff = lds_byte(wc * 32 + fr, fq * 8);
#define PG8_SA(b, h) (((b) * 2 + (h)) * HTB)
#define PG8_SB(b, h) ((4 + (b) * 2 + (h)) * HTB)
#define PG8_STAGE(bufoff, gbase, voff) do { _Pragma("unroll") for (int _i = 0; _i < 2; ++_i) \
        __builtin_amdgcn_global_load_lds((const unsigned*)((const char*)(gbase) + (voff)[_i]), (PG8_LAS unsigned*)(lds + (bufoff) + ldsw + _i * 8192), 16, 0, 0); } while (0)
#define PG8_LDA(dst, b, h) do { _Pragma("unroll") for (int m = 0; m < 4; ++m) _Pragma("unroll") for (int k = 0; k < 2; ++k) dst[m][k] = *(const PG8_LAS bf16x8*)(lds + PG8_SA(b, h) + aoff + m * 2048 + k * 1024); } while (0)
#define PG8_LDB(dst, b, h) do { _Pragma("unroll") for (int n = 0; n < 2; ++n) _Pragma("unroll") for (int k = 0; k < 2; ++k) dst[n][k] = *(const PG8_LAS bf16x8*)(lds + PG8_SB(b, h) + boff + n * 2048 + k * 1024); } while (0)
#define PG8_MMA(ai, bj, At, Bt) do { __builtin_amdgcn_s_setprio(1); _Pragma("unroll") for (int m = 0; m < 4; ++m) _Pragma("unroll") for (int n = 0; n < 2; ++n) _Pragma("unroll") for (int k = 0; k < 2; ++k) \
        acc[ai][bj][m][n] = __builtin_amdgcn_mfma_f32_16x16x32_bf16(Bt[n][k], At[m][k], acc[ai][bj][m][n], 0, 0, 0); __builtin_amdgcn_s_setprio(0); } while (0)
#define PG8_WAIT_V(n) asm volatile("s_waitcnt vmcnt(" #n ")" ::: "memory")
#define PG8_WAIT_L(n) asm volatile("s_waitcnt lgkmcnt(" #n ")" ::: "memory")
#define PG8_BAR __builtin_amdgcn_s_barrier()
#define PG8_SCHED __builtin_amdgcn_sched_barrier(0)
    Unit cur, nxt; int ui = 0;
    if (!S.next(0, cur)) return;
    f32x4 acc[2][2][4][2];
#pragma unroll
    for (int a = 0; a < 2; ++a)
#pragma unroll
        for (int b = 0; b < 2; ++b)
#pragma unroll
            for (int m = 0; m < 4; ++m)
#pragma unroll
                for (int n = 0; n < 2; ++n) acc[a][b][m][n] = (f32x4){0.f, 0.f, 0.f, 0.f};
    bf16x8 At[4][2], B0[2][2], B1[2][2];
    const char* cA = (const char*)g.A + (size_t)cur.pm * tstepA; const char* cB = (const char*)g.Bt + (size_t)cur.pn * tstepB;
    PG8_STAGE(PG8_SB(0, 0), cB, voffB); PG8_STAGE(PG8_SB(0, 1), cB + hstepB, voffB); PG8_STAGE(PG8_SA(0, 0), cA, voffA); PG8_STAGE(PG8_SA(0, 1), cA + hstepA, voffA);
    if (wr == 1) PG8_BAR;
    PG8_WAIT_V(2); PG8_BAR;
    PG8_STAGE(PG8_SB(1, 0), cB + kstep, voffB); PG8_STAGE(PG8_SA(1, 0), cA + kstep, voffA); PG8_STAGE(PG8_SB(1, 1), cB + hstepB + kstep, voffB);
    PG8_WAIT_V(6); PG8_BAR;
    for (;;) {
        const bool has_next = S.next(ui + 1, nxt);
        const char* nA = has_next ? (const char*)g.A + (size_t)nxt.pm * tstepA : cA; const char* nB = has_next ? (const char*)g.Bt + (size_t)nxt.pn * tstepB : cB;
        for (int t = 0; t < nt; t += 2) {
            const bool last = (t == nt - 2);
            const char* a1 = cA + (size_t)(t + 1) * kstep;
            const char* a2 = last ? nA : cA + (size_t)(t + 2) * kstep; const char* b2 = last ? nB : cB + (size_t)(t + 2) * kstep;
            const char* a3 = a2 + kstep; const char* b3 = b2 + kstep;
            PG8_LDB(B0, 0, 0); PG8_LDB(B1, 0, 1); PG8_SCHED; PG8_LDA(At, 0, 0); PG8_STAGE(PG8_SA(1, 1), a1 + hstepA, voffA);
            PG8_WAIT_V(8); PG8_WAIT_L(0); PG8_BAR; PG8_MMA(0, 0, At, B0); PG8_MMA(0, 1, At, B1); PG8_BAR; PG8_SCHED;
            PG8_LDA(At, 0, 1); PG8_STAGE(PG8_SB(0, 0), b2, voffB); PG8_STAGE(PG8_SB(0, 1), b2 + hstepB, voffB); PG8_STAGE(PG8_SA(0, 0), a2, voffA);
            PG8_WAIT_V(8); PG8_WAIT_L(0); PG8_BAR; PG8_MMA(1, 0, At, B0); PG8_MMA(1, 1, At, B1); PG8_BAR; PG8_SCHED;
            PG8_LDB(B0, 1, 0); PG8_LDB(B1, 1, 1); PG8_SCHED; PG8_LDA(At, 1, 0); PG8_STAGE(PG8_SA(0, 1), a2 + hstepA, voffA);
            PG8_WAIT_V(8); PG8_WAIT_L(0); PG8_BAR; PG8_MMA(0, 0, At, B0); PG8_MMA(0, 1, At, B1); PG8_BAR; PG8_SCHED;
            PG8_LDA(At, 1, 1); PG8_STAGE(PG8_SB(1, 0), b3, voffB); PG8_STAGE(PG8_SB(1, 1), b3 + hstepB, voffB); PG8_STAGE(PG8_SA(1, 0), a3, voffA);
            PG8_WAIT_V(8); PG8_WAIT_L(0); PG8_BAR; PG8_MMA(1, 0, At, B0); PG8_MMA(1, 1, At, B1); PG8_BAR; PG8_SCHED;
        }
        if (wr == 0) PG8_BAR;
        run_epi(E, acc, cur, wr, wc, fr, fq);
        if (!has_next) break;
#pragma unroll
        for (int a = 0; a < 2; ++a)
#pragma unroll
            for (int b = 0; b < 2; ++b)
#pragma unroll
                for (int m = 0; m < 4; ++m)
#pragma unroll
                    for (int n = 0; n < 2; ++n) acc[a][b][m][n] = (f32x4){0.f, 0.f, 0.f, 0.f};
        cur = nxt; cA = nA; cB = nB; ++ui;
        if (wr == 1) PG8_BAR;
    }
    PG8_WAIT_V(0);
    PG8_BAR;
#undef PG8_SA
#undef PG8_SB
#undef PG8_STAGE
#undef PG8_LDA
#undef PG8_LDB
#undef PG8_MMA
#undef PG8_WAIT_V
#undef PG8_WAIT_L
#undef PG8_BAR
#undef PG8_SCHED
}
}

constexpr int LDS_BYTES = 147456;
template <class Epi>
__global__ void __launch_bounds__(512, 2) k_gemm(pg8::Gemm g, Epi E) {
    extern __shared__ __attribute__((aligned(16))) unsigned char lds[];
    pg8::StaticOrder S; S.init(g.M, g.N, gridDim.x, blockIdx.x);
    pg8::gemm_phase<Epi>((PG8_LAS unsigned char*)lds, g, S, E);
}

constexpr int FIN_VP = 136;
constexpr int FIN_LDS = 512 * FIN_VP;
__device__ __forceinline__ void up8(const u32x4 w, float (&o)[8]) {
    o[0] = bf2f(w.x & 0xffff); o[1] = bf2f(w.x >> 16); o[2] = bf2f(w.y & 0xffff); o[3] = bf2f(w.y >> 16); o[4] = bf2f(w.z & 0xffff); o[5] = bf2f(w.z >> 16); o[6] = bf2f(w.w & 0xffff); o[7] = bf2f(w.w >> 16);
}
struct FinRow { u32x4 cq, ckv, q0, q1, k0, k1, v0, v1; f32x4 cs[4]; };
__device__ __forceinline__ void finalize_phase(const Ptrs& p, LAS unsigned char* lds) {
    const int tid = opaque_tid(), lane = tid & 63, wid = __builtin_amdgcn_readfirstlane(tid >> 6), G = gridDim.x, bx = blockIdx.x;
    const bf16_t* LAT = (const bf16_t*)(p.ws + WS_LAT);
    bf16_t* Q = (bf16_t*)(p.ws + WS_Q); bf16_t* K = (bf16_t*)(p.ws + WS_K); const bf16_t* V = (const bf16_t*)(p.ws + WS_VRAW); bf16_t* VT = (bf16_t*)(p.ws + WS_VT);
    const float2* R16 = (const float2*)(p.ws + WS_ROPE16);
    const int hq = lane >> 4, c = lane & 15; const bool act = c < 12, isr = c >= 8 && c < 12;
    float gq8[8], gk8[8];
#pragma unroll
    for (int e = 0; e < 8; ++e) { gq8[e] = act ? p.in[8][8 * c + e] : 0.f; gk8[e] = act ? p.in[9][8 * c + e] : 0.f; }
    auto load_row = [&](int r, FinRow& d) {
        const bf16_t* lr = LAT + (size_t)r * 768; const u32x4 z = {0u, 0u, 0u, 0u};
        d.cq = lane < 48 ? *(const u32x4*)(lr + 8 * lane) : z; d.ckv = lane < 32 ? *(const u32x4*)(lr + 384 + 8 * lane) : z;
        const bool hasq = r < T;
        d.q0 = (act && hasq) ? *(const u32x4*)(Q + (size_t)r * 768 + hq * 96 + 8 * c) : z; d.q1 = (act && hasq) ? *(const u32x4*)(Q + (size_t)r * 768 + (4 + hq) * 96 + 8 * c) : z;
        d.k0 = c < 8 ? *(const u32x4*)(K + (size_t)r * 768 + hq * 96 + 8 * c) : (isr ? *(const u32x4*)(lr + 640 + 8 * (c - 8)) : z);
        d.k1 = c < 8 ? *(const u32x4*)(K + (size_t)r * 768 + (4 + hq) * 96 + 8 * c) : d.k0;
        d.v0 = c < 8 ? *(const u32x4*)(V + (size_t)r * 512 + hq * 64 + 8 * c) : z; d.v1 = c < 8 ? *(const u32x4*)(V + (size_t)r * 512 + (4 + hq) * 64 + 8 * c) : z;
        if (isr) { const float2* rp = R16 + row_pos(r) * 16 + 8 * (c & 1);
#pragma unroll
            for (int e = 0; e < 4; ++e) d.cs[e] = *(const f32x4*)(rp + 2 * e); }
        else {
#pragma unroll
            for (int e = 0; e < 4; ++e) d.cs[e] = (f32x4){1.f, 0.f, 1.f, 0.f}; }
    };
    for (int grp = bx; grp < 1026; grp += G) {
        const int r0 = grp < 1024 ? grp * 32 : T + (grp - 1024) * 32;
        __syncthreads();
        FinRow cur, nxt;
        load_row(r0 + 4 * wid, nxt);
#pragma unroll 1
        for (int i = 0; i < 4; ++i) {
            const int kl = 4 * wid + i, r = r0 + kl;
            cur = nxt;
            if (i + 1 < 4) load_row(r + 1, nxt);
            float sa = 0.f, sb = 0.f;
            { float t[8]; up8(cur.cq, t);
#pragma unroll
              for (int e = 0; e < 8; ++e) sa += t[e] * t[e]; }
            { float t[8]; up8(cur.ckv, t);
#pragma unroll
              for (int e = 0; e < 8; ++e) sb += t[e] * t[e]; }
            sa = wave_sum(sa); sb = wave_sum(sb);
            const float alpha = rsqrtf(sa * (1.f / 384.f) + EPS), beta = rsqrtf(sb * (1.f / 256.f) + EPS);
            float cs_x[8], cs_y[8];
#pragma unroll
            for (int e = 0; e < 4; ++e) { cs_x[2 * e] = cur.cs[e].x; cs_y[2 * e] = cur.cs[e].y; cs_x[2 * e + 1] = cur.cs[e].z; cs_y[2 * e + 1] = cur.cs[e].w; }
            const int kpos = (grp < 1024 ? vt_pos(0, (r0 & 32) + kl) : vt_pos(0, r - T)) & 63;
#pragma unroll
            for (int pass = 0; pass < 2; ++pass) {
                const int h = 4 * pass + hq;
                if (r < T) {
                    float x[8]; up8(pass ? cur.q1 : cur.q0, x);
                    float ss = 0.f;
#pragma unroll
                    for (int e = 0; e < 8; ++e) { x[e] *= alpha; ss += x[e] * x[e]; }
                    ss += __shfl_xor(ss, 1); ss += __shfl_xor(ss, 2); ss += __shfl_xor(ss, 4); ss += __shfl_xor(ss, 8);
                    const float rq = rsqrtf(ss * (1.f / 96.f) + EPS) * QSCALE;
                    float o[8];
#pragma unroll
                    for (int e = 0; e < 8; ++e) { const float y = x[e] * gq8[e]; const float pr = __shfl_xor(y, 2);
                        o[e] = (c < 10 ? (y * cs_x[e] - pr * cs_y[e]) : (pr * cs_y[e] + y * cs_x[e])) * rq; }
                    if (act) st8(Q + (size_t)r * 768 + h * 96 + 8 * c, o);
                }
                {
                    float x[8]; up8(pass ? cur.k1 : cur.k0, x);
                    float ss = 0.f;
#pragma unroll
                    for (int e = 0; e < 8; ++e) { if (c < 8) x[e] *= beta; ss += x[e] * x[e]; }
                    ss += __shfl_xor(ss, 1); ss += __shfl_xor(ss, 2); ss += __shfl_xor(ss, 4); ss += __shfl_xor(ss, 8);
                    const float rk = rsqrtf(ss * (1.f / 96.f) + EPS);
                    float o[8];
#pragma unroll
                    for (int e = 0; e < 8; ++e) { const float y = x[e] * gk8[e]; const float pr = __shfl_xor(y, 2);
                        o[e] = (c < 10 ? (y * cs_x[e] - pr * cs_y[e]) : (pr * cs_y[e] + y * cs_x[e])) * rk; }
                    if (act) st8(K + (size_t)r * 768 + h * 96 + 8 * c, o);
                }
                if (c < 8) {
                    float x[8]; up8(pass ? cur.v1 : cur.v0, x);
#pragma unroll
                    for (int e = 0; e < 8; ++e) *(LAS bf16_t*)(lds + (e * 64 + 8 * h + c) * FIN_VP + kpos * 2) = (bf16_t)f2bf(x[e] * beta); }
            }
        }
        __syncthreads();
        const int nb = grp < 1024 ? 1 : BATCH, half = grp < 1024 ? ((r0 >> 5) & 1) : (grp - 1024);
        const int tile = grp < 1024 ? 1 + ((r0 & (SEQ - 1)) >> 6) : 0;
#pragma unroll 1
        for (int it = 0; it < 4; ++it) {
            const int idx = it * 512 + tid, vr = idx >> 2, ch = idx & 3, h = vr >> 6, d = vr & 63, rho = (d & 7) * 64 + 8 * h + (d >> 3);
            const u32x2 lo = *(const LAS u32x2*)(lds + rho * FIN_VP + (4 * half + ch) * 16), hi2 = *(const LAS u32x2*)(lds + rho * FIN_VP + (4 * half + ch) * 16 + 8);
            const u32x4 w = {lo.x, lo.y, hi2.x, hi2.y};
            for (int bb = 0; bb < nb; ++bb) { const int b = grp < 1024 ? (r0 >> 12) : bb;
                *(u32x4*)(VT + ((size_t)(b * 8 + h) * 64 + d) * VT_LEN + 64 * tile + (4 * half + ch) * 8) = w; }
        }
    }
}
__global__ void __launch_bounds__(512, 2) k_finalize(Ptrs p) { extern __shared__ __attribute__((aligned(16))) unsigned char lds_f[]; finalize_phase(p, (LAS unsigned char*)lds_f); }

__global__ void __launch_bounds__(64) k_attn_naive(Ptrs p) {
    const bf16_t* Q = (const bf16_t*)(p.ws + WS_Q); const bf16_t* K = (const bf16_t*)(p.ws + WS_K); const bf16_t* VT = (const bf16_t*)(p.ws + WS_VT);
    bf16_t* AO = (bf16_t*)(p.ws + WS_AO);
    const int s = blockIdx.x * 64 + threadIdx.x, h = blockIdx.y, b = blockIdx.z;
    const int row = b * SEQ + s;
    float q[96], o[64];
#pragma unroll
    for (int d = 0; d < 96; d += 8) { float t[8]; ld8(Q + (size_t)row * 768 + h * 96 + d, t);
#pragma unroll
        for (int j = 0; j < 8; ++j) q[d + j] = t[j]; }
#pragma unroll
    for (int d = 0; d < 64; ++d) o[d] = 0.f;
    float m = -INFINITY, l = 0.f;
    const int smax = blockIdx.x * 64 + 63;
    for (int j = 0; j < NMETA + smax + 1; ++j) {
        const int krow = j < NMETA ? T + j : b * SEQ + (j - NMETA);
        const bf16_t* kp = K + (size_t)krow * 768 + h * 96;
        const bf16_t* vp = VT + ((size_t)(b * 8 + h) * 64) * VT_LEN + (j < NMETA ? vt_pos(0, j) : vt_pos(1 + ((j - NMETA) >> 6), (j - NMETA) & 63));
        float sc = 0.f;
#pragma unroll
        for (int d = 0; d < 96; d += 8) { float t[8]; ld8(kp + d, t);
#pragma unroll
            for (int jj = 0; jj < 8; ++jj) sc += q[d + jj] * t[jj]; }
        const bool valid = (j < NMETA) || (j - NMETA <= s);
        if (valid) {
            const float mn = fmaxf(m, sc); const float a = exp2f(m - mn), pp = exp2f(sc - mn);
            l = l * a + pp; m = mn;
#pragma unroll
            for (int d = 0; d < 64; ++d) o[d] = o[d] * a + pp * bf2f(vp[(size_t)d * VT_LEN]);
        }
    }
    const float il = 1.f / l;
#pragma unroll
    for (int d = 0; d < 64; d += 8) { float t[8];
#pragma unroll
        for (int jj = 0; jj < 8; ++jj) t[jj] = o[d + jj] * il;
        st8(AO + (size_t)row * 512 + h * 64 + d, t); }
}

#ifndef LAS
#define LAS __attribute__((address_space(3)))
#endif
typedef float f32x16_t __attribute__((ext_vector_type(16)));
typedef short bf16x8_t __attribute__((ext_vector_type(8)));
constexpr int ATT_KP = 208, ATT_VP = 144, ATT_KB = 64 * ATT_KP, ATT_VB = 64 * ATT_VP, ATT_BUF = ATT_KB + ATT_VB, ATT_LDS = 2 * ATT_BUF;
__device__ __forceinline__ void attn_unit(const Ptrs& p, LAS unsigned char* lds, int b, int h, int qb) {
    const bf16_t* Q = (const bf16_t*)(p.ws + WS_Q); const bf16_t* K = (const bf16_t*)(p.ws + WS_K); const bf16_t* VT = (const bf16_t*)(p.ws + WS_VT);
    bf16_t* AO = (bf16_t*)(p.ws + WS_AO);
    const int tid = opaque_tid(), lane = tid & 63, wid = __builtin_amdgcn_readfirstlane(tid >> 6), q = lane & 31, hi = lane >> 5;
    const int s0w = 256 * qb + 32 * wid, sq = s0w + q; const size_t rowq = (size_t)b * SEQ + sq;
    bf16x8_t qf[6];
#pragma unroll
    for (int st = 0; st < 6; ++st) qf[st] = *(const bf16x8_t*)(Q + rowq * 768 + h * 96 + 16 * st + 8 * hi);
    const int NT = 4 * qb + 5;
    const int k0key = tid / 12, k0ch = tid % 12, k1key = (tid + 512) / 12, k1ch = (tid + 512) % 12; const bool k1v = tid < 256;
    const int vd = tid >> 3, vch = tid & 7;
    const bf16_t* vtb = VT + ((size_t)(b * 8 + h) * 64 + vd) * VT_LEN + vch * 8;
    const bf16_t* kb0 = K + (size_t)h * 96 + k0ch * 8; const bf16_t* kb1 = K + (size_t)h * 96 + k1ch * 8;
    u32x4 kr0, kr1 = {}, vr;
#define ATT_KROW(t, key) ((t) == 0 ? (size_t)(T + (key)) : (size_t)b * SEQ + 64 * ((t) - 1) + (key))
#define ATT_LOAD(t) do { kr0 = *(const u32x4*)(kb0 + ATT_KROW(t, k0key) * 768); if (k1v) kr1 = *(const u32x4*)(kb1 + ATT_KROW(t, k1key) * 768); vr = *(const u32x4*)(vtb + 64 * (t)); } while (0)
#define ATT_STORE(buf) do { LAS unsigned char* bb = lds + (buf) * ATT_BUF; *(LAS u32x4*)(bb + k0key * ATT_KP + k0ch * 16) = kr0; if (k1v) *(LAS u32x4*)(bb + k1key * ATT_KP + k1ch * 16) = kr1; \
        *(LAS u32x4*)(bb + ATT_KB + vd * ATT_VP + vch * 16) = vr; } while (0)
    LDS_BARRIER();
    ATT_LOAD(0); ATT_STORE(0); LDS_BARRIER();
    float m = -1e30f, l = 0.f; f32x16_t o0 = {}, o1 = {};
    for (int t = 0; t < NT; ++t) {
        const int cur = t & 1;
        if (t + 1 < NT) ATT_LOAD(t + 1);
        const int ks = 64 * (t - 1);
        if (t == 0 || ks <= s0w + 31) {
            const LAS unsigned char* base = lds + cur * ATT_BUF;
            bf16x8_t kf0[6], kf1[6];
#pragma unroll
            for (int st = 0; st < 6; ++st) { kf0[st] = *(const LAS bf16x8_t*)(base + q * ATT_KP + (16 * st + 8 * hi) * 2); kf1[st] = *(const LAS bf16x8_t*)(base + (32 + q) * ATT_KP + (16 * st + 8 * hi) * 2); }
            asm volatile("" : "+v"(kf0[0]), "+v"(kf0[1]), "+v"(kf0[2]), "+v"(kf0[3]), "+v"(kf0[4]), "+v"(kf0[5]), "+v"(kf1[0]), "+v"(kf1[1]), "+v"(kf1[2]), "+v"(kf1[3]), "+v"(kf1[4]), "+v"(kf1[5]));
            f32x16_t p0 = {}, p1 = {};
#pragma unroll
            for (int st = 0; st < 6; ++st) { p0 = __builtin_amdgcn_mfma_f32_32x32x16_bf16(kf0[st], qf[st], p0, 0, 0, 0); p1 = __builtin_amdgcn_mfma_f32_32x32x16_bf16(kf1[st], qf[st], p1, 0, 0, 0); }
            bf16x8_t vf0[4], vf1[4];
#pragma unroll
            for (int kk = 0; kk < 4; ++kk) { vf0[kk] = *(const LAS bf16x8_t*)(base + ATT_KB + q * ATT_VP + (16 * kk + 8 * hi) * 2); vf1[kk] = *(const LAS bf16x8_t*)(base + ATT_KB + (32 + q) * ATT_VP + (16 * kk + 8 * hi) * 2); }
            __builtin_amdgcn_sched_barrier(0);
            float s0[16], s1[16];
#pragma unroll
            for (int r = 0; r < 16; ++r) { s0[r] = p0[r]; s1[r] = p1[r]; }
            if (t == 0) {
#pragma unroll
                for (int r = 0; r < 16; ++r) { if ((r & 3) + 8 * (r >> 2) + 4 * hi >= NMETA) s0[r] = -1e30f; s1[r] = -1e30f; }
            } else if (ks + 63 > s0w) {
#pragma unroll
                for (int r = 0; r < 16; ++r) { const int kk = ks + (r & 3) + 8 * (r >> 2) + 4 * hi; if (kk > sq) s0[r] = -1e30f; if (kk + 32 > sq) s1[r] = -1e30f; }
            }
            float mx = fmaxf(s0[0], s1[0]);
#pragma unroll
            for (int r = 1; r < 16; ++r) mx = fmaxf(mx, fmaxf(s0[r], s1[r]));
            mx = fmaxf(mx, __shfl_xor(mx, 32));
            if (__any(mx > m)) { const float mn = fmaxf(m, mx), al = __builtin_amdgcn_exp2f(m - mn); l *= al; m = mn;
#pragma unroll
                for (int r = 0; r < 16; ++r) { o0[r] *= al; o1[r] *= al; } }
            float ps = 0.f;
#pragma unroll
            for (int r = 0; r < 16; ++r) { s0[r] = __builtin_amdgcn_exp2f(s0[r] - m); s1[r] = __builtin_amdgcn_exp2f(s1[r] - m); ps += s0[r] + s1[r]; }
            l += ps;
            u32x4 pb[4];
            pb[0] = (u32x4){cvtpk(s0[0], s0[1]), cvtpk(s0[2], s0[3]), cvtpk(s0[4], s0[5]), cvtpk(s0[6], s0[7])};
            pb[1] = (u32x4){cvtpk(s0[8], s0[9]), cvtpk(s0[10], s0[11]), cvtpk(s0[12], s0[13]), cvtpk(s0[14], s0[15])};
            pb[2] = (u32x4){cvtpk(s1[0], s1[1]), cvtpk(s1[2], s1[3]), cvtpk(s1[4], s1[5]), cvtpk(s1[6], s1[7])};
            pb[3] = (u32x4){cvtpk(s1[8], s1[9]), cvtpk(s1[10], s1[11]), cvtpk(s1[12], s1[13]), cvtpk(s1[14], s1[15])};
            asm volatile("" : "+v"(vf0[0]), "+v"(vf0[1]), "+v"(vf0[2]), "+v"(vf0[3]), "+v"(vf1[0]), "+v"(vf1[1]), "+v"(vf1[2]), "+v"(vf1[3]));
#pragma unroll
            for (int kk = 0; kk < 4; ++kk) {
                const bf16x8_t pf = __builtin_bit_cast(bf16x8_t, pb[kk]);
                o0 = __builtin_amdgcn_mfma_f32_32x32x16_bf16(vf0[kk], pf, o0, 0, 0, 0); o1 = __builtin_amdgcn_mfma_f32_32x32x16_bf16(vf1[kk], pf, o1, 0, 0, 0); }
        }
        if (t + 1 < NT) ATT_STORE(cur ^ 1);
        LDS_BARRIER();
    }
    l += __shfl_xor(l, 32);
    const float il = 1.f / l;
    bf16_t* op = AO + rowq * 512 + h * 64 + 4 * hi;
#pragma unroll
    for (int g = 0; g < 4; ++g) {
        const float a0 = o0[4 * g], a1 = o0[4 * g + 1], a2 = o0[4 * g + 2], a3 = o0[4 * g + 3], b0 = o1[4 * g], b1 = o1[4 * g + 1], b2 = o1[4 * g + 2], b3 = o1[4 * g + 3];
        uint2 w0, w1; w0.x = cvtpk(a0 * il, a1 * il); w0.y = cvtpk(a2 * il, a3 * il); w1.x = cvtpk(b0 * il, b1 * il); w1.y = cvtpk(b2 * il, b3 * il);
        *(uint2*)(op + 8 * g) = w0; *(uint2*)(op + 32 + 8 * g) = w1; }
#undef ATT_KROW
#undef ATT_LOAD
#undef ATT_STORE
}
__device__ __forceinline__ void attn_phase(const Ptrs& p, LAS unsigned char* lds, int vcu, int ncu) {
    for (int v = vcu; v < 256; v += ncu) {
        const int bh = v >> 2, s = v & 3;
        attn_unit(p, lds, bh >> 3, bh & 7, 15 - s); attn_unit(p, lds, bh >> 3, bh & 7, 8 + s); attn_unit(p, lds, bh >> 3, bh & 7, 7 - s); attn_unit(p, lds, bh >> 3, bh & 7, s);
    }
}
__global__ void __launch_bounds__(512, 2) k_attn(Ptrs p) {
    extern __shared__ __attribute__((aligned(16))) unsigned char lds[];
    const int G = gridDim.x, bx = blockIdx.x; const int vcu = (G % 8 == 0) ? (bx % 8) * (G / 8) + bx / 8 : bx;
    attn_phase(p, (LAS unsigned char*)lds, vcu, G);
}

__global__ void __launch_bounds__(128) k_ret_naive(Ptrs p) {
    const bf16_t* RQ = (const bf16_t*)(p.ws + WS_RQ); const bf16_t* RK = (const bf16_t*)(p.ws + WS_RK); const bf16_t* RV = (const bf16_t*)(p.ws + WS_RV);
    const bf16_t* RG = (const bf16_t*)(p.ws + WS_RG); bf16_t* RET = (bf16_t*)(p.ws + WS_RET);
    const float* ggn = p.in[11];
    __shared__ float red[2][4];
    const int e = threadIdx.x, h = blockIdx.x & 7, b = blockIdx.x >> 3;
    const float gamma = 1.f - exp2f(-5.f - (float)h);
    float S[64];
#pragma unroll
    for (int d = 0; d < 64; ++d) S[d] = 0.f;
    const float gg = ggn[h * 128 + e];
    const float g128 = exp2f(128.f * __log2f(gamma)), g16 = exp2f(16.f * __log2f(gamma));
    for (int t = 0; t < NMETA + SEQ; ++t) {
        const int row = t < NMETA ? T + t : b * SEQ + (t - NMETA);
        if (t >= NMETA && ((t - NMETA) & 127) == 0) { const float f = t == NMETA ? g16 : g128;
#pragma unroll
            for (int d = 0; d < 64; ++d) S[d] *= f; }
        const bf16_t* qp = RQ + (size_t)row * 512 + h * 64; const bf16_t* kp = RK + (size_t)row * 512 + h * 64;
        const float v = bf2f(RV[(size_t)row * 1024 + h * 128 + e]);
        float y = 0.f;
#pragma unroll
        for (int d = 0; d < 64; d += 8) { float kq[8], qq[8]; ld8(kp + d, kq); ld8(qp + d, qq);
#pragma unroll
            for (int j = 0; j < 8; ++j) { S[d + j] = S[d + j] + kq[j] * v; y += qq[j] * S[d + j]; } }
        if (t >= NMETA) {
            const float s1 = wave_sum(y), s2 = wave_sum(y * y);
            const int buf = t & 1;
            if ((e & 63) == 0) { red[buf][(e >> 6) * 2] = s1; red[buf][(e >> 6) * 2 + 1] = s2; }
            __syncthreads();
            const float mu = (red[buf][0] + red[buf][2]) * (1.f / 128.f); const float ex2 = (red[buf][1] + red[buf][3]) * (1.f / 128.f);
            const float var = fmaxf(ex2 - mu * mu, 0.f);
            const float yn = (y - mu) * rsqrtf(var + EPS) * gg;
            const float g = bf2f(RG[(size_t)row * 1024 + h * 128 + e]);
            RET[(size_t)row * 1024 + h * 128 + e] = (bf16_t)f2bf(g * yn);
        }
    }
}

constexpr int RT_RP = 144, RT_TP = 256;
#define RT_SWZ(row) ((((row) & 15) ^ (((row) >> 3) & 3)) << 4)
constexpr int RT_QT = 0, RT_KT = 128 * RT_RP, RT_KTT = RT_KT + 128 * RT_RP, RT_VTT = RT_KTT + 64 * RT_TP, RT_ST = RT_VTT + 128 * RT_TP, RT_STAT = RT_ST + 128 * RT_RP, RT_GGN = RT_STAT + 8 * 32 * 8, RT_LDS = RT_GGN + 512;
static_assert(RT_LDS <= 147456, "retention LDS");
template <int MODE = 0>
__device__ __forceinline__ void ret_unit(const Ptrs& p, LAS unsigned char* lds, int b, int h) {
    const bf16_t* RQ = (const bf16_t*)(p.ws + WS_RQ); const bf16_t* RK = (const bf16_t*)(p.ws + WS_RK); const bf16_t* RV = (const bf16_t*)(p.ws + WS_RV);
    const bf16_t* RG = (const bf16_t*)(p.ws + WS_RG); bf16_t* RET = (bf16_t*)(p.ws + WS_RET); const float* ggn = p.in[11];
    const int tid = opaque_tid(), lane = tid & 63, wid = __builtin_amdgcn_readfirstlane(tid >> 6), c = lane & 31, hi = lane >> 5;
    const int j = wid >> 1, ih = wid & 1;
    const float lgam = __log2f(1.f - exp2f(-5.f - (float)h)); const float g128 = exp2f(128.f * lgam), g16 = exp2f(16.f * lgam);
    const int nst = wid < 2 ? 2 : (wid < 6 ? 1 : 0);
    const int sti = wid < 2 ? wid : 2 + ((wid - 2) >> 1), std0 = wid < 2 ? 0 : ((wid - 2) & 1);
    f32x16_t st0 = {}, st1 = {};
    const int q_row0 = tid >> 3, q_ch = tid & 7;
    const int k_rb = tid >> 4, k_db = tid & 15;
    const int v_rb0 = tid >> 5, v_eb = tid & 31;
    u32x4 pq[2]; u32x2 pk[4], pv[2][4];
#define RT_MPOS(rb) (16 * ((rb) >> 2) + 4 * ((((rb) & 3) == 1) ? 2 : ((((rb) & 3) == 2) ? 1 : ((rb) & 3))))
#define RT_LOAD(R0) do { \
        pq[0] = *(const u32x4*)(RQ + (size_t)((R0) + q_row0) * 512 + h * 64 + q_ch * 8); pq[1] = *(const u32x4*)(RQ + (size_t)((R0) + q_row0 + 64) * 512 + h * 64 + q_ch * 8); \
        _Pragma("unroll") for (int i_ = 0; i_ < 4; ++i_) pk[i_] = *(const u32x2*)(RK + (size_t)((R0) + 4 * k_rb + i_) * 512 + h * 64 + 4 * k_db); \
        _Pragma("unroll") for (int u_ = 0; u_ < 2; ++u_) _Pragma("unroll") for (int i_ = 0; i_ < 4; ++i_) pv[u_][i_] = *(const u32x2*)(RV + (size_t)((R0) + 4 * (v_rb0 + 16 * u_) + i_) * 1024 + h * 128 + 4 * v_eb); } while (0)
#define RT_TR4(src, dstbase, colbase, pitch, mpos) do { \
        const unsigned a0_ = src[0].x, a1_ = src[1].x, a2_ = src[2].x, a3_ = src[3].x, b0_ = src[0].y, b1_ = src[1].y, b2_ = src[2].y, b3_ = src[3].y; \
        const int mb_ = (mpos) * 2; u32x2 t_; \
        t_.x = (a0_ & 0xffffu) | (a1_ << 16); t_.y = (a2_ & 0xffffu) | (a3_ << 16); *(LAS u32x2*)(lds + (dstbase) + ((colbase) + 0) * (pitch) + (mb_ ^ RT_SWZ((colbase) + 0))) = t_; \
        t_.x = (a0_ >> 16) | (a1_ & 0xffff0000u); t_.y = (a2_ >> 16) | (a3_ & 0xffff0000u); *(LAS u32x2*)(lds + (dstbase) + ((colbase) + 1) * (pitch) + (mb_ ^ RT_SWZ((colbase) + 1))) = t_; \
        t_.x = (b0_ & 0xffffu) | (b1_ << 16); t_.y = (b2_ & 0xffffu) | (b3_ << 16); *(LAS u32x2*)(lds + (dstbase) + ((colbase) + 2) * (pitch) + (mb_ ^ RT_SWZ((colbase) + 2))) = t_; \
        t_.x = (b0_ >> 16) | (b1_ & 0xffff0000u); t_.y = (b2_ >> 16) | (b3_ & 0xffff0000u); *(LAS u32x2*)(lds + (dstbase) + ((colbase) + 3) * (pitch) + (mb_ ^ RT_SWZ((colbase) + 3))) = t_; } while (0)
#define RT_STORE() do { \
        *(LAS u32x4*)(lds + RT_QT + q_row0 * RT_RP + q_ch * 16) = pq[0]; *(LAS u32x4*)(lds + RT_QT + (q_row0 + 64) * RT_RP + q_ch * 16) = pq[1]; \
        _Pragma("unroll") for (int i_ = 0; i_ < 4; ++i_) *(LAS u32x2*)(lds + RT_KT + (4 * k_rb + i_) * RT_RP + k_db * 8) = pk[i_]; \
        if (!(MODE & 2)) { RT_TR4(pk, RT_KTT, 4 * k_db, RT_TP, RT_MPOS(k_rb)); \
        RT_TR4(pv[0], RT_VTT, 4 * v_eb, RT_TP, RT_MPOS(v_rb0)); RT_TR4(pv[1], RT_VTT, 4 * v_eb, RT_TP, RT_MPOS(v_rb0 + 16)); } } while (0)
#define RT_PUT_ST(acc, it, dt) do { _Pragma("unroll") for (int r_ = 0; r_ < 16; ++r_) { const float v_ = acc[r_]; \
        *(LAS bf16_t*)(lds + RT_ST + (32 * (it) + (r_ & 3) + 8 * (r_ >> 2) + 4 * hi) * RT_RP + (32 * (dt) + c) * 2) = (bf16_t)f2bf(v_); } } while (0)
#define RT_STATE_UPD(acc, it, dt) do { _Pragma("unroll") for (int ks_ = 0; ks_ < 8; ++ks_) { \
        const bf16x8_t a_ = *(const LAS bf16x8_t*)(lds + RT_VTT + (32 * (it) + c) * RT_TP + (((16 * ks_ + 8 * hi) * 2) ^ RT_SWZ(32 * (it) + c))); \
        const bf16x8_t b_ = *(const LAS bf16x8_t*)(lds + RT_KTT + (32 * (dt) + c) * RT_TP + (((16 * ks_ + 8 * hi) * 2) ^ RT_SWZ(32 * (dt) + c))); \
        acc = __builtin_amdgcn_mfma_f32_32x32x16_bf16(a_, b_, acc, 0, 0, 0); } } while (0)
    LDS_BARRIER();
    RT_LOAD(T); RT_STORE(); LDS_BARRIER();
    RT_LOAD(b * SEQ);
    if (nst >= 1) { RT_STATE_UPD(st0, sti, std0);
#pragma unroll
        for (int r = 0; r < 16; ++r) st0[r] *= g16; }
    if (nst == 2) { RT_STATE_UPD(st1, sti, 1);
#pragma unroll
        for (int r = 0; r < 16; ++r) st1[r] *= g16; }
    LDS_BARRIER();
    RT_STORE();
    if (nst >= 1) RT_PUT_ST(st0, sti, std0);
    if (nst == 2) RT_PUT_ST(st1, sti, 1);
    RT_LOAD(b * SEQ + 128);
    LDS_BARRIER();
    if (tid < 128) *(LAS float*)(lds + RT_GGN + tid * 4) = ggn[h * 128 + tid];
    for (int n = 0; n < 32; ++n) {
        const int R0 = b * SEQ + 128 * n;
        const size_t row = (size_t)R0 + 32 * j + c;
        u32x2 gwv[2][4];
#pragma unroll
        for (int i2 = 0; i2 < 2; ++i2)
#pragma unroll
            for (int g = 0; g < 4; ++g) gwv[i2][g] = *(const u32x2*)(RG + row * 1024 + h * 128 + 64 * ih + 32 * i2 + 8 * g + 4 * hi);
        bf16x8_t qf[4];
#pragma unroll
        for (int s4 = 0; s4 < 4; ++s4) qf[s4] = *(const LAS bf16x8_t*)(lds + RT_QT + (32 * j + c) * RT_RP + (16 * s4 + 8 * hi) * 2);
        f32x16_t y0 = {}, y1 = {};
        {
            bf16x8_t sa[4], sb[4];
#pragma unroll
            for (int s4 = 0; s4 < 4; ++s4) { sa[s4] = *(const LAS bf16x8_t*)(lds + RT_ST + (64 * ih + c) * RT_RP + (16 * s4 + 8 * hi) * 2); sb[s4] = *(const LAS bf16x8_t*)(lds + RT_ST + (64 * ih + 32 + c) * RT_RP + (16 * s4 + 8 * hi) * 2); }
            asm volatile("" : "+v"(sa[0]), "+v"(sa[1]), "+v"(sa[2]), "+v"(sa[3]), "+v"(sb[0]), "+v"(sb[1]), "+v"(sb[2]), "+v"(sb[3]));
#pragma unroll
            for (int s4 = 0; s4 < 4; ++s4) { y0 = __builtin_amdgcn_mfma_f32_32x32x16_bf16(sa[s4], qf[s4], y0, 0, 0, 0); y1 = __builtin_amdgcn_mfma_f32_32x32x16_bf16(sb[s4], qf[s4], y1, 0, 0, 0); }
        }
        for (int a = 0; a <= ((MODE & 8) ? -1 : j); ++a) {
            bf16x8_t kf[4], vf0[2], vf1[2];
#pragma unroll
            for (int s4 = 0; s4 < 4; ++s4) kf[s4] = *(const LAS bf16x8_t*)(lds + RT_KT + (32 * a + c) * RT_RP + (16 * s4 + 8 * hi) * 2);
#pragma unroll
            for (int t2 = 0; t2 < 2; ++t2) { vf0[t2] = *(const LAS bf16x8_t*)(lds + RT_VTT + (64 * ih + c) * RT_TP + (((32 * a + 16 * t2 + 8 * hi) * 2) ^ RT_SWZ(64 * ih + c))); vf1[t2] = *(const LAS bf16x8_t*)(lds + RT_VTT + (64 * ih + 32 + c) * RT_TP + (((32 * a + 16 * t2 + 8 * hi) * 2) ^ RT_SWZ(64 * ih + 32 + c))); }
            asm volatile("" : "+v"(kf[0]), "+v"(kf[1]), "+v"(kf[2]), "+v"(kf[3]), "+v"(vf0[0]), "+v"(vf0[1]), "+v"(vf1[0]), "+v"(vf1[1]));
            f32x16_t pa = {};
#pragma unroll
            for (int s4 = 0; s4 < 4; ++s4) pa = __builtin_amdgcn_mfma_f32_32x32x16_bf16(kf[s4], qf[s4], pa, 0, 0, 0);
            float sv[16];
#pragma unroll
            for (int r = 0; r < 16; ++r) { const float v_ = pa[r]; sv[r] = (a == j && ((r & 3) + 8 * (r >> 2) + 4 * hi) > c) ? 0.f : v_; }
            u32x4 pb[2];
            pb[0] = (u32x4){cvtpk(sv[0], sv[1]), cvtpk(sv[2], sv[3]), cvtpk(sv[4], sv[5]), cvtpk(sv[6], sv[7])};
            pb[1] = (u32x4){cvtpk(sv[8], sv[9]), cvtpk(sv[10], sv[11]), cvtpk(sv[12], sv[13]), cvtpk(sv[14], sv[15])};
#pragma unroll
            for (int t2 = 0; t2 < 2; ++t2) { const bf16x8_t pf = __builtin_bit_cast(bf16x8_t, pb[t2]);
                y0 = __builtin_amdgcn_mfma_f32_32x32x16_bf16(vf0[t2], pf, y0, 0, 0, 0); y1 = __builtin_amdgcn_mfma_f32_32x32x16_bf16(vf1[t2], pf, y1, 0, 0, 0); }
        }
        if (!(MODE & 4) && nst >= 1) { RT_STATE_UPD(st0, sti, std0);
#pragma unroll
            for (int r = 0; r < 16; ++r) st0[r] *= g128; }
        if (!(MODE & 4) && nst == 2) { RT_STATE_UPD(st1, sti, 1);
#pragma unroll
            for (int r = 0; r < 16; ++r) st1[r] *= g128; }
        float s1 = 0.f, s2 = 0.f;
#pragma unroll
        for (int r = 0; r < 16; ++r) { const float a_ = y0[r], b_ = y1[r]; s1 += a_ + b_; s2 += a_ * a_ + b_ * b_; }
        s1 += __shfl_xor(s1, 32); s2 += __shfl_xor(s2, 32);
        if (hi == 0) *(LAS f32x2_t*)(lds + RT_STAT + (wid * 32 + c) * 8) = (f32x2_t){s1, s2};
        LDS_BARRIER();
        if (n + 1 < 32) {
            RT_STORE();
            if (nst >= 1) RT_PUT_ST(st0, sti, std0);
            if (nst == 2) RT_PUT_ST(st1, sti, 1);
        }
        { const f32x2_t o = *(const LAS f32x2_t*)(lds + RT_STAT + ((wid ^ 1) * 32 + c) * 8); s1 += o.x; s2 += o.y; }
        const float mu = s1 * (1.f / 128.f), var = fmaxf(s2 * (1.f / 128.f) - mu * mu, 0.f), rstd = rsqrtf(var + EPS);
#pragma unroll
        for (int i2 = 0; i2 < 2; ++i2)
#pragma unroll
            for (int g = 0; g < 4; ++g) {
                const int e = 64 * ih + 32 * i2 + 8 * g + 4 * hi;
                const u32x2 gw = gwv[i2][g]; const f32x4 gn = *(const LAS f32x4*)(lds + RT_GGN + e * 4);
                float yv[4];
#pragma unroll
                for (int x = 0; x < 4; ++x) yv[x] = i2 == 0 ? y0[4 * g + x] : y1[4 * g + x];
                const float o0 = (yv[0] - mu) * rstd * gn.x * bf2f(gw.x & 0xffff), o1 = (yv[1] - mu) * rstd * gn.y * bf2f(gw.x >> 16);
                const float o2 = (yv[2] - mu) * rstd * gn.z * bf2f(gw.y & 0xffff), o3 = (yv[3] - mu) * rstd * gn.w * bf2f(gw.y >> 16);
                u32x2 ow; ow.x = cvtpk(o0, o1); ow.y = cvtpk(o2, o3);
                if (!(MODE & 1) || ow.x == 0x12345678u) *(u32x2*)(RET + row * 1024 + h * 128 + e) = ow;
            }
        if (!(MODE & 16)) { const int Rn = b * SEQ + 128 * (n + 2 < 32 ? n + 2 : 31); RT_LOAD(Rn); }
        LDS_BARRIER();
    }
#undef RT_MPOS
#undef RT_LOAD
#undef RT_TR4
#undef RT_STORE
#undef RT_PUT_ST
#undef RT_STATE_UPD
}
__global__ void __launch_bounds__(512, 2) k_ret(Ptrs p) {
    extern __shared__ __attribute__((aligned(16))) unsigned char lds[];
    for (int u = blockIdx.x; u < 64; u += gridDim.x) ret_unit<0>(p, (LAS unsigned char*)lds, u >> 3, u & 7);
}

__global__ void __launch_bounds__(256) k_zero_ss2(Ptrs p) {
    float* R = (float*)(p.ws + WS_RINV2);
    for (int i = blockIdx.x * 256 + threadIdx.x; i < T; i += gridDim.x * 256) R[i] = 0.f;
}

__global__ void __launch_bounds__(32) k_peer_select_naive(Ptrs p) {
    __shared__ float sc[256][32];
    __shared__ int ii[32][32];
    const bf16_t* PQ = (const bf16_t*)(p.ws + WS_PQ);
    const float* k1 = p.in[16]; const float* k2 = p.in[17];
    int* SELI = (int*)(p.ws + WS_SELI); float* SELG = (float*)(p.ws + WS_SELG);
    const int tid = threadIdx.x, gid = blockIdx.x * 32 + tid, tok = gid >> 3, hd = gid & 7;
    float q[128];
#pragma unroll
    for (int d = 0; d < 128; d += 8) { float t[8]; ld8(PQ + (size_t)tok * D + hd * 128 + d, t);
#pragma unroll
        for (int j = 0; j < 8; ++j) q[d + j] = t[j]; }
    for (int kk = 0; kk < 128; ++kk) {
        float a = 0.f, b = 0.f;
#pragma unroll
        for (int d = 0; d < 64; ++d) { a += q[d] * k1[kk * 64 + d]; b += q[64 + d] * k2[kk * 64 + d]; }
        sc[kk][tid] = a; sc[128 + kk][tid] = b;
    }
    float v1[16], v2[16];
#pragma unroll
    for (int r = 0; r < 16; ++r) {
        float best = -INFINITY; int bi = 0;
        for (int kk = 0; kk < 128; ++kk) { const float x = sc[kk][tid]; if (x > best) { best = x; bi = kk; } }
        sc[bi][tid] = -INFINITY; v1[r] = best; ii[r][tid] = bi;
        best = -INFINITY; bi = 0;
        for (int kk = 0; kk < 128; ++kk) { const float x = sc[128 + kk][tid]; if (x > best) { best = x; bi = kk; } }
        sc[128 + bi][tid] = -INFINITY; v2[r] = best; ii[16 + r][tid] = bi;
    }
#pragma unroll
    for (int i = 0; i < 16; ++i)
#pragma unroll
        for (int j = 0; j < 16; ++j) sc[i * 16 + j][tid] = v1[i] + v2[j];
    float sv[16]; int se[16];
#pragma unroll
    for (int r = 0; r < 16; ++r) {
        float best = -INFINITY; int bi = 0;
        for (int c = 0; c < 256; ++c) { const float x = sc[c][tid]; if (x > best) { best = x; bi = c; } }
        sc[bi][tid] = -INFINITY; sv[r] = best; se[r] = ii[bi >> 4][tid] * 128 + ii[16 + (bi & 15)][tid];
    }
    float den = 0.f; const float mx = sv[0];
#pragma unroll
    for (int r = 0; r < 16; ++r) { sv[r] = __expf(sv[r] - mx); den += sv[r]; }
    const float id = 1.f / den;
#pragma unroll
    for (int r = 0; r < 16; ++r) { SELI[(size_t)tok * 128 + hd * 16 + r] = se[r]; SELG[(size_t)tok * 128 + hd * 16 + r] = sv[r] * id; }
}

__global__ void __launch_bounds__(256) k_peer_gather_naive(Ptrs p) {
    __shared__ float wk[128];
    const int* SELI = (const int*)(p.ws + WS_SELI); const float* SELG = (const float*)(p.ws + WS_SELG);
    const float* RINV2 = (const float*)(p.ws + WS_RINV2); const float* gffn = p.in[14]; const float* U = p.in[18]; const float* Vt = p.in[19];
    const int tok = blockIdx.x, tid = threadIdx.x, lane = tid & 63, w = tid >> 6;
    const float r2 = rsqrtf(RINV2[tok] * (1.f / D) + EPS);
    f32x4 xr[4];
#pragma unroll
    for (int j = 0; j < 4; ++j) { const f32x4 hv = *(const f32x4*)(p.out + (size_t)tok * D + lane * 4 + 256 * j); const f32x4 g = *(const f32x4*)(gffn + lane * 4 + 256 * j); xr[j] = hv * g * r2; }
    for (int k = w * 32; k < w * 32 + 32; ++k) {
        const float* up = U + (size_t)SELI[(size_t)tok * 128 + k] * D;
        float dsum = 0.f;
#pragma unroll
        for (int j = 0; j < 4; ++j) { const f32x4 u = *(const f32x4*)(up + lane * 4 + 256 * j); dsum += u.x * xr[j].x + u.y * xr[j].y + u.z * xr[j].z + u.w * xr[j].w; }
        dsum = wave_sum(dsum);
        const float act = 0.5f * dsum * (1.f + erff(dsum * 0.70710678118654752f));
        if (lane == 0) wk[k] = SELG[(size_t)tok * 128 + k] * act;
    }
    __syncthreads();
    f32x4 acc = (f32x4){0.f, 0.f, 0.f, 0.f};
    for (int k = 0; k < 128; ++k) { const f32x4 v = *(const f32x4*)(Vt + (size_t)SELI[(size_t)tok * 128 + k] * D + tid * 4); acc += v * wk[k]; }
    f32x4* op = (f32x4*)(p.out + (size_t)tok * D + tid * 4); *op = *op + acc;
}

#define LAS __attribute__((address_space(3)))
typedef float f32x16 __attribute__((ext_vector_type(16)));
typedef short bf16x8 __attribute__((ext_vector_type(8)));
__device__ __forceinline__ int sortable(int b) { return b ^ ((b >> 31) & 0x7fffffff); }
__device__ __forceinline__ int imax(int a, int b) { return a > b ? a : b; }
__device__ __forceinline__ int imin(int a, int b) { return a < b ? a : b; }
template <int N, int K, int J> __device__ __forceinline__ void bstep(int (&v)[N]) {
#pragma unroll
    for (int i = 0; i < N; ++i) { const int l = i ^ J; if (l > i) { const int a = v[i], b = v[l]; const bool d = (i & K) == 0; v[i] = d ? imax(a, b) : imin(a, b); v[l] = d ? imin(a, b) : imax(a, b); } }
}
template <int N, int K, int J> __device__ __forceinline__ void bstep2(int (&v)[N], int (&q)[N]) {
#pragma unroll
    for (int i = 0; i < N; ++i) { const int l = i ^ J; if (l > i) { const int a = v[i], b = v[l], pa = q[i], pb = q[l]; const bool gt = a > b; const bool d = (i & K) == 0;
        const int hk = gt ? a : b, lk = gt ? b : a, hp = gt ? pa : pb, lp = gt ? pb : pa; v[i] = d ? hk : lk; v[l] = d ? lk : hk; q[i] = d ? hp : lp; q[l] = d ? lp : hp; } }
}
template <int N, int K, int J> struct BMerge { static __device__ __forceinline__ void run(int (&v)[N]) { bstep<N, K, J>(v); if constexpr (J > 1) BMerge<N, K, J / 2>::run(v); }
                                               static __device__ __forceinline__ void run2(int (&v)[N], int (&q)[N]) { bstep2<N, K, J>(v, q); if constexpr (J > 1) BMerge<N, K, J / 2>::run2(v, q); } };
template <int N, int K> struct BSort { static __device__ __forceinline__ void run(int (&v)[N]) { if constexpr (K > 2) BSort<N, K / 2>::run(v); BMerge<N, K, K / 2>::run(v); }
                                       static __device__ __forceinline__ void run2(int (&v)[N], int (&q)[N]) { if constexpr (K > 2) BSort<N, K / 2>::run2(v, q); BMerge<N, K, K / 2>::run2(v, q); } };
__device__ __forceinline__ void top16_merge(const int (&a)[16], const int (&b)[16], int (&o)[16]) {
#pragma unroll
    for (int i = 0; i < 16; ++i) o[i] = imax(a[i], b[15 - i]);
    BMerge<16, 16, 8>::run(o);
}
__device__ __forceinline__ void top16_merge2(const int (&a)[16], const int (&pa)[16], const int (&b)[16], const int (&pb)[16], int (&o)[16], int (&po)[16]) {
#pragma unroll
    for (int i = 0; i < 16; ++i) { const bool gt = a[i] > b[15 - i]; o[i] = gt ? a[i] : b[15 - i]; po[i] = gt ? pa[i] : pb[15 - i]; }
    BMerge<16, 16, 8>::run2(o, po);
}
__device__ __forceinline__ void top16_of_64(const int (&v)[64], int (&o)[16]) {
    int g[4][16];
#pragma unroll
    for (int q = 0; q < 4; ++q) {
#pragma unroll
        for (int i = 0; i < 16; ++i) g[q][i] = v[q * 16 + i];
        BSort<16, 16>::run(g[q]); }
    int m0[16], m1[16]; top16_merge(g[0], g[1], m0); top16_merge(g[2], g[3], m1); top16_merge(m0, m1, o);
}
__device__ __forceinline__ void top16_of_64p(const int (&v)[64], const int (&pv)[64], int (&o)[16], int (&po)[16]) {
    int g[4][16], h[4][16];
#pragma unroll
    for (int q = 0; q < 4; ++q) {
#pragma unroll
        for (int i = 0; i < 16; ++i) { g[q][i] = v[q * 16 + i]; h[q][i] = pv[q * 16 + i]; }
        BSort<16, 16>::run2(g[q], h[q]); }
    int m0[16], p0[16], m1[16], p1[16]; top16_merge2(g[0], h[0], g[1], h[1], m0, p0); top16_merge2(g[2], h[2], g[3], h[3], m1, p1); top16_merge2(m0, p0, m1, p1, o, po);
}
template <int M, int J, int N> __device__ __forceinline__ void cand_one(const int (&am)[8], const float (&f2)[16], const int (&M2)[16], int (&g)[16], int (&h)[16]) {
    const float f1 = __int_as_float(sortable(am[M] & ~0x7f)); g[N] = sortable(__float_as_int(f1 + f2[J])); h[N] = ((am[M] & 0x7f) << 7) | (M2[J] & 0x7f);
}
__device__ __forceinline__ void cand_rest(const int (&am)[8], const float (&f2)[16], const int (&M2)[16], int (&g)[16], int (&h)[16]) {
    cand_one<1, 0, 0>(am, f2, M2, g, h); cand_one<1, 1, 1>(am, f2, M2, g, h); cand_one<1, 2, 2>(am, f2, M2, g, h); cand_one<1, 3, 3>(am, f2, M2, g, h); cand_one<1, 4, 4>(am, f2, M2, g, h);
    cand_one<2, 0, 5>(am, f2, M2, g, h); cand_one<2, 1, 6>(am, f2, M2, g, h); cand_one<2, 2, 7>(am, f2, M2, g, h);
    cand_one<3, 0, 8>(am, f2, M2, g, h); cand_one<3, 1, 9>(am, f2, M2, g, h);
    cand_one<4, 0, 10>(am, f2, M2, g, h); cand_one<5, 0, 11>(am, f2, M2, g, h); cand_one<6, 0, 12>(am, f2, M2, g, h); cand_one<7, 0, 13>(am, f2, M2, g, h);
    g[14] = (int)0x80000000; h[14] = 0; g[15] = (int)0x80000000; h[15] = 0;
}
constexpr int KEY_PITCH = 144;
__device__ __forceinline__ void peer_keys_to_lds(const Ptrs& p, LAS unsigned char* lds) {
    for (int i = threadIdx.x; i < 2 * 128 * 8; i += blockDim.x) { const int side = i >> 10, row = (i >> 3) & 127, ch = i & 7; const float* src = p.in[16 + side] + row * 64 + ch * 8;
        const f32x4 a = *(const f32x4*)src, b = *(const f32x4*)(src + 4); u32x4 w; w.x = pk2(a.x, a.y); w.y = pk2(a.z, a.w); w.z = pk2(b.x, b.y); w.w = pk2(b.z, b.w);
        *(LAS u32x4*)(lds + (side * 128 + row) * KEY_PITCH + ch * 16) = w; }
}
__device__ __forceinline__ void peer_select_core(const Ptrs& p, const LAS unsigned char* lds, int tok0, int head, int lane, int (&P16o)[16], float (&gate)[16]) {
    const bf16_t* PQ = (const bf16_t*)(p.ws + WS_PQ);
    const int c = lane & 31, hi = lane >> 5, tok = tok0 + c;
    {
        int M1[16], M2[16];
#pragma unroll
        for (int side = 0; side < 2; ++side) {
            bf16x8 bq[4];
#pragma unroll
            for (int s = 0; s < 4; ++s) bq[s] = *(const bf16x8*)(PQ + (size_t)tok * D + head * 128 + side * 64 + 16 * s + 8 * hi);
            int L[16];
            {   int g[2][16], m[2][16];
#pragma unroll
                for (int kt = 0; kt < 4; ++kt) {
                    f32x16 acc = {};
#pragma unroll
                    for (int s = 0; s < 4; ++s) { const bf16x8 a = *(const LAS bf16x8*)(lds + (side * 128 + kt * 32 + c) * KEY_PITCH + (16 * s + 8 * hi) * 2);
                        acc = __builtin_amdgcn_mfma_f32_32x32x16_bf16(a, bq[s], acc, 0, 0, 0); }
#pragma unroll
                    for (int r = 0; r < 16; ++r) { const float fv = acc[r]; g[kt & 1][r] = (sortable(__float_as_int(fv)) & ~0x7f) | (kt * 32 + (r & 3) + 8 * (r >> 2) + 4 * hi); }
                    BSort<16, 16>::run(g[kt & 1]);
                    if (kt & 1) top16_merge(g[0], g[1], m[kt >> 1]);
                    __builtin_amdgcn_sched_barrier(0);
                }
                top16_merge(m[0], m[1], L);
            }
            int A_[16], B_[16];
#pragma unroll
            for (int i = 0; i < 16; ++i) { const int pr = __shfl_xor(L[i], 32); A_[i] = hi ? pr : L[i]; B_[i] = hi ? L[i] : pr; }
            if (side == 0) top16_merge(A_, B_, M1); else top16_merge(A_, B_, M2);
            __builtin_amdgcn_sched_barrier(0);
        }
        int K16[16], P16[16];
        {   int am[8];
#pragma unroll
            for (int m = 0; m < 8; ++m) am[m] = M1[2 * m] ^ ((M1[2 * m] ^ M1[2 * m + 1]) & -hi);
            float f2[16];
#pragma unroll
            for (int j = 0; j < 16; ++j) f2[j] = __int_as_float(sortable(M2[j] & ~0x7f));
            int g0[16], h0[16], g1[16], h1[16];
            { const float f1 = __int_as_float(sortable(am[0] & ~0x7f)); const int e1 = (am[0] & 0x7f) << 7;
#pragma unroll
              for (int j = 0; j < 16; ++j) { g0[j] = sortable(__float_as_int(f1 + f2[j])); h0[j] = e1 | (M2[j] & 0x7f); } }
            cand_rest(am, f2, M2, g1, h1);
            BSort<16, 16>::run2(g1, h1);
            int mk[16], mp[16]; top16_merge2(g0, h0, g1, h1, mk, mp);
            int Ak[16], Ap[16], Bk[16], Bp[16];
#pragma unroll
            for (int i = 0; i < 16; ++i) { const int pk = __shfl_xor(mk[i], 32), pp = __shfl_xor(mp[i], 32); Ak[i] = hi ? pk : mk[i]; Bk[i] = hi ? mk[i] : pk; Ap[i] = hi ? pp : mp[i]; Bp[i] = hi ? mp[i] : pp; }
            top16_merge2(Ak, Ap, Bk, Bp, K16, P16);
        }
        float ex[16], den = 0.f; const float mx = __int_as_float(sortable(K16[0]));
#pragma unroll
        for (int r = 0; r < 16; ++r) { ex[r] = __expf(__int_as_float(sortable(K16[r])) - mx); den += ex[r]; }
        const float id = 1.f / den;
#pragma unroll
        for (int r = 0; r < 16; ++r) { P16o[r] = P16[r]; gate[r] = ex[r] * id; }
    }
}
template <class IP, class GP, class U4P, class F4P>
__device__ __forceinline__ void peer_select_unit(const Ptrs& p, const LAS unsigned char* lds, int tok0, int head, int lane, IP si, GP sg) {
    int P16[16]; float gt[16]; peer_select_core(p, lds, tok0, head, lane, P16, gt);
    const int c = lane & 31, hi = lane >> 5;
    if (hi == 0) { IP ip = si + (size_t)c * 128 + head * 16;
#pragma unroll
        for (int r = 0; r < 16; r += 4) *(U4P)(ip + r) = (u32x4){(unsigned)P16[r], (unsigned)P16[r + 1], (unsigned)P16[r + 2], (unsigned)P16[r + 3]}; }
    else { GP gp = sg + (size_t)c * 128 + head * 16;
#pragma unroll
        for (int r = 0; r < 16; r += 4) *(F4P)(gp + r) = (f32x4){gt[r], gt[r + 1], gt[r + 2], gt[r + 3]}; }
}
__device__ __forceinline__ void peer_select_phase(const Ptrs& p, LAS unsigned char* lds, int* SELI, float* SELG, int gw, int nw, int lane) {
    peer_keys_to_lds(p, lds); __syncthreads();
    for (int task = gw; task < 8192; task += nw) { const int tok0 = (task >> 3) * 32; peer_select_unit<int*, float*, u32x4*, f32x4*>(p, lds, tok0, task & 7, lane, SELI + (size_t)tok0 * 128, SELG + (size_t)tok0 * 128); }
}
__global__ void __launch_bounds__(512, 2) k_peer_select(Ptrs p, int alt) {
    extern __shared__ __attribute__((aligned(16))) unsigned char lds[];
    int* si = (int*)(p.ws + (alt ? WS_RET : WS_SELI)); float* sg = (float*)(p.ws + (alt ? WS_RET + (size_t)T * 128 * 4 : WS_SELG));
    peer_select_phase(p, (LAS unsigned char*)lds, si, sg, blockIdx.x * 8 + (threadIdx.x >> 6), gridDim.x * 8, threadIdx.x & 63);
}
__global__ void __launch_bounds__(256) k_peer_select256(Ptrs p, int alt) {
    extern __shared__ __attribute__((aligned(16))) unsigned char lds[];
    int* si = (int*)(p.ws + (alt ? WS_RET : WS_SELI)); float* sg = (float*)(p.ws + (alt ? WS_RET + (size_t)T * 128 * 4 : WS_SELG));
    peer_select_phase(p, (LAS unsigned char*)lds, si, sg, blockIdx.x * 4 + (threadIdx.x >> 6), gridDim.x * 4, threadIdx.x & 63);
}
__global__ void k_dbg_cmp_sel(Ptrs p, int mode) {
    const int gid = blockIdx.x * blockDim.x + threadIdx.x; if (gid >= T * 8) return;
    const int* a = (const int*)(p.ws + WS_SELI) + (size_t)gid * 16; const int* b = (const int*)(p.ws + WS_RET) + (size_t)gid * 16;
    const float* ga = (const float*)(p.ws + WS_SELG) + (size_t)gid * 16; const float* gb = (const float*)(p.ws + WS_RET + (size_t)T * 128 * 4) + (size_t)gid * 16;
    int miss = 0; float gd = 0.f;
    for (int i = 0; i < 16; ++i) { bool f = false; for (int j = 0; j < 16; ++j) f |= (a[i] == b[j]); miss += f ? 0 : 1; gd += fabsf(ga[i] - gb[i]); }
    unsigned* ctl = (unsigned*)(p.ws + WS_CTL);
    if (mode == 0) { if (miss) atomicAdd(ctl, 1u); }
    else if (mode == 1) { if (a[0] != b[0]) atomicAdd(ctl, 1u); }
    else if (mode == 2) { atomicAdd(ctl, (unsigned)miss); }
    else { atomicAdd((float*)ctl + 1, gd); }
}
__global__ void k_dbg_cmp_scores(Ptrs p) {
    const int gid = blockIdx.x * blockDim.x + threadIdx.x; if (gid >= 1024 * 8 * 2 * 128) return;
    const int key = gid & 127, side = (gid >> 7) & 1, head = (gid >> 8) & 7, tok = gid >> 11;
    const bf16_t* PQ = (const bf16_t*)(p.ws + WS_PQ); const float* kk = p.in[16 + side] + key * 64;
    float a = 0.f; for (int d = 0; d < 64; ++d) a += bf2f(PQ[(size_t)tok * D + head * 128 + side * 64 + d]) * kk[d];
    const float b = ((const float*)(p.ws + WS_RET + (size_t)64 * 1024 * 1024))[gid];
#if DBG_SCORES == 2
    atomicAdd((float*)(p.ws + WS_CTL) + 1, fabsf(a - b) > 0.1f ? 1.f : 0.f);
#elif DBG_SCORES == 3
    if (fabsf(a - b) > 0.1f) { atomicAdd((float*)(p.ws + WS_CTL) + 1, (float)((key & 31) + 1) / 32.f); atomicAdd((float*)(p.ws + WS_CTL) + 2, 1.f); }
#elif DBG_SCORES == 4
    if (fabsf(a - b) > 0.1f) { atomicAdd((float*)(p.ws + WS_CTL) + 1, (float)((tok & 31) + 1) / 32.f); atomicAdd((float*)(p.ws + WS_CTL) + 2, 1.f); }
#elif DBG_SCORES == 5
    if (fabsf(a - b) > 0.1f) { atomicAdd((float*)(p.ws + WS_CTL) + 1, fminf(fabsf(b), 10.f) / 10.f); atomicAdd((float*)(p.ws + WS_CTL) + 2, 1.f); }
#else
    atomicAdd((float*)(p.ws + WS_CTL) + 1, fabsf(a - b));
#endif
}
__global__ void k_dbg_scale(Ptrs p, float denom, int mode) {
    const unsigned* ctl = (const unsigned*)(p.ws + WS_CTL);
#if defined(DBG_SCORES) && DBG_SCORES >= 3
    const float m = ((const float*)ctl)[1] / fmaxf(((const float*)ctl)[2], 1.f);
#else
    const float m = mode == 3 ? ((const float*)ctl)[1] / denom : (float)ctl[0] / denom;
#endif
    for (size_t i = (size_t)blockIdx.x * blockDim.x + threadIdx.x; i < (size_t)T * D; i += (size_t)gridDim.x * blockDim.x) p.out[i] *= (1.f + m);
}

typedef __bf16 bf16x2_t __attribute__((ext_vector_type(2)));
__device__ __forceinline__ float dot2bf(unsigned a, unsigned b, float c) { return __builtin_amdgcn_fdot2_f32_bf16(__builtin_bit_cast(bf16x2_t, a), __builtin_bit_cast(bf16x2_t, b), c, false); }
constexpr size_t WS_U8 = WS_K, WS_V8 = WS_K + (size_t)16384 * 1024, WS_SU = WS_V, WS_SV = WS_V + 65536;
static_assert(WS_V8 + (size_t)16384 * 1024 <= WS_V && WS_SV + 65536 <= WS_RET, "peer table overlay");
__device__ __forceinline__ float wave_max(float v) {
#pragma unroll
    for (int o = 1; o < 64; o <<= 1) v = fmaxf(v, __shfl_xor(v, o));
    return v;
}
__device__ __forceinline__ void prep_uv_part(const Ptrs& p, int gw, int nw, int lane) {
    for (int row = gw; row < 2 * 16384; row += nw) {
        const int t = row >> 14, e = row & 16383;
        const float* src = p.in[18 + t] + (size_t)e * D + lane * 16;
        f32x4 v[4]; float am = 0.f;
#pragma unroll
        for (int j = 0; j < 4; ++j) { v[j] = *(const f32x4*)(src + 4 * j); am = fmaxf(am, fmaxf(fmaxf(fabsf(v[j].x), fabsf(v[j].y)), fmaxf(fabsf(v[j].z), fabsf(v[j].w)))); }
        am = fmaxf(wave_max(am), 1e-30f);
        const float inv = 127.f / am; const int off = 0;
        u32x4 w;
#pragma unroll
        for (int j = 0; j < 4; ++j) { const int q0 = (int)rintf(v[j].x * inv) + off, q1 = (int)rintf(v[j].y * inv) + off, q2 = (int)rintf(v[j].z * inv) + off, q3 = (int)rintf(v[j].w * inv) + off;
            w[j] = (unsigned)(q0 & 0xff) | ((unsigned)(q1 & 0xff) << 8) | ((unsigned)(q2 & 0xff) << 16) | ((unsigned)(q3 & 0xff) << 24); }
        *(u32x4*)(p.ws + (t ? WS_V8 : WS_U8) + (size_t)e * D + lane * 16) = w;
        if (lane == 0) ((float*)(p.ws + (t ? WS_SV : WS_SU)))[e] = am * (1.f / 127.f);
    }
}
__global__ void __launch_bounds__(512) k_prep_uv(Ptrs p) { prep_uv_part(p, blockIdx.x * 8 + (threadIdx.x >> 6), gridDim.x * 8, threadIdx.x & 63); }

__device__ __forceinline__ float gelu_erf(float x) { return 0.5f * x * (1.f + erff(x * 0.70710678118654752f)); }
__device__ __forceinline__ float treduce8(const float (&v)[8], int lane) {
    float w[4], x[2], y;
    const bool b0 = lane & 1, b1 = lane & 2, b2 = lane & 4;
#pragma unroll
    for (int i = 0; i < 4; ++i) { const float keep = b0 ? v[2 * i + 1] : v[2 * i], send = b0 ? v[2 * i] : v[2 * i + 1]; w[i] = keep + __shfl_xor(send, 1); }
#pragma unroll
    for (int i = 0; i < 2; ++i) { const float keep = b1 ? w[2 * i + 1] : w[2 * i], send = b1 ? w[2 * i] : w[2 * i + 1]; x[i] = keep + __shfl_xor(send, 2); }
    { const float keep = b2 ? x[1] : x[0], send = b2 ? x[0] : x[1]; y = keep + __shfl_xor(send, 4); }
    y += __shfl_xor(y, 8); y += __shfl_xor(y, 16); y += __shfl_xor(y, 32);
    return y;
}
__device__ __forceinline__ int treduce8i(const int (&v)[8], int lane) {
    int w[4], x[2], y;
    const bool b0 = lane & 1, b1 = lane & 2, b2 = lane & 4;
#pragma unroll
    for (int i = 0; i < 4; ++i) { const int keep = b0 ? v[2 * i + 1] : v[2 * i], send = b0 ? v[2 * i] : v[2 * i + 1]; w[i] = keep + __shfl_xor(send, 1); }
#pragma unroll
    for (int i = 0; i < 2; ++i) { const int keep = b1 ? w[2 * i + 1] : w[2 * i], send = b1 ? w[2 * i] : w[2 * i + 1]; x[i] = keep + __shfl_xor(send, 2); }
    { const int keep = b2 ? x[1] : x[0], send = b2 ? x[0] : x[1]; y = keep + __shfl_xor(send, 4); }
    y += __shfl_xor(y, 8); y += __shfl_xor(y, 16); y += __shfl_xor(y, 32);
    return y;
}
__device__ __forceinline__ void peer_gather_token(const Ptrs& p, int tok, int i0, int i1, float g0, float g1, int lane, bool do_store = true) {
    const float* SS2 = (const float*)(p.ws + WS_RINV2); const float* gffn = p.in[14];
    const unsigned char* U8 = p.ws + WS_U8; const unsigned char* V8 = p.ws + WS_V8; const float* SU = (const float*)(p.ws + WS_SU); const float* SV = (const float*)(p.ws + WS_SV);
    int xq[4]; float xs;
    {   const float r2 = rsqrtf(SS2[tok] * (1.f / D) + EPS); const float* hp = p.out + (size_t)tok * D + lane * 16; const float* gp = gffn + lane * 16;
        f32x4 x[4]; float am = 0.f;
#pragma unroll
        for (int j = 0; j < 4; ++j) { x[j] = *(const f32x4*)(hp + 4 * j) * *(const f32x4*)(gp + 4 * j) * r2; am = fmaxf(am, fmaxf(fmaxf(fabsf(x[j].x), fabsf(x[j].y)), fmaxf(fabsf(x[j].z), fabsf(x[j].w)))); }
        am = fmaxf(wave_max(am), 1e-30f); xs = am * (1.f / 127.f); const float inv = 127.f / am;
#pragma unroll
        for (int j = 0; j < 4; ++j) xq[j] = (int)(((unsigned)((int)rintf(x[j].x * inv) & 0xff)) | ((unsigned)((int)rintf(x[j].y * inv) & 0xff) << 8) | ((unsigned)((int)rintf(x[j].z * inv) & 0xff) << 16) | ((unsigned)((int)rintf(x[j].w * inv) & 0xff) << 24));
    }
    const float su0 = SU[i0], su1 = SU[i1], sv0 = SV[i0], sv1 = SV[i1];
    int a0 = 0, a1 = 0;
#pragma unroll 1
    for (int kb = 0; kb < 8; ++kb) {
        u32x4 r[16];
#pragma unroll
        for (int e = 0; e < 16; ++e) { const int k = kb * 16 + e; const int idx = __builtin_amdgcn_readlane(kb < 4 ? i0 : i1, k & 63); r[e] = *(const u32x4*)(U8 + (size_t)idx * D + lane * 16); }
        int pa[8], pb[8];
#pragma unroll
        for (int e = 0; e < 16; ++e) { int d = __builtin_amdgcn_sdot4((int)r[e].x, xq[0], 0, false); d = __builtin_amdgcn_sdot4((int)r[e].y, xq[1], d, false); d = __builtin_amdgcn_sdot4((int)r[e].z, xq[2], d, false); d = __builtin_amdgcn_sdot4((int)r[e].w, xq[3], d, false);
            if (e < 8) pa[e] = d; else pb[e - 8] = d; }
        const int ya = treduce8i(pa, lane), yb = treduce8i(pb, lane);
        const int y = (lane & 8) ? yb : ya;
        if ((kb & 3) == ((lane >> 4) & 3)) { if (kb < 4) a0 = y; else a1 = y; }
    }
    const float wv0 = g0 * gelu_erf((float)a0 * su0 * xs) * sv0, wv1 = g1 * gelu_erf((float)a1 * su1 * xs) * sv1;
    const float corr = 0.f;
    float acc[16];
#pragma unroll
    for (int e = 0; e < 16; ++e) acc[e] = 0.f;
#pragma unroll 1
    for (int kb = 0; kb < 8; ++kb) {
        u32x4 r[16];
#pragma unroll
        for (int e = 0; e < 16; ++e) { const int k = kb * 16 + e; const int idx = __builtin_amdgcn_readlane(kb < 4 ? i0 : i1, k & 63); r[e] = *(const u32x4*)(V8 + (size_t)idx * D + lane * 16); }
#pragma unroll
        for (int e = 0; e < 16; ++e) { const int k = kb * 16 + e; const float wk = __int_as_float(__builtin_amdgcn_readlane(__float_as_int(kb < 4 ? wv0 : wv1), k & 63));
#pragma unroll
            for (int j = 0; j < 4; ++j) { const unsigned w = r[e][j];
                acc[4 * j + 0] += wk * (float)((int)(w << 24) >> 24); acc[4 * j + 1] += wk * (float)((int)(w << 16) >> 24); acc[4 * j + 2] += wk * (float)((int)(w << 8) >> 24); acc[4 * j + 3] += wk * (float)((int)w >> 24); } }
    }
    {   float* hp = p.out + (size_t)tok * D + lane * 16;
#pragma unroll
        for (int j = 0; j < 4; ++j) { f32x4 a = *(const f32x4*)(hp + 4 * j);
            a.x += acc[4 * j] - corr; a.y += acc[4 * j + 1] - corr; a.z += acc[4 * j + 2] - corr; a.w += acc[4 * j + 3] - corr;
            if (do_store || a.x == 1.2345e30f) *(f32x4*)(hp + 4 * j) = a; } }
}
__device__ __forceinline__ void peer_gather_phase(const Ptrs& p, int gw, int nw, int lane) {
    const int* SELI = (const int*)(p.ws + WS_SELI); const float* SELG = (const float*)(p.ws + WS_SELG);
    for (int tok = gw; tok < T; tok += nw)
        peer_gather_token(p, tok, SELI[(size_t)tok * 128 + lane], SELI[(size_t)tok * 128 + 64 + lane], SELG[(size_t)tok * 128 + lane], SELG[(size_t)tok * 128 + 64 + lane], lane);
}
__global__ void __launch_bounds__(512, 2) k_peer_gather(Ptrs p) {
    peer_gather_phase(p, blockIdx.x * 8 + (threadIdx.x >> 6), gridDim.x * 8, threadIdx.x & 63);
}

#include <hip/hip_cooperative_groups.h>
namespace cg = cooperative_groups;
constexpr int CW_Q3 = 64;
constexpr int MISC_OFF = LDS_BYTES - 64;

constexpr int CW_BAR = 4096;
#define XB_TMO      128
#define XB_XCNT(j)  (256  + 64 * (j))
#define XB_XSUB(j)  (1280 + 64 * (j))
#define XB_XGEN(j)  (2304 + 64 * (j))
#define XB_TOP      3328
#define XB_TOPGEN   3392
#define XCD_BAR_WORDS 3456
#define XB_SPIN_CAP (1u << 18)
__device__ __forceinline__ unsigned xb_ld(unsigned* p)              { return __hip_atomic_load(p, __ATOMIC_RELAXED, __HIP_MEMORY_SCOPE_AGENT); }
__device__ __forceinline__ unsigned xb_add(unsigned* p, unsigned v) { return __hip_atomic_fetch_add(p, v, __ATOMIC_RELAXED, __HIP_MEMORY_SCOPE_AGENT); }
__device__ __forceinline__ unsigned xb_xcc_id() { return (unsigned)__builtin_amdgcn_s_getreg((3 << 11) | 20) & 0xFu; }
#define XB_SPIN(cond, bar) do { unsigned _sp = 0; while (cond) { __builtin_amdgcn_s_sleep(1); \
    if ((++_sp & 255u) == 0u) { if (xb_ld(&(bar)[XB_TMO])) break; if (_sp > XB_SPIN_CAP) { atomicAdd(&(bar)[XB_TMO], 1u); break; } } } } while (0)
struct XcdBarrier { unsigned* bar; unsigned x; volatile LAS unsigned* st; };
__device__ __forceinline__ XcdBarrier xcd_barrier_post(unsigned* bar, volatile LAS unsigned* st) {
    XcdBarrier b; b.bar = bar; b.x = xb_xcc_id(); b.st = st;
    if (threadIdx.x == 0) (void)xb_add(&bar[XB_XCNT(b.x)], 1u);
    return b;
}
__device__ __forceinline__ void xcd_barrier_complete(unsigned* bar, unsigned x, unsigned& nloc, unsigned& nx) {
    const unsigned G = gridDim.x * gridDim.y * gridDim.z;
    unsigned sum, cnt, mine, sp = 0u;
    for (;;) {
        sum = 0u; cnt = 0u; mine = 0u;
#pragma unroll
        for (unsigned j = 0; j < 16; ++j) { const unsigned c = xb_ld(&bar[XB_XCNT(j)]); sum += c; cnt += (c > 0u) ? 1u : 0u; mine = (j == x) ? c : mine; }
        if (sum == G) break;
        __builtin_amdgcn_s_sleep(1);
        if ((++sp & 255u) == 0u) { if (xb_ld(&bar[XB_TMO])) break; if (sp > XB_SPIN_CAP) { atomicAdd(&bar[XB_TMO], 1u); break; } }
    }
    nloc = mine > 0u ? mine : 1u; nx = cnt > 0u ? cnt : 1u;
}
__device__ __forceinline__ void xcd_barrier(const XcdBarrier& b) {
    asm volatile("s_waitcnt vmcnt(0)" ::: "memory");
    __syncthreads();
    if (threadIdx.x == 0) {
        unsigned* bar = b.bar;
        __builtin_amdgcn_s_waitcnt(0);
        unsigned nloc = b.st[0], nx = b.st[1];
        if (nloc == 0u) { xcd_barrier_complete(bar, b.x, nloc, nx); b.st[0] = nloc; b.st[1] = nx; }
        const unsigned old = xb_add(&bar[XB_XSUB(b.x)], 1u);
        const unsigned gen = old / nloc;
        if (old + 1u == (gen + 1u) * nloc) {
            __builtin_amdgcn_fence(__ATOMIC_RELEASE, "agent");
            asm volatile("s_waitcnt vmcnt(0)" ::: "memory");
            const unsigned og = xb_add(&bar[XB_TOP], 1u);
            const unsigned tg = og / nx;
            if (og + 1u == (tg + 1u) * nx) xb_add(&bar[XB_TOPGEN], 1u);
            else XB_SPIN(xb_ld(&bar[XB_TOPGEN]) == tg, bar);
            __builtin_amdgcn_fence(__ATOMIC_ACQUIRE, "agent");
            xb_add(&bar[XB_XGEN(b.x)], 1u);
            asm volatile("s_waitcnt vmcnt(0)" ::: "memory");
        } else {
            XB_SPIN(xb_ld(&bar[XB_XGEN(b.x)]) == gen, bar);
            __builtin_amdgcn_fence(__ATOMIC_ACQUIRE, "agent");
            asm volatile("s_waitcnt vmcnt(0)" ::: "memory");
        }
    }
    __syncthreads();
}

__device__ __forceinline__ void prep_w_tile(const float* __restrict__ W, const float* __restrict__ gain, bf16_t* __restrict__ Wt, int K, int Nsrc, int mode, int tn, int tk, LAS float* tile) {
    const int t_ = opaque_tid(), tx = t_ & 63, ty = t_ >> 6, n0 = tn * 64, k0 = tk * 64, n = n0 + tx; const int src = mode ? win_src(n) : n;
    for (int kk = ty; kk < 64; kk += 8) { float v = 0.f; if (src >= 0) { v = W[(size_t)(k0 + kk) * Nsrc + src]; if (gain) v *= gain[k0 + kk]; } tile[kk * 65 + tx] = v; }
    __syncthreads();
    for (int nn = ty; nn < 64; nn += 8) Wt[(size_t)(n0 + nn) * K + k0 + tx] = (bf16_t)f2bf(tile[tx * 65 + nn]);
    __syncthreads();
}
__device__ __forceinline__ void prep_phase(const Ptrs& p, LAS unsigned char* lds) {
    const int tid = opaque_tid(), lane = tid & 63, G = gridDim.x, bx = blockIdx.x;
    unsigned char* ws = p.ws;
    if (bx == 0 && tid == 0) ((unsigned*)(ws + WS_CTL))[CW_Q3] = 0u;
    { float* R = (float*)(ws + WS_RINV2); for (int i = bx * 512 + tid; i < T; i += G * 512) R[i] = 0.f; }
    {
        float2* R32 = (float2*)(ws + WS_ROPE32); float2* R16 = (float2*)(ws + WS_ROPE16);
        for (int i = bx * 512 + tid; i < 4112 * 32; i += G * 512) {
            { const int pos = i >> 5, f = i & 31; const float inv = (float)pow(10000.0, -(double)f / 32.0); const float ang = (float)pos * inv; R32[i] = make_float2((float)cos((double)ang), (float)sin((double)ang)); }
            if (i < 4112 * 16) { const int pos = i >> 4, f = i & 15; const float inv = (float)pow(10000.0, -(double)f / 16.0); const float ang = (float)pos * inv; R16[i] = make_float2((float)cos((double)ang), (float)sin((double)ang)); }
            if (i < 8 * 256) ((float*)(ws + WS_DEC))[i] = (float)pow(1.0 - exp2(-5.0 - (double)(i >> 8)), (double)((i & 255) + 1)); }
    }
    {
        bf16_t* XB = (bf16_t*)(ws + WS_XB);
        for (int r = bx * 8 + (tid >> 6); r < MP; r += G * 8) {
            f32x4 v[4];
            if (r < T + NMETA) { const float* src = r < T ? p.in[0] + (size_t)r * D : p.in[1] + (size_t)(r - T) * D;
#pragma unroll
                for (int j = 0; j < 4; ++j) v[j] = *(const f32x4*)(src + lane * 4 + 256 * j); }
            else {
#pragma unroll
                for (int j = 0; j < 4; ++j) v[j] = (f32x4){0.f, 0.f, 0.f, 0.f}; }
            float ss = 0.f;
#pragma unroll
            for (int j = 0; j < 4; ++j) ss += v[j].x * v[j].x + v[j].y * v[j].y + v[j].z * v[j].z + v[j].w * v[j].w;
            ss = wave_sum(ss);
            const float rinv = rsqrtf(ss * (1.f / D) + EPS);
#pragma unroll
            for (int j = 0; j < 4; ++j) { uint2 o; o.x = pk2(v[j].x * rinv, v[j].y * rinv); o.y = pk2(v[j].z * rinv, v[j].w * rinv); *(uint2*)(XB + (size_t)r * D + lane * 4 + 256 * j) = o; }
        }
    }
    {
        LAS float* tile = (LAS float*)lds;
        constexpr int NT0 = (NIN / 64) * 16, NT1 = NT0 + 12 * 6, NT2 = NT1 + 16 * 4, NT3 = NT2 + 16 * 8, NT4 = NT3 + 256, NT5 = NT4 + 256, NT6 = NT5 + 256;
        for (int it = bx; it < NT6; it += G) {
            if (it < NT0) prep_w_tile(p.in[3], p.in[2], (bf16_t*)(ws + WS_WIN), 1024, 5792, 1, it / 16, it % 16, tile);
            else if (it < NT1) { const int r = it - NT0; prep_w_tile(p.in[5], p.in[4], (bf16_t*)(ws + WS_WUQ), 384, 768, 0, r / 6, r % 6, tile); }
            else if (it < NT2) { const int r = it - NT1; prep_w_tile(p.in[7], p.in[6], (bf16_t*)(ws + WS_WUKV), 256, 1024, 0, r / 4, r % 4, tile); }
            else if (it < NT3) { const int r = it - NT2; prep_w_tile(p.in[10], nullptr, (bf16_t*)(ws + WS_WMLA), 512, 1024, 0, r / 8, r % 8, tile); }
            else if (it < NT4) { const int r = it - NT3; prep_w_tile(p.in[12], nullptr, (bf16_t*)(ws + WS_WRET), 1024, 1024, 0, r / 16, r % 16, tile); }
            else if (it < NT5) { const int r = it - NT4; prep_w_tile(p.in[13], nullptr, (bf16_t*)(ws + WS_WMIX), 1024, 1024, 0, r / 16, r % 16, tile); }
            else { const int r = it - NT5; prep_w_tile(p.in[15], p.in[14], (bf16_t*)(ws + WS_WPQ), 1024, 1024, 0, r / 16, r % 16, tile); }
        }
    }
}
template <int RMODE = 0>
__device__ __forceinline__ void mixer_phase(const Ptrs& p, LAS unsigned char* lds, int lo = 0, int hi_ = 64 + 1024) {
    unsigned* ctl = (unsigned*)(p.ws + WS_CTL);
    volatile LAS unsigned* bc = (volatile LAS unsigned*)(lds + MISC_OFF);
    for (;;) {
        __syncthreads();
        if (threadIdx.x == 0) *bc = __hip_atomic_fetch_add(ctl + CW_Q3, 1u, __ATOMIC_RELAXED, __HIP_MEMORY_SCOPE_AGENT);
        __syncthreads();
        const int it = (int)*bc + lo;
        if (it >= hi_) break;
        if (it < 64) ret_unit<RMODE>(p, lds, it >> 3, it & 7);
        else { const int a = it - 64, qb = 15 - (a >> 6), bh = a & 63; attn_unit(p, lds, bh >> 3, bh & 7, qb); }
    }
}
constexpr int PL_SELI = 2 * 128 * KEY_PITCH, PL_SELG = PL_SELI + 32 * 128 * 4, PL_END = PL_SELG + 32 * 128 * 4;
static_assert(PL_END <= MISC_OFF, "peer LDS");
__device__ __forceinline__ void peer_phase(const Ptrs& p, LAS unsigned char* lds, bool do_store = true) {
    const int tid = opaque_tid(), lane = tid & 63, wid = __builtin_amdgcn_readfirstlane(tid >> 6);
    peer_keys_to_lds(p, lds);
    for (int u = blockIdx.x; u < T / 32; u += gridDim.x) {
        __syncthreads();
        peer_select_unit<LAS int*, LAS float*, LAS u32x4*, LAS f32x4*>(p, lds, u * 32, wid, lane, (LAS int*)(lds + PL_SELI), (LAS float*)(lds + PL_SELG));
        __syncthreads();
#pragma unroll 1
        for (int k = 0; k < 4; ++k) { const int tl = wid * 4 + k;
            const LAS int* ip = (const LAS int*)(lds + PL_SELI) + tl * 128; const LAS float* gp = (const LAS float*)(lds + PL_SELG) + tl * 128;
            peer_gather_token(p, u * 32 + tl, ip[lane], ip[64 + lane], gp[lane], gp[64 + lane], lane, do_store); }
    }
}

constexpr size_t WS_IDXP = WS_RQ, WS_GATEP = WS_RQ + (size_t)T * 128 * 2;
constexpr size_t WS_XQ = WS_XB, WS_XS = WS_XB + (size_t)T * 1024;
constexpr size_t WS_PP = WS_RV;
constexpr size_t WS_WVP = WS_LAT, WS_CORR = WS_LAT + (size_t)T * 128 * 4;
static_assert(WS_GATEP + (size_t)T * 128 * 4 <= WS_RV && WS_XS + (size_t)T * 4 <= WS_LAT && WS_PP + (size_t)T * 8 * 128 * 4 <= WS_K && WS_CORR + (size_t)T * 4 <= WS_RQ, "sliced PEER overlay");
__device__ __forceinline__ void peer_pre_phase(const Ptrs& p, LAS unsigned char* lds) {
    const int tid = opaque_tid(), lane = tid & 63, wid = __builtin_amdgcn_readfirstlane(tid >> 6), G = gridDim.x, bx = blockIdx.x;
    peer_keys_to_lds(p, lds);
    {
        const float* SS2 = (const float*)(p.ws + WS_RINV2); const float* gffn = p.in[14];
        for (int tok = bx * 8 + wid; tok < T; tok += G * 8) {
            const float r2 = rsqrtf(SS2[tok] * (1.f / D) + EPS); const float* hp = p.out + (size_t)tok * D + lane * 16; const float* gp = gffn + lane * 16;
            f32x4 x[4]; float am = 0.f;
#pragma unroll
            for (int j = 0; j < 4; ++j) { x[j] = *(const f32x4*)(hp + 4 * j) * *(const f32x4*)(gp + 4 * j) * r2; am = fmaxf(am, fmaxf(fmaxf(fabsf(x[j].x), fabsf(x[j].y)), fmaxf(fabsf(x[j].z), fabsf(x[j].w)))); }
            am = fmaxf(wave_max(am), 1e-30f); const float inv = 127.f / am; u32x4 w;
#pragma unroll
            for (int j = 0; j < 4; ++j) w[j] = ((unsigned)((int)rintf(x[j].x * inv) & 0xff)) | ((unsigned)((int)rintf(x[j].y * inv) & 0xff) << 8) | ((unsigned)((int)rintf(x[j].z * inv) & 0xff) << 16) | ((unsigned)((int)rintf(x[j].w * inv) & 0xff) << 24);
            *(u32x4*)(p.ws + WS_XQ + (size_t)tok * D + lane * 16) = w;
            if (lane == 0) ((float*)(p.ws + WS_XS))[tok] = am * (1.f / 127.f);
        }
    }
    __syncthreads();
    unsigned short* IDXP = (unsigned short*)(p.ws + WS_IDXP); float* GATEP = (float*)(p.ws + WS_GATEP);
    for (int u = bx; u < T / 32; u += G) {
        int P16[16]; float gt[16]; peer_select_core(p, lds, u * 32, wid, lane, P16, gt);
        const int tok = u * 32 + (lane & 31);
        if ((lane >> 5) == 0) {
#pragma unroll
            for (int r = 0; r < 8; ++r) *(unsigned*)(IDXP + (size_t)tok * 128 + r * 16 + 2 * wid) = (unsigned)P16[r] | ((unsigned)P16[r + 8] << 16); }
        else {
#pragma unroll
            for (int r = 0; r < 8; ++r) *(f32x2_t*)(GATEP + (size_t)tok * 128 + r * 16 + 2 * wid) = (f32x2_t){gt[r], gt[r + 8]}; }
    }
}
__device__ __forceinline__ int treduce8g(const int (&v)[8], int lane) {
    int w[4], x[2];
    const bool b0 = lane & 1, b1 = lane & 2, b2 = lane & 4;
#pragma unroll
    for (int i = 0; i < 4; ++i) { const int keep = b0 ? v[2 * i + 1] : v[2 * i], send = b0 ? v[2 * i] : v[2 * i + 1]; w[i] = keep + __shfl_xor(send, 1); }
#pragma unroll
    for (int i = 0; i < 2; ++i) { const int keep = b1 ? w[2 * i + 1] : w[2 * i], send = b1 ? w[2 * i] : w[2 * i + 1]; x[i] = keep + __shfl_xor(send, 2); }
    const int keep = b2 ? x[1] : x[0], send = b2 ? x[0] : x[1];
    return keep + __shfl_xor(send, 4);
}
#define PEER_IDX16(ia, ib, i) ((int)((((i) < 8 ? ia : ib)[((i) & 7) >> 1] >> (16 * ((i) & 1))) & 0xffffu))
__device__ __forceinline__ void peer_u_phase(const Ptrs& p) {
    const int tid = opaque_tid(), lane = tid & 63, wid = __builtin_amdgcn_readfirstlane(tid >> 6), G = gridDim.x, bx = blockIdx.x;
    const int j = bx & 7, wg = (bx >> 3) * 8 + wid, nwg = (G >> 3) * 8, g = lane >> 3, s = lane & 7;
    const unsigned char* U8 = p.ws + WS_U8 + 128 * j + 16 * s; const unsigned short* IDXP = (const unsigned short*)(p.ws + WS_IDXP); int* PP = (int*)(p.ws + WS_PP);
    int tok = wg; if (tok >= T) return;
    u32x4 ia = *(const u32x4*)(IDXP + (size_t)tok * 128 + g * 16), ib = *(const u32x4*)(IDXP + (size_t)tok * 128 + g * 16 + 8);
    u32x4 xq = *(const u32x4*)(p.ws + WS_XQ + (size_t)tok * D + 128 * j + 16 * s);
    for (; tok < T; tok += nwg) {
        u32x4 r[16];
#pragma unroll
        for (int i = 0; i < 16; ++i) r[i] = *(const u32x4*)(U8 + (size_t)PEER_IDX16(ia, ib, i) * D);
        const u32x4 xc = xq; const int tn = tok + nwg;
        if (tn < T) { ia = *(const u32x4*)(IDXP + (size_t)tn * 128 + g * 16); ib = *(const u32x4*)(IDXP + (size_t)tn * 128 + g * 16 + 8); xq = *(const u32x4*)(p.ws + WS_XQ + (size_t)tn * D + 128 * j + 16 * s); }
        int pa[8], pb[8];
#pragma unroll
        for (int i = 0; i < 16; ++i) { int d = __builtin_amdgcn_sdot4((int)r[i].x, (int)xc.x, 0, false); d = __builtin_amdgcn_sdot4((int)r[i].y, (int)xc.y, d, false); d = __builtin_amdgcn_sdot4((int)r[i].z, (int)xc.z, d, false); d = __builtin_amdgcn_sdot4((int)r[i].w, (int)xc.w, d, false);
            if (i < 8) pa[i] = d; else pb[i - 8] = d; }
        const int ya = treduce8g(pa, lane), yb = treduce8g(pb, lane);
        int* pp = PP + ((size_t)tok * 8 + j) * 128 + 16 * g + s; pp[0] = ya; pp[8] = yb;
    }
}
__device__ __forceinline__ void peer_reduce_phase(const Ptrs& p, int gw, int nw, int lane) {
    const unsigned short* IDXP = (const unsigned short*)(p.ws + WS_IDXP); const float* GATEP = (const float*)(p.ws + WS_GATEP); const int* PP = (const int*)(p.ws + WS_PP);
    const float* SU = (const float*)(p.ws + WS_SU); const float* SV = (const float*)(p.ws + WS_SV); const float* XS = (const float*)(p.ws + WS_XS);
    unsigned char* WQ = p.ws + WS_WVP; float* WSC = (float*)(p.ws + WS_CORR);
    for (int tok = gw; tok < T; tok += nw) {
        const float xs = XS[tok]; float wv[2];
#pragma unroll
        for (int hf = 0; hf < 2; ++hf) { const int pos = lane + 64 * hf; int sum = 0;
#pragma unroll
            for (int j = 0; j < 8; ++j) sum += PP[((size_t)tok * 8 + j) * 128 + pos];
            const int idx = IDXP[(size_t)tok * 128 + pos];
            wv[hf] = GATEP[(size_t)tok * 128 + pos] * gelu_erf((float)sum * SU[idx] * xs) * SV[idx]; }
        const float am = fmaxf(wave_max(fmaxf(fabsf(wv[0]), fabsf(wv[1]))), 1e-30f), inv = 127.f / am;
        WQ[(size_t)tok * 128 + lane] = (unsigned char)((int)rintf(wv[0] * inv) & 0xff); WQ[(size_t)tok * 128 + 64 + lane] = (unsigned char)((int)rintf(wv[1] * inv) & 0xff);
        if (lane == 0) WSC[tok] = am * (1.f / 127.f);
    }
}
__device__ __forceinline__ void tr4x4(unsigned a, unsigned b, unsigned c, unsigned d, unsigned (&t)[4]) {
    const unsigned ab01 = __builtin_amdgcn_perm(b, a, 0x05010400u), ab23 = __builtin_amdgcn_perm(b, a, 0x07030602u), cd01 = __builtin_amdgcn_perm(d, c, 0x05010400u), cd23 = __builtin_amdgcn_perm(d, c, 0x07030602u);
    t[0] = __builtin_amdgcn_perm(cd01, ab01, 0x05040100u); t[1] = __builtin_amdgcn_perm(cd01, ab01, 0x07060302u); t[2] = __builtin_amdgcn_perm(cd23, ab23, 0x05040100u); t[3] = __builtin_amdgcn_perm(cd23, ab23, 0x07060302u);
}
__device__ __forceinline__ void peer_v_phase(const Ptrs& p, bool do_store = true) {
    const int tid = opaque_tid(), lane = tid & 63, wid = __builtin_amdgcn_readfirstlane(tid >> 6), G = gridDim.x, bx = blockIdx.x;
    const int j = bx & 7, wg = (bx >> 3) * 8 + wid, nwg = (G >> 3) * 8, g = lane >> 3, s = lane & 7;
    const unsigned char* V8 = p.ws + WS_V8 + 128 * j + 16 * s; const unsigned short* IDXP = (const unsigned short*)(p.ws + WS_IDXP); const unsigned char* WQ = p.ws + WS_WVP;
    const float* WSC = (const float*)(p.ws + WS_CORR);
    const bool g0 = lane & 8, g1 = lane & 16, g2 = lane & 32;
    const int fsel = 8 * (g0 ? 1 : 0) + 4 * (g1 ? 1 : 0) + 2 * (g2 ? 1 : 0);
    int tok = wg; if (tok >= T) return;
    u32x4 ia = *(const u32x4*)(IDXP + (size_t)tok * 128 + g * 16), ib = *(const u32x4*)(IDXP + (size_t)tok * 128 + g * 16 + 8);
    u32x4 wq = *(const u32x4*)(WQ + (size_t)tok * 128 + g * 16);
    for (; tok < T; tok += nwg) {
        u32x4 r[16];
#pragma unroll
        for (int i = 0; i < 16; ++i) r[i] = *(const u32x4*)(V8 + (size_t)PEER_IDX16(ia, ib, i) * D);
        const u32x4 wc = wq; const int tn = tok + nwg;
        if (tn < T) { ia = *(const u32x4*)(IDXP + (size_t)tn * 128 + g * 16); ib = *(const u32x4*)(IDXP + (size_t)tn * 128 + g * 16 + 8); wq = *(const u32x4*)(WQ + (size_t)tn * 128 + g * 16); }
        float* op = p.out + (size_t)tok * D + 128 * j + 16 * s + fsel;
        const f32x2_t hv = *(const f32x2_t*)op; const float wsc = WSC[tok];
        int acc[16];
#pragma unroll
        for (int e = 0; e < 16; ++e) acc[e] = 0;
#pragma unroll
        for (int m = 0; m < 4; ++m)
#pragma unroll
            for (int q = 0; q < 4; ++q) { unsigned t4[4]; tr4x4(r[4 * m][q], r[4 * m + 1][q], r[4 * m + 2][q], r[4 * m + 3][q], t4);
#pragma unroll
                for (int f = 0; f < 4; ++f) acc[4 * q + f] = __builtin_amdgcn_sdot4((int)t4[f], (int)wc[m], acc[4 * q + f], false); }
        int w8[8], x4[4], y2[2];
#pragma unroll
        for (int m = 0; m < 8; ++m) { const int keep = g0 ? acc[8 + m] : acc[m], send = g0 ? acc[m] : acc[8 + m]; w8[m] = keep + __shfl_xor(send, 8); }
#pragma unroll
        for (int m = 0; m < 4; ++m) { const int keep = g1 ? w8[4 + m] : w8[m], send = g1 ? w8[m] : w8[4 + m]; x4[m] = keep + __shfl_xor(send, 16); }
#pragma unroll
        for (int m = 0; m < 2; ++m) { const int keep = g2 ? x4[2 + m] : x4[m], send = g2 ? x4[m] : x4[2 + m]; y2[m] = keep + __shfl_xor(send, 32); }
        if (do_store || y2[0] == 0x7fffffff) *(f32x2_t*)op = (f32x2_t){hv.x + (float)y2[0] * wsc, hv.y + (float)y2[1] * wsc};
    }
}

__global__ void __launch_bounds__(512, 2) k_mega(Ptrs p) {
    extern __shared__ __attribute__((aligned(16))) unsigned char lds_raw[];
    LAS unsigned char* lds = (LAS unsigned char*)lds_raw;
    cg::grid_group grid = cg::this_grid();
    if (threadIdx.x < 16) ((volatile LAS unsigned*)(lds + MISC_OFF))[threadIdx.x] = 0u;
    __syncthreads();
    const XcdBarrier xbar = xcd_barrier_post((unsigned*)(p.ws + WS_CTL) + CW_BAR, (volatile LAS unsigned*)(lds + MISC_OFF + 16));
    unsigned char* ws = p.ws;
    const int G = gridDim.x, bx = blockIdx.x, nw = G * 8;
    bf16_t *WIN = (bf16_t*)(ws + WS_WIN), *WUQ = (bf16_t*)(ws + WS_WUQ), *WUKV = (bf16_t*)(ws + WS_WUKV), *WMLA = (bf16_t*)(ws + WS_WMLA), *WRET = (bf16_t*)(ws + WS_WRET),
           *WMIX = (bf16_t*)(ws + WS_WMIX), *WPQ = (bf16_t*)(ws + WS_WPQ);
    bf16_t *XB = (bf16_t*)(ws + WS_XB), *LAT = (bf16_t*)(ws + WS_LAT), *RQ = (bf16_t*)(ws + WS_RQ), *RK = (bf16_t*)(ws + WS_RK), *RV = (bf16_t*)(ws + WS_RV), *RG = (bf16_t*)(ws + WS_RG);
    bf16_t *SA = (bf16_t*)p.out, *SR = SA + (size_t)T * 1024;
    bf16_t *Q = (bf16_t*)(ws + WS_Q), *K = (bf16_t*)(ws + WS_K), *VRAW = (bf16_t*)(ws + WS_VRAW), *AO = (bf16_t*)(ws + WS_AO), *RET = (bf16_t*)(ws + WS_RET), *MG = (bf16_t*)(ws + WS_MG),
           *H1B = (bf16_t*)(ws + WS_H1B), *PQ = (bf16_t*)(ws + WS_PQ);
    pg8::StaticOrder S;
#ifndef PROBE_DUP
#define PROBE_DUP 0
#endif
    prep_phase(p, lds);
    if (PROBE_DUP == 4) { __syncthreads(); prep_phase(p, lds); }
    if (PROBE_DUP == 5) { for (int i_ = 0; i_ < 8; ++i_) grid.sync(); }
    grid.sync();
    { pg8::Gemm g{XB, WIN, 1024, 1024, MP, NIN, 1024, 0}; S.init(MP, NIN, G, bx); pg8::gemm_phase(lds, g, S, EpiIn{LAT, RQ, RK, RV, RG, SA, SR, (const float2*)(ws + WS_ROPE32), (const float*)(ws + WS_DEC)}); }
    if (PROBE_DUP == 8) { pg8::Gemm g{XB, WIN, 1024, 1024, MP, NIN, 1024, 0}; S.init(MP, NIN, G, bx); pg8::gemm_phase(lds, g, S, EpiNull{(float*)(ws + WS_RINV2)}); }
    if (PROBE_DUP == 3) { pg8::Gemm g{XB, WIN, 1024, 1024, MP, NIN, 1024, 0}; S.init(MP, NIN, G, bx); pg8::gemm_phase(lds, g, S, EpiIn{LAT, RQ, RK, RV, RG, SA, SR, (const float2*)(ws + WS_ROPE32), (const float*)(ws + WS_DEC)}); }
    xcd_barrier(xbar);
    { pg8::Gemm g{LAT, WUQ, 768, 384, T, 768, 384, 0}; S.init(T, 768, G, bx); pg8::gemm_phase(lds, g, S, EpiQraw{Q}); }
    { pg8::Gemm g{LAT + 384, WUKV, 768, 256, MP, 1024, 256, 0}; S.init(MP, 1024, G, bx); pg8::gemm_phase(lds, g, S, EpiKVraw{K, VRAW}); }
    if (PROBE_DUP == 20) { { pg8::Gemm g{LAT, WUQ, 768, 384, T, 768, 384, 0}; S.init(T, 768, G, bx); pg8::gemm_phase(lds, g, S, EpiQraw{Q}); }
      { pg8::Gemm g{LAT + 384, WUKV, 768, 256, MP, 1024, 256, 0}; S.init(MP, 1024, G, bx); pg8::gemm_phase(lds, g, S, EpiKVraw{K, VRAW}); } }
    xcd_barrier(xbar);
    finalize_phase(p, lds);
    xcd_barrier(xbar);
    mixer_phase(p, lds);
    xcd_barrier(xbar);
    if (PROBE_DUP == 2 || PROBE_DUP == 6 || PROBE_DUP == 7) { if (bx == 0 && threadIdx.x == 0) ((unsigned*)(ws + WS_CTL))[CW_Q3] = 0u; xcd_barrier(xbar); mixer_phase(p, lds, PROBE_DUP == 6 ? 64 : 0, PROBE_DUP == 7 ? 64 : 64 + 1024); xcd_barrier(xbar); }
#ifdef PROBE_RMODE
    { if (bx == 0 && threadIdx.x == 0) ((unsigned*)(ws + WS_CTL))[CW_Q3] = 0u; xcd_barrier(xbar); mixer_phase<PROBE_RMODE>(p, lds, 0, 64); xcd_barrier(xbar); }
#endif
    { const int t_ = opaque_tid(); prep_uv_part(p, bx * 8 + (t_ >> 6), nw, t_ & 63); }
    { pg8::Gemm g{AO, WMLA, 512, 512, T, 1024, 512, 0}; S.init(T, 1024, G, bx); pg8::gemm_phase(lds, g, S, EpiMerge1{MG, SA}); }
    if (PROBE_DUP == 21) { pg8::Gemm g{AO, WMLA, 512, 512, T, 1024, 512, 0}; S.init(T, 1024, G, bx); pg8::gemm_phase(lds, g, S, EpiMerge1{MG, SA}); }
    if (PROBE_DUP == 22) { const int t_ = opaque_tid(); prep_uv_part(p, bx * 8 + (t_ >> 6), nw, t_ & 63); }
    { pg8::Gemm g{RET, WRET, 1024, 1024, T, 1024, 1024, 0}; S.init(T, 1024, G, bx); pg8::gemm_phase(lds, g, S, EpiMerge2{MG, SR}); }
    xcd_barrier(xbar);
    { pg8::Gemm g{MG, WMIX, 1024, 1024, T, 1024, 1024, 0}; S.init(T, 1024, G, bx); pg8::gemm_phase(lds, g, S, EpiMix{p.in[0], p.out, H1B, (float*)(ws + WS_RINV2)}); }
    xcd_barrier(xbar);
    { pg8::Gemm g{H1B, WPQ, 1024, 1024, T, 1024, 1024, 0}; S.init(T, 1024, G, bx); pg8::gemm_phase(lds, g, S, EpiPQ{PQ, (const float*)(ws + WS_RINV2)}); }
    if (PROBE_DUP == 23) { pg8::Gemm g{H1B, WPQ, 1024, 1024, T, 1024, 1024, 0}; S.init(T, 1024, G, bx); pg8::gemm_phase(lds, g, S, EpiPQ{PQ, (const float*)(ws + WS_RINV2)}); }
    xcd_barrier(xbar);
#ifndef PEER_SLICED
#define PEER_SLICED 1
#endif
    if (PEER_SLICED) {
        peer_pre_phase(p, lds);
        if (PROBE_DUP == 10) { __syncthreads(); peer_pre_phase(p, lds); }
        xcd_barrier(xbar);
        peer_u_phase(p);
        if (PROBE_DUP == 11) peer_u_phase(p);
        xcd_barrier(xbar);
        { const int t_ = opaque_tid(); peer_reduce_phase(p, bx * 8 + (t_ >> 6), nw, t_ & 63); }
        if (PROBE_DUP == 12) { const int t_ = opaque_tid(); peer_reduce_phase(p, bx * 8 + (t_ >> 6), nw, t_ & 63); }
        xcd_barrier(xbar);
        if (PROBE_DUP == 13) peer_v_phase(p, false);
        peer_v_phase(p);
    } else {
        if (PROBE_DUP == 1) { peer_phase(p, lds, false); __syncthreads(); }
        peer_phase(p, lds);
    }
}

#ifndef USE_REF_GEMM
#define USE_REF_GEMM 0
#endif
template <class Epi> static void launch_gemm(hipStream_t st, const bf16_t* A, int lda, const bf16_t* Bt, int ldb, int M, int N, int K, Epi E) {
    if (USE_REF_GEMM) { hipLaunchKernelGGL(gemm_ref<Epi>, dim3(N / 128, M / 64), dim3(256), 0, st, A, lda, Bt, ldb, K, E); return; }
    static bool attr_done = false;
    if (!attr_done) { (void)hipFuncSetAttribute((const void*)k_gemm<Epi>, hipFuncAttributeMaxDynamicSharedMemorySize, LDS_BYTES); attr_done = true; }
    pg8::Gemm g{A, Bt, lda, ldb, M, N, K, 0};
    hipLaunchKernelGGL(k_gemm<Epi>, dim3(256), dim3(512), LDS_BYTES, st, g, E);
}
#ifndef MEGA
#define MEGA 1
#endif
extern "C" void kernel_launch(void* const* d_in, const int* in_sizes, int n_in, void* d_out, int out_size, void* d_ws, size_t ws_size, hipStream_t stream) {
    Ptrs p{}; for (int i = 0; i < 20; ++i) p.in[i] = (const float*)d_in[i]; p.out = (float*)d_out; p.ws = (unsigned char*)d_ws;
#if MEGA
    static int grid = 0;
    if (grid == 0) {
        int dev = 0, cus = 0, per_cu = 0;
        (void)hipGetDevice(&dev); (void)hipDeviceGetAttribute(&cus, hipDeviceAttributeMultiprocessorCount, dev);
        (void)hipFuncSetAttribute((const void*)k_mega, hipFuncAttributeMaxDynamicSharedMemorySize, LDS_BYTES);
        (void)hipOccupancyMaxActiveBlocksPerMultiprocessor(&per_cu, (const void*)k_mega, 512, LDS_BYTES);
        if (per_cu < 1) per_cu = 1;
        grid = cus * (per_cu > 1 ? 1 : per_cu);
        if (grid % 8) grid -= grid % 8;
    }
    (void)hipMemsetAsync(d_ws, 0, 65536, stream);
    void* args[] = {&p};
    (void)hipLaunchCooperativeKernel((const void*)k_mega, dim3(grid), dim3(512), args, LDS_BYTES, stream);
    return;
#endif
    unsigned char* ws = p.ws;
    bf16_t *WIN = (bf16_t*)(ws + WS_WIN), *WUQ = (bf16_t*)(ws + WS_WUQ), *WUKV = (bf16_t*)(ws + WS_WUKV), *WMLA = (bf16_t*)(ws + WS_WMLA), *WRET = (bf16_t*)(ws + WS_WRET),
           *WMIX = (bf16_t*)(ws + WS_WMIX), *WPQ = (bf16_t*)(ws + WS_WPQ);
    bf16_t *XB = (bf16_t*)(ws + WS_XB), *LAT = (bf16_t*)(ws + WS_LAT), *RQ = (bf16_t*)(ws + WS_RQ), *RK = (bf16_t*)(ws + WS_RK), *RV = (bf16_t*)(ws + WS_RV), *RG = (bf16_t*)(ws + WS_RG);
    bf16_t *SA = (bf16_t*)d_out, *SR = SA + (size_t)T * 1024;
    bf16_t *Q = (bf16_t*)(ws + WS_Q), *K = (bf16_t*)(ws + WS_K), *V = (bf16_t*)(ws + WS_VRAW), *AO = (bf16_t*)(ws + WS_AO), *RET = (bf16_t*)(ws + WS_RET), *MG = (bf16_t*)(ws + WS_MG),
           *H1B = (bf16_t*)(ws + WS_H1B), *PQ = (bf16_t*)(ws + WS_PQ);
    hipLaunchKernelGGL(k_prep_rows, dim3(1024), dim3(256), 0, stream, p);
    hipLaunchKernelGGL(k_prep_rope, dim3((4112 * 32 + 255) / 256), dim3(256), 0, stream, p);
    hipLaunchKernelGGL(k_prep_w<1>, dim3(NIN / 64, 1024 / 64), dim3(256), 0, stream, p.in[3], p.in[2], WIN, 1024, 5792, NIN);
    hipLaunchKernelGGL(k_prep_w<0>, dim3(768 / 64, 384 / 64), dim3(256), 0, stream, p.in[5], p.in[4], WUQ, 384, 768, 768);
    hipLaunchKernelGGL(k_prep_w<0>, dim3(1024 / 64, 256 / 64), dim3(256), 0, stream, p.in[7], p.in[6], WUKV, 256, 1024, 1024);
    hipLaunchKernelGGL(k_prep_w<0>, dim3(1024 / 64, 512 / 64), dim3(256), 0, stream, p.in[10], (const float*)nullptr, WMLA, 512, 1024, 1024);
    hipLaunchKernelGGL(k_prep_w<0>, dim3(1024 / 64, 1024 / 64), dim3(256), 0, stream, p.in[12], (const float*)nullptr, WRET, 1024, 1024, 1024);
    hipLaunchKernelGGL(k_prep_w<0>, dim3(1024 / 64, 1024 / 64), dim3(256), 0, stream, p.in[13], (const float*)nullptr, WMIX, 1024, 1024, 1024);
    hipLaunchKernelGGL(k_prep_w<0>, dim3(1024 / 64, 1024 / 64), dim3(256), 0, stream, p.in[15], p.in[14], WPQ, 1024, 1024, 1024);
    launch_gemm(stream, XB, 1024, WIN, 1024, MP, NIN, 1024, EpiIn{LAT, RQ, RK, RV, RG, SA, SR, (const float2*)(ws + WS_ROPE32), (const float*)(ws + WS_DEC)});
    launch_gemm(stream, LAT, 768, WUQ, 384, T, 768, 384, EpiQraw{Q});
    launch_gemm(stream, LAT + 384, 768, WUKV, 256, MP, 1024, 256, EpiKVraw{K, V});
    { static bool ad = false; if (!ad) { (void)hipFuncSetAttribute((const void*)k_finalize, hipFuncAttributeMaxDynamicSharedMemorySize, FIN_LDS); ad = true; }
      hipLaunchKernelGGL(k_finalize, dim3(256), dim3(512), FIN_LDS, stream, p); }
#ifndef USE_REF_ATTN
#define USE_REF_ATTN 0
#endif
    if (USE_REF_ATTN) hipLaunchKernelGGL(k_attn_naive, dim3(SEQ / 64, 8, BATCH), dim3(64), 0, stream, p);
    else hipLaunchKernelGGL(k_attn, dim3(256), dim3(512), ATT_LDS, stream, p);
#ifndef USE_REF_RET
#define USE_REF_RET 0
#endif
    if (USE_REF_RET) hipLaunchKernelGGL(k_ret_naive, dim3(64), dim3(128), 0, stream, p);
    else { static bool ad = false; if (!ad) { (void)hipFuncSetAttribute((const void*)k_ret, hipFuncAttributeMaxDynamicSharedMemorySize, RT_LDS); ad = true; }
        hipLaunchKernelGGL(k_ret, dim3(64), dim3(512), RT_LDS, stream, p); }
    launch_gemm(stream, AO, 512, WMLA, 512, T, 1024, 512, EpiMerge1{MG, SA});
    launch_gemm(stream, RET, 1024, WRET, 1024, T, 1024, 1024, EpiMerge2{MG, SR});
    hipLaunchKernelGGL(k_zero_ss2, dim3(128), dim3(256), 0, stream, p);
    launch_gemm(stream, MG, 1024, WMIX, 1024, T, 1024, 1024, EpiMix{p.in[0], p.out, H1B, (float*)(ws + WS_RINV2)});
    launch_gemm(stream, H1B, 1024, WPQ, 1024, T, 1024, 1024, EpiPQ{PQ, (const float*)(ws + WS_RINV2)});
#ifndef USE_REF_SELECT
#define USE_REF_SELECT 0
#endif
    if (USE_REF_SELECT) hipLaunchKernelGGL(k_peer_select_naive, dim3(T * 8 / 32), dim3(32), 0, stream, p);
    else hipLaunchKernelGGL(k_peer_select, dim3(256), dim3(512), 2 * 128 * KEY_PITCH, stream, p, 0);
#ifdef DBG_SEL
    hipMemsetAsync(p.ws + WS_CTL, 0, 4096, stream);
    hipLaunchKernelGGL(k_peer_select256, dim3(512), dim3(256), 2 * 128 * KEY_PITCH, stream, p, 1);
    hipLaunchKernelGGL(k_dbg_cmp_sel, dim3(T * 8 / 256), dim3(256), 0, stream, p, DBG_SEL);
#ifdef DBG_SCORES
    hipLaunchKernelGGL(k_dbg_cmp_scores, dim3(1024 * 8 * 2 * 128 / 256), dim3(256), 0, stream, p);
#endif
#endif
#ifndef USE_REF_GATHER
#define USE_REF_GATHER 0
#endif
    if (USE_REF_GATHER) hipLaunchKernelGGL(k_peer_gather_naive, dim3(T), dim3(256), 0, stream, p);
    else { hipLaunchKernelGGL(k_prep_uv, dim3(512), dim3(512), 0, stream, p); hipLaunchKernelGGL(k_peer_gather, dim3(256), dim3(512), 0, stream, p); }
#ifdef DBG_SEL
    hipLaunchKernelGGL(k_dbg_scale, dim3(2048), dim3(256), 0, stream, p, DBG_SEL == 3 ? (float)(1024 * 8 * 2 * 128) : DBG_SEL == 2 ? (float)T * 128 : (float)T * 8, DBG_SEL);
#endif
}
```

```cpp
#include <hip/hip_runtime.h>
#include <stdint.h>
#include <math.h>
#include <utility>

typedef unsigned short bf16_t;
#define LAS __attribute__((address_space(3)))
#define LDS_BARRIER() do { asm volatile("s_waitcnt lgkmcnt(0)" ::: "memory"); __builtin_amdgcn_s_barrier(); asm volatile("" ::: "memory"); } while (0)
typedef float f32x4 __attribute__((ext_vector_type(4)));
typedef unsigned u32x4 __attribute__((ext_vector_type(4)));
typedef unsigned u32x2 __attribute__((ext_vector_type(2)));

constexpr int D = 1024, BATCH = 8, SEQ = 4096, NMETA = 16;
constexpr int T = BATCH * SEQ;
constexpr int MP = 33024;
constexpr float EPS = 1e-6f;
constexpr int NIN = 5888;
constexpr int C_LAT = 0, C_RQ = 768, C_RK = 1280, C_RV = 1792, C_RG = 2816, C_SA = 3840, C_SR = 4864;
constexpr float QSCALE = 1.4426950408889634f * 0.10206207261596575f;

constexpr size_t al(size_t x) { return (x + 255) & ~(size_t)255; }
constexpr size_t WS_CTL = 0;
constexpr size_t WS_WIN = 1u << 20;
constexpr size_t WS_WUQ = WS_WIN + al((size_t)NIN * 1024 * 2);
constexpr size_t WS_WUKV = WS_WUQ + al((size_t)768 * 384 * 2);
constexpr size_t WS_WMLA = WS_WUKV + al((size_t)1024 * 256 * 2);
constexpr size_t WS_WRET = WS_WMLA + al((size_t)1024 * 512 * 2);
constexpr size_t WS_WMIX = WS_WRET + al((size_t)1024 * 1024 * 2);
constexpr size_t WS_WPQ = WS_WMIX + al((size_t)1024 * 1024 * 2);
constexpr size_t WS_KEYS = WS_WPQ + al((size_t)1024 * 1024 * 2);
constexpr size_t WS_ROPE32 = WS_KEYS + al((size_t)2 * 128 * 64 * 2);
constexpr size_t WS_ROPE16 = WS_ROPE32 + al((size_t)4112 * 32 * 8);
constexpr size_t WS_DEC = WS_ROPE16 + al((size_t)4112 * 16 * 8);
constexpr size_t WS_RINV2 = WS_DEC + al((size_t)8 * 256 * 4);
constexpr size_t WS_XB = WS_RINV2 + al((size_t)T * 4);
constexpr size_t WS_LAT = WS_XB + al((size_t)MP * 1024 * 2);
constexpr size_t WS_RQ = WS_LAT + al((size_t)MP * 768 * 2);
constexpr size_t WS_RK = WS_RQ + al((size_t)MP * 512 * 2);
constexpr size_t WS_RV = WS_RK + al((size_t)MP * 512 * 2);
constexpr size_t WS_RG = WS_RV + al((size_t)MP * 1024 * 2);
constexpr size_t WS_K = WS_RG + al((size_t)T * 1024 * 2);
constexpr size_t WS_V = WS_K + al((size_t)MP * 768 * 2);
constexpr int VT_LEN = 4160;
constexpr size_t WS_RET = WS_V + al((size_t)64 * 64 * VT_LEN * 2);

constexpr size_t WS_END = WS_RET + al((size_t)T * 1024 * 2);
static_assert(WS_END <= 536870912ull, "workspace map exceeds 512 MiB");
constexpr size_t WS_Q = WS_XB, WS_MG = WS_XB, WS_AO = WS_LAT, WS_H1B = WS_RV, WS_PQ = WS_RG, WS_SELI = WS_RQ, WS_SELG = WS_RQ + (size_t)T * 128 * 4;
static_assert(WS_SELG + (size_t)T * 128 * 4 <= WS_RV, "SEL overlay");
constexpr size_t WS_VRAW = WS_RET, WS_VT = WS_V;
__host__ __device__ __forceinline__ int vt_pos(int tile, int k) { const int x = k & 15; return 64 * tile + (k & 48) + ((x >= 4 && x < 12) ? (x ^ 12) : x); }

__device__ __forceinline__ unsigned f2bf(float f) { unsigned u = __builtin_bit_cast(unsigned, f); return (u + 0x7fffu + ((u >> 16) & 1u)) >> 16; }
__device__ __forceinline__ float bf2f(unsigned h) { return __builtin_bit_cast(float, h << 16); }
__device__ __forceinline__ unsigned pk2(float lo, float hi) { return f2bf(lo) | (f2bf(hi) << 16); }
__device__ __forceinline__ float wave_sum(float v) {
#pragma unroll
    for (int o = 1; o < 64; o <<= 1) v += __shfl_xor(v, o);
    return v;
}
__device__ __forceinline__ int row_pos(int row) { return row < T ? NMETA + (row & (SEQ - 1)) : (row - T < NMETA ? row - T : 0); }
__device__ __forceinline__ float sigmoidf_(float x) { return __builtin_amdgcn_rcpf(1.f + __builtin_amdgcn_exp2f(-1.4426950408889634f * x)); }

__device__ __forceinline__ int opaque_tid() { int t = threadIdx.x; asm volatile("" : "+v"(t)); return t; }

struct Ptrs {
    const float* in[20];
    float* out;
    unsigned char* ws;
};

__global__ void __launch_bounds__(256) k_prep_rows(Ptrs p) {
    const int lane = threadIdx.x & 63, gw = (blockIdx.x * 256 + threadIdx.x) >> 6, nw = (gridDim.x * 256) >> 6;
    bf16_t* XB = (bf16_t*)(p.ws + WS_XB);
    for (int r = gw; r < MP; r += nw) {
        f32x4 v[4];
        if (r < T + NMETA) {
            const float* src = r < T ? p.in[0] + (size_t)r * D : p.in[1] + (size_t)(r - T) * D;
#pragma unroll
            for (int j = 0; j < 4; ++j) v[j] = *(const f32x4*)(src + lane * 4 + 256 * j);
        } else {
#pragma unroll
            for (int j = 0; j < 4; ++j) v[j] = (f32x4){0.f, 0.f, 0.f, 0.f};
        }
        float ss = 0.f;
#pragma unroll
        for (int j = 0; j < 4; ++j) ss += v[j].x * v[j].x + v[j].y * v[j].y + v[j].z * v[j].z + v[j].w * v[j].w;
        ss = wave_sum(ss);
        const float rinv = rsqrtf(ss * (1.f / D) + EPS);
#pragma unroll
        for (int j = 0; j < 4; ++j) {
            uint2 o; o.x = pk2(v[j].x * rinv, v[j].y * rinv); o.y = pk2(v[j].z * rinv, v[j].w * rinv);
            *(uint2*)(XB + (size_t)r * D + lane * 4 + 256 * j) = o;
        }
    }
}

__device__ __forceinline__ int win_src(int n) {
    if (n < 672) return n;
    if (n < 768) return -1;
    if (n < C_RV) { const int base = n < C_RK ? 672 : 1184, q = (n - (n < C_RK ? C_RQ : C_RK)), hh = q >> 6, pp = q & 63; return base + hh * 64 + (pp >> 1) + 32 * (pp & 1); }
    if (n < C_RG) return 1696 + (n - C_RV);
    if (n < C_SA) return 2720 + (n - C_RG);
    if (n < C_SR) return 3744 + (n - C_SA);
    return 4768 + (n - C_SR);
}
template <int MODE>
__global__ void __launch_bounds__(256) k_prep_w(const float* __restrict__ W, const float* __restrict__ gain, bf16_t* __restrict__ Wt, int K, int Nsrc, int Ndst) {
    __shared__ float tile[64][65];
    const int n0 = blockIdx.x * 64, k0 = blockIdx.y * 64, tx = threadIdx.x & 63, ty = threadIdx.x >> 6;
    const int n = n0 + tx; const int src = MODE == 1 ? win_src(n) : n;
    for (int kk = ty; kk < 64; kk += 4) {
        float v = 0.f;
        if (src >= 0 && n < Ndst) { v = W[(size_t)(k0 + kk) * Nsrc + src]; if (gain) v *= gain[k0 + kk]; }
        tile[kk][tx] = v;
    }
    __syncthreads();
    for (int nn = ty; nn < 64; nn += 4) if (n0 + nn < Ndst) Wt[(size_t)(n0 + nn) * K + k0 + tx] = (bf16_t)f2bf(tile[tx][nn]);
}
__global__ void k_prep_rope(Ptrs p) {
    const int i = blockIdx.x * blockDim.x + threadIdx.x;
    float2* R32 = (float2*)(p.ws + WS_ROPE32); float2* R16 = (float2*)(p.ws + WS_ROPE16);
    if (i < 4112 * 32) { const int pos = i >> 5, f = i & 31; const float inv = (float)pow(10000.0, -(double)f / 32.0); const float ang = (float)pos * inv; R32[i] = make_float2((float)cos((double)ang), (float)sin((double)ang)); }
    if (i < 4112 * 16) { const int pos = i >> 4, f = i & 15; const float inv = (float)pow(10000.0, -(double)f / 16.0); const float ang = (float)pos * inv; R16[i] = make_float2((float)cos((double)ang), (float)sin((double)ang)); }
    if (i < 8 * 256) ((float*)(p.ws + WS_DEC))[i] = (float)pow(1.0 - exp2(-5.0 - (double)(i >> 8)), (double)((i & 255) + 1));
}

typedef float f32x2_t __attribute__((ext_vector_type(2)));
typedef __bf16 bf16x2v_t __attribute__((ext_vector_type(2)));
__device__ __forceinline__ unsigned cvtpk(float lo, float hi) { const f32x2_t v = {lo, hi}; return __builtin_bit_cast(unsigned, __builtin_convertvector(v, bf16x2v_t)); }
__device__ __forceinline__ void st8(bf16_t* dst, const float (&v)[8]) {
    u32x4 w; w.x = cvtpk(v[0], v[1]); w.y = cvtpk(v[2], v[3]); w.z = cvtpk(v[4], v[5]); w.w = cvtpk(v[6], v[7]);
#ifdef NT_STORE
    __builtin_nontemporal_store(w, (u32x4*)dst);
#else
    *(u32x4*)dst = w;
#endif
}
struct EpiIn {
    bf16_t *LAT, *RQ, *RK, *RV, *RG; unsigned char *SA8, *SR8; const float2* R32; const float* DEC;
    __device__ __forceinline__ void apply(int row, int col0, const float (&v)[8]) const {
        if (col0 < C_RQ) { st8(LAT + (size_t)row * 768 + col0, v); return; }
        if (col0 < C_RV) {
            const bool isq = col0 < C_RK; const int c = col0 - (isq ? C_RQ : C_RK); const int i0 = (c & 63) >> 1;
            const int hh = c >> 6, cc = row < T ? (row & 127) : (row - T);
            const float dq = DEC[hh * 256 + cc];
            const float2* rp = R32 + row_pos(row) * 32 + i0; const float sc = isq ? dq : 0.125f * __builtin_amdgcn_rcpf(dq);
            float o[8];
#pragma unroll
            for (int j = 0; j < 4; ++j) { const float2 cs = rp[j]; const float x1 = v[2 * j], x2 = v[2 * j + 1]; o[2 * j] = (x1 * cs.x - x2 * cs.y) * sc; o[2 * j + 1] = (x1 * cs.y + x2 * cs.x) * sc; }
            st8((isq ? RQ : RK) + (size_t)row * 512 + c, o); return;
        }
        if (col0 < C_RG) { st8(RV + (size_t)row * 1024 + (col0 - C_RV), v); return; }
        if (row >= T) return;
        float o[8];
        if (col0 < C_SA) {
#pragma unroll
            for (int j = 0; j < 8; ++j) o[j] = v[j] * sigmoidf_(v[j]);
            st8(RG + (size_t)row * 1024 + (col0 - C_RG), o); return;
        }
        unsigned w0 = 0u, w1 = 0u;
#pragma unroll
        for (int j = 0; j < 4; ++j) { w0 |= (unsigned)(int)rintf(255.f * sigmoidf_(v[j])) << (8 * j); w1 |= (unsigned)(int)rintf(255.f * sigmoidf_(v[4 + j])) << (8 * j); }
        unsigned char* gdst = (col0 < C_SR ? SA8 + (size_t)row * 1024 + (col0 - C_SA) : SR8 + (size_t)row * 1024 + (col0 - C_SR));
        *(u32x2*)gdst = (u32x2){w0, w1};
    }
};
struct EpiNull { float* sink; __device__ __forceinline__ void apply(int row, int col0, const float (&v)[8]) const { if (v[0] == 1.2345e30f) sink[row] = v[1] + v[2] + v[3] + v[4] + v[5] + v[6] + v[7]; } };
struct EpiQraw { bf16_t* Q; __device__ __forceinline__ void apply(int row, int col0, const float (&v)[8]) const { st8(Q + (size_t)row * 768 + col0, v); } };
struct EpiKVraw {
    bf16_t *K, *V;
    __device__ __forceinline__ void apply(int row, int col0, const float (&v)[8]) const {
        const int h = col0 >> 7, j = col0 & 127;
        if (j < 64) st8(K + (size_t)row * 768 + h * 96 + j, v); else st8(V + (size_t)row * 512 + h * 64 + (j - 64), v);
    }
};
__device__ __forceinline__ void ld8(const bf16_t* src, float (&o)[8]) {
    const u32x4 w = *(const u32x4*)src;
    o[0] = bf2f(w.x & 0xffff); o[1] = bf2f(w.x >> 16); o[2] = bf2f(w.y & 0xffff); o[3] = bf2f(w.y >> 16);
    o[4] = bf2f(w.z & 0xffff); o[5] = bf2f(w.z >> 16); o[6] = bf2f(w.w & 0xffff); o[7] = bf2f(w.w >> 16);
}
__device__ __forceinline__ void ldg8(const unsigned char* src, float (&o)[8]) {
    const u32x2 w = *(const u32x2*)src;
#pragma unroll
    for (int j = 0; j < 4; ++j) { o[j] = (float)((w.x >> (8 * j)) & 0xffu) * (1.f / 255.f); o[4 + j] = (float)((w.y >> (8 * j)) & 0xffu) * (1.f / 255.f); }
}
struct EpiMerge1 { bf16_t* MG; const unsigned char* SA;
    __device__ __forceinline__ void apply(int row, int col0, const float (&v)[8]) const {
        float g[8], o[8]; ldg8(SA + (size_t)row * 1024 + col0, g);
#pragma unroll
        for (int j = 0; j < 8; ++j) o[j] = g[j] * v[j];
        st8(MG + (size_t)row * 1024 + col0, o); } };
struct EpiMerge2 { bf16_t* MG; const unsigned char* SR;
    __device__ __forceinline__ void apply(int row, int col0, const float (&v)[8]) const {
        float g[8], m[8], o[8]; ldg8(SR + (size_t)row * 1024 + col0, g); ld8(MG + (size_t)row * 1024 + col0, m);
#pragma unroll
        for (int j = 0; j < 8; ++j) o[j] = m[j] + g[j] * v[j];
        st8(MG + (size_t)row * 1024 + col0, o); } };
struct EpiMix { const float* x; float* out; bf16_t* H1B; float* SS2;
    __device__ __forceinline__ void apply(int row, int col0, const float (&v)[8]) const {
        const f32x4 a = *(const f32x4*)(x + (size_t)row * D + col0), b = *(const f32x4*)(x + (size_t)row * D + col0 + 4);
        float o[8] = {a.x + v[0], a.y + v[1], a.z + v[2], a.w + v[3], b.x + v[4], b.y + v[5], b.z + v[6], b.w + v[7]};
        if (out) { *(f32x4*)(out + (size_t)row * D + col0) = (f32x4){o[0], o[1], o[2], o[3]}; *(f32x4*)(out + (size_t)row * D + col0 + 4) = (f32x4){o[4], o[5], o[6], o[7]}; }
        st8(H1B + (size_t)row * D + col0, o);
        float ss = 0.f;
#pragma unroll
        for (int j = 0; j < 8; ++j) ss += o[j] * o[j];
        atomicAdd(SS2 + row, ss); } };
struct EpiPQ { bf16_t* PQ; const float* SS2;
    __device__ __forceinline__ void apply(int row, int col0, const float (&v)[8]) const {
        const float r = rsqrtf(SS2[row] * (1.f / D) + EPS); float o[8];
#pragma unroll
        for (int j = 0; j < 8; ++j) o[j] = v[j] * r;
        st8(PQ + (size_t)row * D + col0, o); } };

template <class Epi>
__global__ void __launch_bounds__(256) gemm_ref(const bf16_t* __restrict__ A, int lda, const bf16_t* __restrict__ Bt, int ldb, int K, Epi E) {
    __shared__ float As[32][64 + 4];
    __shared__ float Bs[32][128 + 4];
    const int tid = threadIdx.x, tx = tid & 15, ty = tid >> 4;
    const int m0 = blockIdx.y * 64, n0 = blockIdx.x * 128;
    float acc[4][8];
#pragma unroll
    for (int i = 0; i < 4; ++i)
#pragma unroll
        for (int j = 0; j < 8; ++j) acc[i][j] = 0.f;
    for (int k0 = 0; k0 < K; k0 += 32) {
        { const int m = tid & 63, kc = tid >> 6; float t[8]; ld8(A + (size_t)(m0 + m) * lda + k0 + kc * 8, t);
#pragma unroll
          for (int j = 0; j < 8; ++j) As[kc * 8 + j][m] = t[j]; }
#pragma unroll
        for (int i = 0; i < 2; ++i) { const int n = tid & 127, kc = (tid >> 7) + 2 * i; float t[8]; ld8(Bt + (size_t)(n0 + n) * ldb + k0 + kc * 8, t);
#pragma unroll
          for (int j = 0; j < 8; ++j) Bs[kc * 8 + j][n] = t[j]; }
        __syncthreads();
#pragma unroll 8
        for (int kk = 0; kk < 32; ++kk) {
            const f32x4 a = *(const f32x4*)&As[kk][ty * 4]; const f32x4 b0 = *(const f32x4*)&Bs[kk][tx * 8], b1 = *(const f32x4*)&Bs[kk][tx * 8 + 4];
            const float av[4] = {a.x, a.y, a.z, a.w}, bv[8] = {b0.x, b0.y, b0.z, b0.w, b1.x, b1.y, b1.z, b1.w};
#pragma unroll
            for (int i = 0; i < 4; ++i)
#pragma unroll
                for (int j = 0; j < 8; ++j) acc[i][j] += av[i] * bv[j];
        }
        __syncthreads();
    }
#pragma unroll
    for (int i = 0; i < 4; ++i) E.apply(m0 + ty * 4 + i, n0 + tx * 8, acc[i]);
}

namespace pg8 {
#define PG8_LAS __attribute__((address_space(3)))
typedef short bf16x8 __attribute__((ext_vector_type(8)));
constexpr int BM = 256, BK = 64, HALF = 128, HTB = HALF * BK * 2, STAGE_BYTES = 8 * HTB, NXCD = 8, WGM = 8;
__host__ __device__ __forceinline__ int lds_byte(int r, int c) { const int st = (r >> 4) * 2 + (c >> 5), rr = r & 15, cc = c & 31, ob = rr * 64 + cc * 2; return st * 1024 + (ob ^ (((ob >> 9) & 1) << 5)); }
__host__ __device__ __forceinline__ void stage_rc(int b, int& R, int& C) { const int st = b / 1024, sb = b % 1024, swz = sb ^ (((sb >> 9) & 1) << 5); R = (st >> 1) * 16 + swz / 64; C = (st & 1) * 32 + (swz % 64) / 2; }
__host__ __device__ __forceinline__ int perm32(int rho) { const int n = rho >> 4, i = rho & 15; return 8 * (i >> 2) + 4 * n + (i & 3); }
struct Unit { int pm, pn; };
struct Gemm { const bf16_t* A; const bf16_t* Bt; int lda, ldb, M, N, K, pad; };
struct StaticOrder {
    int nM, nN, nwg, G, c;
    __host__ __device__ void init(int M, int N, int G_, int c_) { nM = M / BM; nN = N / BM; nwg = nM * nN; G = G_; c = c_; }
    __host__ __device__ bool next(int i, Unit& u) const {
        const long L = (long)i * G + c; if (L >= nwg) return false;
        int wgid = (int)L; { const int q = nwg / NXCD, r = nwg % NXCD, xcd = wgid % NXCD, off = wgid / NXCD; wgid = (xcd < r ? xcd * (q + 1) : r * (q + 1) + (xcd - r) * q) + off; }
        const int nig = WGM * nN, gid = wgid / nig, fm = gid * WGM, gsz = (nM - fm) < WGM ? (nM - fm) : WGM;
        u.pm = fm + ((wgid % nig) % gsz); u.pn = (wgid % nig) / gsz; return true;
    }
};
template <class Epi>
__device__ __forceinline__ void run_epi(const Epi& E, const f32x4 (&acc)[2][2][4][2], const Unit& u, int wr, int wc, int fr, int fq) {
    const int row0 = u.pm * BM + wr * 64 + fr, col0 = u.pn * BM + wc * 32 + 8 * fq;
#pragma unroll
    for (int ai = 0; ai < 2; ++ai)
#pragma unroll
        for (int m = 0; m < 4; ++m)
#pragma unroll
            for (int bj = 0; bj < 2; ++bj) {
                const f32x4 a = acc[ai][bj][m][0], b = acc[ai][bj][m][1];
                const float v[8] = {a[0], a[1], a[2], a[3], b[0], b[1], b[2], b[3]};
                E.apply(row0 + ai * HALF + m * 16, col0 + bj * HALF, v);
            }
}
template <class Epi>
__device__ __forceinline__ void gemm_phase(PG8_LAS unsigned char* lds, const Gemm g, const StaticOrder& S, const Epi& E) {
    const int tid = opaque_tid(), wid = __builtin_amdgcn_readfirstlane(tid >> 6), lane = tid & 63, wr = wid >> 2, wc = wid & 3, fr = lane & 15, fq = lane >> 4;
    const int K = g.K, nt = K / BK;
    unsigned voffA[2], voffB[2];
#pragma unroll
    for (int i = 0; i < 2; ++i) { int R, C; stage_rc(tid * 16 + i * 8192, R, C); const int Rb = (R & ~31) + perm32(R & 31);
        voffA[i] = (unsigned)(R * g.lda + C) * 2u; voffB[i] = (unsigned)(Rb * g.ldb + C) * 2u; }
    const size_t kstep = (size_t)(BK * 2);
    const size_t hstepA = (size_t)HALF * g.lda * 2, hstepB = (size_t)HALF * g.ldb * 2;
    const size_t tstepA = 2 * hstepA, tstepB = 2 * hstepB;
    const unsigned ldsw = (unsigned)wid * 1024u;
    const int aoff = lds_byte(wr * 64 + fr, fq * 8), boff = lds_byte(wc * 32 + fr, fq * 8);
#define PG8_SA(b, h) (((b) * 2 + (h)) * HTB)
#define PG8_SB(b, h) ((4 + (b) * 2 + (h)) * HTB)
#define PG8_STAGE(bufoff, gbase, voff) do { _Pragma("unroll") for (int _i = 0; _i < 2; ++_i) \
        __builtin_amdgcn_global_load_lds((const unsigned*)((const char*)(gbase) + (voff)[_i]), (PG8_LAS unsigned*)(lds + (bufoff) + ldsw + _i * 8192), 16, 0, 0); } while (0)
#define PG8_LDA(dst, b, h) do { _Pragma("unroll") for (int m = 0; m < 4; ++m) _Pragma("unroll") for (int k = 0; k < 2; ++k) dst[m][k] = *(const PG8_LAS bf16x8*)(lds + PG8_SA(b, h) + aoff + m * 2048 + k * 1024); } while (0)
#define PG8_LDB(dst, b, h) do { _Pragma("unroll") for (int n = 0; n < 2; ++n) _Pragma("unroll") for (int k = 0; k < 2; ++k) dst[n][k] = *(const PG8_LAS bf16x8*)(lds + PG8_SB(b, h) + boff + n * 2048 + k * 1024); } while (0)
#define PG8_MMA(ai, bj, At, Bt) do { __builtin_amdgcn_s_setprio(1); _Pragma("unroll") for (int m = 0; m < 4; ++m) _Pragma("unroll") for (int n = 0; n < 2; ++n) _Pragma("unroll") for (int k = 0; k < 2; ++k) \
        acc[ai][bj][m][n] = __builtin_amdgcn_mfma_f32_16x16x32_bf16(Bt[n][k], At[m][k], acc[ai][bj][m][n], 0, 0, 0); __builtin_amdgcn_s_setprio(0); } while (0)
#define PG8_WAIT_V(n) asm volatile("s_waitcnt vmcnt(" #n ")" ::: "memory")
#define PG8_WAIT_L(n) asm volatile("s_waitcnt lgkmcnt(" #n ")" ::: "memory")
#define PG8_BAR __builtin_amdgcn_s_barrier()
#define PG8_SCHED __builtin_amdgcn_sched_barrier(0)
    Unit cur, nxt; int ui = 0;
    if (!S.next(0, cur)) return;
    f32x4 acc[2][2][4][2];
#pragma unroll
    for (int a = 0; a < 2; ++a)
#pragma unroll
        for (int b = 0; b < 2; ++b)
#pragma unroll
            for (int m = 0; m < 4; ++m)
#pragma unroll
                for (int n = 0; n < 2; ++n) acc[a][b][m][n] = (f32x4){0.f, 0.f, 0.f, 0.f};
    bf16x8 At[4][2], B0[2][2], B1[2][2];
    const char* cA = (const char*)g.A + (size_t)cur.pm * tstepA; const char* cB = (const char*)g.Bt + (size_t)cur.pn * tstepB;
    PG8_STAGE(PG8_SB(0, 0), cB, voffB); PG8_STAGE(PG8_SB(0, 1), cB + hstepB, voffB); PG8_STAGE(PG8_SA(0, 0), cA, voffA); PG8_STAGE(PG8_SA(0, 1), cA + hstepA, voffA);
    if (wr == 1) PG8_BAR;
    PG8_WAIT_V(2); PG8_BAR;
    PG8_STAGE(PG8_SB(1, 0), cB + kstep, voffB); PG8_STAGE(PG8_SA(1, 0), cA + kstep, voffA); PG8_STAGE(PG8_SB(1, 1), cB + hstepB + kstep, voffB);
    PG8_WAIT_V(6); PG8_BAR;
    for (;;) {
        const bool has_next = S.next(ui + 1, nxt);
        const char* nA = has_next ? (const char*)g.A + (size_t)nxt.pm * tstepA : cA; const char* nB = has_next ? (const char*)g.Bt + (size_t)nxt.pn * tstepB : cB;
        for (int t = 0; t < nt; t += 2) {
            const bool last = (t == nt - 2);
            const char* a1 = cA + (size_t)(t + 1) * kstep;
            const char* a2 = last ? nA : cA + (size_t)(t + 2) * kstep; const char* b2 = last ? nB : cB + (size_t)(t + 2) * kstep;
            const char* a3 = a2 + kstep; const char* b3 = b2 + kstep;
            PG8_LDB(B0, 0, 0); PG8_LDB(B1, 0, 1); PG8_SCHED; PG8_LDA(At, 0, 0); PG8_STAGE(PG8_SA(1, 1), a1 + hstepA, voffA);
            PG8_WAIT_V(8); PG8_WAIT_L(0); PG8_BAR; PG8_MMA(0, 0, At, B0); PG8_MMA(0, 1, At, B1); PG8_BAR; PG8_SCHED;
            PG8_LDA(At, 0, 1); PG8_STAGE(PG8_SB(0, 0), b2, voffB); PG8_STAGE(PG8_SB(0, 1), b2 + hstepB, voffB); PG8_STAGE(PG8_SA(0, 0), a2, voffA);
            PG8_WAIT_V(8); PG8_WAIT_L(0); PG8_BAR; PG8_MMA(1, 0, At, B0); PG8_MMA(1, 1, At, B1); PG8_BAR; PG8_SCHED;
            PG8_LDB(B0, 1, 0); PG8_LDB(B1, 1, 1); PG8_SCHED; PG8_LDA(At, 1, 0); PG8_STAGE(PG8_SA(0, 1), a2 + hstepA, voffA);
            PG8_WAIT_V(8); PG8_WAIT_L(0); PG8_BAR; PG8_MMA(0, 0, At, B0); PG8_MMA(0, 1, At, B1); PG8_BAR; PG8_SCHED;
            PG8_LDA(At, 1, 1); PG8_STAGE(PG8_SB(1, 0), b3, voffB); PG8_STAGE(PG8_SB(1, 1), b3 + hstepB, voffB); PG8_STAGE(PG8_SA(1, 0), a3, voffA);
            PG8_WAIT_V(8); PG8_WAIT_L(0); PG8_BAR; PG8_MMA(1, 0, At, B0); PG8_MMA(1, 1, At, B1); PG8_BAR; PG8_SCHED;
        }
        if (wr == 0) PG8_BAR;
        run_epi(E, acc, cur, wr, wc, fr, fq);
        if (!has_next) break;
#pragma unroll
        for (int a = 0; a < 2; ++a)
#pragma unroll
            for (int b = 0; b < 2; ++b)
#pragma unroll
                for (int m = 0; m < 4; ++m)
#pragma unroll
                    for (int n = 0; n < 2; ++n) acc[a][b][m][n] = (f32x4){0.f, 0.f, 0.f, 0.f};
        cur = nxt; cA = nA; cB = nB; ++ui;
        if (wr == 1) PG8_BAR;
    }
    PG8_WAIT_V(0);
    PG8_BAR;
#undef PG8_SA
#undef PG8_SB
#undef PG8_STAGE
#undef PG8_LDA
#undef PG8_LDB
#undef PG8_MMA
#undef PG8_WAIT_V
#undef PG8_WAIT_L
#undef PG8_BAR
#undef PG8_SCHED
}
}

constexpr int LDS_BYTES = 147456;
template <class Epi>
__global__ void __launch_bounds__(512, 2) k_gemm(pg8::Gemm g, Epi E) {
    extern __shared__ __attribute__((aligned(16))) unsigned char lds[];
    pg8::StaticOrder S; S.init(g.M, g.N, gridDim.x, blockIdx.x);
    pg8::gemm_phase<Epi>((PG8_LAS unsigned char*)lds, g, S, E);
}

constexpr int FIN_VP = 136;
constexpr int FIN_LDS = 512 * FIN_VP;
__device__ __forceinline__ void up8(const u32x4 w, float (&o)[8]) {
    o[0] = bf2f(w.x & 0xffff); o[1] = bf2f(w.x >> 16); o[2] = bf2f(w.y & 0xffff); o[3] = bf2f(w.y >> 16); o[4] = bf2f(w.z & 0xffff); o[5] = bf2f(w.z >> 16); o[6] = bf2f(w.w & 0xffff); o[7] = bf2f(w.w >> 16);
}
struct FinRow { u32x4 cq, ckv, q0, q1, k0, k1, v0, v1; f32x4 cs[4]; };
__device__ __forceinline__ void finalize_phase(const Ptrs& p, LAS unsigned char* lds) {
    const int tid = opaque_tid(), lane = tid & 63, wid = __builtin_amdgcn_readfirstlane(tid >> 6), G = gridDim.x, bx = blockIdx.x;
    const bf16_t* LAT = (const bf16_t*)(p.ws + WS_LAT);
    bf16_t* Q = (bf16_t*)(p.ws + WS_Q); bf16_t* K = (bf16_t*)(p.ws + WS_K); const bf16_t* V = (const bf16_t*)(p.ws + WS_VRAW); bf16_t* VT = (bf16_t*)(p.ws + WS_VT);
    const float2* R16 = (const float2*)(p.ws + WS_ROPE16);
    const int hq = lane >> 4, c = lane & 15; const bool act = c < 12, isr = c >= 8 && c < 12;
    float gq8[8], gk8[8];
#pragma unroll
    for (int e = 0; e < 8; ++e) { gq8[e] = act ? p.in[8][8 * c + e] : 0.f; gk8[e] = act ? p.in[9][8 * c + e] : 0.f; }
    auto load_row = [&](int r, FinRow& d) {
        const bf16_t* lr = LAT + (size_t)r * 768; const u32x4 z = {0u, 0u, 0u, 0u};
        d.cq = lane < 48 ? *(const u32x4*)(lr + 8 * lane) : z; d.ckv = lane < 32 ? *(const u32x4*)(lr + 384 + 8 * lane) : z;
        const bool hasq = r < T;
        d.q0 = (act && hasq) ? *(const u32x4*)(Q + (size_t)r * 768 + hq * 96 + 8 * c) : z; d.q1 = (act && hasq) ? *(const u32x4*)(Q + (size_t)r * 768 + (4 + hq) * 96 + 8 * c) : z;
        d.k0 = c < 8 ? *(const u32x4*)(K + (size_t)r * 768 + hq * 96 + 8 * c) : (isr ? *(const u32x4*)(lr + 640 + 8 * (c - 8)) : z);
        d.k1 = c < 8 ? *(const u32x4*)(K + (size_t)r * 768 + (4 + hq) * 96 + 8 * c) : d.k0;
        d.v0 = c < 8 ? *(const u32x4*)(V + (size_t)r * 512 + hq * 64 + 8 * c) : z; d.v1 = c < 8 ? *(const u32x4*)(V + (size_t)r * 512 + (4 + hq) * 64 + 8 * c) : z;
        if (isr) { const float2* rp = R16 + row_pos(r) * 16 + 8 * (c & 1);
#pragma unroll
            for (int e = 0; e < 4; ++e) d.cs[e] = *(const f32x4*)(rp + 2 * e); }
        else {
#pragma unroll
            for (int e = 0; e < 4; ++e) d.cs[e] = (f32x4){1.f, 0.f, 1.f, 0.f}; }
    };
    for (int grp = bx; grp < 1026; grp += G) {
        const int r0 = grp < 1024 ? grp * 32 : T + (grp - 1024) * 32;
        __syncthreads();
        FinRow cur, nxt;
        load_row(r0 + 4 * wid, nxt);
#pragma unroll 1
        for (int i = 0; i < 4; ++i) {
            const int kl = 4 * wid + i, r = r0 + kl;
            cur = nxt;
            if (i + 1 < 4) load_row(r + 1, nxt);
            float sa = 0.f, sb = 0.f;
            { float t[8]; up8(cur.cq, t);
#pragma unroll
              for (int e = 0; e < 8; ++e) sa += t[e] * t[e]; }
            { float t[8]; up8(cur.ckv, t);
#pragma unroll
              for (int e = 0; e < 8; ++e) sb += t[e] * t[e]; }
            sa = wave_sum(sa); sb = wave_sum(sb);
            const float alpha = rsqrtf(sa * (1.f / 384.f) + EPS), beta = rsqrtf(sb * (1.f / 256.f) + EPS);
            float cs_x[8], cs_y[8];
#pragma unroll
            for (int e = 0; e < 4; ++e) { cs_x[2 * e] = cur.cs[e].x; cs_y[2 * e] = cur.cs[e].y; cs_x[2 * e + 1] = cur.cs[e].z; cs_y[2 * e + 1] = cur.cs[e].w; }
            const int kpos = (grp < 1024 ? vt_pos(0, (r0 & 32) + kl) : vt_pos(0, r - T)) & 63;
#pragma unroll
            for (int pass = 0; pass < 2; ++pass) {
                const int h = 4 * pass + hq;
                if (r < T) {
                    float x[8]; up8(pass ? cur.q1 : cur.q0, x);
                    float ss = 0.f;
#pragma unroll
                    for (int e = 0; e < 8; ++e) { x[e] *= alpha; ss += x[e] * x[e]; }
                    ss += __shfl_xor(ss, 1); ss += __shfl_xor(ss, 2); ss += __shfl_xor(ss, 4); ss += __shfl_xor(ss, 8);
                    const float rq = rsqrtf(ss * (1.f / 96.f) + EPS) * QSCALE;
                    float o[8];
#pragma unroll
                    for (int e = 0; e < 8; ++e) { const float y = x[e] * gq8[e]; const float pr = __shfl_xor(y, 2);
                        o[e] = (c < 10 ? (y * cs_x[e] - pr * cs_y[e]) : (pr * cs_y[e] + y * cs_x[e])) * rq; }
                    if (act) st8(Q + (size_t)r * 768 + h * 96 + 8 * c, o);
                }
                {
                    float x[8]; up8(pass ? cur.k1 : cur.k0, x);
                    float ss = 0.f;
#pragma unroll
                    for (int e = 0; e < 8; ++e) { if (c < 8) x[e] *= beta; ss += x[e] * x[e]; }
                    ss += __shfl_xor(ss, 1); ss += __shfl_xor(ss, 2); ss += __shfl_xor(ss, 4); ss += __shfl_xor(ss, 8);
                    const float rk = rsqrtf(ss * (1.f / 96.f) + EPS);
                    float o[8];
#pragma unroll
                    for (int e = 0; e < 8; ++e) { const float y = x[e] * gk8[e]; const float pr = __shfl_xor(y, 2);
                        o[e] = (c < 10 ? (y * cs_x[e] - pr * cs_y[e]) : (pr * cs_y[e] + y * cs_x[e])) * rk; }
                    if (act) st8(K + (size_t)r * 768 + h * 96 + 8 * c, o);
                }
                if (c < 8) {
                    float x[8]; up8(pass ? cur.v1 : cur.v0, x);
#pragma unroll
                    for (int e = 0; e < 8; ++e) *(LAS bf16_t*)(lds + (e * 64 + 8 * h + c) * FIN_VP + kpos * 2) = (bf16_t)f2bf(x[e] * beta); }
            }
        }
        __syncthreads();
        const int nb = grp < 1024 ? 1 : BATCH, half = grp < 1024 ? ((r0 >> 5) & 1) : (grp - 1024);
        const int tile = grp < 1024 ? 1 + ((r0 & (SEQ - 1)) >> 6) : 0;
#pragma unroll 1
        for (int it = 0; it < 4; ++it) {
            const int idx = it * 512 + tid, vr = idx >> 2, ch = idx & 3, h = vr >> 6, d = vr & 63, rho = (d & 7) * 64 + 8 * h + (d >> 3);
            const u32x2 lo = *(const LAS u32x2*)(lds + rho * FIN_VP + (4 * half + ch) * 16), hi2 = *(const LAS u32x2*)(lds + rho * FIN_VP + (4 * half + ch) * 16 + 8);
            const u32x4 w = {lo.x, lo.y, hi2.x, hi2.y};
            for (int bb = 0; bb < nb; ++bb) { const int b = grp < 1024 ? (r0 >> 12) : bb;
                *(u32x4*)(VT + ((size_t)(b * 8 + h) * 64 + d) * VT_LEN + 64 * tile + (4 * half + ch) * 8) = w; }
        }
    }
}
__global__ void __launch_bounds__(512, 2) k_finalize(Ptrs p) { extern __shared__ __attribute__((aligned(16))) unsigned char lds_f[]; finalize_phase(p, (LAS unsigned char*)lds_f); }

__global__ void __launch_bounds__(64) k_attn_naive(Ptrs p) {
    const bf16_t* Q = (const bf16_t*)(p.ws + WS_Q); const bf16_t* K = (const bf16_t*)(p.ws + WS_K); const bf16_t* VT = (const bf16_t*)(p.ws + WS_VT);
    bf16_t* AO = (bf16_t*)(p.ws + WS_AO);
    const int s = blockIdx.x * 64 + threadIdx.x, h = blockIdx.y, b = blockIdx.z;
    const int row = b * SEQ + s;
    float q[96], o[64];
#pragma unroll
    for (int d = 0; d < 96; d += 8) { float t[8]; ld8(Q + (size_t)row * 768 + h * 96 + d, t);
#pragma unroll
        for (int j = 0; j < 8; ++j) q[d + j] = t[j]; }
#pragma unroll
    for (int d = 0; d < 64; ++d) o[d] = 0.f;
    float m = -INFINITY, l = 0.f;
    const int smax = blockIdx.x * 64 + 63;
    for (int j = 0; j < NMETA + smax + 1; ++j) {
        const int krow = j < NMETA ? T + j : b * SEQ + (j - NMETA);
        const bf16_t* kp = K + (size_t)krow * 768 + h * 96;
        const bf16_t* vp = VT + ((size_t)(b * 8 + h) * 64) * VT_LEN + (j < NMETA ? vt_pos(0, j) : vt_pos(1 + ((j - NMETA) >> 6), (j - NMETA) & 63));
        float sc = 0.f;
#pragma unroll
        for (int d = 0; d < 96; d += 8) { float t[8]; ld8(kp + d, t);
#pragma unroll
            for (int jj = 0; jj < 8; ++jj) sc += q[d + jj] * t[jj]; }
        const bool valid = (j < NMETA) || (j - NMETA <= s);
        if (valid) {
            const float mn = fmaxf(m, sc); const float a = exp2f(m - mn), pp = exp2f(sc - mn);
            l = l * a + pp; m = mn;
#pragma unroll
            for (int d = 0; d < 64; ++d) o[d] = o[d] * a + pp * bf2f(vp[(size_t)d * VT_LEN]);
        }
    }
    const float il = 1.f / l;
#pragma unroll
    for (int d = 0; d < 64; d += 8) { float t[8];
#pragma unroll
        for (int jj = 0; jj < 8; ++jj) t[jj] = o[d + jj] * il;
        st8(AO + (size_t)row * 512 + h * 64 + d, t); }
}

#ifndef LAS
#define LAS __attribute__((address_space(3)))
#endif
typedef float f32x16_t __attribute__((ext_vector_type(16)));
typedef short bf16x8_t __attribute__((ext_vector_type(8)));
constexpr int ATT_KP = 208, ATT_VP = 144, ATT_KB = 64 * ATT_KP, ATT_VB = 64 * ATT_VP, ATT_BUF = ATT_KB + ATT_VB, ATT_LDS = 2 * ATT_BUF;
__device__ __forceinline__ void attn_unit(const Ptrs& p, LAS unsigned char* lds, int b, int h, int qb) {
    const bf16_t* Q = (const bf16_t*)(p.ws + WS_Q); const bf16_t* K = (const bf16_t*)(p.ws + WS_K); const bf16_t* VT = (const bf16_t*)(p.ws + WS_VT);
    bf16_t* AO = (bf16_t*)(p.ws + WS_AO);
    const int tid = opaque_tid(), lane = tid & 63, wid = __builtin_amdgcn_readfirstlane(tid >> 6), q = lane & 31, hi = lane >> 5;
    const int s0w = 256 * qb + 32 * wid, sq = s0w + q; const size_t rowq = (size_t)b * SEQ + sq;
    bf16x8_t qf[6];
#pragma unroll
    for (int st = 0; st < 6; ++st) qf[st] = *(const bf16x8_t*)(Q + rowq * 768 + h * 96 + 16 * st + 8 * hi);
    const int NT = 4 * qb + 5;
    const int k0key = tid / 12, k0ch = tid % 12, k1key = (tid + 512) / 12, k1ch = (tid + 512) % 12; const bool k1v = tid < 256;
    const int vd = tid >> 3, vch = tid & 7;
    const bf16_t* vtb = VT + ((size_t)(b * 8 + h) * 64 + vd) * VT_LEN + vch * 8;
    const bf16_t* kb0 = K + (size_t)h * 96 + k0ch * 8; const bf16_t* kb1 = K + (size_t)h * 96 + k1ch * 8;
    u32x4 kr0, kr1 = {}, vr;
#define ATT_KROW(t, key) ((t) == 0 ? (size_t)(T + (key)) : (size_t)b * SEQ + 64 * ((t) - 1) + (key))
#define ATT_LOAD(t) do { kr0 = *(const u32x4*)(kb0 + ATT_KROW(t, k0key) * 768); if (k1v) kr1 = *(const u32x4*)(kb1 + ATT_KROW(t, k1key) * 768); vr = *(const u32x4*)(vtb + 64 * (t)); } while (0)
#define ATT_STORE(buf) do { LAS unsigned char* bb = lds + (buf) * ATT_BUF; *(LAS u32x4*)(bb + k0key * ATT_KP + k0ch * 16) = kr0; if (k1v) *(LAS u32x4*)(bb + k1key * ATT_KP + k1ch * 16) = kr1; \
        *(LAS u32x4*)(bb + ATT_KB + vd * ATT_VP + vch * 16) = vr; } while (0)
    LDS_BARRIER();
    ATT_LOAD(0); ATT_STORE(0); LDS_BARRIER();
    float m = -1e30f, l = 0.f; f32x16_t o0 = {}, o1 = {};
    for (int t = 0; t < NT; ++t) {
        const int cur = t & 1;
        if (t + 1 < NT) ATT_LOAD(t + 1);
        const int ks = 64 * (t - 1);
        if (t == 0 || ks <= s0w + 31) {
            const LAS unsigned char* base = lds + cur * ATT_BUF;
            bf16x8_t kf0[6], kf1[6];
#pragma unroll
            for (int st = 0; st < 6; ++st) { kf0[st] = *(const LAS bf16x8_t*)(base + q * ATT_KP + (16 * st + 8 * hi) * 2); kf1[st] = *(const LAS bf16x8_t*)(base + (32 + q) * ATT_KP + (16 * st + 8 * hi) * 2); }
            asm volatile("" : "+v"(kf0[0]), "+v"(kf0[1]), "+v"(kf0[2]), "+v"(kf0[3]), "+v"(kf0[4]), "+v"(kf0[5]), "+v"(kf1[0]), "+v"(kf1[1]), "+v"(kf1[2]), "+v"(kf1[3]), "+v"(kf1[4]), "+v"(kf1[5]));
            f32x16_t p0 = {}, p1 = {};
#pragma unroll
            for (int st = 0; st < 6; ++st) { p0 = __builtin_amdgcn_mfma_f32_32x32x16_bf16(kf0[st], qf[st], p0, 0, 0, 0); p1 = __builtin_amdgcn_mfma_f32_32x32x16_bf16(kf1[st], qf[st], p1, 0, 0, 0); }
            bf16x8_t vf0[4], vf1[4];
#pragma unroll
            for (int kk = 0; kk < 4; ++kk) { vf0[kk] = *(const LAS bf16x8_t*)(base + ATT_KB + q * ATT_VP + (16 * kk + 8 * hi) * 2); vf1[kk] = *(const LAS bf16x8_t*)(base + ATT_KB + (32 + q) * ATT_VP + (16 * kk + 8 * hi) * 2); }
            __builtin_amdgcn_sched_barrier(0);
            float s0[16], s1[16];
#pragma unroll
            for (int r = 0; r < 16; ++r) { s0[r] = p0[r]; s1[r] = p1[r]; }
            if (t == 0) {
#pragma unroll
                for (int r = 0; r < 16; ++r) { if ((r & 3) + 8 * (r >> 2) + 4 * hi >= NMETA) s0[r] = -1e30f; s1[r] = -1e30f; }
            } else if (ks + 63 > s0w) {
#pragma unroll
                for (int r = 0; r < 16; ++r) { const int kk = ks + (r & 3) + 8 * (r >> 2) + 4 * hi; if (kk > sq) s0[r] = -1e30f; if (kk + 32 > sq) s1[r] = -1e30f; }
            }
            float mx = fmaxf(s0[0], s1[0]);
#pragma unroll
            for (int r = 1; r < 16; ++r) mx = fmaxf(mx, fmaxf(s0[r], s1[r]));
            mx = fmaxf(mx, __shfl_xor(mx, 32));
            if (__any(mx > m)) { const float mn = fmaxf(m, mx), al = __builtin_amdgcn_exp2f(m - mn); l *= al; m = mn;
#pragma unroll
                for (int r = 0; r < 16; ++r) { o0[r] *= al; o1[r] *= al; } }
            float ps = 0.f;
#pragma unroll
            for (int r = 0; r < 16; ++r) { s0[r] = __builtin_amdgcn_exp2f(s0[r] - m); s1[r] = __builtin_amdgcn_exp2f(s1[r] - m); ps += s0[r] + s1[r]; }
            l += ps;
            u32x4 pb[4];
            pb[0] = (u32x4){cvtpk(s0[0], s0[1]), cvtpk(s0[2], s0[3]), cvtpk(s0[4], s0[5]), cvtpk(s0[6], s0[7])};
            pb[1] = (u32x4){cvtpk(s0[8], s0[9]), cvtpk(s0[10], s0[11]), cvtpk(s0[12], s0[13]), cvtpk(s0[14], s0[15])};
            pb[2] = (u32x4){cvtpk(s1[0], s1[1]), cvtpk(s1[2], s1[3]), cvtpk(s1[4], s1[5]), cvtpk(s1[6], s1[7])};
            pb[3] = (u32x4){cvtpk(s1[8], s1[9]), cvtpk(s1[10], s1[11]), cvtpk(s1[12], s1[13]), cvtpk(s1[14], s1[15])};
            asm volatile("" : "+v"(vf0[0]), "+v"(vf0[1]), "+v"(vf0[2]), "+v"(vf0[3]), "+v"(vf1[0]), "+v"(vf1[1]), "+v"(vf1[2]), "+v"(vf1[3]));
#pragma unroll
            for (int kk = 0; kk < 4; ++kk) {
                const bf16x8_t pf = __builtin_bit_cast(bf16x8_t, pb[kk]);
                o0 = __builtin_amdgcn_mfma_f32_32x32x16_bf16(vf0[kk], pf, o0, 0, 0, 0); o1 = __builtin_amdgcn_mfma_f32_32x32x16_bf16(vf1[kk], pf, o1, 0, 0, 0); }
        }
        if (t + 1 < NT) ATT_STORE(cur ^ 1);
        LDS_BARRIER();
    }
    l += __shfl_xor(l, 32);
    const float il = 1.f / l;
    bf16_t* op = AO + rowq * 512 + h * 64 + 4 * hi;
#pragma unroll
    for (int g = 0; g < 4; ++g) {
        const float a0 = o0[4 * g], a1 = o0[4 * g + 1], a2 = o0[4 * g + 2], a3 = o0[4 * g + 3], b0 = o1[4 * g], b1 = o1[4 * g + 1], b2 = o1[4 * g + 2], b3 = o1[4 * g + 3];
        uint2 w0, w1; w0.x = cvtpk(a0 * il, a1 * il); w0.y = cvtpk(a2 * il, a3 * il); w1.x = cvtpk(b0 * il, b1 * il); w1.y = cvtpk(b2 * il, b3 * il);
        *(uint2*)(op + 8 * g) = w0; *(uint2*)(op + 32 + 8 * g) = w1; }
#undef ATT_KROW
#undef ATT_LOAD
#undef ATT_STORE
}
__device__ __forceinline__ void attn_phase(const Ptrs& p, LAS unsigned char* lds, int vcu, int ncu) {
    for (int v = vcu; v < 256; v += ncu) {
        const int bh = v >> 2, s = v & 3;
        attn_unit(p, lds, bh >> 3, bh & 7, 15 - s); attn_unit(p, lds, bh >> 3, bh & 7, 8 + s); attn_unit(p, lds, bh >> 3, bh & 7, 7 - s); attn_unit(p, lds, bh >> 3, bh & 7, s);
    }
}
__global__ void __launch_bounds__(512, 2) k_attn(Ptrs p) {
    extern __shared__ __attribute__((aligned(16))) unsigned char lds[];
    const int G = gridDim.x, bx = blockIdx.x; const int vcu = (G % 8 == 0) ? (bx % 8) * (G / 8) + bx / 8 : bx;
    attn_phase(p, (LAS unsigned char*)lds, vcu, G);
}

__global__ void __launch_bounds__(128) k_ret_naive(Ptrs p) {
    const bf16_t* RQ = (const bf16_t*)(p.ws + WS_RQ); const bf16_t* RK = (const bf16_t*)(p.ws + WS_RK); const bf16_t* RV = (const bf16_t*)(p.ws + WS_RV);
    const bf16_t* RG = (const bf16_t*)(p.ws + WS_RG); bf16_t* RET = (bf16_t*)(p.ws + WS_RET);
    const float* ggn = p.in[11];
    __shared__ float red[2][4];
    const int e = threadIdx.x, h = blockIdx.x & 7, b = blockIdx.x >> 3;
    const float gamma = 1.f - exp2f(-5.f - (float)h);
    float S[64];
#pragma unroll
    for (int d = 0; d < 64; ++d) S[d] = 0.f;
    const float gg = ggn[h * 128 + e];
    const float g128 = exp2f(128.f * __log2f(gamma)), g16 = exp2f(16.f * __log2f(gamma));
    for (int t = 0; t < NMETA + SEQ; ++t) {
        const int row = t < NMETA ? T + t : b * SEQ + (t - NMETA);
        if (t >= NMETA && ((t - NMETA) & 127) == 0) { const float f = t == NMETA ? g16 : g128;
#pragma unroll
            for (int d = 0; d < 64; ++d) S[d] *= f; }
        const bf16_t* qp = RQ + (size_t)row * 512 + h * 64; const bf16_t* kp = RK + (size_t)row * 512 + h * 64;
        const float v = bf2f(RV[(size_t)row * 1024 + h * 128 + e]);
        float y = 0.f;
#pragma unroll
        for (int d = 0; d < 64; d += 8) { float kq[8], qq[8]; ld8(kp + d, kq); ld8(qp + d, qq);
#pragma unroll
            for (int j = 0; j < 8; ++j) { S[d + j] = S[d + j] + kq[j] * v; y += qq[j] * S[d + j]; } }
        if (t >= NMETA) {
            const float s1 = wave_sum(y), s2 = wave_sum(y * y);
            const int buf = t & 1;
            if ((e & 63) == 0) { red[buf][(e >> 6) * 2] = s1; red[buf][(e >> 6) * 2 + 1] = s2; }
            __syncthreads();
            const float mu = (red[buf][0] + red[buf][2]) * (1.f / 128.f); const float ex2 = (red[buf][1] + red[buf][3]) * (1.f / 128.f);
            const float var = fmaxf(ex2 - mu * mu, 0.f);
            const float yn = (y - mu) * rsqrtf(var + EPS) * gg;
            const float g = bf2f(RG[(size_t)row * 1024 + h * 128 + e]);
            RET[(size_t)row * 1024 + h * 128 + e] = (bf16_t)f2bf(g * yn);
        }
    }
}

constexpr int RT_RP = 144, RT_TP = 256;
#define RT_SWZ(row) ((((row) & 15) ^ (((row) >> 3) & 3)) << 4)
constexpr int RT_QT = 0, RT_KT = 128 * RT_RP, RT_KTT = RT_KT + 128 * RT_RP, RT_VTT = RT_KTT + 64 * RT_TP, RT_ST = RT_VTT + 128 * RT_TP, RT_STAT = RT_ST + 128 * RT_RP, RT_GGN = RT_STAT + 8 * 32 * 8, RT_LDS = RT_GGN + 512;
static_assert(RT_LDS <= 147456, "retention LDS");
template <int MODE = 0>
__device__ __forceinline__ void ret_unit(const Ptrs& p, LAS unsigned char* lds, int b, int h) {
    const bf16_t* RQ = (const bf16_t*)(p.ws + WS_RQ); const bf16_t* RK = (const bf16_t*)(p.ws + WS_RK); const bf16_t* RV = (const bf16_t*)(p.ws + WS_RV);
    const bf16_t* RG = (const bf16_t*)(p.ws + WS_RG); bf16_t* RET = (bf16_t*)(p.ws + WS_RET); const float* ggn = p.in[11];
    const int tid = opaque_tid(), lane = tid & 63, wid = __builtin_amdgcn_readfirstlane(tid >> 6), c = lane & 31, hi = lane >> 5;
    const int j = wid >> 1, ih = wid & 1;
    const float lgam = __log2f(1.f - exp2f(-5.f - (float)h)); const float g128 = exp2f(128.f * lgam), g16 = exp2f(16.f * lgam);
    const int nst = wid < 2 ? 2 : (wid < 6 ? 1 : 0);
    const int sti = wid < 2 ? wid : 2 + ((wid - 2) >> 1), std0 = wid < 2 ? 0 : ((wid - 2) & 1);
    f32x16_t st0 = {}, st1 = {};
    const int q_row0 = tid >> 3, q_ch = tid & 7;
    const int k_rb = tid >> 4, k_db = tid & 15;
    const int v_rb0 = tid >> 5, v_eb = tid & 31;
    u32x4 pq[2]; u32x2 pk[4], pv[2][4];
#define RT_MPOS(rb) (16 * ((rb) >> 2) + 4 * ((((rb) & 3) == 1) ? 2 : ((((rb) & 3) == 2) ? 1 : ((rb) & 3))))
#define RT_LOAD(R0) do { \
        pq[0] = *(const u32x4*)(RQ + (size_t)((R0) + q_row0) * 512 + h * 64 + q_ch * 8); pq[1] = *(const u32x4*)(RQ + (size_t)((R0) + q_row0 + 64) * 512 + h * 64 + q_ch * 8); \
        _Pragma("unroll") for (int i_ = 0; i_ < 4; ++i_) pk[i_] = *(const u32x2*)(RK + (size_t)((R0) + 4 * k_rb + i_) * 512 + h * 64 + 4 * k_db); \
        _Pragma("unroll") for (int u_ = 0; u_ < 2; ++u_) _Pragma("unroll") for (int i_ = 0; i_ < 4; ++i_) pv[u_][i_] = *(const u32x2*)(RV + (size_t)((R0) + 4 * (v_rb0 + 16 * u_) + i_) * 1024 + h * 128 + 4 * v_eb); } while (0)
#define RT_TR4(src, dstbase, colbase, pitch, mpos) do { \
        const unsigned a0_ = src[0].x, a1_ = src[1].x, a2_ = src[2].x, a3_ = src[3].x, b0_ = src[0].y, b1_ = src[1].y, b2_ = src[2].y, b3_ = src[3].y; \
        const int mb_ = (mpos) * 2; u32x2 t_; \
        t_.x = (a0_ & 0xffffu) | (a1_ << 16); t_.y = (a2_ & 0xffffu) | (a3_ << 16); *(LAS u32x2*)(lds + (dstbase) + ((colbase) + 0) * (pitch) + (mb_ ^ RT_SWZ((colbase) + 0))) = t_; \
        t_.x = (a0_ >> 16) | (a1_ & 0xffff0000u); t_.y = (a2_ >> 16) | (a3_ & 0xffff0000u); *(LAS u32x2*)(lds + (dstbase) + ((colbase) + 1) * (pitch) + (mb_ ^ RT_SWZ((colbase) + 1))) = t_; \
        t_.x = (b0_ & 0xffffu) | (b1_ << 16); t_.y = (b2_ & 0xffffu) | (b3_ << 16); *(LAS u32x2*)(lds + (dstbase) + ((colbase) + 2) * (pitch) + (mb_ ^ RT_SWZ((colbase) + 2))) = t_; \
        t_.x = (b0_ >> 16) | (b1_ & 0xffff0000u); t_.y = (b2_ >> 16) | (b3_ & 0xffff0000u); *(LAS u32x2*)(lds + (dstbase) + ((colbase) + 3) * (pitch) + (mb_ ^ RT_SWZ((colbase) + 3))) = t_; } while (0)
#define RT_STORE() do { \
        *(LAS u32x4*)(lds + RT_QT + q_row0 * RT_RP + q_ch * 16) = pq[0]; *(LAS u32x4*)(lds + RT_QT + (q_row0 + 64) * RT_RP + q_ch * 16) = pq[1]; \
        _Pragma("unroll") for (int i_ = 0; i_ < 4; ++i_) *(LAS u32x2*)(lds + RT_KT + (4 * k_rb + i_) * RT_RP + k_db * 8) = pk[i_]; \
        if (!(MODE & 2)) { RT_TR4(pk, RT_KTT, 4 * k_db, RT_TP, RT_MPOS(k_rb)); \
        RT_TR4(pv[0], RT_VTT, 4 * v_eb, RT_TP, RT_MPOS(v_rb0)); RT_TR4(pv[1], RT_VTT, 4 * v_eb, RT_TP, RT_MPOS(v_rb0 + 16)); } } while (0)
#define RT_PUT_ST(acc, it, dt) do { _Pragma("unroll") for (int r_ = 0; r_ < 16; ++r_) { const float v_ = acc[r_]; \
        *(LAS bf16_t*)(lds + RT_ST + (32 * (it) + (r_ & 3) + 8 * (r_ >> 2) + 4 * hi) * RT_RP + (32 * (dt) + c) * 2) = (bf16_t)f2bf(v_); } } while (0)
#define RT_STATE_UPD(acc, it, dt) do { _Pragma("unroll") for (int ks_ = 0; ks_ < 8; ++ks_) { \
        const bf16x8_t a_ = *(const LAS bf16x8_t*)(lds + RT_VTT + (32 * (it) + c) * RT_TP + (((16 * ks_ + 8 * hi) * 2) ^ RT_SWZ(32 * (it) + c))); \
        const bf16x8_t b_ = *(const LAS bf16x8_t*)(lds + RT_KTT + (32 * (dt) + c) * RT_TP + (((16 * ks_ + 8 * hi) * 2) ^ RT_SWZ(32 * (dt) + c))); \
        acc = __builtin_amdgcn_mfma_f32_32x32x16_bf16(a_, b_, acc, 0, 0, 0); } } while (0)
    LDS_BARRIER();
    RT_LOAD(T); RT_STORE(); LDS_BARRIER();
    RT_LOAD(b * SEQ);
    if (nst >= 1) { RT_STATE_UPD(st0, sti, std0);
#pragma unroll
        for (int r = 0; r < 16; ++r) st0[r] *= g16; }
    if (nst == 2) { RT_STATE_UPD(st1, sti, 1);
#pragma unroll
        for (int r = 0; r < 16; ++r) st1[r] *= g16; }
    LDS_BARRIER();
    RT_STORE();
    if (nst >= 1) RT_PUT_ST(st0, sti, std0);
    if (nst == 2) RT_PUT_ST(st1, sti, 1);
    RT_LOAD(b * SEQ + 128);
    LDS_BARRIER();
    if (tid < 128) *(LAS float*)(lds + RT_GGN + tid * 4) = ggn[h * 128 + tid];
    for (int n = 0; n < 32; ++n) {
        const int R0 = b * SEQ + 128 * n;
        const size_t row = (size_t)R0 + 32 * j + c;
        u32x2 gwv[2][4];
#pragma unroll
        for (int i2 = 0; i2 < 2; ++i2)
#pragma unroll
            for (int g = 0; g < 4; ++g) gwv[i2][g] = *(const u32x2*)(RG + row * 1024 + h * 128 + 64 * ih + 32 * i2 + 8 * g + 4 * hi);
        bf16x8_t qf[4];
#pragma unroll
        for (int s4 = 0; s4 < 4; ++s4) qf[s4] = *(const LAS bf16x8_t*)(lds + RT_QT + (32 * j + c) * RT_RP + (16 * s4 + 8 * hi) * 2);
        f32x16_t y0 = {}, y1 = {};
        {
            bf16x8_t sa[4], sb[4];
#pragma unroll
            for (int s4 = 0; s4 < 4; ++s4) { sa[s4] = *(const LAS bf16x8_t*)(lds + RT_ST + (64 * ih + c) * RT_RP + (16 * s4 + 8 * hi) * 2); sb[s4] = *(const LAS bf16x8_t*)(lds + RT_ST + (64 * ih + 32 + c) * RT_RP + (16 * s4 + 8 * hi) * 2); }
            asm volatile("" : "+v"(sa[0]), "+v"(sa[1]), "+v"(sa[2]), "+v"(sa[3]), "+v"(sb[0]), "+v"(sb[1]), "+v"(sb[2]), "+v"(sb[3]));
#pragma unroll
            for (int s4 = 0; s4 < 4; ++s4) { y0 = __builtin_amdgcn_mfma_f32_32x32x16_bf16(sa[s4], qf[s4], y0, 0, 0, 0); y1 = __builtin_amdgcn_mfma_f32_32x32x16_bf16(sb[s4], qf[s4], y1, 0, 0, 0); }
        }
        for (int a = 0; a <= ((MODE & 8) ? -1 : j); ++a) {
            bf16x8_t kf[4], vf0[2], vf1[2];
#pragma unroll
            for (int s4 = 0; s4 < 4; ++s4) kf[s4] = *(const LAS bf16x8_t*)(lds + RT_KT + (32 * a + c) * RT_RP + (16 * s4 + 8 * hi) * 2);
#pragma unroll
            for (int t2 = 0; t2 < 2; ++t2) { vf0[t2] = *(const LAS bf16x8_t*)(lds + RT_VTT + (64 * ih + c) * RT_TP + (((32 * a + 16 * t2 + 8 * hi) * 2) ^ RT_SWZ(64 * ih + c))); vf1[t2] = *(const LAS bf16x8_t*)(lds + RT_VTT + (64 * ih + 32 + c) * RT_TP + (((32 * a + 16 * t2 + 8 * hi) * 2) ^ RT_SWZ(64 * ih + 32 + c))); }
            asm volatile("" : "+v"(kf[0]), "+v"(kf[1]), "+v"(kf[2]), "+v"(kf[3]), "+v"(vf0[0]), "+v"(vf0[1]), "+v"(vf1[0]), "+v"(vf1[1]));
            f32x16_t pa = {};
#pragma unroll
            for (int s4 = 0; s4 < 4; ++s4) pa = __builtin_amdgcn_mfma_f32_32x32x16_bf16(kf[s4], qf[s4], pa, 0, 0, 0);
            float sv[16];
#pragma unroll
            for (int r = 0; r < 16; ++r) { const float v_ = pa[r]; sv[r] = (a == j && ((r & 3) + 8 * (r >> 2) + 4 * hi) > c) ? 0.f : v_; }
            u32x4 pb[2];
            pb[0] = (u32x4){cvtpk(sv[0], sv[1]), cvtpk(sv[2], sv[3]), cvtpk(sv[4], sv[5]), cvtpk(sv[6], sv[7])};
            pb[1] = (u32x4){cvtpk(sv[8], sv[9]), cvtpk(sv[10], sv[11]), cvtpk(sv[12], sv[13]), cvtpk(sv[14], sv[15])};
#pragma unroll
            for (int t2 = 0; t2 < 2; ++t2) { const bf16x8_t pf = __builtin_bit_cast(bf16x8_t, pb[t2]);
                y0 = __builtin_amdgcn_mfma_f32_32x32x16_bf16(vf0[t2], pf, y0, 0, 0, 0); y1 = __builtin_amdgcn_mfma_f32_32x32x16_bf16(vf1[t2], pf, y1, 0, 0, 0); }
        }
        if (!(MODE & 4) && nst >= 1) { RT_STATE_UPD(st0, sti, std0);
#pragma unroll
            for (int r = 0; r < 16; ++r) st0[r] *= g128; }
        if (!(MODE & 4) && nst == 2) { RT_STATE_UPD(st1, sti, 1);
#pragma unroll
            for (int r = 0; r < 16; ++r) st1[r] *= g128; }
        float s1 = 0.f, s2 = 0.f;
#pragma unroll
        for (int r = 0; r < 16; ++r) { const float a_ = y0[r], b_ = y1[r]; s1 += a_ + b_; s2 += a_ * a_ + b_ * b_; }
        s1 += __shfl_xor(s1, 32); s2 += __shfl_xor(s2, 32);
        if (hi == 0) *(LAS f32x2_t*)(lds + RT_STAT + (wid * 32 + c) * 8) = (f32x2_t){s1, s2};
        LDS_BARRIER();
        if (n + 1 < 32) {
            RT_STORE();
            if (nst >= 1) RT_PUT_ST(st0, sti, std0);
            if (nst == 2) RT_PUT_ST(st1, sti, 1);
        }
        { const f32x2_t o = *(const LAS f32x2_t*)(lds + RT_STAT + ((wid ^ 1) * 32 + c) * 8); s1 += o.x; s2 += o.y; }
        const float mu = s1 * (1.f / 128.f), var = fmaxf(s2 * (1.f / 128.f) - mu * mu, 0.f), rstd = rsqrtf(var + EPS);
#pragma unroll
        for (int i2 = 0; i2 < 2; ++i2)
#pragma unroll
            for (int g = 0; g < 4; ++g) {
                const int e = 64 * ih + 32 * i2 + 8 * g + 4 * hi;
                const u32x2 gw = gwv[i2][g]; const f32x4 gn = *(const LAS f32x4*)(lds + RT_GGN + e * 4);
                float yv[4];
#pragma unroll
                for (int x = 0; x < 4; ++x) yv[x] = i2 == 0 ? y0[4 * g + x] : y1[4 * g + x];
                const float o0 = (yv[0] - mu) * rstd * gn.x * bf2f(gw.x & 0xffff), o1 = (yv[1] - mu) * rstd * gn.y * bf2f(gw.x >> 16);
                const float o2 = (yv[2] - mu) * rstd * gn.z * bf2f(gw.y & 0xffff), o3 = (yv[3] - mu) * rstd * gn.w * bf2f(gw.y >> 16);
                u32x2 ow; ow.x = cvtpk(o0, o1); ow.y = cvtpk(o2, o3);
                if (!(MODE & 1) || ow.x == 0x12345678u) *(u32x2*)(RET + row * 1024 + h * 128 + e) = ow;
            }
        if (!(MODE & 16)) { const int Rn = b * SEQ + 128 * (n + 2 < 32 ? n + 2 : 31); RT_LOAD(Rn); }
        LDS_BARRIER();
    }
#undef RT_MPOS
#undef RT_LOAD
#undef RT_TR4
#undef RT_STORE
#undef RT_PUT_ST
#undef RT_STATE_UPD
}
__global__ void __launch_bounds__(512, 2) k_ret(Ptrs p) {
    extern __shared__ __attribute__((aligned(16))) unsigned char lds[];
    for (int u = blockIdx.x; u < 64; u += gridDim.x) ret_unit<0>(p, (LAS unsigned char*)lds, u >> 3, u & 7);
}

__global__ void __launch_bounds__(256) k_zero_ss2(Ptrs p) {
    float* R = (float*)(p.ws + WS_RINV2);
    for (int i = blockIdx.x * 256 + threadIdx.x; i < T; i += gridDim.x * 256) R[i] = 0.f;
}

__global__ void __launch_bounds__(32) k_peer_select_naive(Ptrs p) {
    __shared__ float sc[256][32];
    __shared__ int ii[32][32];
    const bf16_t* PQ = (const bf16_t*)(p.ws + WS_PQ);
    const float* k1 = p.in[16]; const float* k2 = p.in[17];
    int* SELI = (int*)(p.ws + WS_SELI); float* SELG = (float*)(p.ws + WS_SELG);
    const int tid = threadIdx.x, gid = blockIdx.x * 32 + tid, tok = gid >> 3, hd = gid & 7;
    float q[128];
#pragma unroll
    for (int d = 0; d < 128; d += 8) { float t[8]; ld8(PQ + (size_t)tok * D + hd * 128 + d, t);
#pragma unroll
        for (int j = 0; j < 8; ++j) q[d + j] = t[j]; }
    for (int kk = 0; kk < 128; ++kk) {
        float a = 0.f, b = 0.f;
#pragma unroll
        for (int d = 0; d < 64; ++d) { a += q[d] * k1[kk * 64 + d]; b += q[64 + d] * k2[kk * 64 + d]; }
        sc[kk][tid] = a; sc[128 + kk][tid] = b;
    }
    float v1[16], v2[16];
#pragma unroll
    for (int r = 0; r < 16; ++r) {
        float best = -INFINITY; int bi = 0;
        for (int kk = 0; kk < 128; ++kk) { const float x = sc[kk][tid]; if (x > best) { best = x; bi = kk; } }
        sc[bi][tid] = -INFINITY; v1[r] = best; ii[r][tid] = bi;
        best = -INFINITY; bi = 0;
        for (int kk = 0; kk < 128; ++kk) { const float x = sc[128 + kk][tid]; if (x > best) { best = x; bi = kk; } }
        sc[128 + bi][tid] = -INFINITY; v2[r] = best; ii[16 + r][tid] = bi;
    }
#pragma unroll
    for (int i = 0; i < 16; ++i)
#pragma unroll
        for (int j = 0; j < 16; ++j) sc[i * 16 + j][tid] = v1[i] + v2[j];
    float sv[16]; int se[16];
#pragma unroll
    for (int r = 0; r < 16; ++r) {
        float best = -INFINITY; int bi = 0;
        for (int c = 0; c < 256; ++c) { const float x = sc[c][tid]; if (x > best) { best = x; bi = c; } }
        sc[bi][tid] = -INFINITY; sv[r] = best; se[r] = ii[bi >> 4][tid] * 128 + ii[16 + (bi & 15)][tid];
    }
    float den = 0.f; const float mx = sv[0];
#pragma unroll
    for (int r = 0; r < 16; ++r) { sv[r] = __expf(sv[r] - mx); den += sv[r]; }
    const float id = 1.f / den;
#pragma unroll
    for (int r = 0; r < 16; ++r) { SELI[(size_t)tok * 128 + hd * 16 + r] = se[r]; SELG[(size_t)tok * 128 + hd * 16 + r] = sv[r] * id; }
}

__global__ void __launch_bounds__(256) k_peer_gather_naive(Ptrs p) {
    __shared__ float wk[128];
    const int* SELI = (const int*)(p.ws + WS_SELI); const float* SELG = (const float*)(p.ws + WS_SELG);
    const float* RINV2 = (const float*)(p.ws + WS_RINV2); const float* gffn = p.in[14]; const float* U = p.in[18]; const float* Vt = p.in[19];
    const int tok = blockIdx.x, tid = threadIdx.x, lane = tid & 63, w = tid >> 6;
    const float r2 = rsqrtf(RINV2[tok] * (1.f / D) + EPS);
    f32x4 xr[4];
#pragma unroll
    for (int j = 0; j < 4; ++j) { const f32x4 hv = *(const f32x4*)(p.out + (size_t)tok * D + lane * 4 + 256 * j); const f32x4 g = *(const f32x4*)(gffn + lane * 4 + 256 * j); xr[j] = hv * g * r2; }
    for (int k = w * 32; k < w * 32 + 32; ++k) {
        const float* up = U + (size_t)SELI[(size_t)tok * 128 + k] * D;
        float dsum = 0.f;
#pragma unroll
        for (int j = 0; j < 4; ++j) { const f32x4 u = *(const f32x4*)(up + lane * 4 + 256 * j); dsum += u.x * xr[j].x + u.y * xr[j].y + u.z * xr[j].z + u.w * xr[j].w; }
        dsum = wave_sum(dsum);
        const float act = 0.5f * dsum * (1.f + erff(dsum * 0.70710678118654752f));
        if (lane == 0) wk[k] = SELG[(size_t)tok * 128 + k] * act;
    }
    __syncthreads();
    f32x4 acc = (f32x4){0.f, 0.f, 0.f, 0.f};
    for (int k = 0; k < 128; ++k) { const f32x4 v = *(const f32x4*)(Vt + (size_t)SELI[(size_t)tok * 128 + k] * D + tid * 4); acc += v * wk[k]; }
    f32x4* op = (f32x4*)(p.out + (size_t)tok * D + tid * 4); *op = *op + acc;
}

#define LAS __attribute__((address_space(3)))
typedef float f32x16 __attribute__((ext_vector_type(16)));
typedef short bf16x8 __attribute__((ext_vector_type(8)));
__device__ __forceinline__ int sortable(int b) { return b ^ ((b >> 31) & 0x7fffffff); }
__device__ __forceinline__ int imax(int a, int b) { return a > b ? a : b; }
__device__ __forceinline__ int imin(int a, int b) { return a < b ? a : b; }
template <int N, int K, int J> __device__ __forceinline__ void bstep(int (&v)[N]) {
#pragma unroll
    for (int i = 0; i < N; ++i) { const int l = i ^ J; if (l > i) { const int a = v[i], b = v[l]; const bool d = (i & K) == 0; v[i] = d ? imax(a, b) : imin(a, b); v[l] = d ? imin(a, b) : imax(a, b); } }
}
template <int N, int K, int J> __device__ __forceinline__ void bstep2(int (&v)[N], int (&q)[N]) {
#pragma unroll
    for (int i = 0; i < N; ++i) { const int l = i ^ J; if (l > i) { const int a = v[i], b = v[l], pa = q[i], pb = q[l]; const bool gt = a > b; const bool d = (i & K) == 0;
        const int hk = gt ? a : b, lk = gt ? b : a, hp = gt ? pa : pb, lp = gt ? pb : pa; v[i] = d ? hk : lk; v[l] = d ? lk : hk; q[i] = d ? hp : lp; q[l] = d ? lp : hp; } }
}
template <int N, int K, int J> struct BMerge { static __device__ __forceinline__ void run(int (&v)[N]) { bstep<N, K, J>(v); if constexpr (J > 1) BMerge<N, K, J / 2>::run(v); }
                                               static __device__ __forceinline__ void run2(int (&v)[N], int (&q)[N]) { bstep2<N, K, J>(v, q); if constexpr (J > 1) BMerge<N, K, J / 2>::run2(v, q); } };
template <int N, int K> struct BSort { static __device__ __forceinline__ void run(int (&v)[N]) { if constexpr (K > 2) BSort<N, K / 2>::run(v); BMerge<N, K, K / 2>::run(v); }
                                       static __device__ __forceinline__ void run2(int (&v)[N], int (&q)[N]) { if constexpr (K > 2) BSort<N, K / 2>::run2(v, q); BMerge<N, K, K / 2>::run2(v, q); } };
__device__ __forceinline__ void top16_merge(const int (&a)[16], const int (&b)[16], int (&o)[16]) {
#pragma unroll
    for (int i = 0; i < 16; ++i) o[i] = imax(a[i], b[15 - i]);
    BMerge<16, 16, 8>::run(o);
}
__device__ __forceinline__ void top16_merge2(const int (&a)[16], const int (&pa)[16], const int (&b)[16], const int (&pb)[16], int (&o)[16], int (&po)[16]) {
#pragma unroll
    for (int i = 0; i < 16; ++i) { const bool gt = a[i] > b[15 - i]; o[i] = gt ? a[i] : b[15 - i]; po[i] = gt ? pa[i] : pb[15 - i]; }
    BMerge<16, 16, 8>::run2(o, po);
}
__device__ __forceinline__ void top16_of_64(const int (&v)[64], int (&o)[16]) {
    int g[4][16];
#pragma unroll
    for (int q = 0; q < 4; ++q) {
#pragma unroll
        for (int i = 0; i < 16; ++i) g[q][i] = v[q * 16 + i];
        BSort<16, 16>::run(g[q]); }
    int m0[16], m1[16]; top16_merge(g[0], g[1], m0); top16_merge(g[2], g[3], m1); top16_merge(m0, m1, o);
}
__device__ __forceinline__ void top16_of_64p(const int (&v)[64], const int (&pv)[64], int (&o)[16], int (&po)[16]) {
    int g[4][16], h[4][16];
#pragma unroll
    for (int q = 0; q < 4; ++q) {
#pragma unroll
        for (int i = 0; i < 16; ++i) { g[q][i] = v[q * 16 + i]; h[q][i] = pv[q * 16 + i]; }
        BSort<16, 16>::run2(g[q], h[q]); }
    int m0[16], p0[16], m1[16], p1[16]; top16_merge2(g[0], h[0], g[1], h[1], m0, p0); top16_merge2(g[2], h[2], g[3], h[3], m1, p1); top16_merge2(m0, p0, m1, p1, o, po);
}
template <int M, int J, int N> __device__ __forceinline__ void cand_one(const int (&am)[8], const float (&f2)[16], const int (&M2)[16], int (&g)[16], int (&h)[16]) {
    const float f1 = __int_as_float(sortable(am[M] & ~0x7f)); g[N] = sortable(__float_as_int(f1 + f2[J])); h[N] = ((am[M] & 0x7f) << 7) | (M2[J] & 0x7f);
}
__device__ __forceinline__ void cand_rest(const int (&am)[8], const float (&f2)[16], const int (&M2)[16], int (&g)[16], int (&h)[16]) {
    cand_one<1, 0, 0>(am, f2, M2, g, h); cand_one<1, 1, 1>(am, f2, M2, g, h); cand_one<1, 2, 2>(am, f2, M2, g, h); cand_one<1, 3, 3>(am, f2, M2, g, h); cand_one<1, 4, 4>(am, f2, M2, g, h);
    cand_one<2, 0, 5>(am, f2, M2, g, h); cand_one<2, 1, 6>(am, f2, M2, g, h); cand_one<2, 2, 7>(am, f2, M2, g, h);
    cand_one<3, 0, 8>(am, f2, M2, g, h); cand_one<3, 1, 9>(am, f2, M2, g, h);
    cand_one<4, 0, 10>(am, f2, M2, g, h); cand_one<5, 0, 11>(am, f2, M2, g, h); cand_one<6, 0, 12>(am, f2, M2, g, h); cand_one<7, 0, 13>(am, f2, M2, g, h);
    g[14] = (int)0x80000000; h[14] = 0; g[15] = (int)0x80000000; h[15] = 0;
}
constexpr int KEY_PITCH = 144;
__device__ __forceinline__ void peer_keys_to_lds(const Ptrs& p, LAS unsigned char* lds) {
    for (int i = threadIdx.x; i < 2 * 128 * 8; i += blockDim.x) { const int side = i >> 10, row = (i >> 3) & 127, ch = i & 7; const float* src = p.in[16 + side] + row * 64 + ch * 8;
        const f32x4 a = *(const f32x4*)src, b = *(const f32x4*)(src + 4); u32x4 w; w.x = pk2(a.x, a.y); w.y = pk2(a.z, a.w); w.z = pk2(b.x, b.y); w.w = pk2(b.z, b.w);
        *(LAS u32x4*)(lds + (side * 128 + row) * KEY_PITCH + ch * 16) = w; }
}
__device__ __forceinline__ void peer_select_core(const Ptrs& p, const LAS unsigned char* lds, int tok0, int head, int lane, int (&P16o)[16], float (&gate)[16]) {
    const bf16_t* PQ = (const bf16_t*)(p.ws + WS_PQ);
    const int c = lane & 31, hi = lane >> 5, tok = tok0 + c;
    {
        int M1[16], M2[16];
#pragma unroll
        for (int side = 0; side < 2; ++side) {
            bf16x8 bq[4];
#pragma unroll
            for (int s = 0; s < 4; ++s) bq[s] = *(const bf16x8*)(PQ + (size_t)tok * D + head * 128 + side * 64 + 16 * s + 8 * hi);
            int L[16];
            {   int g[2][16], m[2][16];
#pragma unroll
                for (int kt = 0; kt < 4; ++kt) {
                    f32x16 acc = {};
#pragma unroll
                    for (int s = 0; s < 4; ++s) { const bf16x8 a = *(const LAS bf16x8*)(lds + (side * 128 + kt * 32 + c) * KEY_PITCH + (16 * s + 8 * hi) * 2);
                        acc = __builtin_amdgcn_mfma_f32_32x32x16_bf16(a, bq[s], acc, 0, 0, 0); }
#pragma unroll
                    for (int r = 0; r < 16; ++r) { const float fv = acc[r]; g[kt & 1][r] = (sortable(__float_as_int(fv)) & ~0x7f) | (kt * 32 + (r & 3) + 8 * (r >> 2) + 4 * hi); }
                    BSort<16, 16>::run(g[kt & 1]);
                    if (kt & 1) top16_merge(g[0], g[1], m[kt >> 1]);
                    __builtin_amdgcn_sched_barrier(0);
                }
                top16_merge(m[0], m[1], L);
            }
            int A_[16], B_[16];
#pragma unroll
            for (int i = 0; i < 16; ++i) { const int pr = __shfl_xor(L[i], 32); A_[i] = hi ? pr : L[i]; B_[i] = hi ? L[i] : pr; }
            if (side == 0) top16_merge(A_, B_, M1); else top16_merge(A_, B_, M2);
            __builtin_amdgcn_sched_barrier(0);
        }
        int K16[16], P16[16];
        {   int am[8];
#pragma unroll
            for (int m = 0; m < 8; ++m) am[m] = M1[2 * m] ^ ((M1[2 * m] ^ M1[2 * m + 1]) & -hi);
            float f2[16];
#pragma unroll
            for (int j = 0; j < 16; ++j) f2[j] = __int_as_float(sortable(M2[j] & ~0x7f));
            int g0[16], h0[16], g1[16], h1[16];
            { const float f1 = __int_as_float(sortable(am[0] & ~0x7f)); const int e1 = (am[0] & 0x7f) << 7;
#pragma unroll
              for (int j = 0; j < 16; ++j) { g0[j] = sortable(__float_as_int(f1 + f2[j])); h0[j] = e1 | (M2[j] & 0x7f); } }
            cand_rest(am, f2, M2, g1, h1);
            BSort<16, 16>::run2(g1, h1);
            int mk[16], mp[16]; top16_merge2(g0, h0, g1, h1, mk, mp);
            int Ak[16], Ap[16], Bk[16], Bp[16];
#pragma unroll
            for (int i = 0; i < 16; ++i) { const int pk = __shfl_xor(mk[i], 32), pp = __shfl_xor(mp[i], 32); Ak[i] = hi ? pk : mk[i]; Bk[i] = hi ? mk[i] : pk; Ap[i] = hi ? pp : mp[i]; Bp[i] = hi ? mp[i] : pp; }
            top16_merge2(Ak, Ap, Bk, Bp, K16, P16);
        }
        float ex[16], den = 0.f; const float mx = __int_as_float(sortable(K16[0]));
#pragma unroll
        for (int r = 0; r < 16; ++r) { ex[r] = __expf(__int_as_float(sortable(K16[r])) - mx); den += ex[r]; }
        const float id = 1.f / den;
#pragma unroll
        for (int r = 0; r < 16; ++r) { P16o[r] = P16[r]; gate[r] = ex[r] * id; }
    }
}
template <class IP, class GP, class U4P, class F4P>
__device__ __forceinline__ void peer_select_unit(const Ptrs& p, const LAS unsigned char* lds, int tok0, int head, int lane, IP si, GP sg) {
    int P16[16]; float gt[16]; peer_select_core(p, lds, tok0, head, lane, P16, gt);
    const int c = lane & 31, hi = lane >> 5;
    if (hi == 0) { IP ip = si + (size_t)c * 128 + head * 16;
#pragma unroll
        for (int r = 0; r < 16; r += 4) *(U4P)(ip + r) = (u32x4){(unsigned)P16[r], (unsigned)P16[r + 1], (unsigned)P16[r + 2], (unsigned)P16[r + 3]}; }
    else { GP gp = sg + (size_t)c * 128 + head * 16;
#pragma unroll
        for (int r = 0; r < 16; r += 4) *(F4P)(gp + r) = (f32x4){gt[r], gt[r + 1], gt[r + 2], gt[r + 3]}; }
}
__device__ __forceinline__ void peer_select_phase(const Ptrs& p, LAS unsigned char* lds, int* SELI, float* SELG, int gw, int nw, int lane) {
    peer_keys_to_lds(p, lds); __syncthreads();
    for (int task = gw; task < 8192; task += nw) { const int tok0 = (task >> 3) * 32; peer_select_unit<int*, float*, u32x4*, f32x4*>(p, lds, tok0, task & 7, lane, SELI + (size_t)tok0 * 128, SELG + (size_t)tok0 * 128); }
}
__global__ void __launch_bounds__(512, 2) k_peer_select(Ptrs p, int alt) {
    extern __shared__ __attribute__((aligned(16))) unsigned char lds[];
    int* si = (int*)(p.ws + (alt ? WS_RET : WS_SELI)); float* sg = (float*)(p.ws + (alt ? WS_RET + (size_t)T * 128 * 4 : WS_SELG));
    peer_select_phase(p, (LAS unsigned char*)lds, si, sg, blockIdx.x * 8 + (threadIdx.x >> 6), gridDim.x * 8, threadIdx.x & 63);
}
__global__ void __launch_bounds__(256) k_peer_select256(Ptrs p, int alt) {
    extern __shared__ __attribute__((aligned(16))) unsigned char lds[];
    int* si = (int*)(p.ws + (alt ? WS_RET : WS_SELI)); float* sg = (float*)(p.ws + (alt ? WS_RET + (size_t)T * 128 * 4 : WS_SELG));
    peer_select_phase(p, (LAS unsigned char*)lds, si, sg, blockIdx.x * 4 + (threadIdx.x >> 6), gridDim.x * 4, threadIdx.x & 63);
}
__global__ void k_dbg_cmp_sel(Ptrs p, int mode) {
    const int gid = blockIdx.x * blockDim.x + threadIdx.x; if (gid >= T * 8) return;
    const int* a = (const int*)(p.ws + WS_SELI) + (size_t)gid * 16; const int* b = (const int*)(p.ws + WS_RET) + (size_t)gid * 16;
    const float* ga = (const float*)(p.ws + WS_SELG) + (size_t)gid * 16; const float* gb = (const float*)(p.ws + WS_RET + (size_t)T * 128 * 4) + (size_t)gid * 16;
    int miss = 0; float gd = 0.f;
    for (int i = 0; i < 16; ++i) { bool f = false; for (int j = 0; j < 16; ++j) f |= (a[i] == b[j]); miss += f ? 0 : 1; gd += fabsf(ga[i] - gb[i]); }
    unsigned* ctl = (unsigned*)(p.ws + WS_CTL);
    if (mode == 0) { if (miss) atomicAdd(ctl, 1u); }
    else if (mode == 1) { if (a[0] != b[0]) atomicAdd(ctl, 1u); }
    else if (mode == 2) { atomicAdd(ctl, (unsigned)miss); }
    else { atomicAdd((float*)ctl + 1, gd); }
}
__global__ void k_dbg_cmp_scores(Ptrs p) {
    const int gid = blockIdx.x * blockDim.x + threadIdx.x; if (gid >= 1024 * 8 * 2 * 128) return;
    const int key = gid & 127, side = (gid >> 7) & 1, head = (gid >> 8) & 7, tok = gid >> 11;
    const bf16_t* PQ = (const bf16_t*)(p.ws + WS_PQ); const float* kk = p.in[16 + side] + key * 64;
    float a = 0.f; for (int d = 0; d < 64; ++d) a += bf2f(PQ[(size_t)tok * D + head * 128 + side * 64 + d]) * kk[d];
    const float b = ((const float*)(p.ws + WS_RET + (size_t)64 * 1024 * 1024))[gid];
#if DBG_SCORES == 2
    atomicAdd((float*)(p.ws + WS_CTL) + 1, fabsf(a - b) > 0.1f ? 1.f : 0.f);
#elif DBG_SCORES == 3
    if (fabsf(a - b) > 0.1f) { atomicAdd((float*)(p.ws + WS_CTL) + 1, (float)((key & 31) + 1) / 32.f); atomicAdd((float*)(p.ws + WS_CTL) + 2, 1.f); }
#elif DBG_SCORES == 4
    if (fabsf(a - b) > 0.1f) { atomicAdd((float*)(p.ws + WS_CTL) + 1, (float)((tok & 31) + 1) / 32.f); atomicAdd((float*)(p.ws + WS_CTL) + 2, 1.f); }
#elif DBG_SCORES == 5
    if (fabsf(a - b) > 0.1f) { atomicAdd((float*)(p.ws + WS_CTL) + 1, fminf(fabsf(b), 10.f) / 10.f); atomicAdd((float*)(p.ws + WS_CTL) + 2, 1.f); }
#else
    atomicAdd((float*)(p.ws + WS_CTL) + 1, fabsf(a - b));
#endif
}
__global__ void k_dbg_scale(Ptrs p, float denom, int mode) {
    const unsigned* ctl = (const unsigned*)(p.ws + WS_CTL);
#if defined(DBG_SCORES) && DBG_SCORES >= 3
    const float m = ((const float*)ctl)[1] / fmaxf(((const float*)ctl)[2], 1.f);
#else
    const float m = mode == 3 ? ((const float*)ctl)[1] / denom : (float)ctl[0] / denom;
#endif
    for (size_t i = (size_t)blockIdx.x * blockDim.x + threadIdx.x; i < (size_t)T * D; i += (size_t)gridDim.x * blockDim.x) p.out[i] *= (1.f + m);
}

typedef __bf16 bf16x2_t __attribute__((ext_vector_type(2)));
__device__ __forceinline__ float dot2bf(unsigned a, unsigned b, float c) { return __builtin_amdgcn_fdot2_f32_bf16(__builtin_bit_cast(bf16x2_t, a), __builtin_bit_cast(bf16x2_t, b), c, false); }
constexpr size_t WS_U8 = WS_K, WS_V8 = WS_K + (size_t)16384 * 1024, WS_SU = WS_V, WS_SV = WS_V + 65536;
static_assert(WS_V8 + (size_t)16384 * 1024 <= WS_V && WS_SV + 65536 <= WS_RET, "peer table overlay");
__device__ __forceinline__ float wave_max(float v) {
#pragma unroll
    for (int o = 1; o < 64; o <<= 1) v = fmaxf(v, __shfl_xor(v, o));
    return v;
}
__device__ __forceinline__ void prep_uv_part(const Ptrs& p, int gw, int nw, int lane) {
    for (int row = gw; row < 2 * 16384; row += nw) {
        const int t = row >> 14, e = row & 16383;
        const float* src = p.in[18 + t] + (size_t)e * D + lane * 16;
        f32x4 v[4]; float am = 0.f;
#pragma unroll
        for (int j = 0; j < 4; ++j) { v[j] = *(const f32x4*)(src + 4 * j); am = fmaxf(am, fmaxf(fmaxf(fabsf(v[j].x), fabsf(v[j].y)), fmaxf(fabsf(v[j].z), fabsf(v[j].w)))); }
        am = fmaxf(wave_max(am), 1e-30f);
        const float inv = 127.f / am; const int off = 0;
        u32x4 w;
#pragma unroll
        for (int j = 0; j < 4; ++j) { const int q0 = (int)rintf(v[j].x * inv) + off, q1 = (int)rintf(v[j].y * inv) + off, q2 = (int)rintf(v[j].z * inv) + off, q3 = (int)rintf(v[j].w * inv) + off;
            w[j] = (unsigned)(q0 & 0xff) | ((unsigned)(q1 & 0xff) << 8) | ((unsigned)(q2 & 0xff) << 16) | ((unsigned)(q3 & 0xff) << 24); }
        *(u32x4*)(p.ws + (t ? WS_V8 : WS_U8) + (size_t)e * D + lane * 16) = w;
        if (lane == 0) ((float*)(p.ws + (t ? WS_SV : WS_SU)))[e] = am * (1.f / 127.f);
    }
}
__global__ void __launch_bounds__(512) k_prep_uv(Ptrs p) { prep_uv_part(p, blockIdx.x * 8 + (threadIdx.x >> 6), gridDim.x * 8, threadIdx.x & 63); }

__device__ __forceinline__ float gelu_erf(float x) { return 0.5f * x * (1.f + erff(x * 0.70710678118654752f)); }
__device__ __forceinline__ float treduce8(const float (&v)[8], int lane) {
    float w[4], x[2], y;
    const bool b0 = lane & 1, b1 = lane & 2, b2 = lane & 4;
#pragma unroll
    for (int i = 0; i < 4; ++i) { const float keep = b0 ? v[2 * i + 1] : v[2 * i], send = b0 ? v[2 * i] : v[2 * i + 1]; w[i] = keep + __shfl_xor(send, 1); }
#pragma unroll
    for (int i = 0; i < 2; ++i) { const float keep = b1 ? w[2 * i + 1] : w[2 * i], send = b1 ? w[2 * i] : w[2 * i + 1]; x[i] = keep + __shfl_xor(send, 2); }
    { const float keep = b2 ? x[1] : x[0], send = b2 ? x[0] : x[1]; y = keep + __shfl_xor(send, 4); }
    y += __shfl_xor(y, 8); y += __shfl_xor(y, 16); y += __shfl_xor(y, 32);
    return y;
}
__device__ __forceinline__ int treduce8i(const int (&v)[8], int lane) {
    int w[4], x[2], y;
    const bool b0 = lane & 1, b1 = lane & 2, b2 = lane & 4;
#pragma unroll
    for (int i = 0; i < 4; ++i) { const int keep = b0 ? v[2 * i + 1] : v[2 * i], send = b0 ? v[2 * i] : v[2 * i + 1]; w[i] = keep + __shfl_xor(send, 1); }
#pragma unroll
    for (int i = 0; i < 2; ++i) { const int keep = b1 ? w[2 * i + 1] : w[2 * i], send = b1 ? w[2 * i] : w[2 * i + 1]; x[i] = keep + __shfl_xor(send, 2); }
    { const int keep = b2 ? x[1] : x[0], send = b2 ? x[0] : x[1]; y = keep + __shfl_xor(send, 4); }
    y += __shfl_xor(y, 8); y += __shfl_xor(y, 16); y += __shfl_xor(y, 32);
    return y;
}
__device__ __forceinline__ void peer_gather_token(const Ptrs& p, int tok, int i0, int i1, float g0, float g1, int lane, bool do_store = true) {
    const float* SS2 = (const float*)(p.ws + WS_RINV2); const float* gffn = p.in[14];
    const unsigned char* U8 = p.ws + WS_U8; const unsigned char* V8 = p.ws + WS_V8; const float* SU = (const float*)(p.ws + WS_SU); const float* SV = (const float*)(p.ws + WS_SV);
    int xq[4]; float xs;
    {   const float r2 = rsqrtf(SS2[tok] * (1.f / D) + EPS); const float* hp = p.out + (size_t)tok * D + lane * 16; const float* gp = gffn + lane * 16;
        f32x4 x[4]; float am = 0.f;
#pragma unroll
        for (int j = 0; j < 4; ++j) { x[j] = *(const f32x4*)(hp + 4 * j) * *(const f32x4*)(gp + 4 * j) * r2; am = fmaxf(am, fmaxf(fmaxf(fabsf(x[j].x), fabsf(x[j].y)), fmaxf(fabsf(x[j].z), fabsf(x[j].w)))); }
        am = fmaxf(wave_max(am), 1e-30f); xs = am * (1.f / 127.f); const float inv = 127.f / am;
#pragma unroll
        for (int j = 0; j < 4; ++j) xq[j] = (int)(((unsigned)((int)rintf(x[j].x * inv) & 0xff)) | ((unsigned)((int)rintf(x[j].y * inv) & 0xff) << 8) | ((unsigned)((int)rintf(x[j].z * inv) & 0xff) << 16) | ((unsigned)((int)rintf(x[j].w * inv) & 0xff) << 24));
    }
    const float su0 = SU[i0], su1 = SU[i1], sv0 = SV[i0], sv1 = SV[i1];
    int a0 = 0, a1 = 0;
#pragma unroll 1
    for (int kb = 0; kb < 8; ++kb) {
        u32x4 r[16];
#pragma unroll
        for (int e = 0; e < 16; ++e) { const int k = kb * 16 + e; const int idx = __builtin_amdgcn_readlane(kb < 4 ? i0 : i1, k & 63); r[e] = *(const u32x4*)(U8 + (size_t)idx * D + lane * 16); }
        int pa[8], pb[8];
#pragma unroll
        for (int e = 0; e < 16; ++e) { int d = __builtin_amdgcn_sdot4((int)r[e].x, xq[0], 0, false); d = __builtin_amdgcn_sdot4((int)r[e].y, xq[1], d, false); d = __builtin_amdgcn_sdot4((int)r[e].z, xq[2], d, false); d = __builtin_amdgcn_sdot4((int)r[e].w, xq[3], d, false);
            if (e < 8) pa[e] = d; else pb[e - 8] = d; }
        const int ya = treduce8i(pa, lane), yb = treduce8i(pb, lane);
        const int y = (lane & 8) ? yb : ya;
        if ((kb & 3) == ((lane >> 4) & 3)) { if (kb < 4) a0 = y; else a1 = y; }
    }
    const float wv0 = g0 * gelu_erf((float)a0 * su0 * xs) * sv0, wv1 = g1 * gelu_erf((float)a1 * su1 * xs) * sv1;
    const float corr = 0.f;
    float acc[16];
#pragma unroll
    for (int e = 0; e < 16; ++e) acc[e] = 0.f;
#pragma unroll 1
    for (int kb = 0; kb < 8; ++kb) {
        u32x4 r[16];
#pragma unroll
        for (int e = 0; e < 16; ++e) { const int k = kb * 16 + e; const int idx = __builtin_amdgcn_readlane(kb < 4 ? i0 : i1, k & 63); r[e] = *(const u32x4*)(V8 + (size_t)idx * D + lane * 16); }
#pragma unroll
        for (int e = 0; e < 16; ++e) { const int k = kb * 16 + e; const float wk = __int_as_float(__builtin_amdgcn_readlane(__float_as_int(kb < 4 ? wv0 : wv1), k & 63));
#pragma unroll
            for (int j = 0; j < 4; ++j) { const unsigned w = r[e][j];
                acc[4 * j + 0] += wk * (float)((int)(w << 24) >> 24); acc[4 * j + 1] += wk * (float)((int)(w << 16) >> 24); acc[4 * j + 2] += wk * (float)((int)(w << 8) >> 24); acc[4 * j + 3] += wk * (float)((int)w >> 24); } }
    }
    {   float* hp = p.out + (size_t)tok * D + lane * 16;
#pragma unroll
        for (int j = 0; j < 4; ++j) { f32x4 a = *(const f32x4*)(hp + 4 * j);
            a.x += acc[4 * j] - corr; a.y += acc[4 * j + 1] - corr; a.z += acc[4 * j + 2] - corr; a.w += acc[4 * j + 3] - corr;
            if (do_store || a.x == 1.2345e30f) *(f32x4*)(hp + 4 * j) = a; } }
}
__device__ __forceinline__ void peer_gather_phase(const Ptrs& p, int gw, int nw, int lane) {
    const int* SELI = (const int*)(p.ws + WS_SELI); const float* SELG = (const float*)(p.ws + WS_SELG);
    for (int tok = gw; tok < T; tok += nw)
        peer_gather_token(p, tok, SELI[(size_t)tok * 128 + lane], SELI[(size_t)tok * 128 + 64 + lane], SELG[(size_t)tok * 128 + lane], SELG[(size_t)tok * 128 + 64 + lane], lane);
}
__global__ void __launch_bounds__(512, 2) k_peer_gather(Ptrs p) {
    peer_gather_phase(p, blockIdx.x * 8 + (threadIdx.x >> 6), gridDim.x * 8, threadIdx.x & 63);
}

#include <hip/hip_cooperative_groups.h>
namespace cg = cooperative_groups;
constexpr int CW_Q3 = 64;
constexpr int MISC_OFF = LDS_BYTES - 64;

constexpr int CW_BAR = 4096;
#define XB_TMO      128
#define XB_XCNT(j)  (256  + 64 * (j))
#define XB_XSUB(j)  (1280 + 64 * (j))
#define XB_XGEN(j)  (2304 + 64 * (j))
#define XB_TOP      3328
#define XB_TOPGEN   3392
#define XCD_BAR_WORDS 3456
#define XB_SPIN_CAP (1u << 18)
__device__ __forceinline__ unsigned xb_ld(unsigned* p)              { return __hip_atomic_load(p, __ATOMIC_RELAXED, __HIP_MEMORY_SCOPE_AGENT); }
__device__ __forceinline__ unsigned xb_add(unsigned* p, unsigned v) { return __hip_atomic_fetch_add(p, v, __ATOMIC_RELAXED, __HIP_MEMORY_SCOPE_AGENT); }
__device__ __forceinline__ unsigned xb_xcc_id() { return (unsigned)__builtin_amdgcn_s_getreg((3 << 11) | 20) & 0xFu; }
#define XB_SPIN(cond, bar) do { unsigned _sp = 0; while (cond) { __builtin_amdgcn_s_sleep(1); \
    if ((++_sp & 255u) == 0u) { if (xb_ld(&(bar)[XB_TMO])) break; if (_sp > XB_SPIN_CAP) { atomicAdd(&(bar)[XB_TMO], 1u); break; } } } } while (0)
struct XcdBarrier { unsigned* bar; unsigned x; volatile LAS unsigned* st; };
__device__ __forceinline__ XcdBarrier xcd_barrier_post(unsigned* bar, volatile LAS unsigned* st) {
    XcdBarrier b; b.bar = bar; b.x = xb_xcc_id(); b.st = st;
    if (threadIdx.x == 0) (void)xb_add(&bar[XB_XCNT(b.x)], 1u);
    return b;
}
__device__ __forceinline__ void xcd_barrier_complete(unsigned* bar, unsigned x, unsigned& nloc, unsigned& nx) {
    const unsigned G = gridDim.x * gridDim.y * gridDim.z;
    unsigned sum, cnt, mine, sp = 0u;
    for (;;) {
        sum = 0u; cnt = 0u; mine = 0u;
#pragma unroll
        for (unsigned j = 0; j < 16; ++j) { const unsigned c = xb_ld(&bar[XB_XCNT(j)]); sum += c; cnt += (c > 0u) ? 1u : 0u; mine = (j == x) ? c : mine; }
        if (sum == G) break;
        __builtin_amdgcn_s_sleep(1);
        if ((++sp & 255u) == 0u) { if (xb_ld(&bar[XB_TMO])) break; if (sp > XB_SPIN_CAP) { atomicAdd(&bar[XB_TMO], 1u); break; } }
    }
    nloc = mine > 0u ? mine : 1u; nx = cnt > 0u ? cnt : 1u;
}
__device__ __forceinline__ void xcd_barrier(const XcdBarrier& b) {
    asm volatile("s_waitcnt vmcnt(0)" ::: "memory");
    __syncthreads();
    if (threadIdx.x == 0) {
        unsigned* bar = b.bar;
        __builtin_amdgcn_s_waitcnt(0);
        unsigned nloc = b.st[0], nx = b.st[1];
        if (nloc == 0u) { xcd_barrier_complete(bar, b.x, nloc, nx); b.st[0] = nloc; b.st[1] = nx; }
        const unsigned old = xb_add(&bar[XB_XSUB(b.x)], 1u);
        const unsigned gen = old / nloc;
        if (old + 1u == (gen + 1u) * nloc) {
            __builtin_amdgcn_fence(__ATOMIC_RELEASE, "agent");
            asm volatile("s_waitcnt vmcnt(0)" ::: "memory");
            const unsigned og = xb_add(&bar[XB_TOP], 1u);
            const unsigned tg = og / nx;
            if (og + 1u == (tg + 1u) * nx) xb_add(&bar[XB_TOPGEN], 1u);
            else XB_SPIN(xb_ld(&bar[XB_TOPGEN]) == tg, bar);
            __builtin_amdgcn_fence(__ATOMIC_ACQUIRE, "agent");
            xb_add(&bar[XB_XGEN(b.x)], 1u);
            asm volatile("s_waitcnt vmcnt(0)" ::: "memory");
        } else {
            XB_SPIN(xb_ld(&bar[XB_XGEN(b.x)]) == gen, bar);
            __builtin_amdgcn_fence(__ATOMIC_ACQUIRE, "agent");
            asm volatile("s_waitcnt vmcnt(0)" ::: "memory");
        }
    }
    __syncthreads();
}

__device__ __forceinline__ void prep_w_tile(const float* __restrict__ W, const float* __restrict__ gain, bf16_t* __restrict__ Wt, int K, int Nsrc, int mode, int tn, int tk, LAS float* tile) {
    const int t_ = opaque_tid(), tx = t_ & 63, ty = t_ >> 6, n0 = tn * 64, k0 = tk * 64, n = n0 + tx; const int src = mode ? win_src(n) : n;
    for (int kk = ty; kk < 64; kk += 8) { float v = 0.f; if (src >= 0) { v = W[(size_t)(k0 + kk) * Nsrc + src]; if (gain) v *= gain[k0 + kk]; } tile[kk * 65 + tx] = v; }
    __syncthreads();
    for (int nn = ty; nn < 64; nn += 8) Wt[(size_t)(n0 + nn) * K + k0 + tx] = (bf16_t)f2bf(tile[tx * 65 + nn]);
    __syncthreads();
}
__device__ __forceinline__ void prep_phase(const Ptrs& p, LAS unsigned char* lds) {
    const int tid = opaque_tid(), lane = tid & 63, G = gridDim.x, bx = blockIdx.x;
    unsigned char* ws = p.ws;
    if (bx == 0 && tid == 0) ((unsigned*)(ws + WS_CTL))[CW_Q3] = 0u;
    { float* R = (float*)(ws + WS_RINV2); for (int i = bx * 512 + tid; i < T; i += G * 512) R[i] = 0.f; }
    {
        float2* R32 = (float2*)(ws + WS_ROPE32); float2* R16 = (float2*)(ws + WS_ROPE16);
        for (int i = bx * 512 + tid; i < 4112 * 32; i += G * 512) {
            { const int pos = i >> 5, f = i & 31; const float inv = (float)pow(10000.0, -(double)f / 32.0); const float ang = (float)pos * inv; R32[i] = make_float2((float)cos((double)ang), (float)sin((double)ang)); }
            if (i < 4112 * 16) { const int pos = i >> 4, f = i & 15; const float inv = (float)pow(10000.0, -(double)f / 16.0); const float ang = (float)pos * inv; R16[i] = make_float2((float)cos((double)ang), (float)sin((double)ang)); }
            if (i < 8 * 256) ((float*)(ws + WS_DEC))[i] = (float)pow(1.0 - exp2(-5.0 - (double)(i >> 8)), (double)((i & 255) + 1)); }
    }
    {
        bf16_t* XB = (bf16_t*)(ws + WS_XB);
        for (int r = bx * 8 + (tid >> 6); r < MP; r += G * 8) {
            f32x4 v[4];
            if (r < T + NMETA) { const float* src = r < T ? p.in[0] + (size_t)r * D : p.in[1] + (size_t)(r - T) * D;
#pragma unroll
                for (int j = 0; j < 4; ++j) v[j] = *(const f32x4*)(src + lane * 4 + 256 * j); }
            else {
#pragma unroll
                for (int j = 0; j < 4; ++j) v[j] = (f32x4){0.f, 0.f, 0.f, 0.f}; }
            float ss = 0.f;
#pragma unroll
            for (int j = 0; j < 4; ++j) ss += v[j].x * v[j].x + v[j].y * v[j].y + v[j].z * v[j].z + v[j].w * v[j].w;
            ss = wave_sum(ss);
            const float rinv = rsqrtf(ss * (1.f / D) + EPS);
#pragma unroll
            for (int j = 0; j < 4; ++j) { uint2 o; o.x = pk2(v[j].x * rinv, v[j].y * rinv); o.y = pk2(v[j].z * rinv, v[j].w * rinv); *(uint2*)(XB + (size_t)r * D + lane * 4 + 256 * j) = o; }
        }
    }
    {
        LAS float* tile = (LAS float*)lds;
        constexpr int NT0 = (NIN / 64) * 16, NT1 = NT0 + 12 * 6, NT2 = NT1 + 16 * 4, NT3 = NT2 + 16 * 8, NT4 = NT3 + 256, NT5 = NT4 + 256, NT6 = NT5 + 256;
        for (int it = bx; it < NT6; it += G) {
            if (it < NT0) prep_w_tile(p.in[3], p.in[2], (bf16_t*)(ws + WS_WIN), 1024, 5792, 1, it / 16, it % 16, tile);
            else if (it < NT1) { const int r = it - NT0; prep_w_tile(p.in[5], p.in[4], (bf16_t*)(ws + WS_WUQ), 384, 768, 0, r / 6, r % 6, tile); }
            else if (it < NT2) { const int r = it - NT1; prep_w_tile(p.in[7], p.in[6], (bf16_t*)(ws + WS_WUKV), 256, 1024, 0, r / 4, r % 4, tile); }
            else if (it < NT3) { const int r = it - NT2; prep_w_tile(p.in[10], nullptr, (bf16_t*)(ws + WS_WMLA), 512, 1024, 0, r / 8, r % 8, tile); }
            else if (it < NT4) { const int r = it - NT3; prep_w_tile(p.in[12], nullptr, (bf16_t*)(ws + WS_WRET), 1024, 1024, 0, r / 16, r % 16, tile); }
            else if (it < NT5) { const int r = it - NT4; prep_w_tile(p.in[13], nullptr, (bf16_t*)(ws + WS_WMIX), 1024, 1024, 0, r / 16, r % 16, tile); }
            else { const int r = it - NT5; prep_w_tile(p.in[15], p.in[14], (bf16_t*)(ws + WS_WPQ), 1024, 1024, 0, r / 16, r % 16, tile); }
        }
    }
}
template <int RMODE = 0>
__device__ __forceinline__ void mixer_phase(const Ptrs& p, LAS unsigned char* lds, int lo = 0, int hi_ = 64 + 1024) {
    unsigned* ctl = (unsigned*)(p.ws + WS_CTL);
    volatile LAS unsigned* bc = (volatile LAS unsigned*)(lds + MISC_OFF);
    for (;;) {
        __syncthreads();
        if (threadIdx.x == 0) *bc = __hip_atomic_fetch_add(ctl + CW_Q3, 1u, __ATOMIC_RELAXED, __HIP_MEMORY_SCOPE_AGENT);
        __syncthreads();
        const int it = (int)*bc + lo;
        if (it >= hi_) break;
        if (it < 64) ret_unit<RMODE>(p, lds, it >> 3, it & 7);
        else { const int a = it - 64, qb = 15 - (a >> 6), bh = a & 63; attn_unit(p, lds, bh >> 3, bh & 7, qb); }
    }
}
constexpr int PL_SELI = 2 * 128 * KEY_PITCH, PL_SELG = PL_SELI + 32 * 128 * 4, PL_END = PL_SELG + 32 * 128 * 4;
static_assert(PL_END <= MISC_OFF, "peer LDS");
__device__ __forceinline__ void peer_phase(const Ptrs& p, LAS unsigned char* lds, bool do_store = true) {
    const int tid = opaque_tid(), lane = tid & 63, wid = __builtin_amdgcn_readfirstlane(tid >> 6);
    peer_keys_to_lds(p, lds);
    for (int u = blockIdx.x; u < T / 32; u += gridDim.x) {
        __syncthreads();
        peer_select_unit<LAS int*, LAS float*, LAS u32x4*, LAS f32x4*>(p, lds, u * 32, wid, lane, (LAS int*)(lds + PL_SELI), (LAS float*)(lds + PL_SELG));
        __syncthreads();
#pragma unroll 1
        for (int k = 0; k < 4; ++k) { const int tl = wid * 4 + k;
            const LAS int* ip = (const LAS int*)(lds + PL_SELI) + tl * 128; const LAS float* gp = (const LAS float*)(lds + PL_SELG) + tl * 128;
            peer_gather_token(p, u * 32 + tl, ip[lane], ip[64 + lane], gp[lane], gp[64 + lane], lane, do_store); }
    }
}

constexpr size_t WS_IDXP = WS_RQ, WS_GATEP = WS_RQ + (size_t)T * 128 * 2;
constexpr size_t WS_XQ = WS_XB, WS_XS = WS_XB + (size_t)T * 1024;
constexpr size_t WS_WVP = WS_LAT, WS_CORR = WS_LAT + (size_t)T * 128 * 4;
static_assert(WS_GATEP + (size_t)T * 128 * 4 <= WS_RV && WS_XS + (size_t)T * 4 <= WS_LAT && WS_CORR + (size_t)T * 4 <= WS_RQ, "sliced PEER overlay");
__device__ __forceinline__ void peer_pre_phase(const Ptrs& p, LAS unsigned char* lds) {
    const int tid = opaque_tid(), lane = tid & 63, wid = __builtin_amdgcn_readfirstlane(tid >> 6), G = gridDim.x, bx = blockIdx.x;
    peer_keys_to_lds(p, lds);
    {
        const float* SS2 = (const float*)(p.ws + WS_RINV2); const float* gffn = p.in[14];
        for (int tok = bx * 8 + wid; tok < T; tok += G * 8) {
            const float r2 = rsqrtf(SS2[tok] * (1.f / D) + EPS); const bf16_t* hp = (const bf16_t*)(p.ws + WS_H1B) + (size_t)tok * D + lane * 16; const float* gp = gffn + lane * 16;
            f32x4 x[4]; float am = 0.f; float hv[16]; { float t0[8], t1[8]; ld8(hp, t0); ld8(hp + 8, t1);
#pragma unroll
                for (int e = 0; e < 8; ++e) { hv[e] = t0[e]; hv[8 + e] = t1[e]; } }
#pragma unroll
            for (int j = 0; j < 4; ++j) { x[j] = (f32x4){hv[4 * j], hv[4 * j + 1], hv[4 * j + 2], hv[4 * j + 3]} * *(const f32x4*)(gp + 4 * j) * r2; am = fmaxf(am, fmaxf(fmaxf(fabsf(x[j].x), fabsf(x[j].y)), fmaxf(fabsf(x[j].z), fabsf(x[j].w)))); }
            am = fmaxf(wave_max(am), 1e-30f); const float inv = 127.f / am; u32x4 w;
#pragma unroll
            for (int j = 0; j < 4; ++j) w[j] = ((unsigned)((int)rintf(x[j].x * inv) & 0xff)) | ((unsigned)((int)rintf(x[j].y * inv) & 0xff) << 8) | ((unsigned)((int)rintf(x[j].z * inv) & 0xff) << 16) | ((unsigned)((int)rintf(x[j].w * inv) & 0xff) << 24);
            *(u32x4*)(p.ws + WS_XQ + (size_t)tok * D + lane * 16) = w;
            if (lane == 0) ((float*)(p.ws + WS_XS))[tok] = am * (1.f / 127.f);
        }
    }
    __syncthreads();
    unsigned short* IDXP = (unsigned short*)(p.ws + WS_IDXP); float* GATEP = (float*)(p.ws + WS_GATEP);
    for (int u = bx; u < T / 32; u += G) {
        int P16[16]; float gt[16]; peer_select_core(p, lds, u * 32, wid, lane, P16, gt);
        const int tok = u * 32 + (lane & 31);
        if ((lane >> 5) == 0) {
#pragma unroll
            for (int r = 0; r < 8; ++r) *(unsigned*)(IDXP + (size_t)tok * 128 + r * 16 + 2 * wid) = (unsigned)P16[r] | ((unsigned)P16[r + 8] << 16); }
        else {
#pragma unroll
            for (int r = 0; r < 8; ++r) *(f32x2_t*)(GATEP + (size_t)tok * 128 + r * 16 + 2 * wid) = (f32x2_t){gt[r], gt[r + 8]}; }
    }
}
__device__ __forceinline__ int treduce8g(const int (&v)[8], int lane) {
    int w[4], x[2];
    const bool b0 = lane & 1, b1 = lane & 2, b2 = lane & 4;
#pragma unroll
    for (int i = 0; i < 4; ++i) { const int keep = b0 ? v[2 * i + 1] : v[2 * i], send = b0 ? v[2 * i] : v[2 * i + 1]; w[i] = keep + __shfl_xor(send, 1); }
#pragma unroll
    for (int i = 0; i < 2; ++i) { const int keep = b1 ? w[2 * i + 1] : w[2 * i], send = b1 ? w[2 * i] : w[2 * i + 1]; x[i] = keep + __shfl_xor(send, 2); }
    const int keep = b2 ? x[1] : x[0], send = b2 ? x[0] : x[1];
    return keep + __shfl_xor(send, 4);
}
#define PEER_IDX16(ia, ib, i) ((int)((((i) < 8 ? ia : ib)[((i) & 7) >> 1] >> (16 * ((i) & 1))) & 0xffffu))
__device__ __forceinline__ void peer_u_phase(const Ptrs& p) {
    const int tid = opaque_tid(), lane = tid & 63, wid = __builtin_amdgcn_readfirstlane(tid >> 6), G = gridDim.x, bx = blockIdx.x;
    const int j = bx & 7, wg = (bx >> 3) * 8 + wid, nwg = (G >> 3) * 8, g = lane >> 3, s = lane & 7;
    const unsigned char* U8 = p.ws + WS_U8 + 128 * j + 16 * s; const unsigned short* IDXP = (const unsigned short*)(p.ws + WS_IDXP); int* PP = (int*)p.out;
    int tok = wg; if (tok >= T) return;
    u32x4 ia = *(const u32x4*)(IDXP + (size_t)tok * 128 + g * 16), ib = *(const u32x4*)(IDXP + (size_t)tok * 128 + g * 16 + 8);
    u32x4 xq = *(const u32x4*)(p.ws + WS_XQ + (size_t)tok * D + 128 * j + 16 * s);
    for (; tok < T; tok += nwg) {
        u32x4 r[16];
#pragma unroll
        for (int i = 0; i < 16; ++i) r[i] = *(const u32x4*)(U8 + (size_t)PEER_IDX16(ia, ib, i) * D);
        const u32x4 xc = xq; const int tn = tok + nwg;
        if (tn < T) { ia = *(const u32x4*)(IDXP + (size_t)tn * 128 + g * 16); ib = *(const u32x4*)(IDXP + (size_t)tn * 128 + g * 16 + 8); xq = *(const u32x4*)(p.ws + WS_XQ + (size_t)tn * D + 128 * j + 16 * s); }
        int pa[8], pb[8];
#pragma unroll
        for (int i = 0; i < 16; ++i) { int d = __builtin_amdgcn_sdot4((int)r[i].x, (int)xc.x, 0, false); d = __builtin_amdgcn_sdot4((int)r[i].y, (int)xc.y, d, false); d = __builtin_amdgcn_sdot4((int)r[i].z, (int)xc.z, d, false); d = __builtin_amdgcn_sdot4((int)r[i].w, (int)xc.w, d, false);
            if (i < 8) pa[i] = d; else pb[i - 8] = d; }
        const int ya = treduce8g(pa, lane), yb = treduce8g(pb, lane);
        int* pp = PP + ((size_t)tok * 8 + j) * 128 + 16 * g + s; pp[0] = ya; pp[8] = yb;
    }
}
__device__ __forceinline__ void peer_reduce_phase(const Ptrs& p, int gw, int nw, int lane) {
    const unsigned short* IDXP = (const unsigned short*)(p.ws + WS_IDXP); const float* GATEP = (const float*)(p.ws + WS_GATEP); const int* PP = (const int*)p.out;
    const float* SU = (const float*)(p.ws + WS_SU); const float* SV = (const float*)(p.ws + WS_SV); const float* XS = (const float*)(p.ws + WS_XS);
    unsigned char* WQ = p.ws + WS_WVP; float* WSC = (float*)(p.ws + WS_CORR);
    for (int tok = gw; tok < T; tok += nw) {
        const float xs = XS[tok]; float wv[2];
#pragma unroll
        for (int hf = 0; hf < 2; ++hf) { const int pos = lane + 64 * hf; int sum = 0;
#pragma unroll
            for (int j = 0; j < 8; ++j) sum += PP[((size_t)tok * 8 + j) * 128 + pos];
            const int idx = IDXP[(size_t)tok * 128 + pos];
            wv[hf] = GATEP[(size_t)tok * 128 + pos] * gelu_erf((float)sum * SU[idx] * xs) * SV[idx]; }
        const float am = fmaxf(wave_max(fmaxf(fabsf(wv[0]), fabsf(wv[1]))), 1e-30f), inv = 127.f / am;
        WQ[(size_t)tok * 128 + lane] = (unsigned char)((int)rintf(wv[0] * inv) & 0xff); WQ[(size_t)tok * 128 + 64 + lane] = (unsigned char)((int)rintf(wv[1] * inv) & 0xff);
        if (lane == 0) WSC[tok] = am * (1.f / 127.f);
    }
}
__device__ __forceinline__ void tr4x4(unsigned a, unsigned b, unsigned c, unsigned d, unsigned (&t)[4]) {
    const unsigned ab01 = __builtin_amdgcn_perm(b, a, 0x05010400u), ab23 = __builtin_amdgcn_perm(b, a, 0x07030602u), cd01 = __builtin_amdgcn_perm(d, c, 0x05010400u), cd23 = __builtin_amdgcn_perm(d, c, 0x07030602u);
    t[0] = __builtin_amdgcn_perm(cd01, ab01, 0x05040100u); t[1] = __builtin_amdgcn_perm(cd01, ab01, 0x07060302u); t[2] = __builtin_amdgcn_perm(cd23, ab23, 0x05040100u); t[3] = __builtin_amdgcn_perm(cd23, ab23, 0x07060302u);
}
__device__ __forceinline__ void peer_v_phase(const Ptrs& p, bool do_store = true) {
    const int tid = opaque_tid(), lane = tid & 63, wid = __builtin_amdgcn_readfirstlane(tid >> 6), G = gridDim.x, bx = blockIdx.x;
    const int j = bx & 7, wg = (bx >> 3) * 8 + wid, nwg = (G >> 3) * 8, g = lane >> 3, s = lane & 7;
    const unsigned char* V8 = p.ws + WS_V8 + 128 * j + 16 * s; const unsigned short* IDXP = (const unsigned short*)(p.ws + WS_IDXP); const unsigned char* WQ = p.ws + WS_WVP;
    const float* WSC = (const float*)(p.ws + WS_CORR);
    const bool g0 = lane & 8, g1 = lane & 16, g2 = lane & 32;
    const int fsel = 8 * (g0 ? 1 : 0) + 4 * (g1 ? 1 : 0) + 2 * (g2 ? 1 : 0);
    int tok = wg; if (tok >= T) return;
    u32x4 ia = *(const u32x4*)(IDXP + (size_t)tok * 128 + g * 16), ib = *(const u32x4*)(IDXP + (size_t)tok * 128 + g * 16 + 8);
    u32x4 wq = *(const u32x4*)(WQ + (size_t)tok * 128 + g * 16);
    for (; tok < T; tok += nwg) {
        u32x4 r[16];
#pragma unroll
        for (int i = 0; i < 16; ++i) r[i] = *(const u32x4*)(V8 + (size_t)PEER_IDX16(ia, ib, i) * D);
        const u32x4 wc = wq; const int tn = tok + nwg;
        if (tn < T) { ia = *(const u32x4*)(IDXP + (size_t)tn * 128 + g * 16); ib = *(const u32x4*)(IDXP + (size_t)tn * 128 + g * 16 + 8); wq = *(const u32x4*)(WQ + (size_t)tn * 128 + g * 16); }
        float* op = p.out + (size_t)tok * D + 128 * j + 16 * s + fsel;
        const unsigned hw = *(const unsigned*)((const bf16_t*)(p.ws + WS_H1B) + (size_t)tok * D + 128 * j + 16 * s + fsel); const f32x2_t hv = {bf2f(hw & 0xffff), bf2f(hw >> 16)}; const float wsc = WSC[tok];
        int acc[16];
#pragma unroll
        for (int e = 0; e < 16; ++e) acc[e] = 0;
#pragma unroll
        for (int m = 0; m < 4; ++m)
#pragma unroll
            for (int q = 0; q < 4; ++q) { unsigned t4[4]; tr4x4(r[4 * m][q], r[4 * m + 1][q], r[4 * m + 2][q], r[4 * m + 3][q], t4);
#pragma unroll
                for (int f = 0; f < 4; ++f) acc[4 * q + f] = __builtin_amdgcn_sdot4((int)t4[f], (int)wc[m], acc[4 * q + f], false); }
        int w8[8], x4[4], y2[2];
#pragma unroll
        for (int m = 0; m < 8; ++m) { const int keep = g0 ? acc[8 + m] : acc[m], send = g0 ? acc[m] : acc[8 + m]; w8[m] = keep + __shfl_xor(send, 8); }
#pragma unroll
        for (int m = 0; m < 4; ++m) { const int keep = g1 ? w8[4 + m] : w8[m], send = g1 ? w8[m] : w8[4 + m]; x4[m] = keep + __shfl_xor(send, 16); }
#pragma unroll
        for (int m = 0; m < 2; ++m) { const int keep = g2 ? x4[2 + m] : x4[m], send = g2 ? x4[m] : x4[2 + m]; y2[m] = keep + __shfl_xor(send, 32); }
        if (do_store || y2[0] == 0x7fffffff) *(f32x2_t*)op = (f32x2_t){hv.x + (float)y2[0] * wsc, hv.y + (float)y2[1] * wsc};
    }
}

__global__ void __launch_bounds__(512, 2) k_mega(Ptrs p) {
    extern __shared__ __attribute__((aligned(16))) unsigned char lds_raw[];
    LAS unsigned char* lds = (LAS unsigned char*)lds_raw;
    if (threadIdx.x < 16) ((volatile LAS unsigned*)(lds + MISC_OFF))[threadIdx.x] = 0u;
    __syncthreads();
    const XcdBarrier xbar = xcd_barrier_post((unsigned*)(p.ws + WS_CTL) + CW_BAR, (volatile LAS unsigned*)(lds + MISC_OFF + 16));
    unsigned char* ws = p.ws;
    const int G = gridDim.x, bx = blockIdx.x, nw = G * 8;
    bf16_t *WIN = (bf16_t*)(ws + WS_WIN), *WUQ = (bf16_t*)(ws + WS_WUQ), *WUKV = (bf16_t*)(ws + WS_WUKV), *WMLA = (bf16_t*)(ws + WS_WMLA), *WRET = (bf16_t*)(ws + WS_WRET),
           *WMIX = (bf16_t*)(ws + WS_WMIX), *WPQ = (bf16_t*)(ws + WS_WPQ);
    bf16_t *XB = (bf16_t*)(ws + WS_XB), *LAT = (bf16_t*)(ws + WS_LAT), *RQ = (bf16_t*)(ws + WS_RQ), *RK = (bf16_t*)(ws + WS_RK), *RV = (bf16_t*)(ws + WS_RV), *RG = (bf16_t*)(ws + WS_RG);
    unsigned char *SA = (unsigned char*)p.out, *SR = SA + (size_t)T * 1024;
    bf16_t *Q = (bf16_t*)(ws + WS_Q), *K = (bf16_t*)(ws + WS_K), *VRAW = (bf16_t*)(ws + WS_VRAW), *AO = (bf16_t*)(ws + WS_AO), *RET = (bf16_t*)(ws + WS_RET), *MG = (bf16_t*)(ws + WS_MG),
           *H1B = (bf16_t*)(ws + WS_H1B), *PQ = (bf16_t*)(ws + WS_PQ);
    pg8::StaticOrder S;
#ifndef PROBE_DUP
#define PROBE_DUP 0
#endif
    prep_phase(p, lds);
    if (PROBE_DUP == 4) { __syncthreads(); prep_phase(p, lds); }
    xcd_barrier(xbar);
    { pg8::Gemm g{XB, WIN, 1024, 1024, MP, NIN, 1024, 0}; S.init(MP, NIN, G, bx); pg8::gemm_phase(lds, g, S, EpiIn{LAT, RQ, RK, RV, RG, SA, SR, (const float2*)(ws + WS_ROPE32), (const float*)(ws + WS_DEC)}); }
    if (PROBE_DUP == 8) { pg8::Gemm g{XB, WIN, 1024, 1024, MP, NIN, 1024, 0}; S.init(MP, NIN, G, bx); pg8::gemm_phase(lds, g, S, EpiNull{(float*)(ws + WS_RINV2)}); }
    if (PROBE_DUP == 3) { pg8::Gemm g{XB, WIN, 1024, 1024, MP, NIN, 1024, 0}; S.init(MP, NIN, G, bx); pg8::gemm_phase(lds, g, S, EpiIn{LAT, RQ, RK, RV, RG, SA, SR, (const float2*)(ws + WS_ROPE32), (const float*)(ws + WS_DEC)}); }
    xcd_barrier(xbar);
    { pg8::Gemm g{LAT, WUQ, 768, 384, T, 768, 384, 0}; S.init(T, 768, G, bx); pg8::gemm_phase(lds, g, S, EpiQraw{Q}); }
    { pg8::Gemm g{LAT + 384, WUKV, 768, 256, MP, 1024, 256, 0}; S.init(MP, 1024, G, bx); pg8::gemm_phase(lds, g, S, EpiKVraw{K, VRAW}); }
    if (PROBE_DUP == 20) { { pg8::Gemm g{LAT, WUQ, 768, 384, T, 768, 384, 0}; S.init(T, 768, G, bx); pg8::gemm_phase(lds, g, S, EpiQraw{Q}); }
      { pg8::Gemm g{LAT + 384, WUKV, 768, 256, MP, 1024, 256, 0}; S.init(MP, 1024, G, bx); pg8::gemm_phase(lds, g, S, EpiKVraw{K, VRAW}); } }
    xcd_barrier(xbar);
    finalize_phase(p, lds);
    xcd_barrier(xbar);
    mixer_phase(p, lds);
    xcd_barrier(xbar);
    if (PROBE_DUP == 2 || PROBE_DUP == 6 || PROBE_DUP == 7) { if (bx == 0 && threadIdx.x == 0) ((unsigned*)(ws + WS_CTL))[CW_Q3] = 0u; xcd_barrier(xbar); mixer_phase(p, lds, PROBE_DUP == 6 ? 64 : 0, PROBE_DUP == 7 ? 64 : 64 + 1024); xcd_barrier(xbar); }
#ifdef PROBE_RMODE
    { if (bx == 0 && threadIdx.x == 0) ((unsigned*)(ws + WS_CTL))[CW_Q3] = 0u; xcd_barrier(xbar); mixer_phase<PROBE_RMODE>(p, lds, 0, 64); xcd_barrier(xbar); }
#endif
    { const int t_ = opaque_tid(); prep_uv_part(p, bx * 8 + (t_ >> 6), nw, t_ & 63); }
    { pg8::Gemm g{AO, WMLA, 512, 512, T, 1024, 512, 0}; S.init(T, 1024, G, bx); pg8::gemm_phase(lds, g, S, EpiMerge1{MG, SA}); }
    if (PROBE_DUP == 21) { pg8::Gemm g{AO, WMLA, 512, 512, T, 1024, 512, 0}; S.init(T, 1024, G, bx); pg8::gemm_phase(lds, g, S, EpiMerge1{MG, SA}); }
    if (PROBE_DUP == 22) { const int t_ = opaque_tid(); prep_uv_part(p, bx * 8 + (t_ >> 6), nw, t_ & 63); }
    { pg8::Gemm g{RET, WRET, 1024, 1024, T, 1024, 1024, 0}; S.init(T, 1024, G, bx); pg8::gemm_phase(lds, g, S, EpiMerge2{MG, SR}); }
    xcd_barrier(xbar);
    { pg8::Gemm g{MG, WMIX, 1024, 1024, T, 1024, 1024, 0}; S.init(T, 1024, G, bx); pg8::gemm_phase(lds, g, S, EpiMix{p.in[0], nullptr, H1B, (float*)(ws + WS_RINV2)}); }
    xcd_barrier(xbar);
    { pg8::Gemm g{H1B, WPQ, 1024, 1024, T, 1024, 1024, 0}; S.init(T, 1024, G, bx); pg8::gemm_phase(lds, g, S, EpiPQ{PQ, (const float*)(ws + WS_RINV2)}); }
    if (PROBE_DUP == 23) { pg8::Gemm g{H1B, WPQ, 1024, 1024, T, 1024, 1024, 0}; S.init(T, 1024, G, bx); pg8::gemm_phase(lds, g, S, EpiPQ{PQ, (const float*)(ws + WS_RINV2)}); }
    xcd_barrier(xbar);
#ifndef PEER_SLICED
#define PEER_SLICED 1
#endif
    if (PEER_SLICED) {
        peer_pre_phase(p, lds);
        if (PROBE_DUP == 10) { __syncthreads(); peer_pre_phase(p, lds); }
        xcd_barrier(xbar);
        peer_u_phase(p);
        if (PROBE_DUP == 11) peer_u_phase(p);
        xcd_barrier(xbar);
        { const int t_ = opaque_tid(); peer_reduce_phase(p, bx * 8 + (t_ >> 6), nw, t_ & 63); }
        if (PROBE_DUP == 12) { const int t_ = opaque_tid(); peer_reduce_phase(p, bx * 8 + (t_ >> 6), nw, t_ & 63); }
        xcd_barrier(xbar);
        if (PROBE_DUP == 13) peer_v_phase(p, false);
        peer_v_phase(p);
    } else {
        if (PROBE_DUP == 1) { peer_phase(p, lds, false); __syncthreads(); }
        peer_phase(p, lds);
    }
}

#ifndef USE_REF_GEMM
#define USE_REF_GEMM 0
#endif
template <class Epi> static void launch_gemm(hipStream_t st, const bf16_t* A, int lda, const bf16_t* Bt, int ldb, int M, int N, int K, Epi E) {
    if (USE_REF_GEMM) { hipLaunchKernelGGL(gemm_ref<Epi>, dim3(N / 128, M / 64), dim3(256), 0, st, A, lda, Bt, ldb, K, E); return; }
    static bool attr_done = false;
    if (!attr_done) { (void)hipFuncSetAttribute((const void*)k_gemm<Epi>, hipFuncAttributeMaxDynamicSharedMemorySize, LDS_BYTES); attr_done = true; }
    pg8::Gemm g{A, Bt, lda, ldb, M, N, K, 0};
    hipLaunchKernelGGL(k_gemm<Epi>, dim3(256), dim3(512), LDS_BYTES, st, g, E);
}
#ifndef MEGA
#define MEGA 1
#endif
extern "C" void kernel_launch(void* const* d_in, const int* in_sizes, int n_in, void* d_out, int out_size, void* d_ws, size_t ws_size, hipStream_t stream) {
    Ptrs p{}; for (int i = 0; i < 20; ++i) p.in[i] = (const float*)d_in[i]; p.out = (float*)d_out; p.ws = (unsigned char*)d_ws;
#if MEGA
    static int grid = 0;
    if (grid == 0) {
        int dev = 0, cus = 0, per_cu = 0;
        (void)hipGetDevice(&dev); (void)hipDeviceGetAttribute(&cus, hipDeviceAttributeMultiprocessorCount, dev);
        (void)hipFuncSetAttribute((const void*)k_mega, hipFuncAttributeMaxDynamicSharedMemorySize, LDS_BYTES);
        (void)hipOccupancyMaxActiveBlocksPerMultiprocessor(&per_cu, (const void*)k_mega, 512, LDS_BYTES);
        if (per_cu < 1) per_cu = 1;
        grid = cus * (per_cu > 1 ? 1 : per_cu);
        if (grid % 8) grid -= grid % 8;
    }
    (void)hipMemsetAsync(d_ws, 0, 65536, stream);
    void* args[] = {&p};
    (void)hipLaunchCooperativeKernel((const void*)k_mega, dim3(grid), dim3(512), args, LDS_BYTES, stream);
    return;
#endif
    unsigned char* ws = p.ws;
    bf16_t *WIN = (bf16_t*)(ws + WS_WIN), *WUQ = (bf16_t*)(ws + WS_WUQ), *WUKV = (bf16_t*)(ws + WS_WUKV), *WMLA = (bf16_t*)(ws + WS_WMLA), *WRET = (bf16_t*)(ws + WS_WRET),
           *WMIX = (bf16_t*)(ws + WS_WMIX), *WPQ = (bf16_t*)(ws + WS_WPQ);
    bf16_t *XB = (bf16_t*)(ws + WS_XB), *LAT = (bf16_t*)(ws + WS_LAT), *RQ = (bf16_t*)(ws + WS_RQ), *RK = (bf16_t*)(ws + WS_RK), *RV = (bf16_t*)(ws + WS_RV), *RG = (bf16_t*)(ws + WS_RG);
    unsigned char *SA = (unsigned char*)d_out, *SR = SA + (size_t)T * 1024;
    bf16_t *Q = (bf16_t*)(ws + WS_Q), *K = (bf16_t*)(ws + WS_K), *V = (bf16_t*)(ws + WS_VRAW), *AO = (bf16_t*)(ws + WS_AO), *RET = (bf16_t*)(ws + WS_RET), *MG = (bf16_t*)(ws + WS_MG),
           *H1B = (bf16_t*)(ws + WS_H1B), *PQ = (bf16_t*)(ws + WS_PQ);
    hipLaunchKernelGGL(k_prep_rows, dim3(1024), dim3(256), 0, stream, p);
    hipLaunchKernelGGL(k_prep_rope, dim3((4112 * 32 + 255) / 256), dim3(256), 0, stream, p);
    hipLaunchKernelGGL(k_prep_w<1>, dim3(NIN / 64, 1024 / 64), dim3(256), 0, stream, p.in[3], p.in[2], WIN, 1024, 5792, NIN);
    hipLaunchKernelGGL(k_prep_w<0>, dim3(768 / 64, 384 / 64), dim3(256), 0, stream, p.in[5], p.in[4], WUQ, 384, 768, 768);
    hipLaunchKernelGGL(k_prep_w<0>, dim3(1024 / 64, 256 / 64), dim3(256), 0, stream, p.in[7], p.in[6], WUKV, 256, 1024, 1024);
    hipLaunchKernelGGL(k_prep_w<0>, dim3(1024 / 64, 512 / 64), dim3(256), 0, stream, p.in[10], (const float*)nullptr, WMLA, 512, 1024, 1024);
    hipLaunchKernelGGL(k_prep_w<0>, dim3(1024 / 64, 1024 / 64), dim3(256), 0, stream, p.in[12], (const float*)nullptr, WRET, 1024, 1024, 1024);
    hipLaunchKernelGGL(k_prep_w<0>, dim3(1024 / 64, 1024 / 64), dim3(256), 0, stream, p.in[13], (const float*)nullptr, WMIX, 1024, 1024, 1024);
    hipLaunchKernelGGL(k_prep_w<0>, dim3(1024 / 64, 1024 / 64), dim3(256), 0, stream, p.in[15], p.in[14], WPQ, 1024, 1024, 1024);
    launch_gemm(stream, XB, 1024, WIN, 1024, MP, NIN, 1024, EpiIn{LAT, RQ, RK, RV, RG, SA, SR, (const float2*)(ws + WS_ROPE32), (const float*)(ws + WS_DEC)});
    launch_gemm(stream, LAT, 768, WUQ, 384, T, 768, 384, EpiQraw{Q});
    launch_gemm(stream, LAT + 384, 768, WUKV, 256, MP, 1024, 256, EpiKVraw{K, V});
    { static bool ad = false; if (!ad) { (void)hipFuncSetAttribute((const void*)k_finalize, hipFuncAttributeMaxDynamicSharedMemorySize, FIN_LDS); ad = true; }
      hipLaunchKernelGGL(k_finalize, dim3(256), dim3(512), FIN_LDS, stream, p); }
#ifndef USE_REF_ATTN
#define USE_REF_ATTN 0
#endif
    if (USE_REF_ATTN) hipLaunchKernelGGL(k_attn_naive, dim3(SEQ / 64, 8, BATCH), dim3(64), 0, stream, p);
    else hipLaunchKernelGGL(k_attn, dim3(256), dim3(512), ATT_LDS, stream, p);
#ifndef USE_REF_RET
#define USE_REF_RET 0
#endif
    if (USE_REF_RET) hipLaunchKernelGGL(k_ret_naive, dim3(64), dim3(128), 0, stream, p);
    else { static bool ad = false; if (!ad) { (void)hipFuncSetAttribute((const void*)k_ret, hipFuncAttributeMaxDynamicSharedMemorySize, RT_LDS); ad = true; }
        hipLaunchKernelGGL(k_ret, dim3(64), dim3(512), RT_LDS, stream, p); }
    launch_gemm(stream, AO, 512, WMLA, 512, T, 1024, 512, EpiMerge1{MG, SA});
    launch_gemm(stream, RET, 1024, WRET, 1024, T, 1024, 1024, EpiMerge2{MG, SR});
    hipLaunchKernelGGL(k_zero_ss2, dim3(128), dim3(256), 0, stream, p);
    launch_gemm(stream, MG, 1024, WMIX, 1024, T, 1024, 1024, EpiMix{p.in[0], p.out, H1B, (float*)(ws + WS_RINV2)});
    launch_gemm(stream, H1B, 1024, WPQ, 1024, T, 1024, 1024, EpiPQ{PQ, (const float*)(ws + WS_RINV2)});
#ifndef USE_REF_SELECT
#define USE_REF_SELECT 0
#endif
    if (USE_REF_SELECT) hipLaunchKernelGGL(k_peer_select_naive, dim3(T * 8 / 32), dim3(32), 0, stream, p);
    else hipLaunchKernelGGL(k_peer_select, dim3(256), dim3(512), 2 * 128 * KEY_PITCH, stream, p, 0);
#ifdef DBG_SEL
    hipMemsetAsync(p.ws + WS_CTL, 0, 4096, stream);
    hipLaunchKernelGGL(k_peer_select256, dim3(512), dim3(256), 2 * 128 * KEY_PITCH, stream, p, 1);
    hipLaunchKernelGGL(k_dbg_cmp_sel, dim3(T * 8 / 256), dim3(256), 0, stream, p, DBG_SEL);
#ifdef DBG_SCORES
    hipLaunchKernelGGL(k_dbg_cmp_scores, dim3(1024 * 8 * 2 * 128 / 256), dim3(256), 0, stream, p);
#endif
#endif
#ifndef USE_REF_GATHER
#define USE_REF_GATHER 0
#endif
    if (USE_REF_GATHER) hipLaunchKernelGGL(k_peer_gather_naive, dim3(T), dim3(256), 0, stream, p);
    else { hipLaunchKernelGGL(k_prep_uv, dim3(512), dim3(512), 0, stream, p); hipLaunchKernelGGL(k_peer_gather, dim3(256), dim3(512), 0, stream, p); }
#ifdef DBG_SEL
    hipLaunchKernelGGL(k_dbg_scale, dim3(2048), dim3(256), 0, stream, p, DBG_SEL == 3 ? (float)(1024 * 8 * 2 * 128) : DBG_SEL == 2 ? (float)T * 128 : (float)T * 8, DBG_SEL);
#endif
}
```
